# Optimizing an MI355X kernel written in HIP

```python
import math
import jax
import jax.numpy as jnp
from jax import lax
import numpy as np

D_MODEL = 1024
BATCH = 8
SEQ = 4096
DEPTH = 1

N_MEM = 256
D_MIX = D_MODEL
D_HYENA = D_MIX // 2
HYENA_GROUPS = 8
HYENA_ORDER = 2
D_MLSTM = D_MIX - D_HYENA
MLSTM_HEADS = 4
MLSTM_HEAD_DIM = D_MLSTM // MLSTM_HEADS
MLSTM_CHUNK = 64
FILTER_BANDS = 16
FILTER_EMB = 1 + 2 * FILTER_BANDS
FILTER_HIDDEN = 64
FILTER_DIRS = 2
FILTER_CH = HYENA_ORDER * FILTER_DIRS * D_HYENA
FILTER_OUT_SCALE = 0.05
DECAY_TARGET = 1e-2
SHORT_DECAY_PCT = 0.3
LONG_DECAY_PCT = 1.5
XATTN_HEADS = 4
XATTN_HEAD_DIM = D_MODEL // XATTN_HEADS
D_FF = 4 * D_MODEL
EPS = 1e-6
HY_COLS = (HYENA_ORDER + 1) * D_HYENA
ML_QK_COLS = 2 * D_MLSTM
ML_GATE_COLS = 4 * MLSTM_HEADS
D_IN_PROJ = HY_COLS + ML_QK_COLS + 2 * D_MLSTM + ML_GATE_COLS

kernel_name = 'hybrid_hyena_mlstm_encoder_layer'


def _rms_norm(x, g):
    xf = x.astype(jnp.float32)
    y = xf * lax.rsqrt(jnp.mean(xf * xf, axis=-1, keepdims=True) + EPS)
    return (y * g.astype(jnp.float32)).astype(x.dtype)


def _group_rms_norm(x, g, n_groups):
    lead = x.shape[:-1]
    c = x.shape[-1]
    xg = x.astype(jnp.float32).reshape(*lead, n_groups, c // n_groups)
    xg = xg * lax.rsqrt(jnp.mean(xg * xg, axis=-1, keepdims=True) + EPS)
    return (xg.reshape(*lead, c) * g.astype(jnp.float32)).astype(x.dtype)


def _short_conv_centred(u, w, b):
    L = u.shape[1]
    up = jnp.pad(u, ((0, 0), (1, 1), (0, 0)))
    return up[:, :L] * w[0] + up[:, 1:L + 1] * w[1] + up[:, 2:] * w[2] + b


def _hyena_filter_spectrum(L, w1, b1, fr1, w2, b2, fr2, w3):
    f32 = jnp.float32
    t = jnp.linspace(0.0, 1.0, L, dtype=f32)[:, None]
    ang = (2.0 * math.pi / L) * jnp.arange(L, dtype=f32)[:, None]
    bands = jnp.linspace(1e-4, FILTER_BANDS - 1, FILTER_BANDS, dtype=f32)[None, :]
    z = jnp.concatenate([t, jnp.cos(bands * ang), -jnp.sin(bands * ang)], axis=-1)
    hid = jnp.sin(fr1.astype(f32) * (z @ w1.astype(f32) + b1.astype(f32)))
    hid = jnp.sin(fr2.astype(f32) * (hid @ w2.astype(f32) + b2.astype(f32)))
    filt = (hid @ w3.astype(f32)).reshape(L, HYENA_ORDER, FILTER_DIRS, D_HYENA)
    max_decay = math.log(DECAY_TARGET) / SHORT_DECAY_PCT
    min_decay = math.log(DECAY_TARGET) / LONG_DECAY_PCT
    deltas = jnp.linspace(min_decay, max_decay, D_HYENA, dtype=f32)
    filt = filt * jnp.exp(-t * jnp.abs(deltas))[:, None, None, :]
    fwd = filt[:, :, 0]
    bwd = jnp.flip(filt[1:, :, 1], axis=0)
    two_sided = jnp.concatenate([fwd, jnp.zeros((1, HYENA_ORDER, D_HYENA), f32), bwd], axis=0)
    return jnp.fft.rfft(two_sided, axis=0)


def _hyena(hy, spec, skip):
    L = hy.shape[1]
    u = hy.astype(jnp.float32)
    z, g1, g2 = u[..., :D_HYENA], u[..., D_HYENA:2 * D_HYENA], u[..., 2 * D_HYENA:]
    for o, gate in enumerate((g1, g2)):
        conv = jnp.fft.irfft(jnp.fft.rfft(z, n=2 * L, axis=1) * spec[:, o], n=2 * L, axis=1)[:, :L]
        z = gate * (conv + z * skip[o].astype(jnp.float32))
    return z


def _mlstm_chunkwise(q, k, v, i_pre, log_f):
    B, H, L, Dh = q.shape
    nc = L // MLSTM_CHUNK

    def chunks(a):
        a = a.reshape(B, H, nc, MLSTM_CHUNK, *a.shape[3:])
        return jnp.moveaxis(a, 2, 0)

    lower = jnp.tril(jnp.ones((MLSTM_CHUNK, MLSTM_CHUNK), dtype=bool))

    def step(carry, inp):
        C, n, m = carry
        qc, kc, vc, ic, fc = inp
        F = jnp.cumsum(fc, axis=-1)
        logw = F[..., :, None] - F[..., None, :] + ic[..., None, :]
        logw = jnp.where(lower, logw, -jnp.inf)
        log_inter = F + m[..., None]
        m_t = jnp.maximum(log_inter, jnp.max(logw, axis=-1))
        w = jnp.exp(logw - m_t[..., None])
        inter = jnp.exp(log_inter - m_t)
        s = jnp.einsum('bhtd,bhsd->bhts', qc, kc) * w
        num = jnp.einsum('bhts,bhse->bhte', s, vc) + inter[..., None] * jnp.einsum('bhtd,bhde->bhte', qc, C)
        den = jnp.sum(s, axis=-1) + inter * jnp.einsum('bhtd,bhd->bht', qc, n)
        h = num / jnp.maximum(jnp.abs(den), jnp.exp(-m_t))[..., None]
        F_end = F[..., -1]
        log_end = F_end[..., None] - F + ic
        m_new = jnp.maximum(F_end + m, jnp.max(log_end, axis=-1))
        we = jnp.exp(log_end - m_new[..., None])
        carry_decay = jnp.exp(F_end + m - m_new)
        C_new = carry_decay[..., None, None] * C + jnp.einsum('bhs,bhsd,bhse->bhde', we, kc, vc)
        n_new = carry_decay[..., None] * n + jnp.einsum('bhs,bhsd->bhd', we, kc)
        return (C_new, n_new, m_new), h

    init = (jnp.zeros((B, H, Dh, Dh), jnp.float32),
            jnp.zeros((B, H, Dh), jnp.float32),
            jnp.zeros((B, H), jnp.float32))
    _, hs = lax.scan(step, init, tuple(chunks(a) for a in (q, k, v, i_pre, log_f)))
    return jnp.moveaxis(hs, 0, 2).reshape(B, H, L, Dh)


def _mlstm_bidirectional(q, k, v, o_pre, gates, gate_b):
    B, L, _ = q.shape
    f32 = jnp.float32

    def heads(a):
        return a.astype(f32).reshape(B, L, MLSTM_HEADS, MLSTM_HEAD_DIM).transpose(0, 2, 1, 3)

    qh = heads(q)
    kh = heads(k) * (MLSTM_HEAD_DIM ** -0.5)
    vh = heads(v)
    g = (gates.astype(f32) + gate_b.astype(f32)).reshape(B, L, 4, MLSTM_HEADS).transpose(2, 0, 3, 1)
    i_f, f_f, i_b, f_b = g[0], g[1], g[2], g[3]
    h_f = _mlstm_chunkwise(qh, kh, vh, i_f, jax.nn.log_sigmoid(f_f))

    def flip(a):
        return jnp.flip(a, axis=2)

    h_b = flip(_mlstm_chunkwise(flip(qh), flip(kh), flip(vh), flip(i_b), flip(jax.nn.log_sigmoid(f_b))))
    h_sum = (h_f + h_b).transpose(0, 2, 1, 3).reshape(B, L, D_MLSTM)
    return jax.nn.sigmoid(o_pre.astype(f32)) * h_sum


def _cross_attention(xn, memn, wq, wk, wv, wo):
    B, L, _ = xn.shape
    M = memn.shape[1]
    q = (xn @ wq).reshape(B, L, XATTN_HEADS, XATTN_HEAD_DIM)
    k = (memn @ wk).reshape(B, M, XATTN_HEADS, XATTN_HEAD_DIM)
    v = (memn @ wv).reshape(B, M, XATTN_HEADS, XATTN_HEAD_DIM)
    s = jnp.einsum('blhd,bmhd->bhlm', q, k).astype(jnp.float32) * (XATTN_HEAD_DIM ** -0.5)
    p = jax.nn.softmax(s, axis=-1).astype(v.dtype)
    o = jnp.einsum('bhlm,bmhd->blhd', p, v).reshape(B, L, D_MODEL)
    return o @ wo


def setup_inputs(seed: int = 0) -> dict:
    key = jax.random.key(seed)
    keys = iter(jax.random.split(key, 32))

    def nrm(shape, scale):
        return jax.random.normal(next(keys), shape, jnp.float32) * scale

    def gain(shape):
        return 1.0 + nrm(shape, 0.02)

    D = D_MODEL
    x = nrm((BATCH, SEQ, D), 1.0)
    mem = nrm((BATCH, N_MEM, D), 1.0)
    f_bias = jnp.linspace(3.0, 6.0, MLSTM_HEADS, dtype=jnp.float32)
    zero_b = jnp.zeros_like(f_bias)
    gate_noise = nrm((DEPTH, 4, MLSTM_HEADS), 0.1)
    ml_gate_b = (gate_noise + jnp.stack([zero_b, f_bias, zero_b, f_bias])).reshape(DEPTH, ML_GATE_COLS)
    return {
        'x': x,
        'mem': mem,
        'norm_mix_g': gain((DEPTH, D)),
        'w_in': nrm((DEPTH, D, D_IN_PROJ), D ** -0.5),
        'hy_conv_w': nrm((DEPTH, 3, HY_COLS), 3 ** -0.5),
        'hy_conv_b': nrm((DEPTH, HY_COLS), 0.02),
        'hy_filt_w1': nrm((DEPTH, FILTER_EMB, FILTER_HIDDEN), FILTER_EMB ** -0.5),
        'hy_filt_b1': nrm((DEPTH, FILTER_HIDDEN), 0.1),
        'hy_filt_freq1': gain((DEPTH, FILTER_HIDDEN)),
        'hy_filt_w2': nrm((DEPTH, FILTER_HIDDEN, FILTER_HIDDEN), FILTER_HIDDEN ** -0.5),
        'hy_filt_b2': nrm((DEPTH, FILTER_HIDDEN), 0.1),
        'hy_filt_freq2': gain((DEPTH, FILTER_HIDDEN)),
        'hy_filt_w3': nrm((DEPTH, FILTER_HIDDEN, FILTER_CH), FILTER_OUT_SCALE * FILTER_HIDDEN ** -0.5),
        'hy_skip': nrm((DEPTH, HYENA_ORDER, D_HYENA), 1.0),
        'hy_norm_g': gain((DEPTH, D_HYENA)),
        'ml_conv_w': nrm((DEPTH, 3, ML_QK_COLS), 3 ** -0.5),
        'ml_conv_b': nrm((DEPTH, ML_QK_COLS), 0.02),
        'ml_gate_b': ml_gate_b,
        'ml_norm_g': gain((DEPTH, D_MLSTM)),
        'w_out': nrm((DEPTH, D_MIX, D), D_MIX ** -0.5),
        'norm_x_g': gain((DEPTH, D)),
        'norm_mem_g': gain((DEPTH, D)),
        'xa_wq': nrm((DEPTH, D, D), D ** -0.5),
        'xa_wk': nrm((DEPTH, D, D), D ** -0.5),
        'xa_wv': nrm((DEPTH, D, D), D ** -0.5),
        'xa_wo': nrm((DEPTH, D, D), D ** -0.5),
        'norm_ff_g': gain((DEPTH, D)),
        'ff_w1': nrm((DEPTH, D, D_FF), D ** -0.5),
        'ff_w2': nrm((DEPTH, D_FF, D), D_FF ** -0.5),
        'final_norm_g': gain((D,)),
    }


def reference(x, mem, norm_mix_g, w_in, hy_conv_w, hy_conv_b, hy_filt_w1, hy_filt_b1, hy_filt_freq1,
              hy_filt_w2, hy_filt_b2, hy_filt_freq2, hy_filt_w3, hy_skip, hy_norm_g, ml_conv_w, ml_conv_b,
              ml_gate_b, ml_norm_g, w_out, norm_x_g, norm_mem_g, xa_wq, xa_wk, xa_wv, xa_wo, norm_ff_g,
              ff_w1, ff_w2, final_norm_g):
    L = x.shape[1]
    off = HY_COLS + ML_QK_COLS
    h = x
    for l in range(DEPTH):
        u = _rms_norm(h, norm_mix_g[l])
        proj = u @ w_in[l]
        hy = _short_conv_centred(proj[..., :HY_COLS], hy_conv_w[l], hy_conv_b[l])
        spec = _hyena_filter_spectrum(L, hy_filt_w1[l], hy_filt_b1[l], hy_filt_freq1[l],
                                      hy_filt_w2[l], hy_filt_b2[l], hy_filt_freq2[l], hy_filt_w3[l])
        y_hy = _group_rms_norm(_hyena(hy, spec, hy_skip[l]), hy_norm_g[l], HYENA_GROUPS)
        qk = jax.nn.silu(_short_conv_centred(proj[..., HY_COLS:off], ml_conv_w[l], ml_conv_b[l]))
        y_ml = _mlstm_bidirectional(qk[..., :D_MLSTM], qk[..., D_MLSTM:],
                                    proj[..., off:off + D_MLSTM],
                                    proj[..., off + D_MLSTM:off + 2 * D_MLSTM],
                                    proj[..., off + 2 * D_MLSTM:], ml_gate_b[l])
        y_ml = _group_rms_norm(y_ml, ml_norm_g[l], MLSTM_HEADS)
        mixed = jnp.concatenate([y_hy.astype(h.dtype), y_ml.astype(h.dtype)], axis=-1)
        h = h + mixed @ w_out[l]
        h = h + _cross_attention(_rms_norm(h, norm_x_g[l]), _rms_norm(mem, norm_mem_g[l]),
                                 xa_wq[l], xa_wk[l], xa_wv[l], xa_wo[l])
        h = h + jnp.square(jax.nn.relu(_rms_norm(h, norm_ff_g[l]) @ ff_w1[l])) @ ff_w2[l]
    return _rms_norm(h, final_norm_g)
```

```cpp
#include <hip/hip_runtime.h>
#include <hip/hip_cooperative_groups.h>
#include <cstdio>
#include <cstdint>
namespace cg = cooperative_groups;
namespace pg8 {
#define PG8_LAS __attribute__((address_space(3)))
typedef unsigned short bf16_t;
typedef short bf16x8 __attribute__((ext_vector_type(8)));
typedef float f32x4 __attribute__((ext_vector_type(4)));
typedef unsigned u32x4 __attribute__((ext_vector_type(4)));
constexpr int BM = 256, BK = 64, HALF = 128, HTB = HALF * BK * 2  , STAGE_BYTES = 8 * HTB, NXCD = 8, WGM = 8;

__host__ __device__ __forceinline__ int lds_byte(int r, int c) { const int st = (r >> 4) * 2 + (c >> 5), rr = r & 15, cc = c & 31, ob = rr * 64 + cc * 2; return st * 1024 + (ob ^ (((ob >> 9) & 1) << 5)); }
__host__ __device__ __forceinline__ void stage_rc(int b, int& R, int& C) { const int st = b / 1024, sb = b % 1024, swz = sb ^ (((sb >> 9) & 1) << 5); R = (st >> 1) * 16 + swz / 64; C = (st & 1) * 32 + (swz % 64) / 2; }
__host__ __device__ __forceinline__ int perm32(int rho) { const int n = rho >> 4, i = rho & 15; return 8 * (i >> 2) + 4 * n + (i & 3); }

struct Unit { int pm, pn; };
struct Gemm { const bf16_t* A; const bf16_t* Bt; int lda, ldb, K; };
template <int MODE> __device__ __forceinline__ size_t a_off(const Gemm& g, const Unit& u) {
    if (MODE == 0) return (size_t)u.pm * BM * g.lda * 2;
    return ((size_t)u.pm * BM * g.lda + (size_t)u.pn * BM) * 2; }
template <int MODE> __device__ __forceinline__ size_t b_off(const Gemm& g, const Unit& u) {
    if (MODE == 0) return (size_t)u.pn * BM * g.ldb * 2;
    if (MODE == 1) return ((size_t)(u.pm >> 4) * BM * g.ldb + (size_t)u.pn * BM) * 2;
    return ((size_t)u.pn * BM * g.ldb + (size_t)(u.pm >> 4) * BM) * 2; }

struct StaticOrder {
    int nM, nN, nwg, G, c;
    __host__ __device__ void init(int M, int N, int G_, int c_) { nM = M / BM; nN = N / BM; nwg = nM * nN; G = G_; c = c_; }
    __host__ __device__ bool next(int i, Unit& u) const {
        const long L = (long)i * G + c; if (L >= nwg) return false;
        int wgid = (int)L; { const int q = nwg / NXCD, r = nwg % NXCD, xcd = wgid % NXCD, off = wgid / NXCD; wgid = (xcd < r ? xcd * (q + 1) : r * (q + 1) + (xcd - r) * q) + off; }
        const int nig = WGM * nN, gid = wgid / nig, fm = gid * WGM, gsz = (nM - fm) < WGM ? (nM - fm) : WGM;
        u.pm = fm + ((wgid % nig) % gsz); u.pn = (wgid % nig) / gsz; return true;
    }
    __device__ __forceinline__ void a_ready(const Unit&) const {}
    __device__ __forceinline__ void done(const Unit&) const {}
};

__device__ __forceinline__ unsigned cvt_pk_bf16(float lo, float hi) { unsigned r; asm volatile("v_cvt_pk_bf16_f32 %0, %1, %2" : "=v"(r) : "v"(lo), "v"(hi)); return r; }
typedef unsigned u32x2 __attribute__((ext_vector_type(2)));
template <int ROWSCALE, int ACT> struct EpiBf16S {
    static constexpr bool PERM = true, AFTER_DRAIN = false;
    bf16_t* O; int ldc; int split_cols; size_t split_stride; const float* ssqp; float mul;
    __device__ __forceinline__ void operator()(const f32x4 (&acc)[2][2][4][2], const Unit& u, int wr, int wc, int fr, int fq) const {
        const int row0 = u.pm * BM + wr * 64 + fr; int colt = u.pn * BM; bf16_t* base = O;
        if (split_cols) { const int t = colt / split_cols; base += (size_t)t * split_stride; colt -= t * split_cols; }
        const int col0 = colt + wc * 32 + 8 * fq;
#pragma unroll
        for (int ai = 0; ai < 2; ++ai)
#pragma unroll
            for (int m = 0; m < 4; ++m) { const int row = row0 + ai * HALF + m * 16; float sc = mul;
                if (ROWSCALE) { const f32x4* p = (const f32x4*)(ssqp + (size_t)row * 16); const f32x4 a = p[0], b = p[1], c = p[2], d = p[3];
                    const float s = ((a[0] + a[1]) + (a[2] + a[3])) + ((b[0] + b[1]) + (b[2] + b[3])) + ((c[0] + c[1]) + (c[2] + c[3])) + ((d[0] + d[1]) + (d[2] + d[3]));
                    sc *= 1.0f / sqrtf(s * (1.0f / 1024.0f) + 1e-6f); }
                bf16_t* rowp = base + (size_t)row * ldc + col0;
#pragma unroll
                for (int bj = 0; bj < 2; ++bj) { f32x4 v0 = acc[ai][bj][m][0] * sc, v1 = acc[ai][bj][m][1] * sc;
                    if (ACT == 1) {
#pragma unroll
                        for (int e = 0; e < 4; ++e) { const float a0 = fmaxf(v0[e], 0.f), a1 = fmaxf(v1[e], 0.f); v0[e] = a0 * a0; v1[e] = a1 * a1; } }
                    u32x4 w; w.x = cvt_pk_bf16(v0[0], v0[1]); w.y = cvt_pk_bf16(v0[2], v0[3]); w.z = cvt_pk_bf16(v1[0], v1[1]); w.w = cvt_pk_bf16(v1[2], v1[3]);
                    *(u32x4*)(rowp + bj * HALF) = w; } }
    }
};
struct EpiResid {
    static constexpr bool PERM = false, AFTER_DRAIN = false;
    const float* base; float* out; bf16_t* xn; float* ssqp; int ldc;
    __device__ __forceinline__ void operator()(const f32x4 (&acc)[2][2][4][2], const Unit& u, int wr, int wc, int fr, int fq) const {
        const int row0 = u.pm * BM + wr * 64 + fr, col0 = u.pn * BM + wc * 32 + 4 * fq;
#pragma unroll
        for (int ai = 0; ai < 2; ++ai)
#pragma unroll
            for (int m = 0; m < 4; ++m) { const int row = row0 + ai * HALF + m * 16; const size_t off = (size_t)row * ldc + col0; float ss = 0.f;
#pragma unroll
                for (int bj = 0; bj < 2; ++bj)
#pragma unroll
                    for (int n = 0; n < 2; ++n) { const size_t o2 = off + bj * HALF + n * 16; const f32x4 b = *(const f32x4*)(base + o2); const f32x4 v = b + acc[ai][bj][m][n];
                        *(f32x4*)(out + o2) = v; ss += (v[0] * v[0] + v[1] * v[1]) + (v[2] * v[2] + v[3] * v[3]);
                        if (xn) { u32x2 w; w.x = cvt_pk_bf16(v[0], v[1]); w.y = cvt_pk_bf16(v[2], v[3]); *(u32x2*)(xn + o2) = w; } }
                ss += __shfl_xor(ss, 16); ss += __shfl_xor(ss, 32);
                if (fq == 0) ssqp[(size_t)row * 16 + u.pn * 4 + wc] = ss; }
    }
};

template <class Epi, class Sched, bool ALIGN_EPI = false, bool SP2 = false, int MODE = 0>
__device__ __forceinline__ void gemm_phase(PG8_LAS unsigned char* lds, const Gemm g, const Sched& S, const Epi& E) {
    const int tid = threadIdx.x, wid = __builtin_amdgcn_readfirstlane(tid >> 6), lane = tid & 63, wr = wid >> 2, wc = wid & 3, fr = lane & 15, fq = lane >> 4;
    const int K = g.K, nt = K / BK;
    unsigned voffA[2], voffB[2];
#pragma unroll
    for (int i = 0; i < 2; ++i) { int R, C; stage_rc(tid * 16 + i * 8192, R, C); const int Rb = Epi::PERM ? ((R & ~31) + perm32(R & 31)) : R;
        voffA[i] = (unsigned)(R * g.lda + C) * 2u; voffB[i] = (unsigned)(Rb * g.ldb + C) * 2u; }
    const size_t kstep = (size_t)(BK * 2);
    const size_t hstepA = (size_t)HALF * g.lda * 2, hstepB = (size_t)HALF * g.ldb * 2;
    const unsigned ldsw = (unsigned)wid * 1024u;
    const int aoff = lds_byte(wr * 64 + fr, fq * 8), boff = lds_byte(wc * 32 + fr, fq * 8);
#define PG8_SA(b, h) (((b) * 2 + (h)) * HTB)
#define PG8_SB(b, h) ((4 + (b) * 2 + (h)) * HTB)
#define PG8_STAGE(bufoff, gbase, voff) do { _Pragma("unroll") for (int _i = 0; _i < 2; ++_i) \
        __builtin_amdgcn_global_load_lds((const unsigned*)((const char*)(gbase) + (voff)[_i]), (PG8_LAS unsigned*)(lds + (bufoff) + ldsw + _i * 8192), 16, 0, 0); } while (0)
#define PG8_LDA(dst, b, h) do { _Pragma("unroll") for (int m = 0; m < 4; ++m) _Pragma("unroll") for (int k = 0; k < 2; ++k) dst[m][k] = *(const PG8_LAS bf16x8*)(lds + PG8_SA(b, h) + aoff + m * 2048 + k * 1024); } while (0)
#define PG8_LDB(dst, b, h) do { _Pragma("unroll") for (int n = 0; n < 2; ++n) _Pragma("unroll") for (int k = 0; k < 2; ++k) dst[n][k] = *(const PG8_LAS bf16x8*)(lds + PG8_SB(b, h) + boff + n * 2048 + k * 1024); } while (0)
#define PG8_MMA(ai, bj, At, Bt) do { __builtin_amdgcn_s_setprio(1); _Pragma("unroll") for (int m = 0; m < 4; ++m) _Pragma("unroll") for (int n = 0; n < 2; ++n) _Pragma("unroll") for (int k = 0; k < 2; ++k) \
        acc[ai][bj][m][n] = __builtin_amdgcn_mfma_f32_16x16x32_bf16(Bt[n][k], At[m][k], acc[ai][bj][m][n], 0, 0, 0); __builtin_amdgcn_s_setprio(0); } while (0)
#define PG8_WAIT_V(n) asm volatile("s_waitcnt vmcnt(" #n ")" ::: "memory")
#define PG8_WAIT_L(n) asm volatile("s_waitcnt lgkmcnt(" #n ")" ::: "memory")
#define PG8_BAR __builtin_amdgcn_s_barrier()
#define PG8_SCHED __builtin_amdgcn_sched_barrier(0)
    Unit cur, nxt; int ui = 0;
    if (!S.next(0, cur)) return;
    f32x4 acc[2][2][4][2];
#pragma unroll
    for (int a = 0; a < 2; ++a)
#pragma unroll
        for (int b = 0; b < 2; ++b)
#pragma unroll
            for (int m = 0; m < 4; ++m)
#pragma unroll
                for (int n = 0; n < 2; ++n) acc[a][b][m][n] = (f32x4){0.f, 0.f, 0.f, 0.f};
    bf16x8 At[4][2], B0[2][2], B1[2][2];
    const char* cA = (const char*)g.A + a_off<MODE>(g, cur); const char* cB = (const char*)g.Bt + b_off<MODE>(g, cur);
    S.a_ready(cur);
    if constexpr (SP2) {
        PG8_STAGE(PG8_SB(0, 0), cB, voffB); PG8_STAGE(PG8_SB(0, 1), cB + hstepB, voffB); PG8_STAGE(PG8_SA(0, 0), cA, voffA); PG8_STAGE(PG8_SA(0, 1), cA + hstepA, voffA);
        if (wr == 1) PG8_BAR;
        PG8_WAIT_V(2); PG8_BAR;
        PG8_STAGE(PG8_SB(1, 0), cB + kstep, voffB); PG8_STAGE(PG8_SA(1, 0), cA + kstep, voffA); PG8_STAGE(PG8_SB(1, 1), cB + hstepB + kstep, voffB);
        PG8_WAIT_V(6); PG8_BAR;
    } else {
        PG8_STAGE(PG8_SB(0, 0), cB, voffB); PG8_STAGE(PG8_SA(0, 0), cA, voffA); PG8_STAGE(PG8_SB(0, 1), cB + hstepB, voffB); PG8_STAGE(PG8_SA(0, 1), cA + hstepA, voffA);
        if (wr == 1) PG8_BAR;
        PG8_WAIT_V(4); PG8_BAR;
        PG8_STAGE(PG8_SB(1, 0), cB + kstep, voffB); PG8_STAGE(PG8_SA(1, 0), cA + kstep, voffA); PG8_STAGE(PG8_SB(1, 1), cB + hstepB + kstep, voffB);
        PG8_WAIT_V(6); PG8_BAR;
    }
    for (;;) {
        const bool has_next = S.next(ui + 1, nxt);
        const char* nA = has_next ? (const char*)g.A + a_off<MODE>(g, nxt) : cA; const char* nB = has_next ? (const char*)g.Bt + b_off<MODE>(g, nxt) : cB;
        for (int t = 0; t < nt; t += 2) {
            const bool last = (t == nt - 2);
            const char* a1 = cA + (size_t)(t + 1) * kstep;
            const char* a2 = last ? nA : cA + (size_t)(t + 2) * kstep; const char* b2 = last ? nB : cB + (size_t)(t + 2) * kstep;
            const char* a3 = a2 + kstep; const char* b3 = b2 + kstep;
            if (last && has_next) S.a_ready(nxt);
            if constexpr (SP2) {
            PG8_LDB(B0, 0, 0); PG8_LDB(B1, 0, 1); PG8_SCHED; PG8_LDA(At, 0, 0); PG8_STAGE(PG8_SA(1, 1), a1 + hstepA, voffA);
            PG8_WAIT_V(8); PG8_WAIT_L(0); PG8_BAR; PG8_MMA(0, 0, At, B0); PG8_MMA(0, 1, At, B1); PG8_BAR; PG8_SCHED;
            PG8_LDA(At, 0, 1); PG8_STAGE(PG8_SB(0, 0), b2, voffB); PG8_STAGE(PG8_SB(0, 1), b2 + hstepB, voffB); PG8_STAGE(PG8_SA(0, 0), a2, voffA);
            PG8_WAIT_V(8); PG8_WAIT_L(0); PG8_BAR; PG8_MMA(1, 0, At, B0); PG8_MMA(1, 1, At, B1); PG8_BAR; PG8_SCHED;
            PG8_LDB(B0, 1, 0); PG8_LDB(B1, 1, 1); PG8_SCHED; PG8_LDA(At, 1, 0); PG8_STAGE(PG8_SA(0, 1), a2 + hstepA, voffA);
            PG8_WAIT_V(8); PG8_WAIT_L(0); PG8_BAR; PG8_MMA(0, 0, At, B0); PG8_MMA(0, 1, At, B1); PG8_BAR; PG8_SCHED;
            PG8_LDA(At, 1, 1); PG8_STAGE(PG8_SB(1, 0), b3, voffB); PG8_STAGE(PG8_SB(1, 1), b3 + hstepB, voffB); PG8_STAGE(PG8_SA(1, 0), a3, voffA);
            PG8_WAIT_V(8); PG8_WAIT_L(0); PG8_BAR; PG8_MMA(1, 0, At, B0); PG8_MMA(1, 1, At, B1); PG8_BAR; PG8_SCHED;
            } else {
            PG8_LDB(B0, 0, 0); PG8_SCHED; PG8_LDA(At, 0, 0); PG8_STAGE(PG8_SA(1, 1), a1 + hstepA, voffA);
            PG8_WAIT_L(8); PG8_BAR; PG8_WAIT_L(0); PG8_MMA(0, 0, At, B0); PG8_BAR; PG8_SCHED;
            PG8_LDB(B1, 0, 1); PG8_STAGE(PG8_SB(0, 0), b2, voffB);
            PG8_BAR; PG8_WAIT_L(0); PG8_MMA(0, 1, At, B1); PG8_BAR;
            PG8_LDA(At, 0, 1); PG8_STAGE(PG8_SA(0, 0), a2, voffA);
            PG8_BAR; PG8_WAIT_L(0); PG8_MMA(1, 0, At, B0); PG8_BAR; PG8_SCHED;
            PG8_STAGE(PG8_SB(0, 1), b2 + hstepB, voffB);
            PG8_WAIT_V(6); PG8_BAR; PG8_MMA(1, 1, At, B1); PG8_BAR;
            PG8_LDB(B0, 1, 0); PG8_SCHED; PG8_LDA(At, 1, 0); PG8_STAGE(PG8_SA(0, 1), a2 + hstepA, voffA);
            PG8_WAIT_L(8); PG8_BAR; PG8_WAIT_L(0); PG8_MMA(0, 0, At, B0); PG8_BAR; PG8_SCHED;
            PG8_LDB(B1, 1, 1); PG8_STAGE(PG8_SB(1, 0), b3, voffB);
            PG8_BAR; PG8_WAIT_L(0); PG8_MMA(0, 1, At, B1); PG8_BAR;
            PG8_LDA(At, 1, 1); PG8_STAGE(PG8_SA(1, 0), a3, voffA);
            PG8_BAR; PG8_WAIT_L(0); PG8_MMA(1, 0, At, B0); PG8_BAR; PG8_SCHED;
            PG8_STAGE(PG8_SB(1, 1), b3 + hstepB, voffB);
            PG8_WAIT_V(6); PG8_BAR; PG8_MMA(1, 1, At, B1); PG8_BAR;
            }
        }
        if constexpr (ALIGN_EPI) { if (wr == 0) PG8_BAR; }
        if constexpr (!Epi::AFTER_DRAIN) { E(acc, cur, wr, wc, fr, fq); S.done(cur); }
        if (!has_next) break;
#pragma unroll
        for (int a = 0; a < 2; ++a)
#pragma unroll
            for (int b = 0; b < 2; ++b)
#pragma unroll
                for (int m = 0; m < 4; ++m)
#pragma unroll
                    for (int n = 0; n < 2; ++n) acc[a][b][m][n] = (f32x4){0.f, 0.f, 0.f, 0.f};
        cur = nxt; cA = nA; cB = nB; ++ui;
        if constexpr (ALIGN_EPI) { if (wr == 1) PG8_BAR; }
    }
    PG8_WAIT_V(0);
    if constexpr (!ALIGN_EPI) { if (wr == 0) PG8_BAR; }
    PG8_BAR;
    if constexpr (Epi::AFTER_DRAIN) { E.fused(acc, cur, wr, wc, fr, fq, lds, wid, lane); S.done(cur); }
#undef PG8_SA
#undef PG8_SB
#undef PG8_STAGE
#undef PG8_LDA
#undef PG8_LDB
#undef PG8_MMA
#undef PG8_WAIT_V
#undef PG8_WAIT_L
#undef PG8_BAR
#undef PG8_SCHED
}
}

#define GAS __attribute__((address_space(1)))
#define LAS __attribute__((address_space(3)))
typedef unsigned short bf16;
typedef unsigned v4u __attribute__((ext_vector_type(4)));
typedef unsigned v2u __attribute__((ext_vector_type(2)));
typedef float f32x4 __attribute__((ext_vector_type(4)));
typedef float f32x2 __attribute__((ext_vector_type(2)));
constexpr int NWAVES = 8, NTHREADS = 512;
constexpr int NB = 8, SEQ = 4096, DM = 1024, MTOK = NB * SEQ, NMEMT = 256, MMEM = NB * NMEMT;
constexpr int DINP = 3600, NPROJ = 3584, DFF = 4096, DHY = 512, DML = 512, NHEAD = 4, DHEAD = 128;
constexpr float EPS = 1e-6f;
constexpr size_t MiB = 1u << 20;
constexpr size_t WS_CTL = 0, CTL_ZERO_BYTES = 1 * MiB;
constexpr size_t WS_WIN = 2 * MiB, WS_WOUT = 9 * MiB, WS_WQ = 11 * MiB, WS_WK = 13 * MiB, WS_WV = 15 * MiB, WS_WO = 17 * MiB, WS_W1 = 19 * MiB, WS_W2 = 27 * MiB;
constexpr size_t WS_MEMN = 35 * MiB, WS_KB = 39 * MiB, WS_VT = 43 * MiB, WS_GATES = 47 * MiB, WS_SSQ = 49 * MiB, WS_HID2 = 51 * MiB;
constexpr size_t WS_XN = 64 * MiB;
constexpr size_t WS_MQ = 64 * MiB, WS_MK = 96 * MiB;
constexpr size_t WS_PROJ = 128 * MiB, PROJ_STRIDE = (size_t)MTOK * 512;
constexpr size_t WS_FILT = 352 * MiB;
constexpr size_t WS_Z1 = 384 * MiB;
constexpr size_t WS_YT = 448 * MiB;
constexpr size_t WS_HFB = 128 * MiB;
constexpr size_t WS_MIXED = 384 * MiB;
constexpr size_t WS_Q = 352 * MiB, WS_SP = 416 * MiB, WS_AO = 128 * MiB, WS_HID = 192 * MiB;
constexpr size_t WS_END = 512 * MiB;
constexpr int RING_BYTES = 131072, LDSCTL_OFF = RING_BYTES, LDS_BYTES = 147456;

__device__ __forceinline__ float bf2f(unsigned short h) { return __uint_as_float(((unsigned)h) << 16); }
__device__ __forceinline__ unsigned f2bf(float f) { unsigned u = __float_as_uint(f); return (u + 0x7fffu + ((u >> 16) & 1u)) >> 16; }
__device__ __forceinline__ unsigned pk2(float lo, float hi) { return f2bf(lo) | (f2bf(hi) << 16); }
__device__ __forceinline__ float wave_sum(float v) {
#pragma unroll
    for (int o = 1; o < 64; o <<= 1) v += __shfl_xor(v, o);
    return v;
}
#define LDS_WAIT() asm volatile("s_waitcnt lgkmcnt(0)" ::: "memory")
__device__ __forceinline__ float logsig(float x) { return fminf(x, 0.f) - log1pf(expf(-fabsf(x))); }

struct Args { const float* in[30]; float* out; unsigned char* ws; int ph_lo, ph_hi; };

__device__ __forceinline__ void p0_transpose_item(const float* W, int ldw, int K, int nblk, bf16* WT, const float* gain, LAS float* scr, int item, int lane) {
    const int kb = item / nblk, nb = item % nblk, k0 = 64 * kb, n0 = 32 * nb;
#pragma unroll 8
    for (int i = 0; i < 32; ++i) { const int kk = 2 * i + (lane >> 5); float w = W[(size_t)(k0 + kk) * ldw + n0 + (lane & 31)]; if (gain) w *= gain[k0 + kk]; scr[kk * 33 + (lane & 31)] = w; }
    LDS_WAIT(); asm volatile("" ::: "memory");
    const int c = lane & 7;
#pragma unroll
    for (int j = 0; j < 4; ++j) { const int n = (lane >> 3) + 8 * j; const LAS float* s = scr + (8 * c) * 33 + n;
        v4u o; o.x = pk2(s[0 * 33], s[1 * 33]); o.y = pk2(s[2 * 33], s[3 * 33]); o.z = pk2(s[4 * 33], s[5 * 33]); o.w = pk2(s[6 * 33], s[7 * 33]);
        *(v4u*)(WT + (size_t)(n0 + n) * K + k0 + 8 * c) = o; }
    LDS_WAIT(); asm volatile("" ::: "memory");
}

__device__ __forceinline__ void p0_prologue(const Args& a, LAS unsigned char* lds, int G, int vcu) {
    const int tid = threadIdx.x, lane = tid & 63, wave = __builtin_amdgcn_readfirstlane(tid >> 6);
    const int gw = vcu * NWAVES + wave, NGW = G * NWAVES;
    unsigned char* ws = a.ws;
    {
        LAS float* scr = (LAS float*)(lds + wave * 16384);
        constexpr int I_IN = 16 * 112, I_SQ = 16 * 32, I_1 = 16 * 128, I_2 = 64 * 32;
        constexpr int NITEMS = I_IN + 5 * I_SQ + I_1 + I_2;
        for (int it = gw; it < NITEMS; it += NGW) {
            int r = it;
            if (r < I_IN) { p0_transpose_item(a.in[3], DINP, DM, 112, (bf16*)(ws + WS_WIN), a.in[2], scr, r, lane); continue; } r -= I_IN;
            if (r < I_SQ) { const int k0 = 64 * (r / 32); const float* g = (k0 < 512) ? a.in[14] : (a.in[18] - 512);
                            p0_transpose_item(a.in[19], DM, DM, 32, (bf16*)(ws + WS_WOUT), g, scr, r, lane); continue; } r -= I_SQ;
            if (r < I_SQ) { p0_transpose_item(a.in[22], DM, DM, 32, (bf16*)(ws + WS_WQ), a.in[20], scr, r, lane); continue; } r -= I_SQ;
            if (r < I_SQ) { p0_transpose_item(a.in[23], DM, DM, 32, (bf16*)(ws + WS_WK), a.in[21], scr, r, lane); continue; } r -= I_SQ;
            if (r < I_SQ) { p0_transpose_item(a.in[24], DM, DM, 32, (bf16*)(ws + WS_WV), a.in[21], scr, r, lane); continue; } r -= I_SQ;
            if (r < I_SQ) { p0_transpose_item(a.in[25], DM, DM, 32, (bf16*)(ws + WS_WO), nullptr, scr, r, lane); continue; } r -= I_SQ;
            if (r < I_1) { p0_transpose_item(a.in[27], DFF, DM, 128, (bf16*)(ws + WS_W1), a.in[26], scr, r, lane); continue; } r -= I_1;
            p0_transpose_item(a.in[28], DM, DFF, 32, (bf16*)(ws + WS_W2), nullptr, scr, r, lane);
        }
    }
    __syncthreads();
    LAS float* Wg = (LAS float*)lds;
    for (int idx = tid; idx < 16 * DM; idx += NTHREADS) { const int k = idx >> 4, j = idx & 15; Wg[j * DM + k] = a.in[2][k] * a.in[3][(size_t)k * DINP + NPROJ + j]; }
    __syncthreads();
    for (int m = gw; m < MTOK; m += NGW) {
        const f32x4* xr = (const f32x4*)(a.in[0] + (size_t)m * DM) + lane;
        f32x4 v[4]; float ss = 0.f;
#pragma unroll
        for (int j = 0; j < 4; ++j) { v[j] = xr[64 * j]; ss += (v[j][0] * v[j][0] + v[j][1] * v[j][1]) + (v[j][2] * v[j][2] + v[j][3] * v[j][3]); }
        const float rstd = 1.0f / sqrtf(wave_sum(ss) * (1.0f / DM) + EPS);
        unsigned long long* o8 = (unsigned long long*)((bf16*)(ws + WS_XN) + (size_t)m * DM) + lane;
#pragma unroll
        for (int j = 0; j < 4; ++j) { v[j] = v[j] * rstd; o8[64 * j] = (unsigned long long)pk2(v[j][0], v[j][1]) | ((unsigned long long)pk2(v[j][2], v[j][3]) << 32); }
        float mine = 0.f;
#pragma nounroll
        for (int g = 0; g < 16; ++g) { float s = 0.f;
#pragma unroll
            for (int j = 0; j < 4; ++j) { const f32x4 w = *(const LAS f32x4*)(Wg + g * DM + 4 * lane + 256 * j); s += (v[j][0] * w[0] + v[j][1] * w[1]) + (v[j][2] * w[2] + v[j][3] * w[3]); }
            s = wave_sum(s); mine = (lane == g) ? s : mine; }
        if (lane < 16) { float gv = mine + a.in[17][lane]; if (lane & 4) gv = logsig(gv); ((float*)(ws + WS_GATES))[(size_t)m * 16 + lane] = gv; }
    }
    for (int m = gw; m < MMEM; m += NGW) {
        const f32x4* xr = (const f32x4*)(a.in[1] + (size_t)m * DM) + lane;
        f32x4 v[4]; float ss = 0.f;
#pragma unroll
        for (int j = 0; j < 4; ++j) { v[j] = xr[64 * j]; ss += (v[j][0] * v[j][0] + v[j][1] * v[j][1]) + (v[j][2] * v[j][2] + v[j][3] * v[j][3]); }
        const float rstd = 1.0f / sqrtf(wave_sum(ss) * (1.0f / DM) + EPS);
        unsigned long long* o8 = (unsigned long long*)((bf16*)(ws + WS_MEMN) + (size_t)m * DM) + lane;
#pragma unroll
        for (int j = 0; j < 4; ++j) { v[j] = v[j] * rstd; o8[64 * j] = (unsigned long long)pk2(v[j][0], v[j][1]) | ((unsigned long long)pk2(v[j][2], v[j][3]) << 32); }
    }
    for (int t = gw; t < SEQ; t += NGW) {
        const float tl = (float)t * (1.0f / (float)(SEQ - 1)), ang = (6.283185307179586f / (float)SEQ) * (float)t;
        float s = tl * a.in[6][lane];
#pragma unroll 4
        for (int mb = 0; mb < 16; ++mb) { const float band = 1e-4f + (float)mb * ((15.0f - 1e-4f) / 15.0f); const float ph = band * ang;
            s += cosf(ph) * a.in[6][(1 + mb) * 64 + lane] - sinf(ph) * a.in[6][(17 + mb) * 64 + lane]; }
        const float h1 = sinf(a.in[8][lane] * (s + a.in[7][lane]));
        float s2 = 0.f;
        for (int i = 0; i < 64; ++i) s2 += __shfl(h1, i) * a.in[9][i * 64 + lane];
        const float h2 = sinf(a.in[11][lane] * (s2 + a.in[10][lane]));
        ((float*)(ws + WS_HID2))[(size_t)t * 64 + lane] = h2;
    }
}
__device__ __forceinline__ float silu(float x) { return x / (1.0f + expf(-x)); }
__device__ __forceinline__ float sigm(float x) { return 1.0f / (1.0f + expf(-x)); }

__device__ __forceinline__ void naive_filters(const Args& a, int G, int vcu) {
    const float* hid2 = (const float*)(a.ws + WS_HID2); float* filt = (float*)(a.ws + WS_FILT);
    const size_t N = (size_t)2048 * SEQ, NT = (size_t)G * NTHREADS;
    for (size_t i = (size_t)vcu * NTHREADS + threadIdx.x; i < N; i += NT) {
        const int t = (int)(i % SEQ), ch = (int)(i / SEQ), c = ch & 511;
        const float* h = hid2 + (size_t)t * 64; float s = 0.f;
        for (int j = 0; j < 64; ++j) s += h[j] * a.in[12][(size_t)j * 2048 + ch];
        const float mind = -3.0701134573253944f, maxd = -15.350567286626972f;
        const float delta = mind + (float)c * ((maxd - mind) / 511.0f);
        const float tl = (float)t * (1.0f / (float)(SEQ - 1));
        filt[i] = s * expf(-tl * fabsf(delta));
    }
}
__device__ __forceinline__ void naive_conv(const Args& a, int G, int vcu) {
    const bf16* proj = (const bf16*)(a.ws + WS_PROJ);
    bf16* hyT = (bf16*)a.out;
    const size_t NT = (size_t)G * NTHREADS, gt = (size_t)vcu * NTHREADS + threadIdx.x;
    const size_t N1 = (size_t)NB * 1536 * SEQ;
    for (size_t i = gt; i < N1; i += NT) {
        const int t = (int)(i % SEQ), col = (int)((i / SEQ) % 1536), b = (int)(i / ((size_t)SEQ * 1536));
        const bf16* p = proj + (size_t)(col >> 9) * PROJ_STRIDE + (size_t)(b * SEQ + t) * 512 + (col & 511);
        const float u0 = (t > 0) ? bf2f(p[-512]) : 0.f, u1 = bf2f(p[0]), u2 = (t < SEQ - 1) ? bf2f(p[512]) : 0.f;
        const float v = a.in[5][col] + u0 * a.in[4][col] + u1 * a.in[4][1536 + col] + u2 * a.in[4][3072 + col];
        hyT[i] = (bf16)f2bf(v);
    }
    const size_t N2 = (size_t)MTOK * 1024;
    bf16* mq = (bf16*)(a.ws + WS_MQ); bf16* mk = (bf16*)(a.ws + WS_MK);
    for (size_t i = gt; i < N2; i += NT) {
        const int c2 = (int)(i & 1023), row = (int)(i >> 10), t = row & (SEQ - 1), c = c2 & 511;
        const bf16* p = proj + (size_t)(3 + (c2 >> 9)) * PROJ_STRIDE + (size_t)row * 512 + c;
        const float u0 = (t > 0) ? bf2f(p[-512]) : 0.f, u1 = bf2f(p[0]), u2 = (t < SEQ - 1) ? bf2f(p[512]) : 0.f;
        float v = a.in[16][c2] + u0 * a.in[15][c2] + u1 * a.in[15][1024 + c2] + u2 * a.in[15][2048 + c2];
        v = silu(v);
        if (c2 < 512) mq[(size_t)row * 512 + c] = (bf16)f2bf(v); else mk[(size_t)row * 512 + c] = (bf16)f2bf(v * 0.08838834764831845f);
    }
}
__device__ __forceinline__ void naive_hyena(const Args& a, LAS unsigned char* lds, int G, int vcu) {
    const int tid = threadIdx.x;
    const bf16* hyT = (const bf16*)a.out; const float* filt = (const float*)(a.ws + WS_FILT);
    float* z1g = (float*)(a.ws + WS_Z1); float* yT = (float*)(a.ws + WS_YT);
    LAS float* zs = (LAS float*)lds;
    for (int c = vcu; c < DHY; c += G) {
        for (int o = 0; o < 2; ++o) {
            __syncthreads();
            for (int idx = tid; idx < NB * SEQ; idx += NTHREADS) { const int b = idx >> 12, s = idx & (SEQ - 1);
                zs[s * 8 + b] = (o == 0) ? bf2f(hyT[((size_t)b * 1536 + c) * SEQ + s]) : z1g[((size_t)b * 512 + c) * SEQ + s]; }
            __syncthreads();
            const float* hf = filt + ((size_t)(o * 2 + 0) * 512 + c) * SEQ; const float* hb = filt + ((size_t)(o * 2 + 1) * 512 + c) * SEQ;
            const float skip = a.in[13][o * 512 + c];
            for (int tt = 0; tt < 8; ++tt) {
                const int t = tid + NTHREADS * tt;
                float acc[8];
#pragma unroll
                for (int b = 0; b < 8; ++b) acc[b] = 0.f;
                for (int s = 0; s < SEQ; ++s) {
                    const float h = (s <= t) ? hf[t - s] : hb[s - t];
                    const f32x4 z0 = *(const LAS f32x4*)(zs + s * 8), z1 = *(const LAS f32x4*)(zs + s * 8 + 4);
                    acc[0] += h * z0[0]; acc[1] += h * z0[1]; acc[2] += h * z0[2]; acc[3] += h * z0[3];
                    acc[4] += h * z1[0]; acc[5] += h * z1[1]; acc[6] += h * z1[2]; acc[7] += h * z1[3];
                }
#pragma unroll
                for (int b = 0; b < 8; ++b) {
                    const float gate = bf2f(hyT[((size_t)b * 1536 + 512 * (o + 1) + c) * SEQ + t]);
                    const float r = gate * (acc[b] + zs[t * 8 + b] * skip);
                    if (o == 0) z1g[((size_t)b * 512 + c) * SEQ + t] = r; else yT[((size_t)b * 512 + c) * SEQ + t] = r;
                }
            }
            __threadfence();
        }
    }
    __syncthreads();
}
__device__ __forceinline__ void naive_mlstm(const Args& a, LAS unsigned char* lds, int G, int vcu) {
    const int tid = threadIdx.x;
    const bf16* mq = (const bf16*)(a.ws + WS_MQ); const bf16* mk = (const bf16*)(a.ws + WS_MK);
    const bf16* mv = (const bf16*)(a.ws + WS_PROJ) + 5 * PROJ_STRIDE;
    const float* gates = (const float*)(a.ws + WS_GATES);
    float* hfb = (float*)(a.ws + WS_HFB);
    LAS float* ks = (LAS float*)lds; LAS float* qs = (LAS float*)(lds + 32768); LAS bf16* vs = (LAS bf16*)(lds + 65536);
    LAS float* nums = (LAS float*)(lds + 81920); LAS float* gi = (LAS float*)(lds + 116736); LAS float* gf = (LAS float*)(lds + 116736 + 256);
    for (int ch = vcu; ch < 64; ch += G) {
        const int b = ch >> 3, hh = (ch >> 1) & 3, dir = ch & 1;
        float C[128];
#pragma unroll
        for (int d = 0; d < 128; ++d) C[d] = 0.f;
        for (int jj = 0; jj < 64; ++jj) {
            const int j = dir ? 63 - jj : jj, row0 = b * SEQ + j * 64;
            __syncthreads();
            for (int idx = tid; idx < 64 * 128; idx += NTHREADS) { const int r = idx >> 7, d = idx & 127; const size_t g = (size_t)(row0 + r) * 512 + hh * 128 + d;
                ks[idx] = bf2f(mk[g]); qs[idx] = bf2f(mq[g]); vs[idx] = mv[g]; }
            if (tid < 64) { const float* gp = gates + (size_t)(row0 + tid) * 16 + dir * 8 + hh; gi[tid] = expf(gp[0]); gf[tid] = expf(gp[4]); }
            __syncthreads();
            if (tid < 129) {
                for (int st = 0; st < 64; ++st) {
                    const int r = dir ? 63 - st : st;
                    const float f = gf[r], w = gi[r] * ((tid < 128) ? bf2f(vs[r * 128 + tid]) : 1.0f);
                    float num = 0.f;
#pragma unroll
                    for (int d4 = 0; d4 < 32; ++d4) { const f32x4 k4 = *(const LAS f32x4*)(ks + r * 128 + 4 * d4), q4 = *(const LAS f32x4*)(qs + r * 128 + 4 * d4);
#pragma unroll
                        for (int e = 0; e < 4; ++e) { C[4 * d4 + e] = f * C[4 * d4 + e] + w * k4[e]; num += C[4 * d4 + e] * q4[e]; } }
                    nums[r * 130 + tid] = num;
                }
            }
            __syncthreads();
            for (int idx = tid; idx < 64 * 128; idx += NTHREADS) { const int r = idx >> 7, n = idx & 127;
                const float den = nums[r * 130 + 128];
                hfb[((size_t)dir * MTOK + row0 + r) * 512 + hh * 128 + n] = nums[r * 130 + n] / fmaxf(fabsf(den), 1.0f); }
        }
    }
    __syncthreads();
}
__device__ __forceinline__ void naive_mix(const Args& a, int G, int vcu) {
    const int tid = threadIdx.x, lane = tid & 63, wave = __builtin_amdgcn_readfirstlane(tid >> 6);
    const int gw = vcu * NWAVES + wave, NGW = G * NWAVES;
    const float* yT = (const float*)(a.ws + WS_YT); const float* hfb = (const float*)(a.ws + WS_HFB);
    const bf16* om = (const bf16*)(a.ws + WS_PROJ) + 6 * PROJ_STRIDE; bf16* mixed = (bf16*)(a.ws + WS_MIXED);
    for (int m = gw; m < MTOK; m += NGW) {
        const int b = m >> 12, t = m & (SEQ - 1);
        float y[8]; float ss = 0.f;
#pragma unroll
        for (int e = 0; e < 8; ++e) { y[e] = yT[((size_t)b * 512 + 8 * lane + e) * SEQ + t]; ss += y[e] * y[e]; }
        ss += __shfl_xor(ss, 1); ss += __shfl_xor(ss, 2); ss += __shfl_xor(ss, 4);
        float rs = 1.0f / sqrtf(ss * (1.0f / 64.0f) + EPS);
        v4u o; o.x = pk2(y[0] * rs, y[1] * rs); o.y = pk2(y[2] * rs, y[3] * rs); o.z = pk2(y[4] * rs, y[5] * rs); o.w = pk2(y[6] * rs, y[7] * rs);
        *(v4u*)(mixed + (size_t)m * DM + 8 * lane) = o;
        ss = 0.f;
#pragma unroll
        for (int e = 0; e < 8; ++e) { const size_t g = (size_t)m * 512 + 8 * lane + e; y[e] = (hfb[g] + hfb[(size_t)MTOK * 512 + g]) * sigm(bf2f(om[g])); ss += y[e] * y[e]; }
        ss += __shfl_xor(ss, 1); ss += __shfl_xor(ss, 2); ss += __shfl_xor(ss, 4); ss += __shfl_xor(ss, 8);
        rs = 1.0f / sqrtf(ss * (1.0f / 128.0f) + EPS);
        o.x = pk2(y[0] * rs, y[1] * rs); o.y = pk2(y[2] * rs, y[3] * rs); o.z = pk2(y[4] * rs, y[5] * rs); o.w = pk2(y[6] * rs, y[7] * rs);
        *(v4u*)(mixed + (size_t)m * DM + 512 + 8 * lane) = o;
    }
}
__device__ __forceinline__ void softmax_rows(const Args& a, int G, int vcu) {
    const int tid = threadIdx.x, lane = tid & 63, wave = __builtin_amdgcn_readfirstlane(tid >> 6);
    const int gw = vcu * NWAVES + wave, NGW = G * NWAVES;
    bf16* sp = (bf16*)(a.ws + WS_SP);
    for (int m = gw; m < MTOK; m += NGW) {
        v4u* p = (v4u*)(sp + (size_t)m * DM + 16 * lane);
        const v4u r0 = p[0], r1 = p[1];
        float v[16];
        const unsigned w[8] = {r0.x, r0.y, r0.z, r0.w, r1.x, r1.y, r1.z, r1.w};
        float mx = -1e30f;
#pragma unroll
        for (int e = 0; e < 8; ++e) { v[2 * e] = __uint_as_float(w[e] << 16) * 0.0625f; v[2 * e + 1] = __uint_as_float(w[e] & 0xffff0000u) * 0.0625f; mx = fmaxf(mx, fmaxf(v[2 * e], v[2 * e + 1])); }
        mx = fmaxf(mx, __shfl_xor(mx, 1)); mx = fmaxf(mx, __shfl_xor(mx, 2)); mx = fmaxf(mx, __shfl_xor(mx, 4)); mx = fmaxf(mx, __shfl_xor(mx, 8));
        float sum = 0.f;
#pragma unroll
        for (int e = 0; e < 16; ++e) { v[e] = expf(v[e] - mx); sum += v[e]; }
        sum += __shfl_xor(sum, 1); sum += __shfl_xor(sum, 2); sum += __shfl_xor(sum, 4); sum += __shfl_xor(sum, 8);
        const float inv = 1.0f / sum;
        v4u o0, o1;
        o0.x = pk2(v[0] * inv, v[1] * inv); o0.y = pk2(v[2] * inv, v[3] * inv); o0.z = pk2(v[4] * inv, v[5] * inv); o0.w = pk2(v[6] * inv, v[7] * inv);
        o1.x = pk2(v[8] * inv, v[9] * inv); o1.y = pk2(v[10] * inv, v[11] * inv); o1.z = pk2(v[12] * inv, v[13] * inv); o1.w = pk2(v[14] * inv, v[15] * inv);
        p[0] = o0; p[1] = o1;
    }
}
__device__ __forceinline__ void final_norm(const Args& a, int G, int vcu) {
    const int tid = threadIdx.x, lane = tid & 63, wave = __builtin_amdgcn_readfirstlane(tid >> 6);
    const int gw = vcu * NWAVES + wave, NGW = G * NWAVES;
    const f32x4* gp = (const f32x4*)a.in[29] + lane;
    for (int m = gw; m < MTOK; m += NGW) {
        f32x4* xr = (f32x4*)(a.out + (size_t)m * DM) + lane;
        f32x4 v[4]; float ss = 0.f;
#pragma unroll
        for (int j = 0; j < 4; ++j) { v[j] = xr[64 * j]; ss += (v[j][0] * v[j][0] + v[j][1] * v[j][1]) + (v[j][2] * v[j][2] + v[j][3] * v[j][3]); }
        const float rstd = 1.0f / sqrtf(wave_sum(ss) * (1.0f / DM) + EPS);
#pragma unroll
        for (int j = 0; j < 4; ++j) xr[64 * j] = v[j] * rstd * gp[64 * j];
    }
}
#ifndef MK_ONE_LAUNCH
#define MK_ONE_LAUNCH 0
#endif
constexpr int NPHASE = 14;
#define GEMM_CALL(EPI, MODE, g, S, E) pg8::gemm_phase<EPI, pg8::StaticOrder, true, true, MODE>(ldsp, g, S, E)
__global__ void __launch_bounds__(NTHREADS, 2) mk_fwd(Args a) {
    extern __shared__ __attribute__((aligned(16))) unsigned char lds_raw[];
    LAS unsigned char* ldsp = (LAS unsigned char*)lds_raw;
    const int G = gridDim.x, bx = blockIdx.x;
    const int vcu = (G % 8 == 0) ? (bx % 8) * (G / 8) + bx / 8 : bx;
    unsigned char* ws = a.ws;
    typedef pg8::bf16_t pb;
#if MK_ONE_LAUNCH
    cg::grid_group grid = cg::this_grid();
#define SEAM() grid.sync()
#else
#define SEAM() do {} while (0)
#endif
    const int lo = a.ph_lo, hi = a.ph_hi;
#define IN(k) (lo <= (k) && (k) < hi)
#define PH_END(k) do { if (IN((k) + 1)) SEAM(); } while (0)
    if (IN(0)) { p0_prologue(a, ldsp, G, vcu); __syncthreads(); PH_END(0); }
    if (IN(1)) {
        { pg8::Gemm g{(const pb*)(ws + WS_XN), (const pb*)(ws + WS_WIN), DM, DM, DM}; pg8::StaticOrder S; S.init(MTOK, NPROJ, G, bx);
          typedef pg8::EpiBf16S<0, 0> E_t; E_t E{(pb*)(ws + WS_PROJ), 512, 512, PROJ_STRIDE, nullptr, 1.0f}; GEMM_CALL(E_t, 0, g, S, E); }
        { pg8::Gemm g{(const pb*)(ws + WS_MEMN), (const pb*)(ws + WS_WK), DM, DM, DM}; pg8::StaticOrder S; S.init(MMEM, DM, G, bx);
          typedef pg8::EpiBf16S<0, 0> E_t; E_t E{(pb*)(ws + WS_KB), DM, 0, 0, nullptr, 1.0f}; GEMM_CALL(E_t, 0, g, S, E); }
        { pg8::Gemm g{(const pb*)(ws + WS_WV), (const pb*)(ws + WS_MEMN), DM, DM, DM}; pg8::StaticOrder S; S.init(DM, MMEM, G, (bx + G / 2) % G);
          typedef pg8::EpiBf16S<0, 0> E_t; E_t E{(pb*)(ws + WS_VT), MMEM, 0, 0, nullptr, 1.0f}; GEMM_CALL(E_t, 0, g, S, E); }
        naive_filters(a, G, vcu);
        PH_END(1); }
    if (IN(2)) { naive_conv(a, G, vcu); PH_END(2); }
    if (IN(3)) { naive_hyena(a, ldsp, G, vcu); naive_mlstm(a, ldsp, G, vcu); PH_END(3); }
    if (IN(4)) { naive_mix(a, G, vcu); PH_END(4); }
    if (IN(5)) { pg8::Gemm g{(const pb*)(ws + WS_MIXED), (const pb*)(ws + WS_WOUT), DM, DM, DM}; pg8::StaticOrder S; S.init(MTOK, DM, G, bx);
          pg8::EpiResid E{a.in[0], a.out, (pb*)(ws + WS_XN), (float*)(ws + WS_SSQ), DM}; GEMM_CALL(pg8::EpiResid, 0, g, S, E); PH_END(5); }
    if (IN(6)) { pg8::Gemm g{(const pb*)(ws + WS_XN), (const pb*)(ws + WS_WQ), DM, DM, DM}; pg8::StaticOrder S; S.init(MTOK, DM, G, bx);
          typedef pg8::EpiBf16S<1, 0> E_t; E_t E{(pb*)(ws + WS_Q), DM, 0, 0, (const float*)(ws + WS_SSQ), 1.0f}; GEMM_CALL(E_t, 0, g, S, E); PH_END(6); }
    if (IN(7)) { pg8::Gemm g{(const pb*)(ws + WS_Q), (const pb*)(ws + WS_KB), DM, DM, 256}; pg8::StaticOrder S; S.init(MTOK, DM, G, bx);
          typedef pg8::EpiBf16S<0, 0> E_t; E_t E{(pb*)(ws + WS_SP), DM, 0, 0, nullptr, 1.0f}; GEMM_CALL(E_t, 1, g, S, E); PH_END(7); }
    if (IN(8)) { softmax_rows(a, G, vcu); PH_END(8); }
    if (IN(9)) { pg8::Gemm g{(const pb*)(ws + WS_SP), (const pb*)(ws + WS_VT), DM, MMEM, 256}; pg8::StaticOrder S; S.init(MTOK, DM, G, bx);
          typedef pg8::EpiBf16S<0, 0> E_t; E_t E{(pb*)(ws + WS_AO), DM, 0, 0, nullptr, 1.0f}; GEMM_CALL(E_t, 2, g, S, E); PH_END(9); }
    if (IN(10)) { pg8::Gemm g{(const pb*)(ws + WS_AO), (const pb*)(ws + WS_WO), DM, DM, DM}; pg8::StaticOrder S; S.init(MTOK, DM, G, bx);
          pg8::EpiResid E{a.out, a.out, (pb*)(ws + WS_XN), (float*)(ws + WS_SSQ), DM}; GEMM_CALL(pg8::EpiResid, 0, g, S, E); PH_END(10); }
    if (IN(11)) { pg8::Gemm g{(const pb*)(ws + WS_XN), (const pb*)(ws + WS_W1), DM, DM, DM}; pg8::StaticOrder S; S.init(MTOK, DFF, G, bx);
          typedef pg8::EpiBf16S<1, 1> E_t; E_t E{(pb*)(ws + WS_HID), DFF, 0, 0, (const float*)(ws + WS_SSQ), 1.0f}; GEMM_CALL(E_t, 0, g, S, E); PH_END(11); }
    if (IN(12)) { pg8::Gemm g{(const pb*)(ws + WS_HID), (const pb*)(ws + WS_W2), DFF, DFF, DFF}; pg8::StaticOrder S; S.init(MTOK, DM, G, bx);
          pg8::EpiResid E{a.out, a.out, nullptr, (float*)(ws + WS_SSQ), DM}; GEMM_CALL(pg8::EpiResid, 0, g, S, E); PH_END(12); }
    if (IN(13)) { final_norm(a, G, vcu); }
}

extern "C" void kernel_launch(void* const* d_in, const int* in_sizes, int n_in, void* d_out, int out_size, void* d_ws, size_t ws_size, hipStream_t stream) {
    static int grid = 0;
    if (grid == 0) {
        if (n_in != 30 || in_sizes[0] != MTOK * DM || out_size != MTOK * DM || ws_size < WS_END) {
            fprintf(stderr, "kernel_launch: unexpected shapes (n_in %d, in0 %d, out %d, ws %zu); nothing launched\n", n_in, n_in > 0 ? in_sizes[0] : -1, out_size, ws_size); grid = -1; return; }
        int dev = 0, cus = 0, per_cu = 0;
        if (hipGetDevice(&dev) != hipSuccess || hipDeviceGetAttribute(&cus, hipDeviceAttributeMultiprocessorCount, dev) != hipSuccess) { grid = -1; return; }
        if (hipFuncSetAttribute((const void*)mk_fwd, hipFuncAttributeMaxDynamicSharedMemorySize, LDS_BYTES) != hipSuccess) { fprintf(stderr, "kernel_launch: hipFuncSetAttribute failed\n"); grid = -1; return; }
        if (hipOccupancyMaxActiveBlocksPerMultiprocessor(&per_cu, (const void*)mk_fwd, NTHREADS, LDS_BYTES) != hipSuccess || per_cu < 1) { fprintf(stderr, "kernel_launch: occupancy query says %d\n", per_cu); (void)hipGetLastError(); grid = -1; return; }
        grid = cus;
    }
    if (grid < 0) return;
    Args a{};
    for (int i = 0; i < 30; ++i) a.in[i] = (const float*)d_in[i];
    a.out = (float*)d_out; a.ws = (unsigned char*)d_ws;
#if MK_ONE_LAUNCH
    a.ph_lo = 0; a.ph_hi = NPHASE;
    void* args[] = {&a};
    hipError_t e = hipLaunchCooperativeKernel((const void*)mk_fwd, dim3(grid), dim3(NTHREADS), args, LDS_BYTES, stream);
    if (e != hipSuccess) fprintf(stderr, "cooperative launch failed: %s (grid %d)\n", hipGetErrorString(e), grid);
#else
    for (int ph = 0; ph < NPHASE; ++ph) { a.ph_lo = ph; a.ph_hi = ph + 1; hipLaunchKernelGGL(mk_fwd, dim3(grid), dim3(NTHREADS), LDS_BYTES, stream, a); }
#endif
}
```

```cpp
#include <hip/hip_runtime.h>
#include <hip/hip_cooperative_groups.h>
#include <cstdio>
#include <cstdint>
namespace cg = cooperative_groups;
namespace pg8 {
#define PG8_LAS __attribute__((address_space(3)))
typedef unsigned short bf16_t;
typedef short bf16x8 __attribute__((ext_vector_type(8)));
typedef float f32x4 __attribute__((ext_vector_type(4)));
typedef unsigned u32x4 __attribute__((ext_vector_type(4)));
constexpr int BM = 256, BK = 64, HALF = 128, HTB = HALF * BK * 2  , STAGE_BYTES = 8 * HTB, NXCD = 8, WGM = 8;

__host__ __device__ __forceinline__ int lds_byte(int r, int c) { const int st = (r >> 4) * 2 + (c >> 5), rr = r & 15, cc = c & 31, ob = rr * 64 + cc * 2; return st * 1024 + (ob ^ (((ob >> 9) & 1) << 5)); }
__host__ __device__ __forceinline__ void stage_rc(int b, int& R, int& C) { const int st = b / 1024, sb = b % 1024, swz = sb ^ (((sb >> 9) & 1) << 5); R = (st >> 1) * 16 + swz / 64; C = (st & 1) * 32 + (swz % 64) / 2; }
__host__ __device__ __forceinline__ int perm32(int rho) { const int n = rho >> 4, i = rho & 15; return 8 * (i >> 2) + 4 * n + (i & 3); }

struct Unit { int pm, pn; };
struct Gemm { const bf16_t* A; const bf16_t* Bt; };
template <int MODE, int LDA> __device__ __forceinline__ size_t a_off(const Unit& u) {
    if (MODE == 0) return (size_t)u.pm * BM * LDA * 2;
    return ((size_t)u.pm * BM * LDA + (size_t)u.pn * BM) * 2; }
template <int MODE, int LDB> __device__ __forceinline__ size_t b_off(const Unit& u) {
    if (MODE == 0) return (size_t)u.pn * BM * LDB * 2;
    if (MODE == 1) return ((size_t)(u.pm >> 4) * BM * LDB + (size_t)u.pn * BM) * 2;
    return ((size_t)u.pn * BM * LDB + (size_t)(u.pm >> 4) * BM) * 2; }

struct StaticOrder {
    int nM, nN, nwg, G, c;
    __host__ __device__ void init(int M, int N, int G_, int c_) { nM = M / BM; nN = N / BM; nwg = nM * nN; G = G_; c = c_; }
    __host__ __device__ bool next(int i, Unit& u) const {
        const long L = (long)i * G + c; if (L >= nwg) return false;
        int wgid = (int)L; { const int q = nwg / NXCD, r = nwg % NXCD, xcd = wgid % NXCD, off = wgid / NXCD; wgid = (xcd < r ? xcd * (q + 1) : r * (q + 1) + (xcd - r) * q) + off; }
        const int nig = WGM * nN, gid = wgid / nig, fm = gid * WGM, gsz = (nM - fm) < WGM ? (nM - fm) : WGM;
        u.pm = fm + ((wgid % nig) % gsz); u.pn = (wgid % nig) / gsz; return true;
    }
    __device__ __forceinline__ void a_ready(const Unit&) const {}
    __device__ __forceinline__ void done(const Unit&) const {}
};

__device__ __forceinline__ unsigned cvt_pk_bf16(float lo, float hi) { unsigned r; asm volatile("v_cvt_pk_bf16_f32 %0, %1, %2" : "=v"(r) : "v"(lo), "v"(hi)); return r; }
typedef unsigned u32x2 __attribute__((ext_vector_type(2)));
template <int ROWSCALE, int ACT> struct EpiBf16S {
    static constexpr bool PERM = true, AFTER_DRAIN = false;
    bf16_t* O; int ldc; int split_cols; size_t split_stride; const float* ssqp; float mul;
    __device__ __forceinline__ void operator()(const f32x4 (&acc)[2][2][4][2], const Unit& u, int wr, int wc, int fr, int fq) const {
        const int row0 = u.pm * BM + wr * 64 + fr; int colt = u.pn * BM; bf16_t* base = O;
        if (split_cols) { const int t = colt / split_cols; base += (size_t)t * split_stride; colt -= t * split_cols; }
        const int col0 = colt + wc * 32 + 8 * fq;
#pragma unroll
        for (int ai = 0; ai < 2; ++ai)
#pragma unroll
            for (int m = 0; m < 4; ++m) { const int row = row0 + ai * HALF + m * 16; float sc = mul;
                if (ROWSCALE) { const f32x4* p = (const f32x4*)(ssqp + (size_t)row * 16); const f32x4 a = p[0], b = p[1], c = p[2], d = p[3];
                    const float s = ((a[0] + a[1]) + (a[2] + a[3])) + ((b[0] + b[1]) + (b[2] + b[3])) + ((c[0] + c[1]) + (c[2] + c[3])) + ((d[0] + d[1]) + (d[2] + d[3]));
                    sc *= __builtin_amdgcn_rsqf(s * (1.0f / 1024.0f) + 1e-6f); }
                bf16_t* rowp = base + (size_t)row * ldc + col0;
#pragma unroll
                for (int bj = 0; bj < 2; ++bj) { f32x4 v0 = acc[ai][bj][m][0] * sc, v1 = acc[ai][bj][m][1] * sc;
                    if (ACT == 1) {
#pragma unroll
                        for (int e = 0; e < 4; ++e) { const float a0 = fmaxf(v0[e], 0.f), a1 = fmaxf(v1[e], 0.f); v0[e] = a0 * a0; v1[e] = a1 * a1; } }
                    u32x4 w; w.x = cvt_pk_bf16(v0[0], v0[1]); w.y = cvt_pk_bf16(v0[2], v0[3]); w.z = cvt_pk_bf16(v1[0], v1[1]); w.w = cvt_pk_bf16(v1[2], v1[3]);
                    *(u32x4*)(rowp + bj * HALF) = w; } }
    }
};
struct EpiSoftmax {
    static constexpr bool PERM = true, AFTER_DRAIN = false;
    bf16_t* O; int ldc; PG8_LAS float* xl; float c2;
    __device__ __forceinline__ void operator()(const f32x4 (&acc)[2][2][4][2], const Unit& u, int wr, int wc, int fr, int fq) const {
        const int row0 = u.pm * BM + wr * 64 + fr, col0 = u.pn * BM + wc * 32 + 8 * fq;
        PG8_LAS float* pm = xl; PG8_LAS float* ps = xl + 1024;
        float mx[2][4];
#pragma unroll
        for (int ai = 0; ai < 2; ++ai)
#pragma unroll
            for (int m = 0; m < 4; ++m) { float v = -3.0e38f;
#pragma unroll
                for (int bj = 0; bj < 2; ++bj)
#pragma unroll
                    for (int n = 0; n < 2; ++n) { const f32x4 x = acc[ai][bj][m][n]; v = fmaxf(v, fmaxf(fmaxf(x[0], x[1]), fmaxf(x[2], x[3]))); }
                v = fmaxf(v, __shfl_xor(v, 16)); v = fmaxf(v, __shfl_xor(v, 32));
                if (fq == 0) pm[(ai * HALF + wr * 64 + m * 16 + fr) * 4 + wc] = v; }
        asm volatile("s_waitcnt lgkmcnt(0)" ::: "memory"); __builtin_amdgcn_s_barrier(); asm volatile("" ::: "memory");
        float sm[2][4];
#pragma unroll
        for (int ai = 0; ai < 2; ++ai)
#pragma unroll
            for (int m = 0; m < 4; ++m) { const int rl = ai * HALF + wr * 64 + m * 16 + fr; const f32x4 p4 = *(const PG8_LAS f32x4*)(pm + rl * 4);
                const float mxr = fmaxf(fmaxf(p4[0], p4[1]), fmaxf(p4[2], p4[3])); mx[ai][m] = mxr * c2; float s = 0.f;
#pragma unroll
                for (int bj = 0; bj < 2; ++bj)
#pragma unroll
                    for (int n = 0; n < 2; ++n) { const f32x4 x = acc[ai][bj][m][n];
                        s += (__builtin_amdgcn_exp2f(x[0] * c2 - mx[ai][m]) + __builtin_amdgcn_exp2f(x[1] * c2 - mx[ai][m])) + (__builtin_amdgcn_exp2f(x[2] * c2 - mx[ai][m]) + __builtin_amdgcn_exp2f(x[3] * c2 - mx[ai][m])); }
                s += __shfl_xor(s, 16); s += __shfl_xor(s, 32);
                if (fq == 0) ps[rl * 4 + wc] = s; sm[ai][m] = 0.f; }
        asm volatile("s_waitcnt lgkmcnt(0)" ::: "memory"); __builtin_amdgcn_s_barrier(); asm volatile("" ::: "memory");
#pragma unroll
        for (int ai = 0; ai < 2; ++ai)
#pragma unroll
            for (int m = 0; m < 4; ++m) { const int rl = ai * HALF + wr * 64 + m * 16 + fr; const f32x4 s4 = *(const PG8_LAS f32x4*)(ps + rl * 4);
                const float inv = 1.0f / ((s4[0] + s4[1]) + (s4[2] + s4[3])); const float mr = mx[ai][m];
                bf16_t* rowp = O + (size_t)(row0 + ai * HALF + m * 16) * ldc + col0;
#pragma unroll
                for (int bj = 0; bj < 2; ++bj) { const f32x4 x0 = acc[ai][bj][m][0], x1 = acc[ai][bj][m][1]; u32x4 w;
                    w.x = cvt_pk_bf16(__builtin_amdgcn_exp2f(x0[0] * c2 - mr) * inv, __builtin_amdgcn_exp2f(x0[1] * c2 - mr) * inv); w.y = cvt_pk_bf16(__builtin_amdgcn_exp2f(x0[2] * c2 - mr) * inv, __builtin_amdgcn_exp2f(x0[3] * c2 - mr) * inv);
                    w.z = cvt_pk_bf16(__builtin_amdgcn_exp2f(x1[0] * c2 - mr) * inv, __builtin_amdgcn_exp2f(x1[1] * c2 - mr) * inv); w.w = cvt_pk_bf16(__builtin_amdgcn_exp2f(x1[2] * c2 - mr) * inv, __builtin_amdgcn_exp2f(x1[3] * c2 - mr) * inv);
                    *(u32x4*)(rowp + bj * HALF) = w; } }
        asm volatile("s_waitcnt lgkmcnt(0)" ::: "memory"); __builtin_amdgcn_s_barrier(); asm volatile("" ::: "memory");
    }
};

template <bool BASE_F32> struct EpiResid {
    static constexpr bool PERM = false, AFTER_DRAIN = false;
    const void* base; bf16_t* xn; float* ssqp; int ldc;
    __device__ __forceinline__ void operator()(const f32x4 (&acc)[2][2][4][2], const Unit& u, int wr, int wc, int fr, int fq) const {
        const int row0 = u.pm * BM + wr * 64 + fr, col0 = u.pn * BM + wc * 32 + 4 * fq;
#pragma unroll
        for (int ai = 0; ai < 2; ++ai) {
            f32x4 bf_[4][2][2]; u32x2 bh_[4][2][2];
#pragma unroll
            for (int m = 0; m < 4; ++m) { const size_t off = (size_t)(row0 + ai * HALF + m * 16) * ldc + col0;
#pragma unroll
                for (int bj = 0; bj < 2; ++bj)
#pragma unroll
                    for (int n = 0; n < 2; ++n) { const size_t o2 = off + bj * HALF + n * 16;
                        if (BASE_F32) bf_[m][bj][n] = *(const f32x4*)((const float*)base + o2); else bh_[m][bj][n] = *(const u32x2*)((const bf16_t*)base + o2); } }
#pragma unroll
            for (int m = 0; m < 4; ++m) { const int row = row0 + ai * HALF + m * 16; const size_t off = (size_t)row * ldc + col0; float ss = 0.f;
#pragma unroll
                for (int bj = 0; bj < 2; ++bj)
#pragma unroll
                    for (int n = 0; n < 2; ++n) { const size_t o2 = off + bj * HALF + n * 16; f32x4 b;
                        if (BASE_F32) b = bf_[m][bj][n];
                        else { const u32x2 w = bh_[m][bj][n]; b = (f32x4){__uint_as_float(w.x << 16), __uint_as_float(w.x & 0xffff0000u), __uint_as_float(w.y << 16), __uint_as_float(w.y & 0xffff0000u)}; }
                        const f32x4 v = b + acc[ai][bj][m][n];
                        ss += (v[0] * v[0] + v[1] * v[1]) + (v[2] * v[2] + v[3] * v[3]);
                        u32x2 w2; w2.x = cvt_pk_bf16(v[0], v[1]); w2.y = cvt_pk_bf16(v[2], v[3]); *(u32x2*)(xn + o2) = w2; }
                ss += __shfl_xor(ss, 16); ss += __shfl_xor(ss, 32);
                if (fq == 0) ssqp[(size_t)row * 16 + u.pn * 4 + wc] = ss; }
        }
    }
};

template <class Epi, class Sched, bool ALIGN_EPI, bool SP2, int MODE, int LDA, int LDB, int KK>
__device__ __forceinline__ void gemm_phase(PG8_LAS unsigned char* lds, const Gemm g, const Sched& S, const Epi& E) {
    const int tid = threadIdx.x, wid = __builtin_amdgcn_readfirstlane(tid >> 6), lane = tid & 63, wr = wid >> 2, wc = wid & 3, fr = lane & 15, fq = lane >> 4;
    constexpr int K = KK, nt = K / BK;
    unsigned voffA[2], voffB[2];
#pragma unroll
    for (int i = 0; i < 2; ++i) { int R, C; stage_rc(tid * 16 + i * 8192, R, C); const int Rb = Epi::PERM ? ((R & ~31) + perm32(R & 31)) : R;
        voffA[i] = (unsigned)(R * LDA + C) * 2u; voffB[i] = (unsigned)(Rb * LDB + C) * 2u; }
    const size_t kstep = (size_t)(BK * 2);
    const size_t hstepA = (size_t)HALF * LDA * 2, hstepB = (size_t)HALF * LDB * 2;
    const unsigned ldsw = (unsigned)wid * 1024u;
    const int aoff = lds_byte(wr * 64 + fr, fq * 8), boff = lds_byte(wc * 32 + fr, fq * 8);
#define PG8_SA(b, h) (((b) * 2 + (h)) * HTB)
#define PG8_SB(b, h) ((4 + (b) * 2 + (h)) * HTB)
#define PG8_STAGE(bufoff, gbase, voff) do { _Pragma("unroll") for (int _i = 0; _i < 2; ++_i) \
        __builtin_amdgcn_global_load_lds((const unsigned*)((const char*)(gbase) + (voff)[_i]), (PG8_LAS unsigned*)(lds + (bufoff) + ldsw + _i * 8192), 16, 0, 0); } while (0)
#define PG8_LDA(dst, b, h) do { _Pragma("unroll") for (int m = 0; m < 4; ++m) _Pragma("unroll") for (int k = 0; k < 2; ++k) dst[m][k] = *(const PG8_LAS bf16x8*)(lds + PG8_SA(b, h) + aoff + m * 2048 + k * 1024); } while (0)
#define PG8_LDB(dst, b, h) do { _Pragma("unroll") for (int n = 0; n < 2; ++n) _Pragma("unroll") for (int k = 0; k < 2; ++k) dst[n][k] = *(const PG8_LAS bf16x8*)(lds + PG8_SB(b, h) + boff + n * 2048 + k * 1024); } while (0)
#define PG8_MMA(ai, bj, At, Bt) do { __builtin_amdgcn_s_setprio(1); _Pragma("unroll") for (int m = 0; m < 4; ++m) _Pragma("unroll") for (int n = 0; n < 2; ++n) _Pragma("unroll") for (int k = 0; k < 2; ++k) \
        acc[ai][bj][m][n] = __builtin_amdgcn_mfma_f32_16x16x32_bf16(Bt[n][k], At[m][k], acc[ai][bj][m][n], 0, 0, 0); __builtin_amdgcn_s_setprio(0); } while (0)
#define PG8_WAIT_V(n) asm volatile("s_waitcnt vmcnt(" #n ")" ::: "memory")
#define PG8_WAIT_L(n) asm volatile("s_waitcnt lgkmcnt(" #n ")" ::: "memory")
#define PG8_BAR __builtin_amdgcn_s_barrier()
#define PG8_SCHED __builtin_amdgcn_sched_barrier(0)
    Unit cur, nxt; int ui = 0;
    if (!S.next(0, cur)) return;
    f32x4 acc[2][2][4][2];
#pragma unroll
    for (int a = 0; a < 2; ++a)
#pragma unroll
        for (int b = 0; b < 2; ++b)
#pragma unroll
            for (int m = 0; m < 4; ++m)
#pragma unroll
                for (int n = 0; n < 2; ++n) acc[a][b][m][n] = (f32x4){0.f, 0.f, 0.f, 0.f};
    bf16x8 At[4][2], B0[2][2], B1[2][2];
    const char* cA = (const char*)g.A + a_off<MODE, LDA>(cur); const char* cB = (const char*)g.Bt + b_off<MODE, LDB>(cur);
    S.a_ready(cur);
    if constexpr (SP2) {
        PG8_STAGE(PG8_SB(0, 0), cB, voffB); PG8_STAGE(PG8_SB(0, 1), cB + hstepB, voffB); PG8_STAGE(PG8_SA(0, 0), cA, voffA); PG8_STAGE(PG8_SA(0, 1), cA + hstepA, voffA);
        if (wr == 1) PG8_BAR;
        PG8_WAIT_V(2); PG8_BAR;
        PG8_STAGE(PG8_SB(1, 0), cB + kstep, voffB); PG8_STAGE(PG8_SA(1, 0), cA + kstep, voffA); PG8_STAGE(PG8_SB(1, 1), cB + hstepB + kstep, voffB);
        PG8_WAIT_V(6); PG8_BAR;
    } else {
        PG8_STAGE(PG8_SB(0, 0), cB, voffB); PG8_STAGE(PG8_SA(0, 0), cA, voffA); PG8_STAGE(PG8_SB(0, 1), cB + hstepB, voffB); PG8_STAGE(PG8_SA(0, 1), cA + hstepA, voffA);
        if (wr == 1) PG8_BAR;
        PG8_WAIT_V(4); PG8_BAR;
        PG8_STAGE(PG8_SB(1, 0), cB + kstep, voffB); PG8_STAGE(PG8_SA(1, 0), cA + kstep, voffA); PG8_STAGE(PG8_SB(1, 1), cB + hstepB + kstep, voffB);
        PG8_WAIT_V(6); PG8_BAR;
    }
    for (;;) {
        const bool has_next = S.next(ui + 1, nxt);
        const char* nA = has_next ? (const char*)g.A + a_off<MODE, LDA>(nxt) : cA; const char* nB = has_next ? (const char*)g.Bt + b_off<MODE, LDB>(nxt) : cB;
#pragma nounroll
        for (int t = 0; t < nt; t += 2) {
            const bool last = (t == nt - 2);
            const char* a1 = cA + (size_t)(t + 1) * kstep;
            const char* a2 = last ? nA : cA + (size_t)(t + 2) * kstep; const char* b2 = last ? nB : cB + (size_t)(t + 2) * kstep;
            const char* a3 = a2 + kstep; const char* b3 = b2 + kstep;
            if (last && has_next) S.a_ready(nxt);
            if constexpr (SP2) {
            PG8_LDB(B0, 0, 0); PG8_LDB(B1, 0, 1); PG8_SCHED; PG8_LDA(At, 0, 0); PG8_STAGE(PG8_SA(1, 1), a1 + hstepA, voffA);
            PG8_WAIT_V(8); PG8_WAIT_L(0); PG8_BAR; PG8_MMA(0, 0, At, B0); PG8_MMA(0, 1, At, B1); PG8_BAR; PG8_SCHED;
            PG8_LDA(At, 0, 1); PG8_STAGE(PG8_SB(0, 0), b2, voffB); PG8_STAGE(PG8_SB(0, 1), b2 + hstepB, voffB); PG8_STAGE(PG8_SA(0, 0), a2, voffA);
            PG8_WAIT_V(8); PG8_WAIT_L(0); PG8_BAR; PG8_MMA(1, 0, At, B0); PG8_MMA(1, 1, At, B1); PG8_BAR; PG8_SCHED;
            PG8_LDB(B0, 1, 0); PG8_LDB(B1, 1, 1); PG8_SCHED; PG8_LDA(At, 1, 0); PG8_STAGE(PG8_SA(0, 1), a2 + hstepA, voffA);
            PG8_WAIT_V(8); PG8_WAIT_L(0); PG8_BAR; PG8_MMA(0, 0, At, B0); PG8_MMA(0, 1, At, B1); PG8_BAR; PG8_SCHED;
            PG8_LDA(At, 1, 1); PG8_STAGE(PG8_SB(1, 0), b3, voffB); PG8_STAGE(PG8_SB(1, 1), b3 + hstepB, voffB); PG8_STAGE(PG8_SA(1, 0), a3, voffA);
            PG8_WAIT_V(8); PG8_WAIT_L(0); PG8_BAR; PG8_MMA(1, 0, At, B0); PG8_MMA(1, 1, At, B1); PG8_BAR; PG8_SCHED;
            } else {
            PG8_LDB(B0, 0, 0); PG8_SCHED; PG8_LDA(At, 0, 0); PG8_STAGE(PG8_SA(1, 1), a1 + hstepA, voffA);
            PG8_WAIT_L(8); PG8_BAR; PG8_WAIT_L(0); PG8_MMA(0, 0, At, B0); PG8_BAR; PG8_SCHED;
            PG8_LDB(B1, 0, 1); PG8_STAGE(PG8_SB(0, 0), b2, voffB);
            PG8_BAR; PG8_WAIT_L(0); PG8_MMA(0, 1, At, B1); PG8_BAR;
            PG8_LDA(At, 0, 1); PG8_STAGE(PG8_SA(0, 0), a2, voffA);
            PG8_BAR; PG8_WAIT_L(0); PG8_MMA(1, 0, At, B0); PG8_BAR; PG8_SCHED;
            PG8_STAGE(PG8_SB(0, 1), b2 + hstepB, voffB);
            PG8_WAIT_V(6); PG8_BAR; PG8_MMA(1, 1, At, B1); PG8_BAR;
            PG8_LDB(B0, 1, 0); PG8_SCHED; PG8_LDA(At, 1, 0); PG8_STAGE(PG8_SA(0, 1), a2 + hstepA, voffA);
            PG8_WAIT_L(8); PG8_BAR; PG8_WAIT_L(0); PG8_MMA(0, 0, At, B0); PG8_BAR; PG8_SCHED;
            PG8_LDB(B1, 1, 1); PG8_STAGE(PG8_SB(1, 0), b3, voffB);
            PG8_BAR; PG8_WAIT_L(0); PG8_MMA(0, 1, At, B1); PG8_BAR;
            PG8_LDA(At, 1, 1); PG8_STAGE(PG8_SA(1, 0), a3, voffA);
            PG8_BAR; PG8_WAIT_L(0); PG8_MMA(1, 0, At, B0); PG8_BAR; PG8_SCHED;
            PG8_STAGE(PG8_SB(1, 1), b3 + hstepB, voffB);
            PG8_WAIT_V(6); PG8_BAR; PG8_MMA(1, 1, At, B1); PG8_BAR;
            }
        }
        if constexpr (ALIGN_EPI) { if (wr == 0) PG8_BAR; }
        if constexpr (!Epi::AFTER_DRAIN) { E(acc, cur, wr, wc, fr, fq); S.done(cur); }
        if (!has_next) break;
#pragma unroll
        for (int a = 0; a < 2; ++a)
#pragma unroll
            for (int b = 0; b < 2; ++b)
#pragma unroll
                for (int m = 0; m < 4; ++m)
#pragma unroll
                    for (int n = 0; n < 2; ++n) acc[a][b][m][n] = (f32x4){0.f, 0.f, 0.f, 0.f};
        cur = nxt; cA = nA; cB = nB; ++ui;
        if constexpr (ALIGN_EPI) { if (wr == 1) PG8_BAR; }
    }
    PG8_WAIT_V(0);
    if constexpr (!ALIGN_EPI) { if (wr == 0) PG8_BAR; }
    PG8_BAR;
    if constexpr (Epi::AFTER_DRAIN) { E.fused(acc, cur, wr, wc, fr, fq, lds, wid, lane); S.done(cur); }
#undef PG8_SA
#undef PG8_SB
#undef PG8_STAGE
#undef PG8_LDA
#undef PG8_LDB
#undef PG8_MMA
#undef PG8_WAIT_V
#undef PG8_WAIT_L
#undef PG8_BAR
#undef PG8_SCHED
}
}

#define GAS __attribute__((address_space(1)))
#define LAS __attribute__((address_space(3)))
typedef unsigned short bf16;
typedef unsigned v4u __attribute__((ext_vector_type(4)));
typedef unsigned v2u __attribute__((ext_vector_type(2)));
typedef float f32x4 __attribute__((ext_vector_type(4)));
typedef float f32x2 __attribute__((ext_vector_type(2)));
constexpr int NWAVES = 8, NTHREADS = 512;
constexpr int NB = 8, SEQ = 4096, DM = 1024, MTOK = NB * SEQ, NMEMT = 256, MMEM = NB * NMEMT;
constexpr int DINP = 3600, NPROJ = 3584, DFF = 4096, DHY = 512, DML = 512, NHEAD = 4, DHEAD = 128;
constexpr float EPS = 1e-6f;
constexpr size_t MiB = 1u << 20;
constexpr size_t WS_CTL = 0, CTL_ZERO_BYTES = 1 * MiB;
constexpr size_t WS_WIN = 2 * MiB, WS_WOUT = 9 * MiB, WS_WQ = 11 * MiB, WS_WK = 13 * MiB, WS_WV = 15 * MiB, WS_WO = 17 * MiB, WS_W1 = 19 * MiB, WS_W2 = 27 * MiB;
constexpr size_t WS_MEMN = 35 * MiB, WS_KB = 39 * MiB, WS_VT = 43 * MiB, WS_GATES = 47 * MiB, WS_SSQ = 49 * MiB, WS_HID2 = 51 * MiB;
constexpr size_t WS_GF = 53 * MiB, WS_DEC = 55 * MiB;
constexpr size_t WS_XN = 64 * MiB;
constexpr size_t WS_QF = 64 * MiB, WS_KA = 96 * MiB;
constexpr size_t WS_PROJ = 128 * MiB, PROJ_STRIDE = (size_t)MTOK * 512;
constexpr size_t OUT_FILT = 96 * MiB;
constexpr size_t WS_HSPEC = 384 * MiB;
constexpr size_t WS_YT = 448 * MiB;
constexpr size_t WS_MIXED = 352 * MiB;
constexpr size_t WS_KF = 352 * MiB, WS_VF = 416 * MiB;
constexpr size_t WS_STATES = 128 * MiB;
constexpr size_t WS_Q = 352 * MiB, WS_SP = 416 * MiB, WS_AO = 128 * MiB, WS_HID = 192 * MiB;
constexpr size_t WS_END = 512 * MiB;
constexpr int RING_BYTES = 131072, LDSCTL_OFF = 147456, LDS_BYTES = 163840;

__device__ __forceinline__ float bf2f(unsigned short h) { return __uint_as_float(((unsigned)h) << 16); }
__device__ __forceinline__ unsigned f2bf(float f) { unsigned u = __float_as_uint(f); return (u + 0x7fffu + ((u >> 16) & 1u)) >> 16; }
typedef __bf16 bf16x2_t __attribute__((ext_vector_type(2)));
__device__ __forceinline__ unsigned cvtpk(float lo, float hi) { const f32x2 v = {lo, hi}; const bf16x2_t b = __builtin_convertvector(v, bf16x2_t); return __builtin_bit_cast(unsigned, b); }
__device__ __forceinline__ unsigned pk2(float lo, float hi) { return cvtpk(lo, hi); }
__device__ __forceinline__ float wave_sum(float v) {
#pragma unroll
    for (int o = 1; o < 64; o <<= 1) v += __shfl_xor(v, o);
    return v;
}
#define LDS_WAIT() asm volatile("s_waitcnt lgkmcnt(0)" ::: "memory")
__device__ __forceinline__ float logsig(float x) { return fminf(x, 0.f) - log1pf(expf(-fabsf(x))); }

struct Args { const float* in[30]; float* out; unsigned char* ws; int ph_lo, ph_hi; };

__device__ __forceinline__ void p0_transpose_item(const float* W, int ldw, int K, int nblk, bf16* WT, const float* gain, LAS float* scr, int item, int lane) {
    const int kb = item / nblk, nb = item % nblk, k0 = 64 * kb, n0 = 32 * nb;
#pragma unroll 16
    for (int i = 0; i < 32; ++i) { const int kk = 2 * i + (lane >> 5); float w = W[(size_t)(k0 + kk) * ldw + n0 + (lane & 31)]; if (gain) w *= gain[k0 + kk]; scr[kk * 33 + (lane & 31)] = w; }
    LDS_WAIT(); asm volatile("" ::: "memory");
    const int c = lane & 7;
#pragma unroll
    for (int j = 0; j < 4; ++j) { const int n = (lane >> 3) + 8 * j; const LAS float* s = scr + (8 * c) * 33 + n;
        v4u o; o.x = pk2(s[0 * 33], s[1 * 33]); o.y = pk2(s[2 * 33], s[3 * 33]); o.z = pk2(s[4 * 33], s[5 * 33]); o.w = pk2(s[6 * 33], s[7 * 33]);
        *(v4u*)(WT + (size_t)(n0 + n) * K + k0 + 8 * c) = o; }
    LDS_WAIT(); asm volatile("" ::: "memory");
}

__device__ __forceinline__ void p0_prologue(const Args& a, LAS unsigned char* lds, int G, int vcu) {
    const int tid = threadIdx.x, lane = tid & 63, wave = __builtin_amdgcn_readfirstlane(tid >> 6);
    const int gw = vcu * NWAVES + wave, NGW = G * NWAVES;
    unsigned char* ws = a.ws;
    {
        LAS float* scr = (LAS float*)(lds + wave * 16384);
        constexpr int I_IN = 16 * 112, I_SQ = 16 * 32, I_1 = 16 * 128, I_2 = 64 * 32;
        constexpr int NITEMS = I_IN + 5 * I_SQ + I_1 + I_2;
        for (int it = gw; it < NITEMS; it += NGW) {
            int r = it;
            if (r < I_IN) { p0_transpose_item(a.in[3], DINP, DM, 112, (bf16*)(ws + WS_WIN), a.in[2], scr, r, lane); continue; } r -= I_IN;
            if (r < I_SQ) { const int k0 = 64 * (r / 32); const float* g = (k0 < 512) ? a.in[14] : (a.in[18] - 512);
                            p0_transpose_item(a.in[19], DM, DM, 32, (bf16*)(ws + WS_WOUT), g, scr, r, lane); continue; } r -= I_SQ;
            if (r < I_SQ) { p0_transpose_item(a.in[22], DM, DM, 32, (bf16*)(ws + WS_WQ), a.in[20], scr, r, lane); continue; } r -= I_SQ;
            if (r < I_SQ) { p0_transpose_item(a.in[23], DM, DM, 32, (bf16*)(ws + WS_WK), a.in[21], scr, r, lane); continue; } r -= I_SQ;
            if (r < I_SQ) { p0_transpose_item(a.in[24], DM, DM, 32, (bf16*)(ws + WS_WV), a.in[21], scr, r, lane); continue; } r -= I_SQ;
            if (r < I_SQ) { p0_transpose_item(a.in[25], DM, DM, 32, (bf16*)(ws + WS_WO), nullptr, scr, r, lane); continue; } r -= I_SQ;
            if (r < I_1) { p0_transpose_item(a.in[27], DFF, DM, 128, (bf16*)(ws + WS_W1), a.in[26], scr, r, lane); continue; } r -= I_1;
            p0_transpose_item(a.in[28], DM, DFF, 32, (bf16*)(ws + WS_W2), nullptr, scr, r, lane);
        }
    }
    __syncthreads();
    LAS float* Wg = (LAS float*)lds;
#pragma unroll 8
    for (int idx = tid; idx < 16 * DM; idx += NTHREADS) { const int k = idx >> 4, j = idx & 15; Wg[j * DM + k] = a.in[2][k] * a.in[3][(size_t)k * DINP + NPROJ + j]; }
    __syncthreads();
    f32x4 nx[4];
    if (gw < MTOK) {
#pragma unroll
        for (int j = 0; j < 4; ++j) nx[j] = ((const f32x4*)(a.in[0] + (size_t)gw * DM) + lane)[64 * j]; }
    for (int m = gw; m < MTOK; m += NGW) {
        f32x4 v[4]; float ss = 0.f;
#pragma unroll
        for (int j = 0; j < 4; ++j) { v[j] = nx[j]; ss += (v[j][0] * v[j][0] + v[j][1] * v[j][1]) + (v[j][2] * v[j][2] + v[j][3] * v[j][3]); }
        if (m + NGW < MTOK) {
#pragma unroll
            for (int j = 0; j < 4; ++j) nx[j] = ((const f32x4*)(a.in[0] + (size_t)(m + NGW) * DM) + lane)[64 * j]; }
        const float rstd = __builtin_amdgcn_rsqf(wave_sum(ss) * (1.0f / DM) + EPS);
        unsigned long long* o8 = (unsigned long long*)((bf16*)(ws + WS_XN) + (size_t)m * DM) + lane;
#pragma unroll
        for (int j = 0; j < 4; ++j) { v[j] = v[j] * rstd; o8[64 * j] = (unsigned long long)pk2(v[j][0], v[j][1]) | ((unsigned long long)pk2(v[j][2], v[j][3]) << 32); }
        float gs[16];
#pragma unroll
        for (int g = 0; g < 16; ++g) { float s = 0.f;
#pragma unroll
            for (int j = 0; j < 4; ++j) { const f32x4 w = *(const LAS f32x4*)(Wg + g * DM + 4 * lane + 256 * j); s += (v[j][0] * w[0] + v[j][1] * w[1]) + (v[j][2] * w[2] + v[j][3] * w[3]); }
            gs[g] = s; if ((g & 3) == 3) asm volatile("" ::: "memory"); }
#pragma unroll
        for (int j = 0; j < 8; ++j) { const bool up = lane & 1; const float send = up ? gs[j] : gs[j + 8], keep = up ? gs[j + 8] : gs[j]; gs[j] = keep + __shfl_xor(send, 1); }
#pragma unroll
        for (int j = 0; j < 4; ++j) { const bool up = lane & 2; const float send = up ? gs[j] : gs[j + 4], keep = up ? gs[j + 4] : gs[j]; gs[j] = keep + __shfl_xor(send, 2); }
#pragma unroll
        for (int j = 0; j < 2; ++j) { const bool up = lane & 4; const float send = up ? gs[j] : gs[j + 2], keep = up ? gs[j + 2] : gs[j]; gs[j] = keep + __shfl_xor(send, 4); }
        { const bool up = lane & 8; const float send = up ? gs[0] : gs[1], keep = up ? gs[1] : gs[0]; gs[0] = keep + __shfl_xor(send, 8); }
        float tot = gs[0]; tot += __shfl_xor(tot, 16); tot += __shfl_xor(tot, 32);
        const int gi = ((lane & 1) << 3) | ((lane & 2) << 1) | ((lane & 4) >> 1) | ((lane & 8) >> 3);
        if (lane < 16) { float gv = tot + a.in[17][gi]; if (gi & 4) gv = logsig(gv); ((float*)(ws + WS_GATES))[(size_t)m * 16 + gi] = gv; }
    }
    for (int m = gw; m < MMEM; m += NGW) {
        const f32x4* xr = (const f32x4*)(a.in[1] + (size_t)m * DM) + lane;
        f32x4 v[4]; float ss = 0.f;
#pragma unroll
        for (int j = 0; j < 4; ++j) { v[j] = xr[64 * j]; ss += (v[j][0] * v[j][0] + v[j][1] * v[j][1]) + (v[j][2] * v[j][2] + v[j][3] * v[j][3]); }
        const float rstd = 1.0f / sqrtf(wave_sum(ss) * (1.0f / DM) + EPS);
        unsigned long long* o8 = (unsigned long long*)((bf16*)(ws + WS_MEMN) + (size_t)m * DM) + lane;
#pragma unroll
        for (int j = 0; j < 4; ++j) { v[j] = v[j] * rstd; o8[64 * j] = (unsigned long long)pk2(v[j][0], v[j][1]) | ((unsigned long long)pk2(v[j][2], v[j][3]) << 32); }
    }
    for (int t = gw; t < SEQ; t += NGW) {
        const float tl = (float)t * (1.0f / (float)(SEQ - 1)), ang = (6.283185307179586f / (float)SEQ) * (float)t;
        const int mb = lane & 15; const float band = 1e-4f + (float)mb * ((15.0f - 1e-4f) / 15.0f); const float ph = band * ang;
        const float zf = (lane & 16) ? -sinf(ph) : cosf(ph);
        float s = tl * a.in[6][lane];
#pragma unroll 8
        for (int i = 0; i < 32; ++i) s += __shfl(zf, i) * a.in[6][(1 + i) * 64 + lane];
        const float h1 = sinf(a.in[8][lane] * (s + a.in[7][lane]));
        float s2 = 0.f;
#pragma unroll 8
        for (int i = 0; i < 64; ++i) s2 += __shfl(h1, i) * a.in[9][i * 64 + lane];
        const float h2 = sinf(a.in[11][lane] * (s2 + a.in[10][lane]));
        ((float*)(ws + WS_HID2))[(size_t)t * 64 + lane] = h2;
    }
}
__device__ __forceinline__ float sigm(float x) { return __builtin_amdgcn_rcpf(1.0f + __builtin_amdgcn_exp2f(x * -1.4426950408889634f)); }
__device__ __forceinline__ float silu(float x) { return x * sigm(x); }

__device__ __forceinline__ void filters_phase(const Args& a, LAS unsigned char* lds, int G, int vcu) {
    const int tid = threadIdx.x, lane = tid & 63, wave = __builtin_amdgcn_readfirstlane(tid >> 6);
    const int gw = vcu * NWAVES + wave, NGW = G * NWAVES;
    const float* hid2 = (const float*)(a.ws + WS_HID2); float* filt = (float*)((unsigned char*)a.out + OUT_FILT);
    LAS float* hs = (LAS float*)(lds + 73728 + wave * 4096);
    for (int item = gw; item < 32 * 256; item += NGW) {
        const int cg = item & 31, tb = item >> 5, t0 = tb * 16, ch = cg * 64 + lane, c = ch & 511;
#pragma unroll
        for (int i = 0; i < 4; ++i) *(LAS f32x4*)(hs + (lane + 64 * i) * 4) = *(const f32x4*)(hid2 + (size_t)t0 * 64 + (lane + 64 * i) * 4);
        LDS_WAIT();
        float acc[16];
#pragma unroll
        for (int i = 0; i < 16; ++i) acc[i] = 0.f;
#pragma nounroll
        for (int j4 = 0; j4 < 16; ++j4) {
            const float w0 = a.in[12][(size_t)(4 * j4 + 0) * 2048 + ch], w1 = a.in[12][(size_t)(4 * j4 + 1) * 2048 + ch], w2 = a.in[12][(size_t)(4 * j4 + 2) * 2048 + ch], w3 = a.in[12][(size_t)(4 * j4 + 3) * 2048 + ch];
#pragma unroll
            for (int i = 0; i < 16; ++i) { const f32x4 h4 = *(const LAS f32x4*)(hs + i * 64 + 4 * j4); acc[i] += (h4[0] * w0 + h4[1] * w1) + (h4[2] * w2 + h4[3] * w3); }
        }
        const float mind = -3.0701134573253944f, maxd = -15.350567286626972f;
        const float ad = fabsf(mind + (float)c * ((maxd - mind) / 511.0f));
        float* dst = filt + (size_t)ch * SEQ + t0;
#pragma unroll
        for (int i4 = 0; i4 < 4; ++i4) { f32x4 o;
#pragma unroll
            for (int e = 0; e < 4; ++e) { const float tl = (float)(t0 + 4 * i4 + e) * (1.0f / (float)(SEQ - 1)); o[e] = acc[4 * i4 + e] * expf(-tl * ad); }
            *(f32x4*)(dst + 4 * i4) = o; }
        LDS_WAIT();
    }
}
__device__ __forceinline__ void softmax_rows(const Args& a, int G, int vcu) {
    const int tid = threadIdx.x, lane = tid & 63, wave = __builtin_amdgcn_readfirstlane(tid >> 6);
    const int gw = vcu * NWAVES + wave, NGW = G * NWAVES;
    bf16* sp = (bf16*)(a.ws + WS_SP);
    for (int m = gw; m < MTOK; m += NGW) {
        v4u* p = (v4u*)(sp + (size_t)m * DM + 16 * lane);
        const v4u r0 = p[0], r1 = p[1];
        float v[16];
        const unsigned w[8] = {r0.x, r0.y, r0.z, r0.w, r1.x, r1.y, r1.z, r1.w};
        float mx = -1e30f;
#pragma unroll
        for (int e = 0; e < 8; ++e) { v[2 * e] = __uint_as_float(w[e] << 16) * 0.0625f; v[2 * e + 1] = __uint_as_float(w[e] & 0xffff0000u) * 0.0625f; mx = fmaxf(mx, fmaxf(v[2 * e], v[2 * e + 1])); }
        mx = fmaxf(mx, __shfl_xor(mx, 1)); mx = fmaxf(mx, __shfl_xor(mx, 2)); mx = fmaxf(mx, __shfl_xor(mx, 4)); mx = fmaxf(mx, __shfl_xor(mx, 8));
        float sum = 0.f;
#pragma unroll
        for (int e = 0; e < 16; ++e) { v[e] = expf(v[e] - mx); sum += v[e]; }
        sum += __shfl_xor(sum, 1); sum += __shfl_xor(sum, 2); sum += __shfl_xor(sum, 4); sum += __shfl_xor(sum, 8);
        const float inv = 1.0f / sum;
        v4u o0, o1;
        o0.x = pk2(v[0] * inv, v[1] * inv); o0.y = pk2(v[2] * inv, v[3] * inv); o0.z = pk2(v[4] * inv, v[5] * inv); o0.w = pk2(v[6] * inv, v[7] * inv);
        o1.x = pk2(v[8] * inv, v[9] * inv); o1.y = pk2(v[10] * inv, v[11] * inv); o1.z = pk2(v[12] * inv, v[13] * inv); o1.w = pk2(v[14] * inv, v[15] * inv);
        p[0] = o0; p[1] = o1;
    }
}
__device__ __forceinline__ void final_norm(const Args& a, int G, int vcu) {
    const int tid = threadIdx.x, lane = tid & 63, wave = __builtin_amdgcn_readfirstlane(tid >> 6);
    const int gw = vcu * NWAVES + wave, NGW = G * NWAVES;
    const bf16* xn = (const bf16*)(a.ws + WS_XN);
    f32x4 g4[4];
#pragma unroll
    for (int j = 0; j < 4; ++j) g4[j] = *((const f32x4*)a.in[29] + 4 * lane + j);
    for (int m = gw; m < MTOK; m += NGW) {
        const v4u* p = (const v4u*)(xn + (size_t)m * DM + 16 * lane);
        const v4u r0 = p[0], r1 = p[1];
        const unsigned w[8] = {r0.x, r0.y, r0.z, r0.w, r1.x, r1.y, r1.z, r1.w};
        float v[16]; float ss = 0.f;
#pragma unroll
        for (int e = 0; e < 8; ++e) { v[2 * e] = __uint_as_float(w[e] << 16); v[2 * e + 1] = __uint_as_float(w[e] & 0xffff0000u); ss += v[2 * e] * v[2 * e] + v[2 * e + 1] * v[2 * e + 1]; }
        const float rstd = __builtin_amdgcn_rsqf(wave_sum(ss) * (1.0f / DM) + EPS);
        f32x4* o = (f32x4*)(a.out + (size_t)m * DM + 16 * lane);
#pragma unroll
        for (int j = 0; j < 4; ++j) o[j] = (f32x4){v[4 * j] * rstd * g4[j][0], v[4 * j + 1] * rstd * g4[j][1], v[4 * j + 2] * rstd * g4[j][2], v[4 * j + 3] * rstd * g4[j][3]};
    }
}
__device__ __forceinline__ f32x2 cmul(f32x2 a, f32x2 b) { return (f32x2){a.x * b.x - a.y * b.y, a.x * b.y + a.y * b.x}; }
__device__ __forceinline__ f32x2 cmulc(f32x2 a, f32x2 b) { return (f32x2){a.x * b.x + a.y * b.y, a.y * b.x - a.x * b.y}; }
template <bool INV> __device__ __forceinline__ void dft4(f32x2& x0, f32x2& x1, f32x2& x2, f32x2& x3) {
    const f32x2 s02 = x0 + x2, d02 = x0 - x2, s13 = x1 + x3, d13 = x1 - x3;
    const f32x2 jd = INV ? (f32x2){-d13.y, d13.x} : (f32x2){d13.y, -d13.x};
    x0 = s02 + s13; x1 = d02 + jd; x2 = s02 - s13; x3 = d02 - jd;
}
template <bool INV> __device__ __forceinline__ void fft16(f32x2 (&v)[16]) {
    constexpr float C1 = 0.9238795325112867f, S1 = 0.3826834323650898f, R2 = 0.7071067811865476f;
    constexpr float WR[10] = {1.f, C1, R2, S1, 0.f, 0.f, -R2, 0.f, 0.f, -C1};
    constexpr float WI[10] = {0.f, -S1, -R2, -C1, -1.f, 0.f, -R2, 0.f, 0.f, S1};
#pragma unroll
    for (int b = 0; b < 4; ++b) {
        dft4<INV>(v[b], v[4 + b], v[8 + b], v[12 + b]);
#pragma unroll
        for (int c = 1; c < 4; ++c) { if (b == 0) continue; const f32x2 w = {WR[b * c], INV ? -WI[b * c] : WI[b * c]}; v[4 * c + b] = cmul(v[4 * c + b], w); }
    }
    f32x2 o[16];
#pragma unroll
    for (int c = 0; c < 4; ++c) {
        f32x2 y0 = v[4 * c + 0], y1 = v[4 * c + 1], y2 = v[4 * c + 2], y3 = v[4 * c + 3];
        dft4<INV>(y0, y1, y2, y3);
        o[c] = y0; o[c + 4] = y1; o[c + 8] = y2; o[c + 12] = y3;
    }
#pragma unroll
    for (int k = 0; k < 16; ++k) v[k] = o[k];
}
__device__ __forceinline__ f32x2 w32c(int a) {
    constexpr float CR[16] = {1.f, 0.9807852804032304f, 0.9238795325112867f, 0.8314696123025452f, 0.7071067811865476f, 0.5555702330196022f, 0.3826834323650898f, 0.1950903220161283f,
                              0.f, -0.1950903220161283f, -0.3826834323650898f, -0.5555702330196022f, -0.7071067811865476f, -0.8314696123025452f, -0.9238795325112867f, -0.9807852804032304f};
    constexpr float CI[16] = {0.f, -0.1950903220161283f, -0.3826834323650898f, -0.5555702330196022f, -0.7071067811865476f, -0.8314696123025452f, -0.9238795325112867f, -0.9807852804032304f,
                              -1.f, -0.9807852804032304f, -0.9238795325112867f, -0.8314696123025452f, -0.7071067811865476f, -0.5555702330196022f, -0.3826834323650898f, -0.1950903220161283f};
    return (f32x2){CR[a], CI[a]};
}
constexpr int HY_BUF_BYTES = 34816, HY_TW1_OFF = 2 * HY_BUF_BYTES, HY_TW2_OFF = HY_TW1_OFF + 32768;
__device__ __forceinline__ void hy_fwd(LAS f32x2* hb, int half, int u, f32x2 wu, const LAS f32x2* tw1, const LAS f32x2* tw2, f32x2 (&V)[16]) {
    const int p1 = u + (u >> 4), p2 = 272 * (u >> 4) + (u & 15), p3 = 17 * u;
#pragma unroll
    for (int k = 0; k < 16; ++k) V[k] = hb[272 * k + p1];
    if (half) {
#pragma unroll
        for (int k = 1; k < 16; ++k) V[k] = cmul(V[k], w32c(k));
    }
    fft16<false>(V);
#pragma unroll
    for (int k = 0; k < 16; ++k) { if (k == 0 && !half) continue; V[k] = cmul(V[k], tw1[k * 256 + u]); }
#pragma unroll
    for (int k = 0; k < 16; ++k) hb[272 * k + p1] = V[k];
    __syncthreads();
#pragma unroll
    for (int k = 0; k < 16; ++k) V[k] = hb[p2 + 17 * k];
    fft16<false>(V);
#pragma unroll
    for (int k = 1; k < 16; ++k) V[k] = cmul(V[k], tw2[k * 16 + (u & 15)]);
#pragma unroll
    for (int k = 0; k < 16; ++k) hb[p2 + 17 * k] = V[k];
    __syncthreads();
#pragma unroll
    for (int k = 0; k < 16; ++k) V[k] = hb[p3 + k];
    fft16<false>(V);
}
__device__ __forceinline__ void hy_inv(LAS f32x2* hb, int half, int u, f32x2 wu, const LAS f32x2* tw1, const LAS f32x2* tw2, f32x2 (&V)[16]) {
    const int p1 = u + (u >> 4), p2 = 272 * (u >> 4) + (u & 15), p3 = 17 * u;
    fft16<true>(V);
#pragma unroll
    for (int k = 1; k < 16; ++k) V[k] = cmulc(V[k], tw2[k * 16 + (u & 15)]);
#pragma unroll
    for (int k = 0; k < 16; ++k) hb[p3 + k] = V[k];
    __syncthreads();
#pragma unroll
    for (int k = 0; k < 16; ++k) V[k] = hb[p2 + 17 * k];
    fft16<true>(V);
#pragma unroll
    for (int k = 0; k < 16; ++k) V[k] = cmulc(V[k], tw1[(u >> 4) * 256 + 16 * k + (u & 15)]);
#pragma unroll
    for (int k = 0; k < 16; ++k) hb[p2 + 17 * k] = V[k];
    __syncthreads();
#pragma unroll
    for (int k = 0; k < 16; ++k) V[k] = hb[272 * k + p1];
    fft16<true>(V);
    if (half) {
#pragma unroll
        for (int k = 1; k < 16; ++k) V[k] = cmulc(V[k], w32c(k));
    }
#pragma unroll
    for (int k = 0; k < 16; ++k) hb[272 * k + p1] = V[k];
}
__device__ __forceinline__ int hpos(int n) { return n + (n >> 4); }
typedef __amdgpu_buffer_rsrc_t rsrc_t;
typedef unsigned u32x2v __attribute__((ext_vector_type(2)));
__device__ __forceinline__ rsrc_t mkrsrc(const void* p, unsigned bytes) { return __builtin_amdgcn_make_buffer_rsrc((void*)p, 0, bytes, 0x00020000); }
__device__ __forceinline__ float bld_bf16(rsrc_t r, unsigned off) { return bf2f(__builtin_amdgcn_raw_buffer_load_b16(r, off, 0, 0)); }
__device__ __forceinline__ float bld_bf16s(rsrc_t r, unsigned off, unsigned soff) { return bf2f(__builtin_amdgcn_raw_buffer_load_b16(r, off, soff, 0)); }
__device__ __forceinline__ float bld_f32(rsrc_t r, unsigned off, unsigned soff = 0) { return __uint_as_float(__builtin_amdgcn_raw_buffer_load_b32(r, off, soff, 0)); }
typedef unsigned u32x4b __attribute__((ext_vector_type(4)));
__device__ __forceinline__ v4u bld128(rsrc_t r, unsigned voff, unsigned soff) { const u32x4b w = __builtin_amdgcn_raw_buffer_load_b128(r, voff, soff, 0); return (v4u){w.x, w.y, w.z, w.w}; }
__device__ __forceinline__ v2u bld64(rsrc_t r, unsigned voff, unsigned soff) { const u32x2v w = __builtin_amdgcn_raw_buffer_load_b64(r, voff, soff, 0); return (v2u){w.x, w.y}; }
template <int O> __device__ __forceinline__ void hy_order(const Args& a, LAS f32x2* bufE, LAS f32x2* bufO, LAS f32x2* hb, int half, int u, f32x2 wu, const LAS f32x2* t1, const LAS f32x2* tw2,
                                                          rsrc_t rH, f32x2 (&xin)[8], int c, int b0, float skip) {
    const int tid = threadIdx.x;
    const bf16* hyT = (const bf16*)a.out; bf16* yT = (bf16*)(a.ws + WS_YT);
    f32x2 V[16];
    u32x2v hw[16];
#pragma unroll
    for (int k = 0; k < 16; ++k) hw[k] = __builtin_amdgcn_raw_buffer_load_b64(rH, tid * 8, (O * 16 + k) * 4096, 0);
    __syncthreads();
    hy_fwd(hb, half, u, wu, t1, tw2, V);
    const rsrc_t rg0 = mkrsrc(hyT + ((size_t)b0 * 1536 + 512 * (O + 1) + c) * SEQ, SEQ * 2), rg1 = mkrsrc(hyT + ((size_t)(b0 + 1) * 1536 + 512 * (O + 1) + c) * SEQ, SEQ * 2);
    unsigned short gw0[8], gw1[8];
#pragma unroll
    for (int i = 0; i < 8; ++i) { gw0[i] = __builtin_amdgcn_raw_buffer_load_b16(rg0, (tid + 512 * i) * 2, 0, 0); gw1[i] = __builtin_amdgcn_raw_buffer_load_b16(rg1, (tid + 512 * i) * 2, 0, 0); }
#pragma unroll
    for (int k = 0; k < 16; ++k) V[k] = cmul(V[k], (f32x2){__uint_as_float(hw[k].x), __uint_as_float(hw[k].y)});
    hy_inv(hb, half, u, wu, t1, tw2, V);
    __syncthreads();
    const rsrc_t ry0 = mkrsrc(yT + ((size_t)b0 * 512 + c) * SEQ, SEQ * 2), ry1 = mkrsrc(yT + ((size_t)(b0 + 1) * 512 + c) * SEQ, SEQ * 2);
#pragma unroll
    for (int i = 0; i < 8; ++i) { const int n = tid + 512 * i, p = hpos(n);
        const f32x2 y = (bufE[p] + bufO[p]) * (1.0f / 8192.0f);
        f32x2 r; r.x = bf2f(gw0[i]) * (y.x + skip * xin[i].x); r.y = bf2f(gw1[i]) * (y.y + skip * xin[i].y);
        if (O == 0) { xin[i] = r; bufE[p] = r; bufO[p] = r; }
        else { __builtin_amdgcn_raw_buffer_store_b16((unsigned short)(cvtpk(r.x, 0.f) & 0xffffu), ry0, n * 2, 0, 0); __builtin_amdgcn_raw_buffer_store_b16((unsigned short)(cvtpk(r.y, 0.f) & 0xffffu), ry1, n * 2, 0, 0); } }
}
__device__ __forceinline__ void hyena_fft(const Args& a, LAS unsigned char* lds, int G, int vcu) {
    const int tid = threadIdx.x, half = __builtin_amdgcn_readfirstlane(tid >> 8), u = tid & 255;
    LAS f32x2* bufE = (LAS f32x2*)lds; LAS f32x2* bufO = (LAS f32x2*)(lds + HY_BUF_BYTES);
    LAS f32x2* tw1 = (LAS f32x2*)(lds + HY_TW1_OFF); LAS f32x2* tw2 = (LAS f32x2*)(lds + HY_TW2_OFF);
    LAS f32x2* hb = half ? bufO : bufE;
    LAS f32x2* tw1o = (LAS f32x2*)(lds + HY_TW2_OFF + 2048);
    const LAS f32x2* t1 = half ? tw1o : tw1;
    const bf16* hyT = (const bf16*)a.out; const float* filt = (const float*)((const unsigned char*)a.out + OUT_FILT);
    __syncthreads();
    for (int idx = tid; idx < 4096; idx += NTHREADS) { const int m = (idx & 255) * (idx >> 8); float s, c; sincospif((float)m * (1.0f / 2048.0f), &s, &c); tw1[idx] = (f32x2){c, -s};
        sincospif((float)(2 * m + (idx & 255)) * (1.0f / 4096.0f), &s, &c); tw1o[idx] = (f32x2){c, -s}; }
    if (tid < 256) { const int m = 16 * (tid & 15) * (tid >> 4); float s, c; sincospif((float)m * (1.0f / 2048.0f), &s, &c); tw2[tid] = (f32x2){c, -s}; }
    f32x2 wu; { float s, c; sincospif((float)u * (1.0f / 4096.0f), &s, &c); wu = (f32x2){c, -s}; }
    const rsrc_t rH = mkrsrc(a.ws + WS_HSPEC + (size_t)blockIdx.x * (2 * 16 * NTHREADS * 8), 2 * 16 * NTHREADS * 8);
    for (int c = vcu; c < DHY; c += G) {
#pragma nounroll
        for (int o = 0; o < 2; ++o) {
            const rsrc_t rf = mkrsrc(filt + ((size_t)(o * 2 + 0) * 512 + c) * SEQ, SEQ * 4), rk = mkrsrc(filt + ((size_t)(o * 2 + 1) * 512 + c) * SEQ, SEQ * 4);
            __syncthreads();
#pragma unroll
            for (int i = 0; i < 8; ++i) { const int n = tid + 512 * i, p = hpos(n); const float f = bld_f32(rf, n * 4); float r = bld_f32(rk, (SEQ - n) * 4); r = (n >= 1) ? r : 0.f;
                bufE[p] = (f32x2){f + r, 0.f}; bufO[p] = (f32x2){f - r, 0.f}; }
            __syncthreads();
            f32x2 V[16];
            hy_fwd(hb, half, u, wu, t1, tw2, V);
#pragma unroll
            for (int k = 0; k < 16; ++k) { u32x2v w; w.x = __float_as_uint(V[k].x); w.y = __float_as_uint(V[k].y); __builtin_amdgcn_raw_buffer_store_b64(w, rH, tid * 8, (o * 16 + k) * 4096, 0); }
        }
        const float skip0 = a.in[13][c], skip1 = a.in[13][512 + c];
#pragma nounroll
        for (int pr = 0; pr < 4; ++pr) {
            const int b0 = 2 * pr;
            f32x2 xin[8];
            const rsrc_t rv0 = mkrsrc(hyT + ((size_t)b0 * 1536 + c) * SEQ, SEQ * 2), rv1 = mkrsrc(hyT + ((size_t)(b0 + 1) * 1536 + c) * SEQ, SEQ * 2);
            __syncthreads();
#pragma unroll
            for (int i = 0; i < 8; ++i) { const int n = tid + 512 * i, p = hpos(n); xin[i] = (f32x2){bld_bf16(rv0, n * 2), bld_bf16(rv1, n * 2)}; bufE[p] = xin[i]; bufO[p] = xin[i]; }
            hy_order<0>(a, bufE, bufO, hb, half, u, wu, t1, tw2, rH, xin, c, b0, skip0);
            hy_order<1>(a, bufE, bufO, hb, half, u, wu, t1, tw2, rH, xin, c, b0, skip1);
        }
    }
    __syncthreads();
}
typedef short bf16x8 __attribute__((ext_vector_type(8)));
typedef float f32x16 __attribute__((ext_vector_type(16)));
#define MFMA32(a, b, c) __builtin_amdgcn_mfma_f32_32x32x16_bf16((a), (b), (c), 0, 0, 0)
__device__ __forceinline__ int crow(int r, int h) { return (r & 3) + 8 * (r >> 2) + 4 * h; }
__device__ __forceinline__ bf16x8 scale_frag(v4u raw, float s) {
    v4u o;
#pragma unroll
    for (int e = 0; e < 4; ++e) o[e] = cvtpk(__uint_as_float(raw[e] << 16) * s, __uint_as_float(raw[e] & 0xffff0000u) * s);
    return __builtin_bit_cast(bf16x8, o);
}
__device__ __forceinline__ bf16x8 scale_frag8(v4u raw, f32x4 s0, f32x4 s1) {
    v4u o;
    o[0] = cvtpk(__uint_as_float(raw[0] << 16) * s0[0], __uint_as_float(raw[0] & 0xffff0000u) * s0[1]);
    o[1] = cvtpk(__uint_as_float(raw[1] << 16) * s0[2], __uint_as_float(raw[1] & 0xffff0000u) * s0[3]);
    o[2] = cvtpk(__uint_as_float(raw[2] << 16) * s1[0], __uint_as_float(raw[2] & 0xffff0000u) * s1[1]);
    o[3] = cvtpk(__uint_as_float(raw[3] << 16) * s1[2], __uint_as_float(raw[3] & 0xffff0000u) * s1[3]);
    return __builtin_bit_cast(bf16x8, o);
}
__device__ __forceinline__ float incl_prefix(float x, int lane) {
#pragma unroll
    for (int d = 1; d < 64; d <<= 1) { const float t = __shfl_up(x, d); if (lane >= d) x += t; }
    return x;
}
__device__ __forceinline__ float incl_suffix(float x, int lane) {
#pragma unroll
    for (int d = 1; d < 64; d <<= 1) { const float t = __shfl_down(x, d); if (lane + d < 64) x += t; }
    return x;
}
__device__ __forceinline__ void gate_factors(const Args& a, int G, int vcu) {
    const int tid = threadIdx.x, lane = tid & 63, wave = __builtin_amdgcn_readfirstlane(tid >> 6);
    const int gw = vcu * NWAVES + wave, NGW = G * NWAVES;
    const float* gates = (const float*)(a.ws + WS_GATES); float* gf = (float*)(a.ws + WS_GF); float* dec = (float*)(a.ws + WS_DEC);
    for (int task = gw; task < NB * NHEAD * 64; task += NGW) {
        const int b = task >> 8, hh = (task >> 6) & 3, j = task & 63; const size_t row = (size_t)b * SEQ + j * 64 + lane;
        const float* gp = gates + row * 16 + hh;
        const float i_f = gp[0], a_f = gp[4], i_b = gp[8], a_b = gp[12];
        const float F = incl_prefix(a_f, lane), Gs = incl_suffix(a_b, lane);
        *(f32x4*)(gf + row * 16 + hh * 4) = (f32x4){expf(F), expf(i_f - F), expf(Gs), expf(i_b - Gs)};
        if (lane == 63) dec[(size_t)task * 2] = expf(F);
        if (lane == 0) dec[(size_t)task * 2 + 1] = expf(Gs);
    }
}
__device__ __forceinline__ void mlstm_scan(const Args& a, LAS unsigned char* lds, int G, int vcu) {
    int tid = threadIdx.x; asm volatile("" : "+v"(tid));
    const int lane = tid & 63, wave = __builtin_amdgcn_readfirstlane(tid >> 6), l31 = lane & 31, h = lane >> 5;
    const int gw = wave * G + vcu, NGW = G * NWAVES;
    LAS float* wsc = (LAS float*)(lds + wave * 1024);
    const bf16* KFp = (const bf16*)(a.ws + WS_KF); const bf16* VFp = (const bf16*)(a.ws + WS_VF);
    const float* gf = (const float*)(a.ws + WS_GF); const float* dec = (const float*)(a.ws + WS_DEC); bf16* ST = (bf16*)(a.ws + WS_STATES); bf16* NV = (bf16*)(a.ws + WS_STATES + 128 * MiB);
    for (int cd = vcu; cd < 64 * 4; cd += G) { if (wave >= 5) break;
        const int chain = cd >> 2, dt = cd & 3, nt = wave;
        const int b = chain >> 3, hh = (chain >> 1) & 3, dir = chain & 1;
        f32x16 acc;
#pragma unroll
        for (int r = 0; r < 16; ++r) acc[r] = 0.f;
        const rsrc_t rva = mkrsrc(VFp + (size_t)((b * 4 + hh) * 64) * 8192, 64 * 16384), rkb = mkrsrc(KFp + (size_t)((b * 4 + hh) * 64) * 8192, 64 * 16384);
        const rsrc_t rgf = mkrsrc(gf + (size_t)b * SEQ * 16, SEQ * 64);
        const unsigned vo = lane * 16 + (nt < 4 ? nt : 0) * 4096, ko = lane * 16 + dt * 4096, go = lane * 64 + (hh * 4 + 2 * dir + 1) * 4;
        const float* dbase = dec + (size_t)((b * 4 + hh) * 64) * 2 + dir;
        const v4u ones = {0x3f803f80u, 0x3f803f80u, 0x3f803f80u, 0x3f803f80u}, zeros = {0u, 0u, 0u, 0u};
        struct Stg { v4u ar[4]; bf16x8 br[4]; float be, dc; };
#define SCAN_LOAD(S, jq) do { const int jc_ = (jq) < 0 ? 0 : ((jq) > 63 ? 63 : (jq)); const int j_ = dir ? 63 - jc_ : jc_; _Pragma("unroll") for (int ks = 0; ks < 4; ++ks) { \
            S.ar[ks] = bld128(rva, vo + ks * 1024, j_ * 16384); S.br[ks] = __builtin_bit_cast(bf16x8, bld128(rkb, ko + ks * 1024, j_ * 16384)); } S.be = bld_f32(rgf, go, j_ * 4096); S.dc = dbase[j_ * 2]; } while (0)
#define SCAN_STEP(S, jq) do { const int j_ = dir ? 63 - (jq) : (jq); \
            wsc[lane] = S.be; const float decay = S.dc; \
            if (nt < 4) { bf16* sp = ST + ((size_t)(chain * 64 + j_) * 32 + nt * 8 + 2 * dt + (l31 >> 4)) * 512 + (((l31 >> 3) & 1) * 32) * 8 + (l31 & 7); \
                _Pragma("unroll") for (int r = 0; r < 16; ++r) sp[crow(r, h) * 8] = (bf16)f2bf(acc[r]); } \
            else if (h == 0) NV[(size_t)(chain * 64 + j_) * 128 + 32 * dt + l31] = (bf16)f2bf(acc[0]);     \
            _Pragma("unroll") for (int ks = 0; ks < 4; ++ks) { v4u araw = S.ar[ks]; if (nt == 4) araw = (l31 == 0) ? ones : zeros; \
                const f32x4 b0 = *(const LAS f32x4*)(wsc + 16 * ks + 4 * h), b1 = *(const LAS f32x4*)(wsc + 16 * ks + 8 + 4 * h); \
                acc = MFMA32(scale_frag8(araw, b0, b1), S.br[ks], acc); } \
            _Pragma("unroll") for (int r = 0; r < 16; ++r) acc[r] *= decay; } while (0)
        Stg s0, s1, s2;
        SCAN_LOAD(s0, 0); SCAN_LOAD(s1, 1);
#pragma nounroll
        for (int jj = 0; jj < 63; jj += 3) {
            SCAN_LOAD(s2, jj + 2); SCAN_STEP(s0, jj);
            SCAN_LOAD(s0, jj + 3); SCAN_STEP(s1, jj + 1);
            SCAN_LOAD(s1, jj + 4); SCAN_STEP(s2, jj + 2);
        }
        SCAN_STEP(s0, 63);
#undef SCAN_LOAD
#undef SCAN_STEP
    }
}
constexpr int ML_WAVE_LDS = 18432, ML_YROW = 136;
__device__ __forceinline__ void mlstm_out(const Args& a, LAS unsigned char* lds, int G, int vcu) {
    int tid = threadIdx.x; asm volatile("" : "+v"(tid));
    const int lane = tid & 63, wave = __builtin_amdgcn_readfirstlane(tid >> 6), l31 = lane & 31, h = lane >> 5;
    const int gw = vcu * NWAVES + wave, NGW = G * NWAVES;
    LAS float* sc = (LAS float*)(lds + wave * ML_WAVE_LDS);
    LAS bf16* ybuf = (LAS bf16*)(lds + wave * ML_WAVE_LDS + 1024); LAS float* rsb = (LAS float*)(lds + wave * ML_WAVE_LDS + 1024 + 32 * ML_YROW * 2);
    LAS float* ivb = rsb + 32;
    LAS v4u* pfl = (LAS v4u*)(lds + wave * ML_WAVE_LDS + 10240) + lane;
    const unsigned char* QFp = a.ws + WS_QF; const unsigned char* KAp = a.ws + WS_KA; const unsigned char* VFp = a.ws + WS_VF;
    const bf16* om = (const bf16*)(a.ws + WS_PROJ) + 6 * PROJ_STRIDE; const float* gf = (const float*)(a.ws + WS_GF);
    const bf16* ST = (const bf16*)(a.ws + WS_STATES); const bf16* NV = (const bf16*)(a.ws + WS_STATES + 128 * MiB); bf16* mixed = (bf16*)(a.ws + WS_MIXED);
    const unsigned lo = lane * 16;
    for (int t4 = vcu * NWAVES; t4 < NB * NHEAD * 64; t4 += NGW)
    for (int rr = 0; rr < 2; ++rr) {
        const int task = t4 + rr * 4 + (wave & 3);
        const int b = task >> 8, hh = (task >> 6) & 3, j = task & 63, t0 = j * 64, row0 = b * SEQ + t0;
        { const f32x4 g4 = *(const f32x4*)(gf + (size_t)(row0 + lane) * 16 + hh * 4);
          sc[lane] = g4[0]; sc[64 + lane] = g4[1]; sc[128 + lane] = g4[2]; sc[192 + lane] = g4[3]; }
        const size_t fo = (size_t)(((b * 4 + hh) * 64 + j)) * 16384;
        const rsrc_t rq = mkrsrc(QFp + fo, 16384), rk = mkrsrc(KAp + fo, 16384), rv = mkrsrc(VFp + fo, 16384);
        const rsrc_t rs0 = mkrsrc(ST + ((size_t)(((b * 4 + hh) * 2 + 0) * 64 + j) * 32) * 512, 32768), rs1 = mkrsrc(ST + ((size_t)(((b * 4 + hh) * 2 + 1) * 64 + j) * 32) * 512, 32768);
        const rsrc_t rn0 = mkrsrc(NV + (size_t)(((b * 4 + hh) * 2 + 0) * 64 + j) * 128, 256), rn1 = mkrsrc(NV + (size_t)(((b * 4 + hh) * 2 + 1) * 64 + j) * 128, 256);
        const unsigned lon = (l31 == 0) ? (unsigned)(16 * h) : 0x40000000u;
        const rsrc_t ro = mkrsrc(om + (size_t)row0 * 512 + hh * 128, 64 * 1024), rm = mkrsrc(mixed + (size_t)row0 * DM + 512 + hh * 128, 64 * 2048);
        {
            const int ti = wave >> 2;
            const int t = 32 * ti + l31;
            v4u qf[8];
#pragma unroll
            for (int ks = 0; ks < 8; ++ks) qf[ks] = bld128(rq, lo, ti * 8192 + 1024 * ks);
            {
                f32x16 X[2];
#pragma unroll
                for (int r = 0; r < 16; ++r) { X[0][r] = 0.f; X[1][r] = 0.f; }
                v4u xa[8], xb[8];
#pragma unroll
                for (int ks = 0; ks < 8; ++ks) { xa[ks] = bld128(rk, lo, 1024 * ks); xb[ks] = bld128(rk, lo, 8192 + 1024 * ks); }
#pragma unroll
                for (int ks = 0; ks < 8; ++ks) { const bf16x8 Bq = __builtin_bit_cast(bf16x8, qf[ks]);
                    X[0] = MFMA32(__builtin_bit_cast(bf16x8, xa[ks]), Bq, X[0]); X[1] = MFMA32(__builtin_bit_cast(bf16x8, xb[ks]), Bq, X[1]); }
                asm volatile("" ::: "memory");
#pragma unroll
                for (int si = 0; si < 2; ++si)
#pragma unroll
                    for (int ss = 0; ss < 2; ++ss) {
                        v4u pf, pb;
#pragma unroll
                        for (int e = 0; e < 4; ++e) { float f2[2], b2[2];
#pragma unroll
                            for (int q2 = 0; q2 < 2; ++q2) { const int r = 8 * ss + 2 * e + q2, s = 32 * si + crow(r, h);
                                const float x = X[si][r], bef = sc[64 + s], beb = sc[192 + s];
                                const float vf = x * bef, vb = x * beb;
                                f2[q2] = (s <= t) ? vf : 0.f; b2[q2] = (s >= t) ? vb : 0.f; }
                            pf[e] = cvtpk(f2[0], f2[1]); pb[e] = cvtpk(b2[0], b2[1]); }
                        pfl[(si * 2 + ss) * 64] = pf; pfl[(4 + si * 2 + ss) * 64] = pb;
                    }
            }
            v4u F[8];
#define ML_COMP(D, RN, VO, SB, SS) do { \
        _Pragma("unroll") for (int ks = 0; ks < 8; ++ks) { D = MFMA32(__builtin_bit_cast(bf16x8, qf[ks]), __builtin_bit_cast(bf16x8, F[ks]), D); F[ks] = bld128(RN, VO, (SB) + (SS) * ks); asm volatile("" ::: "memory"); } } while (0)
#define ML_PV(vf_) do { _Pragma("unroll") for (int r = 0; r < 16; ++r) { df[r] = 0.f; db[r] = 0.f; } \
        _Pragma("unroll") for (int si = 0; si < 2; ++si) _Pragma("unroll") for (int ss = 0; ss < 2; ++ss) { const bf16x8 B_ = __builtin_bit_cast(bf16x8, vf_[si * 2 + ss]); \
            if (si <= ti) df = MFMA32(__builtin_bit_cast(bf16x8, pfl[(si * 2 + ss) * 64]), B_, df); if (si >= ti) db = MFMA32(__builtin_bit_cast(bf16x8, pfl[(4 + si * 2 + ss) * 64]), B_, db); } } while (0)
#pragma unroll
            for (int ks = 0; ks < 8; ++ks) F[ks] = bld128(rn0, lon, 32 * ks);
            asm volatile("" ::: "memory");
            {
                f32x16 df, db; v4u vfr[4];
#pragma unroll
                for (int q4 = 0; q4 < 4; ++q4) { const unsigned w1 = (l31 == 0) ? 0x3f803f80u : 0u; vfr[q4] = (v4u){w1, w1, w1, w1}; }
                ML_PV(vfr);
                ML_COMP(df, rn1, lon, 0, 32);
                ML_COMP(db, rs0, lo, 0, 1024);
#pragma unroll
                for (int r = 0; r < 16; ++r) {
                    if (l31 == 0) { const int tl = crow(r, h); const float af = sc[32 * ti + tl], ab = sc[128 + 32 * ti + tl];
                        ivb[tl] = af * __builtin_amdgcn_rcpf(fmaxf(af * fabsf(df[r]), 1.0f)); ivb[32 + tl] = ab * __builtin_amdgcn_rcpf(fmaxf(ab * fabsf(db[r]), 1.0f)); } }
            }
#pragma nounroll
            for (int nt = 0; nt < 4; ++nt) {
                const int n = 32 * nt + l31;
                f32x16 df, db;
                { v4u vfr[4];
#pragma unroll
                  for (int q4 = 0; q4 < 4; ++q4) vfr[q4] = bld128(rv, lo, nt * 4096 + q4 * 1024);
                  ML_PV(vfr); }
                ML_COMP(df, rs1, lo, nt * 8192, 1024);
                ML_COMP(db, rs0, lo, (nt < 3 ? nt + 1 : 3) * 8192, 1024);
                const unsigned oo = (unsigned)(32 * ti + 4 * h) * 1024 + 2 * n;
#pragma unroll
                for (int r = 0; r < 16; ++r) { const int tl = crow(r, h);
                    const float hv = df[r] * ivb[tl] + db[r] * ivb[32 + tl];
                    const float og = bld_bf16(ro, oo + ((r & 3) + 8 * (r >> 2)) * 1024);
                    const float y = hv * __builtin_amdgcn_rcpf(1.0f + __builtin_amdgcn_exp2f(og * -1.4426950408889634f));
                    ybuf[tl * ML_YROW + n] = (bf16)(cvtpk(y, 0.f) & 0xffffu); }
            }
#undef ML_COMP
#undef ML_PV
#pragma unroll
            for (int i = 0; i < 8; ++i) { const int idx = lane + 64 * i, tl = idx >> 4, ch = idx & 15;
                const v4u w = *(const LAS v4u*)(ybuf + tl * ML_YROW + 8 * ch); float y8[8]; float ss = 0.f;
#pragma unroll
                for (int e = 0; e < 4; ++e) { y8[2 * e] = __uint_as_float(w[e] << 16); y8[2 * e + 1] = __uint_as_float(w[e] & 0xffff0000u); ss += y8[2 * e] * y8[2 * e] + y8[2 * e + 1] * y8[2 * e + 1]; }
                ss += __shfl_xor(ss, 1); ss += __shfl_xor(ss, 2); ss += __shfl_xor(ss, 4); ss += __shfl_xor(ss, 8);
                const float rs = __builtin_amdgcn_rsqf(ss * (1.0f / 128.0f) + EPS);
                u32x4b o;
#pragma unroll
                for (int e = 0; e < 4; ++e) o[e] = cvtpk(y8[2 * e] * rs, y8[2 * e + 1] * rs);
                __builtin_amdgcn_raw_buffer_store_b128(o, rm, (unsigned)(32 * ti + tl) * 2048 + 16 * ch, 0, 0); }
        }
    }
}
constexpr int CV_WAVE_LDS = 8704;
__device__ __forceinline__ void conv_tiles(const Args& a, LAS unsigned char* lds, int G, int vcu, int nlight) {
    const int tid = threadIdx.x, lane = tid & 63, wave = __builtin_amdgcn_readfirstlane(tid >> 6);
    const int gw = vcu * NWAVES + wave, NGW = G * NWAVES;
    LAS unsigned char* raw = lds + wave * CV_WAVE_LDS;
    const bf16* proj = (const bf16*)(a.ws + WS_PROJ);
    const int g8 = lane >> 3, c8 = lane & 7;
    v4u nxt[9];
#define CV_FETCH(it_) do { const int buf_ = (it_) % 6, ct_ = ((it_) / 6) & 7, rt_ = (it_) / 48, b_ = rt_ >> 6, t0_ = (rt_ & 63) * 64; \
        const rsrc_t rs_ = mkrsrc(proj + (size_t)buf_ * PROJ_STRIDE + (size_t)b_ * SEQ * 512 + ct_ * 64, SEQ * 1024); \
        _Pragma("unroll") for (int i = 0; i < 9; ++i) { const int rr = g8 + 8 * i; nxt[i] = bld128(rs_, (unsigned)(t0_ - 1 + rr) * 1024u + c8 * 16, 0); } } while (0)
    const int row_lo = (vcu < nlight) ? vcu * 9 : nlight * 9 + (vcu - nlight) * 13, row_n = (G == 256) ? ((vcu < nlight) ? 9 : 13) : 0;
    if (G != 256) {   }
    int item = (G == 256) ? row_lo * 8 + wave : gw; const int istep = (G == 256) ? 8 : NGW; const int iend = (G == 256) ? (row_lo + row_n) * 8 : 6 * 8 * 512;
    if (item < iend) CV_FETCH(item);
    for (; item < iend; item += istep) {
        const int buf = item % 6, ct = (item / 6) & 7, rt = item / 48, b = rt >> 6, t0 = (rt & 63) * 64;
#pragma unroll
        for (int i = 0; i < 9; ++i) { const int rr = g8 + 8 * i;
            if (rr < 66) *(LAS v4u*)(raw + rr * 128 + c8 * 16) = nxt[i]; }
        if (item + istep < iend) CV_FETCH(item + istep);
        LDS_WAIT();
        if (buf == 3 || buf == 4) {
            const float* cw = a.in[15] + (buf - 3) * 512 + ct * 64 + c8 * 8; const float* cb = a.in[16] + (buf - 3) * 512 + ct * 64 + c8 * 8;
            float w0[8], w1[8], w2[8], bb[8];
#pragma unroll
            for (int e = 0; e < 8; ++e) { w0[e] = cw[e]; w1[e] = cw[1024 + e]; w2[e] = cw[2048 + e]; bb[e] = cb[e]; }
            unsigned char* dst = a.ws + (buf == 3 ? WS_QF : WS_KA) + (size_t)(((b * 4 + (ct >> 1)) * 64 + (rt & 63))) * 16384 + (((ct & 1) * 4 + (c8 >> 1)) * 64 + (c8 & 1) * 32) * 16;
            const float sc = (buf == 3) ? 1.0f : 0.08838834764831845f;
#pragma unroll
            for (int i = 0; i < 8; ++i) { const int r = g8 + 8 * i;
                const v4u x0 = *(const LAS v4u*)(raw + r * 128 + c8 * 16), x1 = *(const LAS v4u*)(raw + (r + 1) * 128 + c8 * 16), x2 = *(const LAS v4u*)(raw + (r + 2) * 128 + c8 * 16);
                v4u o;
#pragma unroll
                for (int e = 0; e < 4; ++e) {
                    const float lo = bb[2 * e] + __uint_as_float(x0[e] << 16) * w0[2 * e] + __uint_as_float(x1[e] << 16) * w1[2 * e] + __uint_as_float(x2[e] << 16) * w2[2 * e];
                    const float hi = bb[2 * e + 1] + __uint_as_float(x0[e] & 0xffff0000u) * w0[2 * e + 1] + __uint_as_float(x1[e] & 0xffff0000u) * w1[2 * e + 1] + __uint_as_float(x2[e] & 0xffff0000u) * w2[2 * e + 1];
                    o[e] = cvtpk(silu(lo) * sc, silu(hi) * sc); }
                *(v4u*)(dst + ((r >> 5) * 8 * 64 + (r & 31)) * 16) = o; }
        }
        if (buf != 3) {
            const LAS bf16* col = (const LAS bf16*)raw + lane;
            float w0 = 0.f, w1 = 1.f, w2 = 0.f, bb = 0.f, sc = 1.f; unsigned char* dstf = nullptr;
            if (buf >= 3) { if (buf == 4) { const int ch = 512 + ct * 64 + lane; w0 = a.in[15][ch]; w1 = a.in[15][1024 + ch]; w2 = a.in[15][2048 + ch]; bb = a.in[16][ch]; sc = 0.08838834764831845f; }
                   const int dd = (ct & 1) * 64 + lane;
                   dstf = a.ws + (buf == 4 ? WS_KF : WS_VF) + (size_t)(((b * 4 + (ct >> 1)) * 64 + (rt & 63))) * 16384 + ((dd >> 5) * 4 * 64 + (dd & 31)) * 16; }
            if (buf < 3) {
                const int cs = lane >> 3, tg = lane & 7;
#pragma unroll
                for (int i = 0; i < 8; ++i) { const int cc = cs + 8 * i, ch = buf * 512 + ct * 64 + cc;
                    const float w0 = a.in[4][ch], w1 = a.in[4][1536 + ch], w2 = a.in[4][3072 + ch], bb = a.in[5][ch];
                    const LAS bf16* col = (const LAS bf16*)raw + cc;
                    float x[10];
#pragma unroll
                    for (int e = 0; e < 10; ++e) x[e] = bf2f(col[(8 * tg + e) * 64]);
                    v4u o;
#pragma unroll
                    for (int e = 0; e < 4; ++e) o[e] = cvtpk(bb + x[2 * e] * w0 + x[2 * e + 1] * w1 + x[2 * e + 2] * w2, bb + x[2 * e + 1] * w0 + x[2 * e + 2] * w1 + x[2 * e + 3] * w2);
                    *(v4u*)((bf16*)a.out + ((size_t)b * 1536 + ch) * SEQ + t0 + 8 * tg) = o; }
            } else {
#pragma unroll
            for (int tg = 0; tg < 8; ++tg) {
                float x[10];
#pragma unroll
                for (int e = 0; e < 10; ++e) x[e] = bf2f(col[(8 * tg + e) * 64]);
                float y[8];
#pragma unroll
                for (int e = 0; e < 8; ++e) { float v = bb + x[e] * w0 + x[e + 1] * w1 + x[e + 2] * w2; if (buf == 4) v = silu(v) * sc; y[e] = v; }
                {
                    unsigned char* pz = dstf + ((tg >> 1) * 64) * 16 + 8 * (tg & 1);
                    *(v2u*)(pz) = (v2u){cvtpk(y[0], y[1]), cvtpk(y[2], y[3])}; *(v2u*)(pz + 32 * 16) = (v2u){cvtpk(y[4], y[5]), cvtpk(y[6], y[7])}; }
            }
            }
        }
        LDS_WAIT();
    }
#undef CV_FETCH
}
__device__ __forceinline__ void hy_mix(const Args& a, int G, int vcu) {
    int tid = threadIdx.x; asm volatile("" : "+v"(tid));
    const int lane = tid & 63, wave = __builtin_amdgcn_readfirstlane(tid >> 6);
    const int gw = vcu * NWAVES + wave, NGW = G * NWAVES;
    const bf16* yT = (const bf16*)(a.ws + WS_YT); bf16* mixed = (bf16*)(a.ws + WS_MIXED);
    for (int item = gw; item < NB * 8 * 64; item += NGW) {
        const int tt = item & 63, g = (item >> 6) & 7, b = item >> 9, t0 = tt * 64;
        const rsrc_t ry = mkrsrc(yT + ((size_t)b * 512 + g * 64) * SEQ + t0, 64 * SEQ * 2);
        float v[64]; float ss = 0.f;
#pragma unroll
        for (int c = 0; c < 64; ++c) { v[c] = bld_bf16s(ry, lane * 2, c * (SEQ * 2)); ss += v[c] * v[c]; }
        const float rs = __builtin_amdgcn_rsqf(ss * (1.0f / 64.0f) + EPS);
        bf16* dst = mixed + (size_t)(b * SEQ + t0 + lane) * DM + g * 64;
#pragma unroll
        for (int i = 0; i < 8; ++i) { v4u o; o.x = cvtpk(v[8 * i] * rs, v[8 * i + 1] * rs); o.y = cvtpk(v[8 * i + 2] * rs, v[8 * i + 3] * rs);
            o.z = cvtpk(v[8 * i + 4] * rs, v[8 * i + 5] * rs); o.w = cvtpk(v[8 * i + 6] * rs, v[8 * i + 7] * rs); *(v4u*)(dst + 8 * i) = o; }
    }
}
typedef GAS unsigned gu32;
#define XB_TMO      128
#define XB_XCNT(j)  (256  + 64 * (j))
#define XB_XSUB(j)  (1280 + 64 * (j))
#define XB_XGEN(j)  (2304 + 64 * (j))
#define XB_TOP      3328
#define XB_TOPGEN   3392
#define XCD_BAR_WORDS 3456
#define XB_SPIN_CAP (1u << 18)

__device__ __forceinline__ unsigned xb_ld(unsigned* p)              { return __hip_atomic_load(p, __ATOMIC_RELAXED, __HIP_MEMORY_SCOPE_AGENT); }
__device__ __forceinline__ unsigned xb_add(unsigned* p, unsigned v) { return __hip_atomic_fetch_add(p, v, __ATOMIC_RELAXED, __HIP_MEMORY_SCOPE_AGENT); }
__device__ __forceinline__ unsigned xb_xcc_id() { return (unsigned)__builtin_amdgcn_s_getreg((3 << 11) | 20) & 0xFu; }
#define XB_SPIN(cond, bar) do { unsigned _sp = 0; while (cond) { __builtin_amdgcn_s_sleep(1); \
    if ((++_sp & 255u) == 0u) { if (xb_ld(&(bar)[XB_TMO])) break; if (_sp > XB_SPIN_CAP) { atomicAdd(&(bar)[XB_TMO], 1u); break; } } } } while (0)

struct XcdBarrier {
    unsigned* bar; unsigned x;
    volatile LAS unsigned* st;
};

__device__ __forceinline__ XcdBarrier xcd_barrier_post(unsigned* bar, volatile LAS unsigned* st) {
    XcdBarrier b; b.bar = bar; b.x = xb_xcc_id(); b.st = st;
    if (threadIdx.x == 0) (void)xb_add(&bar[XB_XCNT(b.x)], 1u);
    return b;
}
__device__ __forceinline__ void xcd_barrier_complete(unsigned* bar, unsigned x, unsigned& nloc, unsigned& nx) {
    const unsigned G = gridDim.x * gridDim.y * gridDim.z;
    unsigned sum, cnt, mine, sp = 0u;
    for (;;) {
        sum = 0u; cnt = 0u; mine = 0u;
#pragma unroll
        for (unsigned j = 0; j < 16; ++j) { const unsigned c = xb_ld(&bar[XB_XCNT(j)]); sum += c; cnt += (c > 0u) ? 1u : 0u; mine = (j == x) ? c : mine; }
        if (sum == G) break;
        __builtin_amdgcn_s_sleep(1);
        if ((++sp & 255u) == 0u) { if (xb_ld(&bar[XB_TMO])) break; if (sp > XB_SPIN_CAP) { atomicAdd(&bar[XB_TMO], 1u); break; } }
    }
    nloc = mine > 0u ? mine : 1u; nx = cnt > 0u ? cnt : 1u;
}

__device__ __forceinline__ void xcd_barrier(const XcdBarrier& b) {
    asm volatile("s_waitcnt vmcnt(0)" ::: "memory");
    __syncthreads();
    if (threadIdx.x == 0) {
        unsigned* bar = b.bar;
        __builtin_amdgcn_s_waitcnt(0);
        unsigned nloc = b.st[0], nx = b.st[1];
        if (nloc == 0u) { xcd_barrier_complete(bar, b.x, nloc, nx); b.st[0] = nloc; b.st[1] = nx; }
        const unsigned old = xb_add(&bar[XB_XSUB(b.x)], 1u);
        const unsigned gen = old / nloc;
        if (old + 1u == (gen + 1u) * nloc) {
            __builtin_amdgcn_fence(__ATOMIC_RELEASE, "agent");
            asm volatile("s_waitcnt vmcnt(0)" ::: "memory");
            const unsigned og = xb_add(&bar[XB_TOP], 1u);
            const unsigned tg = og / nx;
            if (og + 1u == (tg + 1u) * nx) xb_add(&bar[XB_TOPGEN], 1u);
            else XB_SPIN(xb_ld(&bar[XB_TOPGEN]) == tg, bar);
            __builtin_amdgcn_fence(__ATOMIC_ACQUIRE, "agent");
            xb_add(&bar[XB_XGEN(b.x)], 1u);
            asm volatile("s_waitcnt vmcnt(0)" ::: "memory");
        } else {
            XB_SPIN(xb_ld(&bar[XB_XGEN(b.x)]) == gen, bar);
            __builtin_amdgcn_fence(__ATOMIC_ACQUIRE, "agent");
            asm volatile("s_waitcnt vmcnt(0)" ::: "memory");
        }
    }
    __syncthreads();
}

#ifndef MK_ONE_LAUNCH
#define MK_ONE_LAUNCH 1
#endif
constexpr int NPHASE = 14;
#define GEMM_CALL(EPI, MODE, g, S, E) pg8::gemm_phase<EPI, pg8::StaticOrder, true, true, MODE, gLDA, gLDB, gK>(ldsp, g, S, E)
__global__ void __launch_bounds__(NTHREADS, 2) mk_fwd(Args a) {
    extern __shared__ __attribute__((aligned(16))) unsigned char lds_raw[];
    LAS unsigned char* ldsp = (LAS unsigned char*)lds_raw;
    const int G = gridDim.x, bx = blockIdx.x;
    const int vcu = (G % 8 == 0) ? (bx % 8) * (G / 8) + bx / 8 : bx;
    unsigned char* ws = a.ws;
    typedef pg8::bf16_t pb;
#if MK_ONE_LAUNCH
    if (threadIdx.x < 64) ((LAS unsigned*)(ldsp + LDSCTL_OFF))[threadIdx.x] = 0u;
    __syncthreads();
    (void)xcd_barrier_post((unsigned*)(ws + WS_CTL) + 4096, (volatile LAS unsigned*)(ldsp + LDSCTL_OFF) + 8);
#define SEAM(k) do { if (a.ph_hi > 1000000) cg::this_grid().sync();   { XcdBarrier xb_; xb_.bar = (unsigned*)(a.ws + WS_CTL) + 4096; xb_.x = xb_xcc_id(); xb_.st = (volatile LAS unsigned*)(ldsp + LDSCTL_OFF) + 8; xcd_barrier(xb_); } } while (0)
#else
#define SEAM(k) do {} while (0)
#endif
    const int lo = a.ph_lo, hi = a.ph_hi;
#define IN(k) (lo <= (k) && (k) < hi)
#define PH_END(k) do { if (IN((k) + 1)) SEAM(k); } while (0)
#ifndef PROBE_MASK
#define PROBE_MASK 0
#endif
#if (PROBE_MASK >> 0) & 1
#define REP0(...) { __VA_ARGS__ } __syncthreads(); { __VA_ARGS__ }
#else
#define REP0(...) { __VA_ARGS__ }
#endif
#if (PROBE_MASK >> 1) & 1
#define REP1(...) { __VA_ARGS__ } __syncthreads(); { __VA_ARGS__ }
#else
#define REP1(...) { __VA_ARGS__ }
#endif
#if (PROBE_MASK >> 2) & 1
#define REP2(...) { __VA_ARGS__ } __syncthreads(); { __VA_ARGS__ }
#else
#define REP2(...) { __VA_ARGS__ }
#endif
#if (PROBE_MASK >> 3) & 1
#define REP3(...) { __VA_ARGS__ } __syncthreads(); { __VA_ARGS__ }
#else
#define REP3(...) { __VA_ARGS__ }
#endif
#if (PROBE_MASK >> 4) & 1
#define REP4(...) { __VA_ARGS__ } __syncthreads(); { __VA_ARGS__ }
#else
#define REP4(...) { __VA_ARGS__ }
#endif
#if (PROBE_MASK >> 5) & 1
#define REP5(...) { __VA_ARGS__ } __syncthreads(); { __VA_ARGS__ }
#else
#define REP5(...) { __VA_ARGS__ }
#endif
#if (PROBE_MASK >> 6) & 1
#define REP6(...) { __VA_ARGS__ } __syncthreads(); { __VA_ARGS__ }
#else
#define REP6(...) { __VA_ARGS__ }
#endif
#if (PROBE_MASK >> 7) & 1
#define REP7(...) { __VA_ARGS__ } __syncthreads(); { __VA_ARGS__ }
#else
#define REP7(...) { __VA_ARGS__ }
#endif
#if (PROBE_MASK >> 8) & 1
#define REP8(...) { __VA_ARGS__ } __syncthreads(); { __VA_ARGS__ }
#else
#define REP8(...) { __VA_ARGS__ }
#endif
#if (PROBE_MASK >> 9) & 1
#define REP9(...) { __VA_ARGS__ } __syncthreads(); { __VA_ARGS__ }
#else
#define REP9(...) { __VA_ARGS__ }
#endif
#if (PROBE_MASK >> 10) & 1
#define REP10(...) { __VA_ARGS__ } __syncthreads(); { __VA_ARGS__ }
#else
#define REP10(...) { __VA_ARGS__ }
#endif
#if (PROBE_MASK >> 11) & 1
#define REP11(...) { __VA_ARGS__ } __syncthreads(); { __VA_ARGS__ }
#else
#define REP11(...) { __VA_ARGS__ }
#endif
#if (PROBE_MASK >> 12) & 1
#define REP12(...) { __VA_ARGS__ } __syncthreads(); { __VA_ARGS__ }
#else
#define REP12(...) { __VA_ARGS__ }
#endif
    if (IN(0)) { REP0( p0_prologue(a, ldsp, G, vcu); __syncthreads(); ) PH_END(0); }
    if (IN(1)) { REP1(
        { pg8::Gemm g{(const pb*)(ws + WS_XN), (const pb*)(ws + WS_WIN)}; constexpr int gLDA = DM, gLDB = DM, gK = DM; pg8::StaticOrder S; S.init(MTOK, NPROJ, G, bx);
          typedef pg8::EpiBf16S<0, 0> E_t; E_t E{(pb*)(ws + WS_PROJ), 512, 512, PROJ_STRIDE, nullptr, 1.0f}; GEMM_CALL(E_t, 0, g, S, E); }
        ) PH_END(1); }
    if (IN(2)) { REP2(
        if (G != 256 || vcu < 64) {
        { pg8::Gemm g{(const pb*)(ws + WS_MEMN), (const pb*)(ws + WS_WK)}; constexpr int gLDA = DM, gLDB = DM, gK = DM; pg8::StaticOrder S; if (G == 256) { S.init(MMEM, DM, 64, vcu); if (vcu >= 32) S.nwg = 0; } else S.init(MMEM, DM, G, bx);
          typedef pg8::EpiBf16S<0, 0> E_t; E_t E{(pb*)(ws + WS_KB), DM, 0, 0, nullptr, 1.0f}; GEMM_CALL(E_t, 0, g, S, E); }
        { pg8::Gemm g{(const pb*)(ws + WS_WV), (const pb*)(ws + WS_MEMN)}; constexpr int gLDA = DM, gLDB = DM, gK = DM; pg8::StaticOrder S; if (G == 256) { S.init(DM, MMEM, 64, vcu >= 32 ? vcu - 32 : 0); if (vcu < 32) S.nwg = 0; } else S.init(DM, MMEM, G, (bx + G / 2) % G);
          typedef pg8::EpiBf16S<0, 0> E_t; E_t E{(pb*)(ws + WS_VT), MMEM, 0, 0, nullptr, 1.0f}; GEMM_CALL(E_t, 0, g, S, E); }
        }
        gate_factors(a, G, vcu); filters_phase(a, ldsp, G, vcu); conv_tiles(a, ldsp, G, vcu, 64); ) PH_END(2); }
    if (IN(3)) { REP3( hyena_fft(a, ldsp, G, vcu); mlstm_scan(a, ldsp, G, vcu); ) PH_END(3); }
    if (IN(4)) { REP4( mlstm_out(a, ldsp, G, vcu); hy_mix(a, G, vcu); ) PH_END(4); }
    if (IN(5)) { REP5( pg8::Gemm g{(const pb*)(ws + WS_MIXED), (const pb*)(ws + WS_WOUT)}; constexpr int gLDA = DM, gLDB = DM, gK = DM; pg8::StaticOrder S; S.init(MTOK, DM, G, bx);
          typedef pg8::EpiResid<true> E_t; E_t E{a.in[0], (pb*)(ws + WS_XN), (float*)(ws + WS_SSQ), DM}; GEMM_CALL(E_t, 0, g, S, E); ) PH_END(5); }
    if (IN(6)) {
#define LOCAL_SEAM() do { if (threadIdx.x == 0) { __builtin_amdgcn_fence(__ATOMIC_ACQUIRE, "agent"); asm volatile("s_waitcnt vmcnt(0)" ::: "memory"); } __syncthreads(); } while (0)
        { pg8::Gemm g{(const pb*)(ws + WS_XN), (const pb*)(ws + WS_WQ)}; constexpr int gLDA = DM, gLDB = DM, gK = DM; pg8::StaticOrder S; S.init(MTOK, DM, G, bx);
          typedef pg8::EpiBf16S<1, 0> E_t; E_t E{(pb*)(ws + WS_Q), DM, 0, 0, (const float*)(ws + WS_SSQ), 1.0f}; GEMM_CALL(E_t, 0, g, S, E); }
        LOCAL_SEAM();
        { pg8::Gemm g{(const pb*)(ws + WS_Q), (const pb*)(ws + WS_KB)}; constexpr int gLDA = DM, gLDB = DM, gK = 256; pg8::StaticOrder S; S.init(MTOK, DM, G, bx);
          pg8::EpiSoftmax E{(pb*)(ws + WS_SP), DM, (LAS float*)(ldsp + LDSCTL_OFF + 1024), 0.0625f * 1.4426950408889634f}; GEMM_CALL(pg8::EpiSoftmax, 1, g, S, E); }
        LOCAL_SEAM();
        { pg8::Gemm g{(const pb*)(ws + WS_SP), (const pb*)(ws + WS_VT)}; constexpr int gLDA = DM, gLDB = MMEM, gK = 256; pg8::StaticOrder S; S.init(MTOK, DM, G, bx);
          typedef pg8::EpiBf16S<0, 0> E_t; E_t E{(pb*)(ws + WS_AO), DM, 0, 0, nullptr, 1.0f}; GEMM_CALL(E_t, 2, g, S, E); }
        PH_END(9); }
    if (IN(10)) { REP10( pg8::Gemm g{(const pb*)(ws + WS_AO), (const pb*)(ws + WS_WO)}; constexpr int gLDA = DM, gLDB = DM, gK = DM; pg8::StaticOrder S; S.init(MTOK, DM, G, bx);
          typedef pg8::EpiResid<false> E_t; E_t E{ws + WS_XN, (pb*)(ws + WS_XN), (float*)(ws + WS_SSQ), DM}; GEMM_CALL(E_t, 0, g, S, E); ) PH_END(10); }
    if (IN(11)) { REP11( pg8::Gemm g{(const pb*)(ws + WS_XN), (const pb*)(ws + WS_W1)}; constexpr int gLDA = DM, gLDB = DM, gK = DM; pg8::StaticOrder S; S.init(MTOK, DFF, G, bx);
          typedef pg8::EpiBf16S<1, 1> E_t; E_t E{(pb*)(ws + WS_HID), DFF, 0, 0, (const float*)(ws + WS_SSQ), 1.0f}; GEMM_CALL(E_t, 0, g, S, E); ) PH_END(11); }
    if (IN(12)) { REP12( pg8::Gemm g{(const pb*)(ws + WS_HID), (const pb*)(ws + WS_W2)}; constexpr int gLDA = DFF, gLDB = DFF, gK = DFF; pg8::StaticOrder S; S.init(MTOK, DM, G, bx);
          typedef pg8::EpiResid<false> E_t; E_t E{ws + WS_XN, (pb*)(ws + WS_XN), (float*)(ws + WS_SSQ), DM}; GEMM_CALL(E_t, 0, g, S, E); ) PH_END(12); }
    if (IN(13)) { final_norm(a, G, vcu); }
}

extern "C" void kernel_launch(void* const* d_in, const int* in_sizes, int n_in, void* d_out, int out_size, void* d_ws, size_t ws_size, hipStream_t stream) {
    static int grid = 0;
    if (grid == 0) {
        if (n_in != 30 || in_sizes[0] != MTOK * DM || out_size != MTOK * DM || ws_size < WS_END) {
            fprintf(stderr, "kernel_launch: unexpected shapes (n_in %d, in0 %d, out %d, ws %zu); nothing launched\n", n_in, n_in > 0 ? in_sizes[0] : -1, out_size, ws_size); grid = -1; return; }
        int dev = 0, cus = 0, per_cu = 0;
        if (hipGetDevice(&dev) != hipSuccess || hipDeviceGetAttribute(&cus, hipDeviceAttributeMultiprocessorCount, dev) != hipSuccess) { grid = -1; return; }
        if (hipFuncSetAttribute((const void*)mk_fwd, hipFuncAttributeMaxDynamicSharedMemorySize, LDS_BYTES) != hipSuccess) { fprintf(stderr, "kernel_launch: hipFuncSetAttribute failed\n"); grid = -1; return; }
        if (hipOccupancyMaxActiveBlocksPerMultiprocessor(&per_cu, (const void*)mk_fwd, NTHREADS, LDS_BYTES) != hipSuccess || per_cu < 1) { fprintf(stderr, "kernel_launch: occupancy query says %d\n", per_cu); (void)hipGetLastError(); grid = -1; return; }
        grid = cus;
    }
    if (grid < 0) return;
    if (hipMemsetAsync((char*)d_ws + WS_CTL, 0, 65536, stream) != hipSuccess) { fprintf(stderr, "kernel_launch: hipMemsetAsync failed\n"); return; }
    Args a{};
    for (int i = 0; i < 30; ++i) a.in[i] = (const float*)d_in[i];
    a.out = (float*)d_out; a.ws = (unsigned char*)d_ws;
#if MK_ONE_LAUNCH
    a.ph_lo = 0; a.ph_hi = NPHASE;
    void* args[] = {&a};
    hipError_t e = hipLaunchCooperativeKernel((const void*)mk_fwd, dim3(grid), dim3(NTHREADS), args, LDS_BYTES, stream);
    if (e != hipSuccess) fprintf(stderr, "cooperative launch failed: %s (grid %d)\n", hipGetErrorString(e), grid);
#else
    for (int ph = 0; ph < NPHASE; ++ph) { a.ph_lo = ph; a.ph_hi = ph + 1; hipLaunchKernelGGL(mk_fwd, dim3(grid), dim3(NTHREADS), LDS_BYTES, stream, a); }
#endif
}
```

```cpp
#include <hip/hip_runtime.h>
#include <hip/hip_cooperative_groups.h>
#include <cstdio>
#include <cstdint>
namespace cg = cooperative_groups;
namespace pg8 {
#define PG8_LAS __attribute__((address_space(3)))
typedef unsigned short bf16_t;
typedef short bf16x8 __attribute__((ext_vector_type(8)));
typedef float f32x4 __attribute__((ext_vector_type(4)));
typedef unsigned u32x4 __attribute__((ext_vector_type(4)));
constexpr int BM = 256, BK = 64, HALF = 128, HTB = HALF * BK * 2  , STAGE_BYTES = 8 * HTB, NXCD = 8, WGM = 8;

__host__ __device__ __forceinline__ int lds_byte(int r, int c) { const int st = (r >> 4) * 2 + (c >> 5), rr = r & 15, cc = c & 31, ob = rr * 64 + cc * 2; return st * 1024 + (ob ^ (((ob >> 9) & 1) << 5)); }
__host__ __device__ __forceinline__ void stage_rc(int b, int& R, int& C) { const int st = b / 1024, sb = b % 1024, swz = sb ^ (((sb >> 9) & 1) << 5); R = (st >> 1) * 16 + swz / 64; C = (st & 1) * 32 + (swz % 64) / 2; }
__host__ __device__ __forceinline__ int perm32(int rho) { const int n = rho >> 4, i = rho & 15; return 8 * (i >> 2) + 4 * n + (i & 3); }

struct Unit { int pm, pn; };
struct Gemm { const bf16_t* A; const bf16_t* Bt; };
template <int MODE, int LDA> __device__ __forceinline__ size_t a_off(const Unit& u) {
    if (MODE == 0 || MODE == 3) return (size_t)u.pm * BM * LDA * 2;
    if (MODE == 4) return ((size_t)(u.pm >> 2) * BM * LDA + (size_t)(u.pm & 3) * BM) * 2;
    return ((size_t)(u.pm & 3) * BM * LDA + (size_t)u.pn * BM) * 2; }
template <int MODE, int LDB> __device__ __forceinline__ size_t b_off(const Unit& u) {
    if (MODE == 0) return (size_t)u.pn * BM * LDB * 2;
    if (MODE == 3) return ((size_t)(u.pm >> 4) * 1024 + (size_t)u.pn * BM) * LDB * 2;
    if (MODE == 4) return ((size_t)u.pn * BM * LDB + (size_t)(u.pm & 3) * BM) * 2;
    return ((size_t)(u.pm >> 2) * BM * LDB + (size_t)u.pn * BM) * 2; }

struct StaticOrder {
    int nM, nN, nwg, G, c;
    __host__ __device__ void init(int M, int N, int G_, int c_) { nM = M / BM; nN = N / BM; nwg = nM * nN; G = G_; c = c_; }
    __host__ __device__ bool next(int i, Unit& u) const {
        const long L = (long)i * G + c; if (L >= nwg) return false;
        int wgid = (int)L; { const int q = nwg / NXCD, r = nwg % NXCD, xcd = wgid % NXCD, off = wgid / NXCD; wgid = (xcd < r ? xcd * (q + 1) : r * (q + 1) + (xcd - r) * q) + off; }
        const int nig = WGM * nN, gid = wgid / nig, fm = gid * WGM, gsz = (nM - fm) < WGM ? (nM - fm) : WGM;
        u.pm = fm + ((wgid % nig) % gsz); u.pn = (wgid % nig) / gsz; return true;
    }
    __device__ __forceinline__ void a_ready(const Unit&) const {}
    __device__ __forceinline__ void done(const Unit&) const {}
};

__device__ __forceinline__ unsigned cvt_pk_bf16(float lo, float hi) { unsigned r; asm volatile("v_cvt_pk_bf16_f32 %0, %1, %2" : "=v"(r) : "v"(lo), "v"(hi)); return r; }
typedef unsigned u32x2 __attribute__((ext_vector_type(2)));
template <int ROWSCALE, int ACT> struct EpiBf16S {
    static constexpr bool PERM = true, AFTER_DRAIN = false;
    bf16_t* O; int ldc; int split_cols; size_t split_stride; const float* ssqp; float mul;
    __device__ __forceinline__ void operator()(const f32x4 (&acc)[2][2][4][2], const Unit& u, int wr, int wc, int fr, int fq) const {
        const int row0 = u.pm * BM + wr * 64 + fr; int colt = u.pn * BM; bf16_t* base = O;
        if (split_cols) { const int t = colt / split_cols; base += (size_t)t * split_stride; colt -= t * split_cols; }
        const int col0 = colt + wc * 32 + 8 * fq;
#pragma unroll
        for (int ai = 0; ai < 2; ++ai)
#pragma unroll
            for (int m = 0; m < 4; ++m) { const int row = row0 + ai * HALF + m * 16; float sc = mul;
                if (ROWSCALE) { const f32x4* p = (const f32x4*)(ssqp + (size_t)row * 16); const f32x4 a = p[0], b = p[1], c = p[2], d = p[3];
                    const float s = ((a[0] + a[1]) + (a[2] + a[3])) + ((b[0] + b[1]) + (b[2] + b[3])) + ((c[0] + c[1]) + (c[2] + c[3])) + ((d[0] + d[1]) + (d[2] + d[3]));
                    sc *= __builtin_amdgcn_rsqf(s * (1.0f / 1024.0f) + 1e-6f); }
                bf16_t* rowp = base + (size_t)row * ldc + col0;
#pragma unroll
                for (int bj = 0; bj < 2; ++bj) { f32x4 v0 = acc[ai][bj][m][0] * sc, v1 = acc[ai][bj][m][1] * sc;
                    if (ACT == 1) {
#pragma unroll
                        for (int e = 0; e < 4; ++e) { const float a0 = fmaxf(v0[e], 0.f), a1 = fmaxf(v1[e], 0.f); v0[e] = a0 * a0; v1[e] = a1 * a1; } }
                    u32x4 w; w.x = cvt_pk_bf16(v0[0], v0[1]); w.y = cvt_pk_bf16(v0[2], v0[3]); w.z = cvt_pk_bf16(v1[0], v1[1]); w.w = cvt_pk_bf16(v1[2], v1[3]);
                    *(u32x4*)(rowp + bj * HALF) = w; } }
    }
};
struct EpiSoftmax {
    static constexpr bool PERM = true, AFTER_DRAIN = false;
    bf16_t* O; int ldc; PG8_LAS float* xl; float c2s; const float* ssqp;
    __device__ __forceinline__ void operator()(const f32x4 (&acc)[2][2][4][2], const Unit& u, int wr, int wc, int fr, int fq) const {
        const int row0 = u.pm * BM + wr * 64 + fr, col0 = u.pn * BM + wc * 32 + 8 * fq;
        PG8_LAS float* pm = xl; PG8_LAS float* ps = xl + 1024;
        float mx[2][4], cr[2][4];
#pragma unroll
        for (int ai = 0; ai < 2; ++ai)
#pragma unroll
            for (int m = 0; m < 4; ++m) { float v = -3.0e38f;
#pragma unroll
                for (int bj = 0; bj < 2; ++bj)
#pragma unroll
                    for (int n = 0; n < 2; ++n) { const f32x4 x = acc[ai][bj][m][n]; v = fmaxf(v, fmaxf(fmaxf(x[0], x[1]), fmaxf(x[2], x[3]))); }
                v = fmaxf(v, __shfl_xor(v, 16)); v = fmaxf(v, __shfl_xor(v, 32));
                if (fq == 0) pm[(ai * HALF + wr * 64 + m * 16 + fr) * 4 + wc] = v; }
        asm volatile("s_waitcnt lgkmcnt(0)" ::: "memory"); __builtin_amdgcn_s_barrier(); asm volatile("" ::: "memory");
        float sm[2][4];
#pragma unroll
        for (int ai = 0; ai < 2; ++ai)
#pragma unroll
            for (int m = 0; m < 4; ++m) { const int rl = ai * HALF + wr * 64 + m * 16 + fr; const f32x4 p4 = *(const PG8_LAS f32x4*)(pm + rl * 4);
                const float mxr = fmaxf(fmaxf(p4[0], p4[1]), fmaxf(p4[2], p4[3]));
                float c2; { const f32x4* pq = (const f32x4*)(ssqp + (size_t)(row0 + ai * HALF + m * 16) * 16); const f32x4 qa = pq[0], qb = pq[1], qc = pq[2], qd = pq[3];
                    const float sq = ((qa[0] + qa[1]) + (qa[2] + qa[3])) + ((qb[0] + qb[1]) + (qb[2] + qb[3])) + ((qc[0] + qc[1]) + (qc[2] + qc[3])) + ((qd[0] + qd[1]) + (qd[2] + qd[3]));
                    c2 = c2s * __builtin_amdgcn_rsqf(sq * (1.0f / 1024.0f) + 1e-6f); cr[ai][m] = c2; }
                mx[ai][m] = mxr * c2; float s = 0.f;
#pragma unroll
                for (int bj = 0; bj < 2; ++bj)
#pragma unroll
                    for (int n = 0; n < 2; ++n) { const f32x4 x = acc[ai][bj][m][n];
                        s += (__builtin_amdgcn_exp2f(x[0] * c2 - mx[ai][m]) + __builtin_amdgcn_exp2f(x[1] * c2 - mx[ai][m])) + (__builtin_amdgcn_exp2f(x[2] * c2 - mx[ai][m]) + __builtin_amdgcn_exp2f(x[3] * c2 - mx[ai][m])); }
                s += __shfl_xor(s, 16); s += __shfl_xor(s, 32);
                if (fq == 0) ps[rl * 4 + wc] = s; sm[ai][m] = 0.f; }
        asm volatile("s_waitcnt lgkmcnt(0)" ::: "memory"); __builtin_amdgcn_s_barrier(); asm volatile("" ::: "memory");
#pragma unroll
        for (int ai = 0; ai < 2; ++ai)
#pragma unroll
            for (int m = 0; m < 4; ++m) { const int rl = ai * HALF + wr * 64 + m * 16 + fr; const f32x4 s4 = *(const PG8_LAS f32x4*)(ps + rl * 4);
                const float inv = 1.0f / ((s4[0] + s4[1]) + (s4[2] + s4[3])); const float mr = mx[ai][m], c2 = cr[ai][m];
                bf16_t* rowp = O + (size_t)(row0 + ai * HALF + m * 16) * ldc + col0;
#pragma unroll
                for (int bj = 0; bj < 2; ++bj) { const f32x4 x0 = acc[ai][bj][m][0], x1 = acc[ai][bj][m][1]; u32x4 w;
                    w.x = cvt_pk_bf16(__builtin_amdgcn_exp2f(x0[0] * c2 - mr) * inv, __builtin_amdgcn_exp2f(x0[1] * c2 - mr) * inv); w.y = cvt_pk_bf16(__builtin_amdgcn_exp2f(x0[2] * c2 - mr) * inv, __builtin_amdgcn_exp2f(x0[3] * c2 - mr) * inv);
                    w.z = cvt_pk_bf16(__builtin_amdgcn_exp2f(x1[0] * c2 - mr) * inv, __builtin_amdgcn_exp2f(x1[1] * c2 - mr) * inv); w.w = cvt_pk_bf16(__builtin_amdgcn_exp2f(x1[2] * c2 - mr) * inv, __builtin_amdgcn_exp2f(x1[3] * c2 - mr) * inv);
                    *(u32x4*)(rowp + bj * HALF) = w; } }
        asm volatile("s_waitcnt lgkmcnt(0)" ::: "memory"); __builtin_amdgcn_s_barrier(); asm volatile("" ::: "memory");
    }
};

template <bool BASE_F32> struct EpiResid {
    static constexpr bool PERM = false, AFTER_DRAIN = false;
    const void* base; bf16_t* xn; float* ssqp; int ldc;
    __device__ __forceinline__ void operator()(const f32x4 (&acc)[2][2][4][2], const Unit& u, int wr, int wc, int fr, int fq) const {
        const int row0 = u.pm * BM + wr * 64 + fr, col0 = u.pn * BM + wc * 32 + 4 * fq;
#pragma unroll
        for (int ai = 0; ai < 2; ++ai) {
            f32x4 bf_[4][2][2]; u32x2 bh_[4][2][2];
#pragma unroll
            for (int m = 0; m < 4; ++m) { const size_t off = (size_t)(row0 + ai * HALF + m * 16) * ldc + col0;
#pragma unroll
                for (int bj = 0; bj < 2; ++bj)
#pragma unroll
                    for (int n = 0; n < 2; ++n) { const size_t o2 = off + bj * HALF + n * 16;
                        if (BASE_F32) bf_[m][bj][n] = *(const f32x4*)((const float*)base + o2); else bh_[m][bj][n] = *(const u32x2*)((const bf16_t*)base + o2); } }
#pragma unroll
            for (int m = 0; m < 4; ++m) { const int row = row0 + ai * HALF + m * 16; const size_t off = (size_t)row * ldc + col0; float ss = 0.f;
#pragma unroll
                for (int bj = 0; bj < 2; ++bj)
#pragma unroll
                    for (int n = 0; n < 2; ++n) { const size_t o2 = off + bj * HALF + n * 16; f32x4 b;
                        if (BASE_F32) b = bf_[m][bj][n];
                        else { const u32x2 w = bh_[m][bj][n]; b = (f32x4){__uint_as_float(w.x << 16), __uint_as_float(w.x & 0xffff0000u), __uint_as_float(w.y << 16), __uint_as_float(w.y & 0xffff0000u)}; }
                        const f32x4 v = b + acc[ai][bj][m][n];
                        ss += (v[0] * v[0] + v[1] * v[1]) + (v[2] * v[2] + v[3] * v[3]);
                        u32x2 w2; w2.x = cvt_pk_bf16(v[0], v[1]); w2.y = cvt_pk_bf16(v[2], v[3]); *(u32x2*)(xn + o2) = w2; }
                ss += __shfl_xor(ss, 16); ss += __shfl_xor(ss, 32);
                if (fq == 0) ssqp[(size_t)row * 16 + u.pn * 4 + wc] = ss; }
        }
    }
};

template <class Epi, class Sched, bool ALIGN_EPI, bool SP2, int MODE, int LDA, int LDB, int KK>
__device__ __forceinline__ void gemm_phase(PG8_LAS unsigned char* lds, const Gemm g, const Sched& S, const Epi& E) {
    const int tid = threadIdx.x, wid = __builtin_amdgcn_readfirstlane(tid >> 6), lane = tid & 63, wr = wid >> 2, wc = wid & 3, fr = lane & 15, fq = lane >> 4;
    constexpr int K = KK, nt = K / BK;
    unsigned voffA[2], voffB[2];
#pragma unroll
    for (int i = 0; i < 2; ++i) { int R, C; stage_rc(tid * 16 + i * 8192, R, C); const int Rb = Epi::PERM ? ((R & ~31) + perm32(R & 31)) : R;
        voffA[i] = (unsigned)(R * LDA + C) * 2u; voffB[i] = (unsigned)(Rb * LDB + C) * 2u; }
    const size_t kstep = (size_t)(BK * 2);
    const size_t hstepA = (size_t)HALF * LDA * 2, hstepB = (size_t)HALF * LDB * 2;
    const unsigned ldsw = (unsigned)wid * 1024u;
    const int aoff = lds_byte(wr * 64 + fr, fq * 8), boff = lds_byte(wc * 32 + fr, fq * 8);
#define PG8_SA(b, h) (((b) * 2 + (h)) * HTB)
#define PG8_SB(b, h) ((4 + (b) * 2 + (h)) * HTB)
#define PG8_STAGE(bufoff, gbase, voff) do { _Pragma("unroll") for (int _i = 0; _i < 2; ++_i) \
        __builtin_amdgcn_global_load_lds((const unsigned*)((const char*)(gbase) + (voff)[_i]), (PG8_LAS unsigned*)(lds + (bufoff) + ldsw + _i * 8192), 16, 0, 0); } while (0)
#define PG8_LDA(dst, b, h) do { _Pragma("unroll") for (int m = 0; m < 4; ++m) _Pragma("unroll") for (int k = 0; k < 2; ++k) dst[m][k] = *(const PG8_LAS bf16x8*)(lds + PG8_SA(b, h) + aoff + m * 2048 + k * 1024); } while (0)
#define PG8_LDB(dst, b, h) do { _Pragma("unroll") for (int n = 0; n < 2; ++n) _Pragma("unroll") for (int k = 0; k < 2; ++k) dst[n][k] = *(const PG8_LAS bf16x8*)(lds + PG8_SB(b, h) + boff + n * 2048 + k * 1024); } while (0)
#define PG8_MMA(ai, bj, At, Bt) do { __builtin_amdgcn_s_setprio(1); _Pragma("unroll") for (int m = 0; m < 4; ++m) _Pragma("unroll") for (int n = 0; n < 2; ++n) _Pragma("unroll") for (int k = 0; k < 2; ++k) \
        acc[ai][bj][m][n] = __builtin_amdgcn_mfma_f32_16x16x32_bf16(Bt[n][k], At[m][k], acc[ai][bj][m][n], 0, 0, 0); __builtin_amdgcn_s_setprio(0); } while (0)
#define PG8_WAIT_V(n) asm volatile("s_waitcnt vmcnt(" #n ")" ::: "memory")
#define PG8_WAIT_L(n) asm volatile("s_waitcnt lgkmcnt(" #n ")" ::: "memory")
#define PG8_BAR __builtin_amdgcn_s_barrier()
#define PG8_SCHED __builtin_amdgcn_sched_barrier(0)
    Unit cur, nxt; int ui = 0;
    if (!S.next(0, cur)) return;
    f32x4 acc[2][2][4][2];
#pragma unroll
    for (int a = 0; a < 2; ++a)
#pragma unroll
        for (int b = 0; b < 2; ++b)
#pragma unroll
            for (int m = 0; m < 4; ++m)
#pragma unroll
                for (int n = 0; n < 2; ++n) acc[a][b][m][n] = (f32x4){0.f, 0.f, 0.f, 0.f};
    bf16x8 At[4][2], B0[2][2], B1[2][2];
    const char* cA = (const char*)g.A + a_off<MODE, LDA>(cur); const char* cB = (const char*)g.Bt + b_off<MODE, LDB>(cur);
    S.a_ready(cur);
    if constexpr (SP2) {
        PG8_STAGE(PG8_SB(0, 0), cB, voffB); PG8_STAGE(PG8_SB(0, 1), cB + hstepB, voffB); PG8_STAGE(PG8_SA(0, 0), cA, voffA); PG8_STAGE(PG8_SA(0, 1), cA + hstepA, voffA);
        if (wr == 1) PG8_BAR;
        PG8_WAIT_V(2); PG8_BAR;
        PG8_STAGE(PG8_SB(1, 0), cB + kstep, voffB); PG8_STAGE(PG8_SA(1, 0), cA + kstep, voffA); PG8_STAGE(PG8_SB(1, 1), cB + hstepB + kstep, voffB);
        PG8_WAIT_V(6); PG8_BAR;
    } else {
        PG8_STAGE(PG8_SB(0, 0), cB, voffB); PG8_STAGE(PG8_SA(0, 0), cA, voffA); PG8_STAGE(PG8_SB(0, 1), cB + hstepB, voffB); PG8_STAGE(PG8_SA(0, 1), cA + hstepA, voffA);
        if (wr == 1) PG8_BAR;
        PG8_WAIT_V(4); PG8_BAR;
        PG8_STAGE(PG8_SB(1, 0), cB + kstep, voffB); PG8_STAGE(PG8_SA(1, 0), cA + kstep, voffA); PG8_STAGE(PG8_SB(1, 1), cB + hstepB + kstep, voffB);
        PG8_WAIT_V(6); PG8_BAR;
    }
    for (;;) {
        const bool has_next = S.next(ui + 1, nxt);
        const char* nA = has_next ? (const char*)g.A + a_off<MODE, LDA>(nxt) : cA; const char* nB = has_next ? (const char*)g.Bt + b_off<MODE, LDB>(nxt) : cB;
#pragma nounroll
        for (int t = 0; t < nt; t += 2) {
            const bool last = (t == nt - 2);
            const char* a1 = cA + (size_t)(t + 1) * kstep;
            const char* a2 = last ? nA : cA + (size_t)(t + 2) * kstep; const char* b2 = last ? nB : cB + (size_t)(t + 2) * kstep;
            const char* a3 = a2 + kstep; const char* b3 = b2 + kstep;
            if (last && has_next) S.a_ready(nxt);
            if constexpr (SP2) {
            PG8_LDB(B0, 0, 0); PG8_LDB(B1, 0, 1); PG8_SCHED; PG8_LDA(At, 0, 0); PG8_STAGE(PG8_SA(1, 1), a1 + hstepA, voffA);
            PG8_WAIT_V(8); PG8_WAIT_L(0); PG8_BAR; PG8_MMA(0, 0, At, B0); PG8_MMA(0, 1, At, B1); PG8_BAR; PG8_SCHED;
            PG8_LDA(At, 0, 1); PG8_STAGE(PG8_SB(0, 0), b2, voffB); PG8_STAGE(PG8_SB(0, 1), b2 + hstepB, voffB); PG8_STAGE(PG8_SA(0, 0), a2, voffA);
            PG8_WAIT_V(8); PG8_WAIT_L(0); PG8_BAR; PG8_MMA(1, 0, At, B0); PG8_MMA(1, 1, At, B1); PG8_BAR; PG8_SCHED;
            PG8_LDB(B0, 1, 0); PG8_LDB(B1, 1, 1); PG8_SCHED; PG8_LDA(At, 1, 0); PG8_STAGE(PG8_SA(0, 1), a2 + hstepA, voffA);
            PG8_WAIT_V(8); PG8_WAIT_L(0); PG8_BAR; PG8_MMA(0, 0, At, B0); PG8_MMA(0, 1, At, B1); PG8_BAR; PG8_SCHED;
            PG8_LDA(At, 1, 1); PG8_STAGE(PG8_SB(1, 0), b3, voffB); PG8_STAGE(PG8_SB(1, 1), b3 + hstepB, voffB); PG8_STAGE(PG8_SA(1, 0), a3, voffA);
            PG8_WAIT_V(8); PG8_WAIT_L(0); PG8_BAR; PG8_MMA(1, 0, At, B0); PG8_MMA(1, 1, At, B1); PG8_BAR; PG8_SCHED;
            } else {
            PG8_LDB(B0, 0, 0); PG8_SCHED; PG8_LDA(At, 0, 0); PG8_STAGE(PG8_SA(1, 1), a1 + hstepA, voffA);
            PG8_WAIT_L(8); PG8_BAR; PG8_WAIT_L(0); PG8_MMA(0, 0, At, B0); PG8_BAR; PG8_SCHED;
            PG8_LDB(B1, 0, 1); PG8_STAGE(PG8_SB(0, 0), b2, voffB);
            PG8_BAR; PG8_WAIT_L(0); PG8_MMA(0, 1, At, B1); PG8_BAR;
            PG8_LDA(At, 0, 1); PG8_STAGE(PG8_SA(0, 0), a2, voffA);
            PG8_BAR; PG8_WAIT_L(0); PG8_MMA(1, 0, At, B0); PG8_BAR; PG8_SCHED;
            PG8_STAGE(PG8_SB(0, 1), b2 + hstepB, voffB);
            PG8_WAIT_V(6); PG8_BAR; PG8_MMA(1, 1, At, B1); PG8_BAR;
            PG8_LDB(B0, 1, 0); PG8_SCHED; PG8_LDA(At, 1, 0); PG8_STAGE(PG8_SA(0, 1), a2 + hstepA, voffA);
            PG8_WAIT_L(8); PG8_BAR; PG8_WAIT_L(0); PG8_MMA(0, 0, At, B0); PG8_BAR; PG8_SCHED;
            PG8_LDB(B1, 1, 1); PG8_STAGE(PG8_SB(1, 0), b3, voffB);
            PG8_BAR; PG8_WAIT_L(0); PG8_MMA(0, 1, At, B1); PG8_BAR;
            PG8_LDA(At, 1, 1); PG8_STAGE(PG8_SA(1, 0), a3, voffA);
            PG8_BAR; PG8_WAIT_L(0); PG8_MMA(1, 0, At, B0); PG8_BAR; PG8_SCHED;
            PG8_STAGE(PG8_SB(1, 1), b3 + hstepB, voffB);
            PG8_WAIT_V(6); PG8_BAR; PG8_MMA(1, 1, At, B1); PG8_BAR;
            }
        }
        if constexpr (ALIGN_EPI) { if (wr == 0) PG8_BAR; }
        if constexpr (!Epi::AFTER_DRAIN) { E(acc, cur, wr, wc, fr, fq); S.done(cur); }
        if (!has_next) break;
#pragma unroll
        for (int a = 0; a < 2; ++a)
#pragma unroll
            for (int b = 0; b < 2; ++b)
#pragma unroll
                for (int m = 0; m < 4; ++m)
#pragma unroll
                    for (int n = 0; n < 2; ++n) acc[a][b][m][n] = (f32x4){0.f, 0.f, 0.f, 0.f};
        cur = nxt; cA = nA; cB = nB; ++ui;
        if constexpr (ALIGN_EPI) { if (wr == 1) PG8_BAR; }
    }
    PG8_WAIT_V(0);
    if constexpr (!ALIGN_EPI) { if (wr == 0) PG8_BAR; }
    PG8_BAR;
    if constexpr (Epi::AFTER_DRAIN) { E.fused(acc, cur, wr, wc, fr, fq, lds, wid, lane); S.done(cur); }
#undef PG8_SA
#undef PG8_SB
#undef PG8_STAGE
#undef PG8_LDA
#undef PG8_LDB
#undef PG8_MMA
#undef PG8_WAIT_V
#undef PG8_WAIT_L
#undef PG8_BAR
#undef PG8_SCHED
}
}

#define GAS __attribute__((address_space(1)))
#define LAS __attribute__((address_space(3)))
typedef unsigned short bf16;
typedef unsigned v4u __attribute__((ext_vector_type(4)));
typedef unsigned v2u __attribute__((ext_vector_type(2)));
typedef float f32x4 __attribute__((ext_vector_type(4)));
typedef float f32x2 __attribute__((ext_vector_type(2)));
constexpr int NWAVES = 8, NTHREADS = 512;
constexpr int NB = 8, SEQ = 4096, DM = 1024, MTOK = NB * SEQ, NMEMT = 256, MMEM = NB * NMEMT;
constexpr int DINP = 3600, NPROJ = 3584, DFF = 4096, DHY = 512, DML = 512, NHEAD = 4, DHEAD = 128;
constexpr float EPS = 1e-6f;
constexpr size_t MiB = 1u << 20;
constexpr size_t WS_CTL = 0, CTL_ZERO_BYTES = 1 * MiB;
constexpr size_t WS_WIN = 2 * MiB, WS_WOUT = 9 * MiB, WS_WQ = 11 * MiB, WS_WK = 13 * MiB, WS_WV = 15 * MiB, WS_WO = 17 * MiB, WS_W1 = 19 * MiB, WS_W2 = 27 * MiB;
constexpr size_t WS_MEMN = 35 * MiB, WS_KB = 39 * MiB, WS_VT = 43 * MiB, WS_GATES = 47 * MiB, WS_SSQ = 49 * MiB, WS_HID2 = 51 * MiB;
constexpr size_t WS_GF = 53 * MiB, WS_DEC = 55 * MiB;
constexpr size_t WS_XN = 64 * MiB;
constexpr size_t WS_QF = 64 * MiB, WS_KA = 96 * MiB;
constexpr size_t WS_PROJ = 128 * MiB, PROJ_STRIDE = (size_t)MTOK * 512;
constexpr size_t OUT_FILT = 96 * MiB;
constexpr size_t WS_HSPEC = 384 * MiB;
constexpr size_t WS_YT = 448 * MiB;
constexpr size_t WS_MIXED = 352 * MiB;
constexpr size_t WS_KF = 352 * MiB, WS_VF = 416 * MiB;
constexpr size_t WS_STATES = 128 * MiB;
constexpr size_t WS_SP = 416 * MiB, WS_HID = 192 * MiB;
constexpr size_t WS_MT = 288 * MiB, WS_VWT = 304 * MiB;
constexpr size_t WS_END = 512 * MiB;
constexpr int RING_BYTES = 131072, LDSCTL_OFF = 147456, LDS_BYTES = 163840;

__device__ __forceinline__ float bf2f(unsigned short h) { return __uint_as_float(((unsigned)h) << 16); }
__device__ __forceinline__ unsigned f2bf(float f) { unsigned u = __float_as_uint(f); return (u + 0x7fffu + ((u >> 16) & 1u)) >> 16; }
typedef __bf16 bf16x2_t __attribute__((ext_vector_type(2)));
__device__ __forceinline__ unsigned cvtpk(float lo, float hi) { const f32x2 v = {lo, hi}; const bf16x2_t b = __builtin_convertvector(v, bf16x2_t); return __builtin_bit_cast(unsigned, b); }
__device__ __forceinline__ unsigned pk2(float lo, float hi) { return cvtpk(lo, hi); }
__device__ __forceinline__ float wave_sum(float v) {
#pragma unroll
    for (int o = 1; o < 64; o <<= 1) v += __shfl_xor(v, o);
    return v;
}
#define LDS_WAIT() asm volatile("s_waitcnt lgkmcnt(0)" ::: "memory")
__device__ __forceinline__ float logsig(float x) { return fminf(x, 0.f) - log1pf(expf(-fabsf(x))); }

struct Args { const float* in[30]; float* out; unsigned char* ws; int ph_lo, ph_hi; };

__device__ __forceinline__ void p0_transpose_item(const float* W, int ldw, int K, int nblk, bf16* WT, const float* gain, LAS float* scr, int item, int lane) {
    const int kb = item / nblk, nb = item % nblk, k0 = 64 * kb, n0 = 32 * nb;
#pragma unroll 16
    for (int i = 0; i < 32; ++i) { const int kk = 2 * i + (lane >> 5); float w = W[(size_t)(k0 + kk) * ldw + n0 + (lane & 31)]; if (gain) w *= gain[k0 + kk]; scr[kk * 33 + (lane & 31)] = w; }
    LDS_WAIT(); asm volatile("" ::: "memory");
    const int c = lane & 7;
#pragma unroll
    for (int j = 0; j < 4; ++j) { const int n = (lane >> 3) + 8 * j; const LAS float* s = scr + (8 * c) * 33 + n;
        v4u o; o.x = pk2(s[0 * 33], s[1 * 33]); o.y = pk2(s[2 * 33], s[3 * 33]); o.z = pk2(s[4 * 33], s[5 * 33]); o.w = pk2(s[6 * 33], s[7 * 33]);
        *(v4u*)(WT + (size_t)(n0 + n) * K + k0 + 8 * c) = o; }
    LDS_WAIT(); asm volatile("" ::: "memory");
}

__device__ __forceinline__ void p0_prologue(const Args& a, LAS unsigned char* lds, int G, int vcu) {
    const int tid = threadIdx.x, lane = tid & 63, wave = __builtin_amdgcn_readfirstlane(tid >> 6);
    const int gw = vcu * NWAVES + wave, NGW = G * NWAVES;
    unsigned char* ws = a.ws;
    {
        LAS float* scr = (LAS float*)(lds + wave * 16384);
        constexpr int I_IN = 16 * 112, I_SQ = 16 * 32, I_1 = 16 * 128, I_2 = 64 * 32;
        constexpr int NITEMS = I_IN + 4 * I_SQ + I_1 + I_2;
        for (int it = gw; it < NITEMS; it += NGW) {
            int r = it;
            if (r < I_IN) { p0_transpose_item(a.in[3], DINP, DM, 112, (bf16*)(ws + WS_WIN), a.in[2], scr, r, lane); continue; } r -= I_IN;
            if (r < I_SQ) { const int k0 = 64 * (r / 32); const float* g = (k0 < 512) ? a.in[14] : (a.in[18] - 512);
                            p0_transpose_item(a.in[19], DM, DM, 32, (bf16*)(ws + WS_WOUT), g, scr, r, lane); continue; } r -= I_SQ;
            if (r < I_SQ) { p0_transpose_item(a.in[23], DM, DM, 32, (bf16*)(ws + WS_WK), a.in[21], scr, r, lane); continue; } r -= I_SQ;
            if (r < I_SQ) { p0_transpose_item(a.in[24], DM, DM, 32, (bf16*)(ws + WS_WV), a.in[21], scr, r, lane); continue; } r -= I_SQ;
            if (r < I_SQ) { p0_transpose_item(a.in[25], DM, DM, 32, (bf16*)(ws + WS_WO), nullptr, scr, r, lane); continue; } r -= I_SQ;
            if (r < I_1) { p0_transpose_item(a.in[27], DFF, DM, 128, (bf16*)(ws + WS_W1), a.in[26], scr, r, lane); continue; } r -= I_1;
            p0_transpose_item(a.in[28], DM, DFF, 32, (bf16*)(ws + WS_W2), nullptr, scr, r, lane);
        }
        for (int r = gw; r < DM; r += NGW) { const float g = a.in[20][r]; const f32x4* src = (const f32x4*)(a.in[22] + (size_t)r * DM) + lane;
            unsigned long long* o8 = (unsigned long long*)((bf16*)(ws + WS_WQ) + (size_t)r * DM) + lane;
#pragma unroll
            for (int j = 0; j < 4; ++j) { const f32x4 v = src[64 * j] * g; o8[64 * j] = (unsigned long long)pk2(v[0], v[1]) | ((unsigned long long)pk2(v[2], v[3]) << 32); } }
    }
    __syncthreads();
    LAS float* Wg = (LAS float*)lds;
#pragma unroll 8
    for (int idx = tid; idx < 16 * DM; idx += NTHREADS) { const int k = idx >> 4, j = idx & 15; Wg[j * DM + k] = a.in[2][k] * a.in[3][(size_t)k * DINP + NPROJ + j]; }
    __syncthreads();
    f32x4 nx[4];
    if (gw < MTOK) {
#pragma unroll
        for (int j = 0; j < 4; ++j) nx[j] = ((const f32x4*)(a.in[0] + (size_t)gw * DM) + lane)[64 * j]; }
    for (int m = gw; m < MTOK; m += NGW) {
        f32x4 v[4]; float ss = 0.f;
#pragma unroll
        for (int j = 0; j < 4; ++j) { v[j] = nx[j]; ss += (v[j][0] * v[j][0] + v[j][1] * v[j][1]) + (v[j][2] * v[j][2] + v[j][3] * v[j][3]); }
        if (m + NGW < MTOK) {
#pragma unroll
            for (int j = 0; j < 4; ++j) nx[j] = ((const f32x4*)(a.in[0] + (size_t)(m + NGW) * DM) + lane)[64 * j]; }
        const float rstd = __builtin_amdgcn_rsqf(wave_sum(ss) * (1.0f / DM) + EPS);
        unsigned long long* o8 = (unsigned long long*)((bf16*)(ws + WS_XN) + (size_t)m * DM) + lane;
#pragma unroll
        for (int j = 0; j < 4; ++j) { v[j] = v[j] * rstd; o8[64 * j] = (unsigned long long)pk2(v[j][0], v[j][1]) | ((unsigned long long)pk2(v[j][2], v[j][3]) << 32); }
        float gs[16];
#pragma unroll
        for (int g = 0; g < 16; ++g) { float s = 0.f;
#pragma unroll
            for (int j = 0; j < 4; ++j) { const f32x4 w = *(const LAS f32x4*)(Wg + g * DM + 4 * lane + 256 * j); s += (v[j][0] * w[0] + v[j][1] * w[1]) + (v[j][2] * w[2] + v[j][3] * w[3]); }
            gs[g] = s; if ((g & 3) == 3) asm volatile("" ::: "memory"); }
#pragma unroll
        for (int j = 0; j < 8; ++j) { const bool up = lane & 1; const float send = up ? gs[j] : gs[j + 8], keep = up ? gs[j + 8] : gs[j]; gs[j] = keep + __shfl_xor(send, 1); }
#pragma unroll
        for (int j = 0; j < 4; ++j) { const bool up = lane & 2; const float send = up ? gs[j] : gs[j + 4], keep = up ? gs[j + 4] : gs[j]; gs[j] = keep + __shfl_xor(send, 2); }
#pragma unroll
        for (int j = 0; j < 2; ++j) { const bool up = lane & 4; const float send = up ? gs[j] : gs[j + 2], keep = up ? gs[j + 2] : gs[j]; gs[j] = keep + __shfl_xor(send, 4); }
        { const bool up = lane & 8; const float send = up ? gs[0] : gs[1], keep = up ? gs[1] : gs[0]; gs[0] = keep + __shfl_xor(send, 8); }
        float tot = gs[0]; tot += __shfl_xor(tot, 16); tot += __shfl_xor(tot, 32);
        const int gi = ((lane & 1) << 3) | ((lane & 2) << 1) | ((lane & 4) >> 1) | ((lane & 8) >> 3);
        if (lane < 16) { float gv = tot + a.in[17][gi]; if (gi & 4) gv = logsig(gv); ((float*)(ws + WS_GATES))[(size_t)m * 16 + gi] = gv; }
    }
    for (int m = gw; m < MMEM; m += NGW) {
        const f32x4* xr = (const f32x4*)(a.in[1] + (size_t)m * DM) + lane;
        f32x4 v[4]; float ss = 0.f;
#pragma unroll
        for (int j = 0; j < 4; ++j) { v[j] = xr[64 * j]; ss += (v[j][0] * v[j][0] + v[j][1] * v[j][1]) + (v[j][2] * v[j][2] + v[j][3] * v[j][3]); }
        const float rstd = 1.0f / sqrtf(wave_sum(ss) * (1.0f / DM) + EPS);
        unsigned long long* o8 = (unsigned long long*)((bf16*)(ws + WS_MEMN) + (size_t)m * DM) + lane;
#pragma unroll
        for (int j = 0; j < 4; ++j) { v[j] = v[j] * rstd; o8[64 * j] = (unsigned long long)pk2(v[j][0], v[j][1]) | ((unsigned long long)pk2(v[j][2], v[j][3]) << 32); }
    }
    for (int t = gw; t < SEQ; t += NGW) {
        const float tl = (float)t * (1.0f / (float)(SEQ - 1)), ang = (6.283185307179586f / (float)SEQ) * (float)t;
        const int mb = lane & 15; const float band = 1e-4f + (float)mb * ((15.0f - 1e-4f) / 15.0f); const float ph = band * ang;
        const float zf = (lane & 16) ? -sinf(ph) : cosf(ph);
        float s = tl * a.in[6][lane];
#pragma unroll 8
        for (int i = 0; i < 32; ++i) s += __shfl(zf, i) * a.in[6][(1 + i) * 64 + lane];
        const float h1 = sinf(a.in[8][lane] * (s + a.in[7][lane]));
        float s2 = 0.f;
#pragma unroll 8
        for (int i = 0; i < 64; ++i) s2 += __shfl(h1, i) * a.in[9][i * 64 + lane];
        const float h2 = sinf(a.in[11][lane] * (s2 + a.in[10][lane]));
        ((float*)(ws + WS_HID2))[(size_t)t * 64 + lane] = h2;
    }
}
__device__ __forceinline__ float sigm(float x) { return __builtin_amdgcn_rcpf(1.0f + __builtin_amdgcn_exp2f(x * -1.4426950408889634f)); }
__device__ __forceinline__ float silu(float x) { return x * sigm(x); }

__device__ __forceinline__ void filters_phase(const Args& a, LAS unsigned char* lds, int G, int vcu) {
    const int tid = threadIdx.x, lane = tid & 63, wave = __builtin_amdgcn_readfirstlane(tid >> 6);
    const int gw = vcu * NWAVES + wave, NGW = G * NWAVES;
    const float* hid2 = (const float*)(a.ws + WS_HID2); float* filt = (float*)((unsigned char*)a.out + OUT_FILT);
    LAS float* hs = (LAS float*)(lds + 73728 + wave * 4096);
    for (int item = gw; item < 32 * 256; item += NGW) {
        const int cg = item & 31, tb = item >> 5, t0 = tb * 16, ch = cg * 64 + lane, c = ch & 511;
#pragma unroll
        for (int i = 0; i < 4; ++i) *(LAS f32x4*)(hs + (lane + 64 * i) * 4) = *(const f32x4*)(hid2 + (size_t)t0 * 64 + (lane + 64 * i) * 4);
        LDS_WAIT();
        float acc[16];
#pragma unroll
        for (int i = 0; i < 16; ++i) acc[i] = 0.f;
#pragma nounroll
        for (int j4 = 0; j4 < 16; ++j4) {
            const float w0 = a.in[12][(size_t)(4 * j4 + 0) * 2048 + ch], w1 = a.in[12][(size_t)(4 * j4 + 1) * 2048 + ch], w2 = a.in[12][(size_t)(4 * j4 + 2) * 2048 + ch], w3 = a.in[12][(size_t)(4 * j4 + 3) * 2048 + ch];
#pragma unroll
            for (int i = 0; i < 16; ++i) { const f32x4 h4 = *(const LAS f32x4*)(hs + i * 64 + 4 * j4); acc[i] += (h4[0] * w0 + h4[1] * w1) + (h4[2] * w2 + h4[3] * w3); }
        }
        const float mind = -3.0701134573253944f, maxd = -15.350567286626972f;
        const float ad = fabsf(mind + (float)c * ((maxd - mind) / 511.0f));
        float* dst = filt + (size_t)ch * SEQ + t0;
#pragma unroll
        for (int i4 = 0; i4 < 4; ++i4) { f32x4 o;
#pragma unroll
            for (int e = 0; e < 4; ++e) { const float tl = (float)(t0 + 4 * i4 + e) * (1.0f / (float)(SEQ - 1)); o[e] = acc[4 * i4 + e] * expf(-tl * ad); }
            *(f32x4*)(dst + 4 * i4) = o; }
        LDS_WAIT();
    }
}
__device__ __forceinline__ void softmax_rows(const Args& a, int G, int vcu) {
    const int tid = threadIdx.x, lane = tid & 63, wave = __builtin_amdgcn_readfirstlane(tid >> 6);
    const int gw = vcu * NWAVES + wave, NGW = G * NWAVES;
    bf16* sp = (bf16*)(a.ws + WS_SP);
    for (int m = gw; m < MTOK; m += NGW) {
        v4u* p = (v4u*)(sp + (size_t)m * DM + 16 * lane);
        const v4u r0 = p[0], r1 = p[1];
        float v[16];
        const unsigned w[8] = {r0.x, r0.y, r0.z, r0.w, r1.x, r1.y, r1.z, r1.w};
        float mx = -1e30f;
#pragma unroll
        for (int e = 0; e < 8; ++e) { v[2 * e] = __uint_as_float(w[e] << 16) * 0.0625f; v[2 * e + 1] = __uint_as_float(w[e] & 0xffff0000u) * 0.0625f; mx = fmaxf(mx, fmaxf(v[2 * e], v[2 * e + 1])); }
        mx = fmaxf(mx, __shfl_xor(mx, 1)); mx = fmaxf(mx, __shfl_xor(mx, 2)); mx = fmaxf(mx, __shfl_xor(mx, 4)); mx = fmaxf(mx, __shfl_xor(mx, 8));
        float sum = 0.f;
#pragma unroll
        for (int e = 0; e < 16; ++e) { v[e] = expf(v[e] - mx); sum += v[e]; }
        sum += __shfl_xor(sum, 1); sum += __shfl_xor(sum, 2); sum += __shfl_xor(sum, 4); sum += __shfl_xor(sum, 8);
        const float inv = 1.0f / sum;
        v4u o0, o1;
        o0.x = pk2(v[0] * inv, v[1] * inv); o0.y = pk2(v[2] * inv, v[3] * inv); o0.z = pk2(v[4] * inv, v[5] * inv); o0.w = pk2(v[6] * inv, v[7] * inv);
        o1.x = pk2(v[8] * inv, v[9] * inv); o1.y = pk2(v[10] * inv, v[11] * inv); o1.z = pk2(v[12] * inv, v[13] * inv); o1.w = pk2(v[14] * inv, v[15] * inv);
        p[0] = o0; p[1] = o1;
    }
}
__device__ __forceinline__ void final_norm(const Args& a, int G, int vcu) {
    const int tid = threadIdx.x, lane = tid & 63, wave = __builtin_amdgcn_readfirstlane(tid >> 6);
    const int gw = vcu * NWAVES + wave, NGW = G * NWAVES;
    const bf16* xn = (const bf16*)(a.ws + WS_XN);
    f32x4 g4[4];
#pragma unroll
    for (int j = 0; j < 4; ++j) g4[j] = *((const f32x4*)a.in[29] + 4 * lane + j);
    for (int m = gw; m < MTOK; m += NGW) {
        const v4u* p = (const v4u*)(xn + (size_t)m * DM + 16 * lane);
        const v4u r0 = p[0], r1 = p[1];
        const unsigned w[8] = {r0.x, r0.y, r0.z, r0.w, r1.x, r1.y, r1.z, r1.w};
        float v[16]; float ss = 0.f;
#pragma unroll
        for (int e = 0; e < 8; ++e) { v[2 * e] = __uint_as_float(w[e] << 16); v[2 * e + 1] = __uint_as_float(w[e] & 0xffff0000u); ss += v[2 * e] * v[2 * e] + v[2 * e + 1] * v[2 * e + 1]; }
        const float rstd = __builtin_amdgcn_rsqf(wave_sum(ss) * (1.0f / DM) + EPS);
        f32x4* o = (f32x4*)(a.out + (size_t)m * DM + 16 * lane);
#pragma unroll
        for (int j = 0; j < 4; ++j) o[j] = (f32x4){v[4 * j] * rstd * g4[j][0], v[4 * j + 1] * rstd * g4[j][1], v[4 * j + 2] * rstd * g4[j][2], v[4 * j + 3] * rstd * g4[j][3]};
    }
}
__device__ __forceinline__ f32x2 cmul(f32x2 a, f32x2 b) { return (f32x2){a.x * b.x - a.y * b.y, a.x * b.y + a.y * b.x}; }
__device__ __forceinline__ f32x2 cmulc(f32x2 a, f32x2 b) { return (f32x2){a.x * b.x + a.y * b.y, a.y * b.x - a.x * b.y}; }
template <bool INV> __device__ __forceinline__ void dft4(f32x2& x0, f32x2& x1, f32x2& x2, f32x2& x3) {
    const f32x2 s02 = x0 + x2, d02 = x0 - x2, s13 = x1 + x3, d13 = x1 - x3;
    const f32x2 jd = INV ? (f32x2){-d13.y, d13.x} : (f32x2){d13.y, -d13.x};
    x0 = s02 + s13; x1 = d02 + jd; x2 = s02 - s13; x3 = d02 - jd;
}
template <bool INV> __device__ __forceinline__ void fft16(f32x2 (&v)[16]) {
    constexpr float C1 = 0.9238795325112867f, S1 = 0.3826834323650898f, R2 = 0.7071067811865476f;
    constexpr float WR[10] = {1.f, C1, R2, S1, 0.f, 0.f, -R2, 0.f, 0.f, -C1};
    constexpr float WI[10] = {0.f, -S1, -R2, -C1, -1.f, 0.f, -R2, 0.f, 0.f, S1};
#pragma unroll
    for (int b = 0; b < 4; ++b) {
        dft4<INV>(v[b], v[4 + b], v[8 + b], v[12 + b]);
#pragma unroll
        for (int c = 1; c < 4; ++c) { if (b == 0) continue; const f32x2 w = {WR[b * c], INV ? -WI[b * c] : WI[b * c]}; v[4 * c + b] = cmul(v[4 * c + b], w); }
    }
    f32x2 o[16];
#pragma unroll
    for (int c = 0; c < 4; ++c) {
        f32x2 y0 = v[4 * c + 0], y1 = v[4 * c + 1], y2 = v[4 * c + 2], y3 = v[4 * c + 3];
        dft4<INV>(y0, y1, y2, y3);
        o[c] = y0; o[c + 4] = y1; o[c + 8] = y2; o[c + 12] = y3;
    }
#pragma unroll
    for (int k = 0; k < 16; ++k) v[k] = o[k];
}
__device__ __forceinline__ f32x2 w32c(int a) {
    constexpr float CR[16] = {1.f, 0.9807852804032304f, 0.9238795325112867f, 0.8314696123025452f, 0.7071067811865476f, 0.5555702330196022f, 0.3826834323650898f, 0.1950903220161283f,
                              0.f, -0.1950903220161283f, -0.3826834323650898f, -0.5555702330196022f, -0.7071067811865476f, -0.8314696123025452f, -0.9238795325112867f, -0.9807852804032304f};
    constexpr float CI[16] = {0.f, -0.1950903220161283f, -0.3826834323650898f, -0.5555702330196022f, -0.7071067811865476f, -0.8314696123025452f, -0.9238795325112867f, -0.9807852804032304f,
                              -1.f, -0.9807852804032304f, -0.9238795325112867f, -0.8314696123025452f, -0.7071067811865476f, -0.5555702330196022f, -0.3826834323650898f, -0.1950903220161283f};
    return (f32x2){CR[a], CI[a]};
}
constexpr int HY_BUF_BYTES = 34816, HY_TW1_OFF = 2 * HY_BUF_BYTES, HY_TW2_OFF = HY_TW1_OFF + 32768;
__device__ __forceinline__ void hy_fwd(LAS f32x2* hb, int half, int u, f32x2 wu, const LAS f32x2* tw1, const LAS f32x2* tw2, f32x2 (&V)[16]) {
    const int p1 = u + (u >> 4), p2 = 272 * (u >> 4) + (u & 15), p3 = 17 * u;
#pragma unroll
    for (int k = 0; k < 16; ++k) V[k] = hb[272 * k + p1];
    if (half) {
#pragma unroll
        for (int k = 1; k < 16; ++k) V[k] = cmul(V[k], w32c(k));
    }
    fft16<false>(V);
#pragma unroll
    for (int k = 0; k < 16; ++k) { if (k == 0 && !half) continue; V[k] = cmul(V[k], tw1[k * 256 + u]); }
#pragma unroll
    for (int k = 0; k < 16; ++k) hb[272 * k + p1] = V[k];
    __syncthreads();
#pragma unroll
    for (int k = 0; k < 16; ++k) V[k] = hb[p2 + 17 * k];
    fft16<false>(V);
#pragma unroll
    for (int k = 1; k < 16; ++k) V[k] = cmul(V[k], tw2[k * 16 + (u & 15)]);
#pragma unroll
    for (int k = 0; k < 16; ++k) hb[p2 + 17 * k] = V[k];
    __syncthreads();
#pragma unroll
    for (int k = 0; k < 16; ++k) V[k] = hb[p3 + k];
    fft16<false>(V);
}
__device__ __forceinline__ void hy_inv(LAS f32x2* hb, int half, int u, f32x2 wu, const LAS f32x2* tw1, const LAS f32x2* tw2, f32x2 (&V)[16]) {
    const int p1 = u + (u >> 4), p2 = 272 * (u >> 4) + (u & 15), p3 = 17 * u;
    fft16<true>(V);
#pragma unroll
    for (int k = 1; k < 16; ++k) V[k] = cmulc(V[k], tw2[k * 16 + (u & 15)]);
#pragma unroll
    for (int k = 0; k < 16; ++k) hb[p3 + k] = V[k];
    __syncthreads();
#pragma unroll
    for (int k = 0; k < 16; ++k) V[k] = hb[p2 + 17 * k];
    fft16<true>(V);
#pragma unroll
    for (int k = 0; k < 16; ++k) V[k] = cmulc(V[k], tw1[(u >> 4) * 256 + 16 * k + (u & 15)]);
#pragma unroll
    for (int k = 0; k < 16; ++k) hb[p2 + 17 * k] = V[k];
    __syncthreads();
#pragma unroll
    for (int k = 0; k < 16; ++k) V[k] = hb[272 * k + p1];
    fft16<true>(V);
    if (half) {
#pragma unroll
        for (int k = 1; k < 16; ++k) V[k] = cmulc(V[k], w32c(k));
    }
#pragma unroll
    for (int k = 0; k < 16; ++k) hb[272 * k + p1] = V[k];
}
__device__ __forceinline__ int hpos(int n) { return n + (n >> 4); }
typedef __amdgpu_buffer_rsrc_t rsrc_t;
typedef unsigned u32x2v __attribute__((ext_vector_type(2)));
__device__ __forceinline__ rsrc_t mkrsrc(const void* p, unsigned bytes) { return __builtin_amdgcn_make_buffer_rsrc((void*)p, 0, bytes, 0x00020000); }
__device__ __forceinline__ float bld_bf16(rsrc_t r, unsigned off) { return bf2f(__builtin_amdgcn_raw_buffer_load_b16(r, off, 0, 0)); }
__device__ __forceinline__ float bld_bf16s(rsrc_t r, unsigned off, unsigned soff) { return bf2f(__builtin_amdgcn_raw_buffer_load_b16(r, off, soff, 0)); }
__device__ __forceinline__ float bld_f32(rsrc_t r, unsigned off, unsigned soff = 0) { return __uint_as_float(__builtin_amdgcn_raw_buffer_load_b32(r, off, soff, 0)); }
typedef unsigned u32x4b __attribute__((ext_vector_type(4)));
__device__ __forceinline__ v4u bld128(rsrc_t r, unsigned voff, unsigned soff) { const u32x4b w = __builtin_amdgcn_raw_buffer_load_b128(r, voff, soff, 0); return (v4u){w.x, w.y, w.z, w.w}; }
__device__ __forceinline__ v2u bld64(rsrc_t r, unsigned voff, unsigned soff) { const u32x2v w = __builtin_amdgcn_raw_buffer_load_b64(r, voff, soff, 0); return (v2u){w.x, w.y}; }
template <int O> __device__ __forceinline__ void hy_order(const Args& a, LAS f32x2* bufE, LAS f32x2* bufO, LAS f32x2* hb, int half, int u, f32x2 wu, const LAS f32x2* t1, const LAS f32x2* tw2,
                                                          rsrc_t rH, f32x2 (&xin)[8], int c, int b0, float skip) {
    const int tid = threadIdx.x;
    const bf16* hyT = (const bf16*)a.out; bf16* yT = (bf16*)(a.ws + WS_YT);
    f32x2 V[16];
    u32x2v hw[16];
#pragma unroll
    for (int k = 0; k < 16; ++k) hw[k] = __builtin_amdgcn_raw_buffer_load_b64(rH, tid * 8, (O * 16 + k) * 4096, 0);
    __syncthreads();
    hy_fwd(hb, half, u, wu, t1, tw2, V);
    const rsrc_t rg0 = mkrsrc(hyT + ((size_t)b0 * 1536 + 512 * (O + 1) + c) * SEQ, SEQ * 2), rg1 = mkrsrc(hyT + ((size_t)(b0 + 1) * 1536 + 512 * (O + 1) + c) * SEQ, SEQ * 2);
    unsigned short gw0[8], gw1[8];
#pragma unroll
    for (int i = 0; i < 8; ++i) { gw0[i] = __builtin_amdgcn_raw_buffer_load_b16(rg0, (tid + 512 * i) * 2, 0, 0); gw1[i] = __builtin_amdgcn_raw_buffer_load_b16(rg1, (tid + 512 * i) * 2, 0, 0); }
#pragma unroll
    for (int k = 0; k < 16; ++k) V[k] = cmul(V[k], (f32x2){__uint_as_float(hw[k].x), __uint_as_float(hw[k].y)});
    hy_inv(hb, half, u, wu, t1, tw2, V);
    __syncthreads();
    const rsrc_t ry0 = mkrsrc(yT + ((size_t)b0 * 512 + c) * SEQ, SEQ * 2), ry1 = mkrsrc(yT + ((size_t)(b0 + 1) * 512 + c) * SEQ, SEQ * 2);
#pragma unroll
    for (int i = 0; i < 8; ++i) { const int n = tid + 512 * i, p = hpos(n);
        const f32x2 y = (bufE[p] + bufO[p]) * (1.0f / 8192.0f);
        f32x2 r; r.x = bf2f(gw0[i]) * (y.x + skip * xin[i].x); r.y = bf2f(gw1[i]) * (y.y + skip * xin[i].y);
        if (O == 0) { xin[i] = r; bufE[p] = r; bufO[p] = r; }
        else { __builtin_amdgcn_raw_buffer_store_b16((unsigned short)(cvtpk(r.x, 0.f) & 0xffffu), ry0, n * 2, 0, 0); __builtin_amdgcn_raw_buffer_store_b16((unsigned short)(cvtpk(r.y, 0.f) & 0xffffu), ry1, n * 2, 0, 0); } }
}
__device__ __forceinline__ void hyena_fft(const Args& a, LAS unsigned char* lds, int G, int vcu) {
    const int tid = threadIdx.x, half = __builtin_amdgcn_readfirstlane(tid >> 8), u = tid & 255;
    LAS f32x2* bufE = (LAS f32x2*)lds; LAS f32x2* bufO = (LAS f32x2*)(lds + HY_BUF_BYTES);
    LAS f32x2* tw1 = (LAS f32x2*)(lds + HY_TW1_OFF); LAS f32x2* tw2 = (LAS f32x2*)(lds + HY_TW2_OFF);
    LAS f32x2* hb = half ? bufO : bufE;
    LAS f32x2* tw1o = (LAS f32x2*)(lds + HY_TW2_OFF + 2048);
    const LAS f32x2* t1 = half ? tw1o : tw1;
    const bf16* hyT = (const bf16*)a.out; const float* filt = (const float*)((const unsigned char*)a.out + OUT_FILT);
    __syncthreads();
    for (int idx = tid; idx < 4096; idx += NTHREADS) { const int m = (idx & 255) * (idx >> 8); float s, c; sincospif((float)m * (1.0f / 2048.0f), &s, &c); tw1[idx] = (f32x2){c, -s};
        sincospif((float)(2 * m + (idx & 255)) * (1.0f / 4096.0f), &s, &c); tw1o[idx] = (f32x2){c, -s}; }
    if (tid < 256) { const int m = 16 * (tid & 15) * (tid >> 4); float s, c; sincospif((float)m * (1.0f / 2048.0f), &s, &c); tw2[tid] = (f32x2){c, -s}; }
    f32x2 wu; { float s, c; sincospif((float)u * (1.0f / 4096.0f), &s, &c); wu = (f32x2){c, -s}; }
    const rsrc_t rH = mkrsrc(a.ws + WS_HSPEC + (size_t)blockIdx.x * (2 * 16 * NTHREADS * 8), 2 * 16 * NTHREADS * 8);
    for (int c = vcu; c < DHY; c += G) {
#pragma nounroll
        for (int o = 0; o < 2; ++o) {
            const rsrc_t rf = mkrsrc(filt + ((size_t)(o * 2 + 0) * 512 + c) * SEQ, SEQ * 4), rk = mkrsrc(filt + ((size_t)(o * 2 + 1) * 512 + c) * SEQ, SEQ * 4);
            __syncthreads();
#pragma unroll
            for (int i = 0; i < 8; ++i) { const int n = tid + 512 * i, p = hpos(n); const float f = bld_f32(rf, n * 4); float r = bld_f32(rk, (SEQ - n) * 4); r = (n >= 1) ? r : 0.f;
                bufE[p] = (f32x2){f + r, 0.f}; bufO[p] = (f32x2){f - r, 0.f}; }
            __syncthreads();
            f32x2 V[16];
            hy_fwd(hb, half, u, wu, t1, tw2, V);
#pragma unroll
            for (int k = 0; k < 16; ++k) { u32x2v w; w.x = __float_as_uint(V[k].x); w.y = __float_as_uint(V[k].y); __builtin_amdgcn_raw_buffer_store_b64(w, rH, tid * 8, (o * 16 + k) * 4096, 0); }
        }
        const float skip0 = a.in[13][c], skip1 = a.in[13][512 + c];
#pragma nounroll
        for (int pr = 0; pr < 4; ++pr) {
            const int b0 = 2 * pr;
            f32x2 xin[8];
            const rsrc_t rv0 = mkrsrc(hyT + ((size_t)b0 * 1536 + c) * SEQ, SEQ * 2), rv1 = mkrsrc(hyT + ((size_t)(b0 + 1) * 1536 + c) * SEQ, SEQ * 2);
            __syncthreads();
#pragma unroll
            for (int i = 0; i < 8; ++i) { const int n = tid + 512 * i, p = hpos(n); xin[i] = (f32x2){bld_bf16(rv0, n * 2), bld_bf16(rv1, n * 2)}; bufE[p] = xin[i]; bufO[p] = xin[i]; }
            hy_order<0>(a, bufE, bufO, hb, half, u, wu, t1, tw2, rH, xin, c, b0, skip0);
            hy_order<1>(a, bufE, bufO, hb, half, u, wu, t1, tw2, rH, xin, c, b0, skip1);
        }
    }
    __syncthreads();
}
typedef short bf16x8 __attribute__((ext_vector_type(8)));
typedef float f32x16 __attribute__((ext_vector_type(16)));
#define MFMA32(a, b, c) __builtin_amdgcn_mfma_f32_32x32x16_bf16((a), (b), (c), 0, 0, 0)
__device__ __forceinline__ int crow(int r, int h) { return (r & 3) + 8 * (r >> 2) + 4 * h; }
__device__ __forceinline__ bf16x8 scale_frag(v4u raw, float s) {
    v4u o;
#pragma unroll
    for (int e = 0; e < 4; ++e) o[e] = cvtpk(__uint_as_float(raw[e] << 16) * s, __uint_as_float(raw[e] & 0xffff0000u) * s);
    return __builtin_bit_cast(bf16x8, o);
}
__device__ __forceinline__ bf16x8 scale_frag8(v4u raw, f32x4 s0, f32x4 s1) {
    v4u o;
    o[0] = cvtpk(__uint_as_float(raw[0] << 16) * s0[0], __uint_as_float(raw[0] & 0xffff0000u) * s0[1]);
    o[1] = cvtpk(__uint_as_float(raw[1] << 16) * s0[2], __uint_as_float(raw[1] & 0xffff0000u) * s0[3]);
    o[2] = cvtpk(__uint_as_float(raw[2] << 16) * s1[0], __uint_as_float(raw[2] & 0xffff0000u) * s1[1]);
    o[3] = cvtpk(__uint_as_float(raw[3] << 16) * s1[2], __uint_as_float(raw[3] & 0xffff0000u) * s1[3]);
    return __builtin_bit_cast(bf16x8, o);
}
__device__ __forceinline__ float incl_prefix(float x, int lane) {
#pragma unroll
    for (int d = 1; d < 64; d <<= 1) { const float t = __shfl_up(x, d); if (lane >= d) x += t; }
    return x;
}
__device__ __forceinline__ float incl_suffix(float x, int lane) {
#pragma unroll
    for (int d = 1; d < 64; d <<= 1) { const float t = __shfl_down(x, d); if (lane + d < 64) x += t; }
    return x;
}
__device__ __forceinline__ void gate_factors(const Args& a, int G, int vcu) {
    const int tid = threadIdx.x, lane = tid & 63, wave = __builtin_amdgcn_readfirstlane(tid >> 6);
    const int gw = vcu * NWAVES + wave, NGW = G * NWAVES;
    const float* gates = (const float*)(a.ws + WS_GATES); float* gf = (float*)(a.ws + WS_GF); float* dec = (float*)(a.ws + WS_DEC);
    for (int task = gw; task < NB * NHEAD * 64; task += NGW) {
        const int b = task >> 8, hh = (task >> 6) & 3, j = task & 63; const size_t row = (size_t)b * SEQ + j * 64 + lane;
        const float* gp = gates + row * 16 + hh;
        const float i_f = gp[0], a_f = gp[4], i_b = gp[8], a_b = gp[12];
        const float F = incl_prefix(a_f, lane), Gs = incl_suffix(a_b, lane);
        *(f32x4*)(gf + row * 16 + hh * 4) = (f32x4){expf(F), expf(i_f - F), expf(Gs), expf(i_b - Gs)};
        if (lane == 63) dec[(size_t)task * 2] = expf(F);
        if (lane == 0) dec[(size_t)task * 2 + 1] = expf(Gs);
    }
}
__device__ __forceinline__ void mlstm_scan(const Args& a, LAS unsigned char* lds, int G, int vcu) {
    int tid = threadIdx.x; asm volatile("" : "+v"(tid));
    const int lane = tid & 63, wave = __builtin_amdgcn_readfirstlane(tid >> 6), l31 = lane & 31, h = lane >> 5;
    const int gw = wave * G + vcu, NGW = G * NWAVES;
    LAS float* wsc = (LAS float*)(lds + wave * 1024);
    const bf16* KFp = (const bf16*)(a.ws + WS_KF); const bf16* VFp = (const bf16*)(a.ws + WS_VF);
    const float* gf = (const float*)(a.ws + WS_GF); const float* dec = (const float*)(a.ws + WS_DEC); bf16* ST = (bf16*)(a.ws + WS_STATES); bf16* NV = (bf16*)(a.ws + WS_STATES + 128 * MiB);
    for (int cd = vcu; cd < 64 * 4; cd += G) { if (wave >= 5) break;
        const int chain = cd >> 2, dt = cd & 3, nt = wave;
        const int b = chain >> 3, hh = (chain >> 1) & 3, dir = chain & 1;
        f32x16 acc;
#pragma unroll
        for (int r = 0; r < 16; ++r) acc[r] = 0.f;
        const rsrc_t rva = mkrsrc(VFp + (size_t)((b * 4 + hh) * 64) * 8192, 64 * 16384), rkb = mkrsrc(KFp + (size_t)((b * 4 + hh) * 64) * 8192, 64 * 16384);
        const rsrc_t rgf = mkrsrc(gf + (size_t)b * SEQ * 16, SEQ * 64);
        const unsigned vo = lane * 16 + (nt < 4 ? nt : 0) * 4096, ko = lane * 16 + dt * 4096, go = lane * 64 + (hh * 4 + 2 * dir + 1) * 4;
        const float* dbase = dec + (size_t)((b * 4 + hh) * 64) * 2 + dir;
        const v4u ones = {0x3f803f80u, 0x3f803f80u, 0x3f803f80u, 0x3f803f80u}, zeros = {0u, 0u, 0u, 0u};
        struct Stg { v4u ar[4]; bf16x8 br[4]; float be, dc; };
#define SCAN_LOAD(S, jq) do { const int jc_ = (jq) < 0 ? 0 : ((jq) > 63 ? 63 : (jq)); const int j_ = dir ? 63 - jc_ : jc_; _Pragma("unroll") for (int ks = 0; ks < 4; ++ks) { \
            S.ar[ks] = bld128(rva, vo + ks * 1024, j_ * 16384); S.br[ks] = __builtin_bit_cast(bf16x8, bld128(rkb, ko + ks * 1024, j_ * 16384)); } S.be = bld_f32(rgf, go, j_ * 4096); S.dc = dbase[j_ * 2]; } while (0)
#define SCAN_STEP(S, jq) do { const int j_ = dir ? 63 - (jq) : (jq); \
            wsc[lane] = S.be; const float decay = S.dc; \
            if (nt < 4) { bf16* sp = ST + ((size_t)(chain * 64 + j_) * 32 + nt * 8 + 2 * dt + (l31 >> 4)) * 512 + (((l31 >> 3) & 1) * 32) * 8 + (l31 & 7); \
                _Pragma("unroll") for (int r = 0; r < 16; ++r) sp[crow(r, h) * 8] = (bf16)f2bf(acc[r]); } \
            else if (h == 0) NV[(size_t)(chain * 64 + j_) * 128 + 32 * dt + l31] = (bf16)f2bf(acc[0]);     \
            _Pragma("unroll") for (int ks = 0; ks < 4; ++ks) { v4u araw = S.ar[ks]; if (nt == 4) araw = (l31 == 0) ? ones : zeros; \
                const f32x4 b0 = *(const LAS f32x4*)(wsc + 16 * ks + 4 * h), b1 = *(const LAS f32x4*)(wsc + 16 * ks + 8 + 4 * h); \
                acc = MFMA32(scale_frag8(araw, b0, b1), S.br[ks], acc); } \
            _Pragma("unroll") for (int r = 0; r < 16; ++r) acc[r] *= decay; } while (0)
        Stg s0, s1, s2;
        SCAN_LOAD(s0, 0); SCAN_LOAD(s1, 1);
#pragma nounroll
        for (int jj = 0; jj < 63; jj += 3) {
            SCAN_LOAD(s2, jj + 2); SCAN_STEP(s0, jj);
            SCAN_LOAD(s0, jj + 3); SCAN_STEP(s1, jj + 1);
            SCAN_LOAD(s1, jj + 4); SCAN_STEP(s2, jj + 2);
        }
        SCAN_STEP(s0, 63);
#undef SCAN_LOAD
#undef SCAN_STEP
    }
}
constexpr int ML_WAVE_LDS = 18432, ML_YROW = 136;
__device__ __forceinline__ void mlstm_out(const Args& a, LAS unsigned char* lds, int G, int vcu) {
    int tid = threadIdx.x; asm volatile("" : "+v"(tid));
    const int lane = tid & 63, wave = __builtin_amdgcn_readfirstlane(tid >> 6), l31 = lane & 31, h = lane >> 5;
    const int gw = vcu * NWAVES + wave, NGW = G * NWAVES;
    LAS float* sc = (LAS float*)(lds + wave * ML_WAVE_LDS);
    LAS bf16* ybuf = (LAS bf16*)(lds + wave * ML_WAVE_LDS + 1024); LAS float* rsb = (LAS float*)(lds + wave * ML_WAVE_LDS + 1024 + 32 * ML_YROW * 2);
    LAS float* ivb = rsb + 32;
    LAS v4u* pfl = (LAS v4u*)(lds + wave * ML_WAVE_LDS + 10240) + lane;
    const unsigned char* QFp = a.ws + WS_QF; const unsigned char* KAp = a.ws + WS_KA; const unsigned char* VFp = a.ws + WS_VF;
    const bf16* om = (const bf16*)(a.ws + WS_PROJ) + 6 * PROJ_STRIDE; const float* gf = (const float*)(a.ws + WS_GF);
    const bf16* ST = (const bf16*)(a.ws + WS_STATES); const bf16* NV = (const bf16*)(a.ws + WS_STATES + 128 * MiB); bf16* mixed = (bf16*)(a.ws + WS_MIXED);
    const unsigned lo = lane * 16;
    for (int t4 = vcu * NWAVES; t4 < NB * NHEAD * 64; t4 += NGW)
    for (int rr = 0; rr < 2; ++rr) {
        const int task = t4 + rr * 4 + (wave & 3);
        const int b = task >> 8, hh = (task >> 6) & 3, j = task & 63, t0 = j * 64, row0 = b * SEQ + t0;
        { const f32x4 g4 = *(const f32x4*)(gf + (size_t)(row0 + lane) * 16 + hh * 4);
          sc[lane] = g4[0]; sc[64 + lane] = g4[1]; sc[128 + lane] = g4[2]; sc[192 + lane] = g4[3]; }
        const size_t fo = (size_t)(((b * 4 + hh) * 64 + j)) * 16384;
        const rsrc_t rq = mkrsrc(QFp + fo, 16384), rk = mkrsrc(KAp + fo, 16384), rv = mkrsrc(VFp + fo, 16384);
        const rsrc_t rs0 = mkrsrc(ST + ((size_t)(((b * 4 + hh) * 2 + 0) * 64 + j) * 32) * 512, 32768), rs1 = mkrsrc(ST + ((size_t)(((b * 4 + hh) * 2 + 1) * 64 + j) * 32) * 512, 32768);
        const rsrc_t rn0 = mkrsrc(NV + (size_t)(((b * 4 + hh) * 2 + 0) * 64 + j) * 128, 256), rn1 = mkrsrc(NV + (size_t)(((b * 4 + hh) * 2 + 1) * 64 + j) * 128, 256);
        const unsigned lon = (l31 == 0) ? (unsigned)(16 * h) : 0x40000000u;
        const rsrc_t ro = mkrsrc(om + (size_t)row0 * 512 + hh * 128, 64 * 1024), rm = mkrsrc(mixed + (size_t)row0 * DM + 512 + hh * 128, 64 * 2048);
        {
            const int ti = wave >> 2;
            const int t = 32 * ti + l31;
            v4u qf[8];
#pragma unroll
            for (int ks = 0; ks < 8; ++ks) qf[ks] = bld128(rq, lo, ti * 8192 + 1024 * ks);
            {
                f32x16 X[2];
#pragma unroll
                for (int r = 0; r < 16; ++r) { X[0][r] = 0.f; X[1][r] = 0.f; }
                v4u xa[8], xb[8];
#pragma unroll
                for (int ks = 0; ks < 8; ++ks) { xa[ks] = bld128(rk, lo, 1024 * ks); xb[ks] = bld128(rk, lo, 8192 + 1024 * ks); }
#pragma unroll
                for (int ks = 0; ks < 8; ++ks) { const bf16x8 Bq = __builtin_bit_cast(bf16x8, qf[ks]);
                    X[0] = MFMA32(__builtin_bit_cast(bf16x8, xa[ks]), Bq, X[0]); X[1] = MFMA32(__builtin_bit_cast(bf16x8, xb[ks]), Bq, X[1]); }
                asm volatile("" ::: "memory");
#pragma unroll
                for (int si = 0; si < 2; ++si)
#pragma unroll
                    for (int ss = 0; ss < 2; ++ss) {
                        v4u pf, pb;
#pragma unroll
                        for (int e = 0; e < 4; ++e) { float f2[2], b2[2];
#pragma unroll
                            for (int q2 = 0; q2 < 2; ++q2) { const int r = 8 * ss + 2 * e + q2, s = 32 * si + crow(r, h);
                                const float x = X[si][r], bef = sc[64 + s], beb = sc[192 + s];
                                const float vf = x * bef, vb = x * beb;
                                f2[q2] = (s <= t) ? vf : 0.f; b2[q2] = (s >= t) ? vb : 0.f; }
                            pf[e] = cvtpk(f2[0], f2[1]); pb[e] = cvtpk(b2[0], b2[1]); }
                        pfl[(si * 2 + ss) * 64] = pf; pfl[(4 + si * 2 + ss) * 64] = pb;
                    }
            }
            v4u F[8];
#define ML_COMP(D, RN, VO, SB, SS) do { \
        _Pragma("unroll") for (int ks = 0; ks < 8; ++ks) { D = MFMA32(__builtin_bit_cast(bf16x8, qf[ks]), __builtin_bit_cast(bf16x8, F[ks]), D); F[ks] = bld128(RN, VO, (SB) + (SS) * ks); asm volatile("" ::: "memory"); } } while (0)
#define ML_PV(vf_) do { _Pragma("unroll") for (int r = 0; r < 16; ++r) { df[r] = 0.f; db[r] = 0.f; } \
        _Pragma("unroll") for (int si = 0; si < 2; ++si) _Pragma("unroll") for (int ss = 0; ss < 2; ++ss) { const bf16x8 B_ = __builtin_bit_cast(bf16x8, vf_[si * 2 + ss]); \
            if (si <= ti) df = MFMA32(__builtin_bit_cast(bf16x8, pfl[(si * 2 + ss) * 64]), B_, df); if (si >= ti) db = MFMA32(__builtin_bit_cast(bf16x8, pfl[(4 + si * 2 + ss) * 64]), B_, db); } } while (0)
#pragma unroll
            for (int ks = 0; ks < 8; ++ks) F[ks] = bld128(rn0, lon, 32 * ks);
            asm volatile("" ::: "memory");
            {
                f32x16 df, db; v4u vfr[4];
#pragma unroll
                for (int q4 = 0; q4 < 4; ++q4) { const unsigned w1 = (l31 == 0) ? 0x3f803f80u : 0u; vfr[q4] = (v4u){w1, w1, w1, w1}; }
                ML_PV(vfr);
                ML_COMP(df, rn1, lon, 0, 32);
                ML_COMP(db, rs0, lo, 0, 1024);
#pragma unroll
                for (int r = 0; r < 16; ++r) {
                    if (l31 == 0) { const int tl = crow(r, h); const float af = sc[32 * ti + tl], ab = sc[128 + 32 * ti + tl];
                        ivb[tl] = af * __builtin_amdgcn_rcpf(fmaxf(af * fabsf(df[r]), 1.0f)); ivb[32 + tl] = ab * __builtin_amdgcn_rcpf(fmaxf(ab * fabsf(db[r]), 1.0f)); } }
            }
#pragma nounroll
            for (int nt = 0; nt < 4; ++nt) {
                const int n = 32 * nt + l31;
                f32x16 df, db;
                { v4u vfr[4];
#pragma unroll
                  for (int q4 = 0; q4 < 4; ++q4) vfr[q4] = bld128(rv, lo, nt * 4096 + q4 * 1024);
                  ML_PV(vfr); }
                ML_COMP(df, rs1, lo, nt * 8192, 1024);
                ML_COMP(db, rs0, lo, (nt < 3 ? nt + 1 : 3) * 8192, 1024);
                const unsigned oo = (unsigned)(32 * ti + 4 * h) * 1024 + 2 * n;
#pragma unroll
                for (int r = 0; r < 16; ++r) { const int tl = crow(r, h);
                    const float hv = df[r] * ivb[tl] + db[r] * ivb[32 + tl];
                    const float og = bld_bf16(ro, oo + ((r & 3) + 8 * (r >> 2)) * 1024);
                    const float y = hv * __builtin_amdgcn_rcpf(1.0f + __builtin_amdgcn_exp2f(og * -1.4426950408889634f));
                    ybuf[tl * ML_YROW + n] = (bf16)(cvtpk(y, 0.f) & 0xffffu); }
            }
#undef ML_COMP
#undef ML_PV
#pragma unroll
            for (int i = 0; i < 8; ++i) { const int idx = lane + 64 * i, tl = idx >> 4, ch = idx & 15;
                const v4u w = *(const LAS v4u*)(ybuf + tl * ML_YROW + 8 * ch); float y8[8]; float ss = 0.f;
#pragma unroll
                for (int e = 0; e < 4; ++e) { y8[2 * e] = __uint_as_float(w[e] << 16); y8[2 * e + 1] = __uint_as_float(w[e] & 0xffff0000u); ss += y8[2 * e] * y8[2 * e] + y8[2 * e + 1] * y8[2 * e + 1]; }
                ss += __shfl_xor(ss, 1); ss += __shfl_xor(ss, 2); ss += __shfl_xor(ss, 4); ss += __shfl_xor(ss, 8);
                const float rs = __builtin_amdgcn_rsqf(ss * (1.0f / 128.0f) + EPS);
                u32x4b o;
#pragma unroll
                for (int e = 0; e < 4; ++e) o[e] = cvtpk(y8[2 * e] * rs, y8[2 * e + 1] * rs);
                __builtin_amdgcn_raw_buffer_store_b128(o, rm, (unsigned)(32 * ti + tl) * 2048 + 16 * ch, 0, 0); }
        }
    }
}
constexpr int CV_WAVE_LDS = 8704;
__device__ __forceinline__ void conv_tiles(const Args& a, LAS unsigned char* lds, int G, int vcu, int nlight) {
    const int tid = threadIdx.x, lane = tid & 63, wave = __builtin_amdgcn_readfirstlane(tid >> 6);
    const int gw = vcu * NWAVES + wave, NGW = G * NWAVES;
    LAS unsigned char* raw = lds + wave * CV_WAVE_LDS;
    const bf16* proj = (const bf16*)(a.ws + WS_PROJ);
    const int g8 = lane >> 3, c8 = lane & 7;
    v4u nxt[9];
#define CV_FETCH(it_) do { const int buf_ = (it_) % 6, ct_ = ((it_) / 6) & 7, rt_ = (it_) / 48, b_ = rt_ >> 6, t0_ = (rt_ & 63) * 64; \
        const rsrc_t rs_ = mkrsrc(proj + (size_t)buf_ * PROJ_STRIDE + (size_t)b_ * SEQ * 512 + ct_ * 64, SEQ * 1024); \
        _Pragma("unroll") for (int i = 0; i < 9; ++i) { const int rr = g8 + 8 * i; nxt[i] = bld128(rs_, (unsigned)(t0_ - 1 + rr) * 1024u + c8 * 16, 0); } } while (0)
    const int row_lo = (vcu < nlight) ? vcu * 9 : nlight * 9 + (vcu - nlight) * 13, row_n = (G == 256) ? ((vcu < nlight) ? 9 : 13) : 0;
    if (G != 256) {   }
    int item = (G == 256) ? row_lo * 8 + wave : gw; const int istep = (G == 256) ? 8 : NGW; const int iend = (G == 256) ? (row_lo + row_n) * 8 : 6 * 8 * 512;
    if (item < iend) CV_FETCH(item);
    for (; item < iend; item += istep) {
        const int buf = item % 6, ct = (item / 6) & 7, rt = item / 48, b = rt >> 6, t0 = (rt & 63) * 64;
#pragma unroll
        for (int i = 0; i < 9; ++i) { const int rr = g8 + 8 * i;
            if (rr < 66) *(LAS v4u*)(raw + rr * 128 + c8 * 16) = nxt[i]; }
        if (item + istep < iend) CV_FETCH(item + istep);
        LDS_WAIT();
        if (buf == 3 || buf == 4) {
            const float* cw = a.in[15] + (buf - 3) * 512 + ct * 64 + c8 * 8; const float* cb = a.in[16] + (buf - 3) * 512 + ct * 64 + c8 * 8;
            float w0[8], w1[8], w2[8], bb[8];
#pragma unroll
            for (int e = 0; e < 8; ++e) { w0[e] = cw[e]; w1[e] = cw[1024 + e]; w2[e] = cw[2048 + e]; bb[e] = cb[e]; }
            unsigned char* dst = a.ws + (buf == 3 ? WS_QF : WS_KA) + (size_t)(((b * 4 + (ct >> 1)) * 64 + (rt & 63))) * 16384 + (((ct & 1) * 4 + (c8 >> 1)) * 64 + (c8 & 1) * 32) * 16;
            const float sc = (buf == 3) ? 1.0f : 0.08838834764831845f;
#pragma unroll
            for (int i = 0; i < 8; ++i) { const int r = g8 + 8 * i;
                const v4u x0 = *(const LAS v4u*)(raw + r * 128 + c8 * 16), x1 = *(const LAS v4u*)(raw + (r + 1) * 128 + c8 * 16), x2 = *(const LAS v4u*)(raw + (r + 2) * 128 + c8 * 16);
                v4u o;
#pragma unroll
                for (int e = 0; e < 4; ++e) {
                    const float lo = bb[2 * e] + __uint_as_float(x0[e] << 16) * w0[2 * e] + __uint_as_float(x1[e] << 16) * w1[2 * e] + __uint_as_float(x2[e] << 16) * w2[2 * e];
                    const float hi = bb[2 * e + 1] + __uint_as_float(x0[e] & 0xffff0000u) * w0[2 * e + 1] + __uint_as_float(x1[e] & 0xffff0000u) * w1[2 * e + 1] + __uint_as_float(x2[e] & 0xffff0000u) * w2[2 * e + 1];
                    o[e] = cvtpk(silu(lo) * sc, silu(hi) * sc); }
                *(v4u*)(dst + ((r >> 5) * 8 * 64 + (r & 31)) * 16) = o; }
        }
        if (buf != 3) {
            const LAS bf16* col = (const LAS bf16*)raw + lane;
            float w0 = 0.f, w1 = 1.f, w2 = 0.f, bb = 0.f, sc = 1.f; unsigned char* dstf = nullptr;
            if (buf >= 3) { if (buf == 4) { const int ch = 512 + ct * 64 + lane; w0 = a.in[15][ch]; w1 = a.in[15][1024 + ch]; w2 = a.in[15][2048 + ch]; bb = a.in[16][ch]; sc = 0.08838834764831845f; }
                   const int dd = (ct & 1) * 64 + lane;
                   dstf = a.ws + (buf == 4 ? WS_KF : WS_VF) + (size_t)(((b * 4 + (ct >> 1)) * 64 + (rt & 63))) * 16384 + ((dd >> 5) * 4 * 64 + (dd & 31)) * 16; }
            if (buf < 3) {
                const int cs = lane >> 3, tg = lane & 7;
#pragma unroll
                for (int i = 0; i < 8; ++i) { const int cc = cs + 8 * i, ch = buf * 512 + ct * 64 + cc;
                    const float w0 = a.in[4][ch], w1 = a.in[4][1536 + ch], w2 = a.in[4][3072 + ch], bb = a.in[5][ch];
                    const LAS bf16* col = (const LAS bf16*)raw + cc;
                    float x[10];
#pragma unroll
                    for (int e = 0; e < 10; ++e) x[e] = bf2f(col[(8 * tg + e) * 64]);
                    v4u o;
#pragma unroll
                    for (int e = 0; e < 4; ++e) o[e] = cvtpk(bb + x[2 * e] * w0 + x[2 * e + 1] * w1 + x[2 * e + 2] * w2, bb + x[2 * e + 1] * w0 + x[2 * e + 2] * w1 + x[2 * e + 3] * w2);
                    *(v4u*)((bf16*)a.out + ((size_t)b * 1536 + ch) * SEQ + t0 + 8 * tg) = o; }
            } else {
#pragma unroll
            for (int tg = 0; tg < 8; ++tg) {
                float x[10];
#pragma unroll
                for (int e = 0; e < 10; ++e) x[e] = bf2f(col[(8 * tg + e) * 64]);
                float y[8];
#pragma unroll
                for (int e = 0; e < 8; ++e) { float v = bb + x[e] * w0 + x[e + 1] * w1 + x[e + 2] * w2; if (buf == 4) v = silu(v) * sc; y[e] = v; }
                {
                    unsigned char* pz = dstf + ((tg >> 1) * 64) * 16 + 8 * (tg & 1);
                    *(v2u*)(pz) = (v2u){cvtpk(y[0], y[1]), cvtpk(y[2], y[3])}; *(v2u*)(pz + 32 * 16) = (v2u){cvtpk(y[4], y[5]), cvtpk(y[6], y[7])}; }
            }
            }
        }
        LDS_WAIT();
    }
#undef CV_FETCH
}
__device__ __forceinline__ void hy_mix(const Args& a, int G, int vcu) {
    int tid = threadIdx.x; asm volatile("" : "+v"(tid));
    const int lane = tid & 63, wave = __builtin_amdgcn_readfirstlane(tid >> 6);
    const int gw = vcu * NWAVES + wave, NGW = G * NWAVES;
    const bf16* yT = (const bf16*)(a.ws + WS_YT); bf16* mixed = (bf16*)(a.ws + WS_MIXED);
    for (int item = gw; item < NB * 8 * 64; item += NGW) {
        const int tt = item & 63, g = (item >> 6) & 7, b = item >> 9, t0 = tt * 64;
        const rsrc_t ry = mkrsrc(yT + ((size_t)b * 512 + g * 64) * SEQ + t0, 64 * SEQ * 2);
        float v[64]; float ss = 0.f;
#pragma unroll
        for (int c = 0; c < 64; ++c) { v[c] = bld_bf16s(ry, lane * 2, c * (SEQ * 2)); ss += v[c] * v[c]; }
        const float rs = __builtin_amdgcn_rsqf(ss * (1.0f / 64.0f) + EPS);
        bf16* dst = mixed + (size_t)(b * SEQ + t0 + lane) * DM + g * 64;
#pragma unroll
        for (int i = 0; i < 8; ++i) { v4u o; o.x = cvtpk(v[8 * i] * rs, v[8 * i + 1] * rs); o.y = cvtpk(v[8 * i + 2] * rs, v[8 * i + 3] * rs);
            o.z = cvtpk(v[8 * i + 4] * rs, v[8 * i + 5] * rs); o.w = cvtpk(v[8 * i + 6] * rs, v[8 * i + 7] * rs); *(v4u*)(dst + 8 * i) = o; }
    }
}
typedef GAS unsigned gu32;
#define XB_TMO      128
#define XB_XCNT(j)  (256  + 64 * (j))
#define XB_XSUB(j)  (1280 + 64 * (j))
#define XB_XGEN(j)  (2304 + 64 * (j))
#define XB_TOP      3328
#define XB_TOPGEN   3392
#define XCD_BAR_WORDS 3456
#define XB_SPIN_CAP (1u << 18)

__device__ __forceinline__ unsigned xb_ld(unsigned* p)              { return __hip_atomic_load(p, __ATOMIC_RELAXED, __HIP_MEMORY_SCOPE_AGENT); }
__device__ __forceinline__ unsigned xb_add(unsigned* p, unsigned v) { return __hip_atomic_fetch_add(p, v, __ATOMIC_RELAXED, __HIP_MEMORY_SCOPE_AGENT); }
__device__ __forceinline__ unsigned xb_xcc_id() { return (unsigned)__builtin_amdgcn_s_getreg((3 << 11) | 20) & 0xFu; }
#define XB_SPIN(cond, bar) do { unsigned _sp = 0; while (cond) { __builtin_amdgcn_s_sleep(1); \
    if ((++_sp & 255u) == 0u) { if (xb_ld(&(bar)[XB_TMO])) break; if (_sp > XB_SPIN_CAP) { atomicAdd(&(bar)[XB_TMO], 1u); break; } } } } while (0)

struct XcdBarrier {
    unsigned* bar; unsigned x;
    volatile LAS unsigned* st;
};

__device__ __forceinline__ XcdBarrier xcd_barrier_post(unsigned* bar, volatile LAS unsigned* st) {
    XcdBarrier b; b.bar = bar; b.x = xb_xcc_id(); b.st = st;
    if (threadIdx.x == 0) (void)xb_add(&bar[XB_XCNT(b.x)], 1u);
    return b;
}
__device__ __forceinline__ void xcd_barrier_complete(unsigned* bar, unsigned x, unsigned& nloc, unsigned& nx) {
    const unsigned G = gridDim.x * gridDim.y * gridDim.z;
    unsigned sum, cnt, mine, sp = 0u;
    for (;;) {
        sum = 0u; cnt = 0u; mine = 0u;
#pragma unroll
        for (unsigned j = 0; j < 16; ++j) { const unsigned c = xb_ld(&bar[XB_XCNT(j)]); sum += c; cnt += (c > 0u) ? 1u : 0u; mine = (j == x) ? c : mine; }
        if (sum == G) break;
        __builtin_amdgcn_s_sleep(1);
        if ((++sp & 255u) == 0u) { if (xb_ld(&bar[XB_TMO])) break; if (sp > XB_SPIN_CAP) { atomicAdd(&bar[XB_TMO], 1u); break; } }
    }
    nloc = mine > 0u ? mine : 1u; nx = cnt > 0u ? cnt : 1u;
}

__device__ __forceinline__ void xcd_barrier(const XcdBarrier& b) {
    asm volatile("s_waitcnt vmcnt(0)" ::: "memory");
    __syncthreads();
    if (threadIdx.x == 0) {
        unsigned* bar = b.bar;
        __builtin_amdgcn_s_waitcnt(0);
        unsigned nloc = b.st[0], nx = b.st[1];
        if (nloc == 0u) { xcd_barrier_complete(bar, b.x, nloc, nx); b.st[0] = nloc; b.st[1] = nx; }
        const unsigned old = xb_add(&bar[XB_XSUB(b.x)], 1u);
        const unsigned gen = old / nloc;
        if (old + 1u == (gen + 1u) * nloc) {
            __builtin_amdgcn_fence(__ATOMIC_RELEASE, "agent");
            asm volatile("s_waitcnt vmcnt(0)" ::: "memory");
            const unsigned og = xb_add(&bar[XB_TOP], 1u);
            const unsigned tg = og / nx;
            if (og + 1u == (tg + 1u) * nx) xb_add(&bar[XB_TOPGEN], 1u);
            else XB_SPIN(xb_ld(&bar[XB_TOPGEN]) == tg, bar);
            __builtin_amdgcn_fence(__ATOMIC_ACQUIRE, "agent");
            xb_add(&bar[XB_XGEN(b.x)], 1u);
            asm volatile("s_waitcnt vmcnt(0)" ::: "memory");
        } else {
            XB_SPIN(xb_ld(&bar[XB_XGEN(b.x)]) == gen, bar);
            __builtin_amdgcn_fence(__ATOMIC_ACQUIRE, "agent");
            asm volatile("s_waitcnt vmcnt(0)" ::: "memory");
        }
    }
    __syncthreads();
}

#ifndef MK_ONE_LAUNCH
#define MK_ONE_LAUNCH 1
#endif
constexpr int NPHASE = 14;
#define GEMM_CALL(EPI, MODE, g, S, E) pg8::gemm_phase<EPI, pg8::StaticOrder, true, true, MODE, gLDA, gLDB, gK>(ldsp, g, S, E)
__global__ void __launch_bounds__(NTHREADS, 2) mk_fwd(Args a) {
    extern __shared__ __attribute__((aligned(16))) unsigned char lds_raw[];
    LAS unsigned char* ldsp = (LAS unsigned char*)lds_raw;
    const int G = gridDim.x, bx = blockIdx.x;
    const int vcu = (G % 8 == 0) ? (bx % 8) * (G / 8) + bx / 8 : bx;
    unsigned char* ws = a.ws;
    typedef pg8::bf16_t pb;
#if MK_ONE_LAUNCH
    if (threadIdx.x < 64) ((LAS unsigned*)(ldsp + LDSCTL_OFF))[threadIdx.x] = 0u;
    __syncthreads();
    (void)xcd_barrier_post((unsigned*)(ws + WS_CTL) + 4096, (volatile LAS unsigned*)(ldsp + LDSCTL_OFF) + 8);
#define SEAM(k) do { if (a.ph_hi > 1000000) cg::this_grid().sync();   { XcdBarrier xb_; xb_.bar = (unsigned*)(a.ws + WS_CTL) + 4096; xb_.x = xb_xcc_id(); xb_.st = (volatile LAS unsigned*)(ldsp + LDSCTL_OFF) + 8; xcd_barrier(xb_); } } while (0)
#else
#define SEAM(k) do {} while (0)
#endif
    const int lo = a.ph_lo, hi = a.ph_hi;
#define IN(k) (lo <= (k) && (k) < hi)
#define PH_END(k) do { if (IN((k) + 1)) SEAM(k); } while (0)
#ifndef PROBE_MASK
#define PROBE_MASK 0
#endif
#if (PROBE_MASK >> 0) & 1
#define REP0(...) { __VA_ARGS__ } __syncthreads(); { __VA_ARGS__ }
#else
#define REP0(...) { __VA_ARGS__ }
#endif
#if (PROBE_MASK >> 1) & 1
#define REP1(...) { __VA_ARGS__ } __syncthreads(); { __VA_ARGS__ }
#else
#define REP1(...) { __VA_ARGS__ }
#endif
#if (PROBE_MASK >> 2) & 1
#define REP2(...) { __VA_ARGS__ } __syncthreads(); { __VA_ARGS__ }
#else
#define REP2(...) { __VA_ARGS__ }
#endif
#if (PROBE_MASK >> 3) & 1
#define REP3(...) { __VA_ARGS__ } __syncthreads(); { __VA_ARGS__ }
#else
#define REP3(...) { __VA_ARGS__ }
#endif
#if (PROBE_MASK >> 4) & 1
#define REP4(...) { __VA_ARGS__ } __syncthreads(); { __VA_ARGS__ }
#else
#define REP4(...) { __VA_ARGS__ }
#endif
#if (PROBE_MASK >> 5) & 1
#define REP5(...) { __VA_ARGS__ } __syncthreads(); { __VA_ARGS__ }
#else
#define REP5(...) { __VA_ARGS__ }
#endif
#if (PROBE_MASK >> 6) & 1
#define REP6(...) { __VA_ARGS__ } __syncthreads(); { __VA_ARGS__ }
#else
#define REP6(...) { __VA_ARGS__ }
#endif
#if (PROBE_MASK >> 7) & 1
#define REP7(...) { __VA_ARGS__ } __syncthreads(); { __VA_ARGS__ }
#else
#define REP7(...) { __VA_ARGS__ }
#endif
#if (PROBE_MASK >> 8) & 1
#define REP8(...) { __VA_ARGS__ } __syncthreads(); { __VA_ARGS__ }
#else
#define REP8(...) { __VA_ARGS__ }
#endif
#if (PROBE_MASK >> 9) & 1
#define REP9(...) { __VA_ARGS__ } __syncthreads(); { __VA_ARGS__ }
#else
#define REP9(...) { __VA_ARGS__ }
#endif
#if (PROBE_MASK >> 10) & 1
#define REP10(...) { __VA_ARGS__ } __syncthreads(); { __VA_ARGS__ }
#else
#define REP10(...) { __VA_ARGS__ }
#endif
#if (PROBE_MASK >> 11) & 1
#define REP11(...) { __VA_ARGS__ } __syncthreads(); { __VA_ARGS__ }
#else
#define REP11(...) { __VA_ARGS__ }
#endif
#if (PROBE_MASK >> 12) & 1
#define REP12(...) { __VA_ARGS__ } __syncthreads(); { __VA_ARGS__ }
#else
#define REP12(...) { __VA_ARGS__ }
#endif
    if (IN(0)) { REP0( p0_prologue(a, ldsp, G, vcu); __syncthreads(); ) PH_END(0); }
    if (IN(1)) { REP1(
        { pg8::Gemm g{(const pb*)(ws + WS_XN), (const pb*)(ws + WS_WIN)}; constexpr int gLDA = DM, gLDB = DM, gK = DM; pg8::StaticOrder S; S.init(MTOK, NPROJ, G, bx);
          typedef pg8::EpiBf16S<0, 0> E_t; E_t E{(pb*)(ws + WS_PROJ), 512, 512, PROJ_STRIDE, nullptr, 1.0f}; GEMM_CALL(E_t, 0, g, S, E); }
        ) PH_END(1); }
    if (IN(2)) { REP2(
        if (G != 256 || vcu < 64) {
        { pg8::Gemm g{(const pb*)(ws + WS_MEMN), (const pb*)(ws + WS_WK)}; constexpr int gLDA = DM, gLDB = DM, gK = DM; pg8::StaticOrder S; if (G == 256) { S.init(MMEM, DM, 64, vcu); if (vcu >= 32) S.nwg = 0; } else S.init(MMEM, DM, G, bx);
          typedef pg8::EpiBf16S<0, 0> E_t; E_t E{(pb*)(ws + WS_KB), DM, 0, 0, nullptr, 1.0f}; GEMM_CALL(E_t, 0, g, S, E); }
        { pg8::Gemm g{(const pb*)(ws + WS_MEMN), (const pb*)(ws + WS_WV)}; constexpr int gLDA = DM, gLDB = DM, gK = DM; pg8::StaticOrder S; if (G == 256) { S.init(MMEM, DM, 64, vcu >= 32 ? vcu - 32 : 0); if (vcu < 32) S.nwg = 0; } else S.init(MMEM, DM, G, (bx + G / 2) % G);
          typedef pg8::EpiBf16S<0, 0> E_t; E_t E{(pb*)(ws + WS_VT), DM, 0, 0, nullptr, 1.0f}; GEMM_CALL(E_t, 0, g, S, E); }
        }
        gate_factors(a, G, vcu); filters_phase(a, ldsp, G, vcu); conv_tiles(a, ldsp, G, vcu, 64); ) PH_END(2); }
    if (IN(3)) { REP3(
        { pg8::Gemm g{(const pb*)(ws + WS_KB), (const pb*)(ws + WS_WQ)}; constexpr int gLDA = DM, gLDB = DM, gK = 256; pg8::StaticOrder S; S.init(8 * DM, DM, G / 2, vcu < G / 2 ? vcu : 0); if (vcu >= G / 2) S.nwg = 0;
          typedef pg8::EpiBf16S<0, 0> E_t; E_t E{(pb*)(ws + WS_MT), DM, 0, 0, nullptr, 1.0f}; GEMM_CALL(E_t, 4, g, S, E); }
        { pg8::Gemm g{(const pb*)(ws + WS_WO), (const pb*)(ws + WS_VT)}; constexpr int gLDA = DM, gLDB = DM, gK = 256; pg8::StaticOrder S; S.init(8 * DM, DM, G / 2, vcu >= G / 2 ? vcu - G / 2 : 0); if (vcu < G / 2) S.nwg = 0;
          typedef pg8::EpiBf16S<0, 0> E_t; E_t E{(pb*)(ws + WS_VWT), DM, 0, 0, nullptr, 1.0f}; GEMM_CALL(E_t, 5, g, S, E); }
        hyena_fft(a, ldsp, G, vcu); mlstm_scan(a, ldsp, G, vcu); ) PH_END(3); }
    if (IN(4)) { REP4( mlstm_out(a, ldsp, G, vcu); hy_mix(a, G, vcu); ) PH_END(4); }
    if (IN(5)) { REP5( pg8::Gemm g{(const pb*)(ws + WS_MIXED), (const pb*)(ws + WS_WOUT)}; constexpr int gLDA = DM, gLDB = DM, gK = DM; pg8::StaticOrder S; S.init(MTOK, DM, G, bx);
          typedef pg8::EpiResid<true> E_t; E_t E{a.in[0], (pb*)(ws + WS_XN), (float*)(ws + WS_SSQ), DM}; GEMM_CALL(E_t, 0, g, S, E); ) PH_END(5); }
    if (IN(6)) { REP6( pg8::Gemm g{(const pb*)(ws + WS_XN), (const pb*)(ws + WS_MT)}; constexpr int gLDA = DM, gLDB = DM, gK = DM; pg8::StaticOrder S; S.init(MTOK, DM, G, bx);
          pg8::EpiSoftmax E{(pb*)(ws + WS_SP), DM, (LAS float*)(ldsp + LDSCTL_OFF + 1024), 0.0625f * 1.4426950408889634f, (const float*)(ws + WS_SSQ)}; GEMM_CALL(pg8::EpiSoftmax, 3, g, S, E); ) PH_END(9); }
    if (IN(10)) { pg8::Gemm g{(const pb*)(ws + WS_SP), (const pb*)(ws + WS_VWT)}; constexpr int gLDA = DM, gLDB = DM, gK = DM; pg8::StaticOrder S; S.init(MTOK, DM, G, bx);
          typedef pg8::EpiResid<false> E_t; E_t E{ws + WS_XN, (pb*)(ws + WS_XN), (float*)(ws + WS_SSQ), DM}; GEMM_CALL(E_t, 3, g, S, E); PH_END(10); }
    if (IN(11)) { REP11( pg8::Gemm g{(const pb*)(ws + WS_XN), (const pb*)(ws + WS_W1)}; constexpr int gLDA = DM, gLDB = DM, gK = DM; pg8::StaticOrder S; S.init(MTOK, DFF, G, bx);
          typedef pg8::EpiBf16S<1, 1> E_t; E_t E{(pb*)(ws + WS_HID), DFF, 0, 0, (const float*)(ws + WS_SSQ), 1.0f}; GEMM_CALL(E_t, 0, g, S, E); ) PH_END(11); }
    if (IN(12)) { REP12( pg8::Gemm g{(const pb*)(ws + WS_HID), (const pb*)(ws + WS_W2)}; constexpr int gLDA = DFF, gLDB = DFF, gK = DFF; pg8::StaticOrder S; S.init(MTOK, DM, G, bx);
          typedef pg8::EpiResid<false> E_t; E_t E{ws + WS_XN, (pb*)(ws + WS_XN), (float*)(ws + WS_SSQ), DM}; GEMM_CALL(E_t, 0, g, S, E); ) PH_END(12); }
    if (IN(13)) { final_norm(a, G, vcu); }
}

extern "C" void kernel_launch(void* const* d_in, const int* in_sizes, int n_in, void* d_out, int out_size, void* d_ws, size_t ws_size, hipStream_t stream) {
    static int grid = 0;
    if (grid == 0) {
        if (n_in != 30 || in_sizes[0] != MTOK * DM || out_size != MTOK * DM || ws_size < WS_END) {
            fprintf(stderr, "kernel_launch: unexpected shapes (n_in %d, in0 %d, out %d, ws %zu); nothing launched\n", n_in, n_in > 0 ? in_sizes[0] : -1, out_size, ws_size); grid = -1; return; }
        int dev = 0, cus = 0, per_cu = 0;
        if (hipGetDevice(&dev) != hipSuccess || hipDeviceGetAttribute(&cus, hipDeviceAttributeMultiprocessorCount, dev) != hipSuccess) { grid = -1; return; }
        if (hipFuncSetAttribute((const void*)mk_fwd, hipFuncAttributeMaxDynamicSharedMemorySize, LDS_BYTES) != hipSuccess) { fprintf(stderr, "kernel_launch: hipFuncSetAttribute failed\n"); grid = -1; return; }
        if (hipOccupancyMaxActiveBlocksPerMultiprocessor(&per_cu, (const void*)mk_fwd, NTHREADS, LDS_BYTES) != hipSuccess || per_cu < 1) { fprintf(stderr, "kernel_launch: occupancy query says %d\n", per_cu); (void)hipGetLastError(); grid = -1; return; }
        grid = cus;
    }
    if (grid < 0) return;
    if (hipMemsetAsync((char*)d_ws + WS_CTL, 0, 65536, stream) != hipSuccess) { fprintf(stderr, "kernel_launch: hipMemsetAsync failed\n"); return; }
    Args a{};
    for (int i = 0; i < 30; ++i) a.in[i] = (const float*)d_in[i];
    a.out = (float*)d_out; a.ws = (unsigned char*)d_ws;
#if MK_ONE_LAUNCH
    a.ph_lo = 0; a.ph_hi = NPHASE;
    void* args[] = {&a};
    hipError_t e = hipLaunchCooperativeKernel((const void*)mk_fwd, dim3(grid), dim3(NTHREADS), args, LDS_BYTES, stream);
    if (e != hipSuccess) fprintf(stderr, "cooperative launch failed: %s (grid %d)\n", hipGetErrorString(e), grid);
#else
    for (int ph = 0; ph < NPHASE; ++ph) { a.ph_lo = ph; a.ph_hi = ph + 1; hipLaunchKernelGGL(mk_fwd, dim3(grid), dim3(NTHREADS), LDS_BYTES, stream, a); }
#endif
}
```

```cpp
#include <hip/hip_runtime.h>
#include <hip/hip_cooperative_groups.h>
#include <cstdio>
#include <cstdint>
namespace cg = cooperative_groups;
namespace pg8 {
#define PG8_LAS __attribute__((address_space(3)))
typedef unsigned short bf16_t;
typedef short bf16x8 __attribute__((ext_vector_type(8)));
typedef float f32x4 __attribute__((ext_vector_type(4)));
typedef unsigned u32x4 __attribute__((ext_vector_type(4)));
constexpr int BM = 256, BK = 64, HALF = 128, HTB = HALF * BK * 2  , STAGE_BYTES = 8 * HTB, NXCD = 8, WGM = 8;

__host__ __device__ __forceinline__ int lds_byte(int r, int c) { const int st = (r >> 4) * 2 + (c >> 5), rr = r & 15, cc = c & 31, ob = rr * 64 + cc * 2; return st * 1024 + (ob ^ (((ob >> 9) & 1) << 5)); }
__host__ __device__ __forceinline__ void stage_rc(int b, int& R, int& C) { const int st = b / 1024, sb = b % 1024, swz = sb ^ (((sb >> 9) & 1) << 5); R = (st >> 1) * 16 + swz / 64; C = (st & 1) * 32 + (swz % 64) / 2; }
__host__ __device__ __forceinline__ int perm32(int rho) { const int n = rho >> 4, i = rho & 15; return 8 * (i >> 2) + 4 * n + (i & 3); }

struct Unit { int pm, pn; };
struct Gemm { const bf16_t* A; const bf16_t* Bt; };
template <int MODE, int LDA> __device__ __forceinline__ size_t a_off(const Unit& u) {
    if (MODE == 0 || MODE == 3) return (size_t)u.pm * BM * LDA * 2;
    if (MODE == 4) return ((size_t)(u.pm >> 2) * BM * LDA + (size_t)(u.pm & 3) * BM) * 2;
    return ((size_t)(u.pm & 3) * BM * LDA + (size_t)u.pn * BM) * 2; }
template <int MODE, int LDB> __device__ __forceinline__ size_t b_off(const Unit& u) {
    if (MODE == 0) return (size_t)u.pn * BM * LDB * 2;
    if (MODE == 3) return ((size_t)(u.pm >> 4) * 1024 + (size_t)u.pn * BM) * LDB * 2;
    if (MODE == 4) return ((size_t)u.pn * BM * LDB + (size_t)(u.pm & 3) * BM) * 2;
    return ((size_t)(u.pm >> 2) * BM * LDB + (size_t)u.pn * BM) * 2; }

struct StaticOrder {
    int nM, nN, nwg, G, c;
    __host__ __device__ void init(int M, int N, int G_, int c_) { nM = M / BM; nN = N / BM; nwg = nM * nN; G = G_; c = c_; }
    __host__ __device__ bool next(int i, Unit& u) const {
        const long L = (long)i * G + c; if (L >= nwg) return false;
        int wgid = (int)L; { const int q = nwg / NXCD, r = nwg % NXCD, xcd = wgid % NXCD, off = wgid / NXCD; wgid = (xcd < r ? xcd * (q + 1) : r * (q + 1) + (xcd - r) * q) + off; }
        const int nig = WGM * nN, gid = wgid / nig, fm = gid * WGM, gsz = (nM - fm) < WGM ? (nM - fm) : WGM;
        u.pm = fm + ((wgid % nig) % gsz); u.pn = (wgid % nig) / gsz; return true;
    }
    __device__ __forceinline__ void a_ready(const Unit&) const {}
    __device__ __forceinline__ void done(const Unit&) const {}
};

__device__ __forceinline__ unsigned cvt_pk_bf16(float lo, float hi) { unsigned r; asm volatile("v_cvt_pk_bf16_f32 %0, %1, %2" : "=v"(r) : "v"(lo), "v"(hi)); return r; }
typedef unsigned u32x2 __attribute__((ext_vector_type(2)));
template <int ROWSCALE, int ACT> struct EpiBf16S {
    static constexpr bool PERM = true, AFTER_DRAIN = false;
    bf16_t* O; int ldc; int split_cols; size_t split_stride; const float* ssqp; float mul;
    __device__ __forceinline__ void operator()(const f32x4 (&acc)[2][2][4][2], const Unit& u, int wr, int wc, int fr, int fq) const {
        const int row0 = u.pm * BM + wr * 64 + fr; int colt = u.pn * BM; bf16_t* base = O;
        if (split_cols) { const int t = colt / split_cols; base += (size_t)t * split_stride; colt -= t * split_cols; }
        const int col0 = colt + wc * 32 + 8 * fq;
#pragma unroll
        for (int ai = 0; ai < 2; ++ai)
#pragma unroll
            for (int m = 0; m < 4; ++m) { const int row = row0 + ai * HALF + m * 16; float sc = mul;
                if (ROWSCALE) { const f32x4* p = (const f32x4*)(ssqp + (size_t)row * 16); const f32x4 a = p[0], b = p[1], c = p[2], d = p[3];
                    const float s = ((a[0] + a[1]) + (a[2] + a[3])) + ((b[0] + b[1]) + (b[2] + b[3])) + ((c[0] + c[1]) + (c[2] + c[3])) + ((d[0] + d[1]) + (d[2] + d[3]));
                    sc *= __builtin_amdgcn_rsqf(s * (1.0f / 1024.0f) + 1e-6f); }
                bf16_t* rowp = base + (size_t)row * ldc + col0;
#pragma unroll
                for (int bj = 0; bj < 2; ++bj) { f32x4 v0 = acc[ai][bj][m][0] * sc, v1 = acc[ai][bj][m][1] * sc;
                    if (ACT == 1) {
#pragma unroll
                        for (int e = 0; e < 4; ++e) { const float a0 = fmaxf(v0[e], 0.f), a1 = fmaxf(v1[e], 0.f); v0[e] = a0 * a0; v1[e] = a1 * a1; } }
                    u32x4 w; w.x = cvt_pk_bf16(v0[0], v0[1]); w.y = cvt_pk_bf16(v0[2], v0[3]); w.z = cvt_pk_bf16(v1[0], v1[1]); w.w = cvt_pk_bf16(v1[2], v1[3]);
                    *(u32x4*)(rowp + bj * HALF) = w; } }
    }
};
struct EpiSoftmax {
    static constexpr bool PERM = true, AFTER_DRAIN = false;
    bf16_t* O; int ldc; PG8_LAS float* xl; float c2s; const float* ssqp;
    __device__ __forceinline__ void operator()(const f32x4 (&acc)[2][2][4][2], const Unit& u, int wr, int wc, int fr, int fq) const {
        const int row0 = u.pm * BM + wr * 64 + fr, col0 = u.pn * BM + wc * 32 + 8 * fq;
        PG8_LAS float* pm = xl; PG8_LAS float* ps = xl + 1024;
        float mx[2][4], cr[2][4];
#pragma unroll
        for (int ai = 0; ai < 2; ++ai)
#pragma unroll
            for (int m = 0; m < 4; ++m) { float v = -3.0e38f;
#pragma unroll
                for (int bj = 0; bj < 2; ++bj)
#pragma unroll
                    for (int n = 0; n < 2; ++n) { const f32x4 x = acc[ai][bj][m][n]; v = fmaxf(v, fmaxf(fmaxf(x[0], x[1]), fmaxf(x[2], x[3]))); }
                v = fmaxf(v, __shfl_xor(v, 16)); v = fmaxf(v, __shfl_xor(v, 32));
                if (fq == 0) pm[(ai * HALF + wr * 64 + m * 16 + fr) * 4 + wc] = v; }
        asm volatile("s_waitcnt lgkmcnt(0)" ::: "memory"); __builtin_amdgcn_s_barrier(); asm volatile("" ::: "memory");
        float sm[2][4];
#pragma unroll
        for (int ai = 0; ai < 2; ++ai)
#pragma unroll
            for (int m = 0; m < 4; ++m) { const int rl = ai * HALF + wr * 64 + m * 16 + fr; const f32x4 p4 = *(const PG8_LAS f32x4*)(pm + rl * 4);
                const float mxr = fmaxf(fmaxf(p4[0], p4[1]), fmaxf(p4[2], p4[3]));
                float c2; { const f32x4* pq = (const f32x4*)(ssqp + (size_t)(row0 + ai * HALF + m * 16) * 16); const f32x4 qa = pq[0], qb = pq[1], qc = pq[2], qd = pq[3];
                    const float sq = ((qa[0] + qa[1]) + (qa[2] + qa[3])) + ((qb[0] + qb[1]) + (qb[2] + qb[3])) + ((qc[0] + qc[1]) + (qc[2] + qc[3])) + ((qd[0] + qd[1]) + (qd[2] + qd[3]));
                    c2 = c2s * __builtin_amdgcn_rsqf(sq * (1.0f / 1024.0f) + 1e-6f); cr[ai][m] = c2; }
                mx[ai][m] = mxr * c2; float s = 0.f;
#pragma unroll
                for (int bj = 0; bj < 2; ++bj)
#pragma unroll
                    for (int n = 0; n < 2; ++n) { const f32x4 x = acc[ai][bj][m][n];
                        s += (__builtin_amdgcn_exp2f(x[0] * c2 - mx[ai][m]) + __builtin_amdgcn_exp2f(x[1] * c2 - mx[ai][m])) + (__builtin_amdgcn_exp2f(x[2] * c2 - mx[ai][m]) + __builtin_amdgcn_exp2f(x[3] * c2 - mx[ai][m])); }
                s += __shfl_xor(s, 16); s += __shfl_xor(s, 32);
                if (fq == 0) ps[rl * 4 + wc] = s; sm[ai][m] = 0.f; }
        asm volatile("s_waitcnt lgkmcnt(0)" ::: "memory"); __builtin_amdgcn_s_barrier(); asm volatile("" ::: "memory");
#pragma unroll
        for (int ai = 0; ai < 2; ++ai)
#pragma unroll
            for (int m = 0; m < 4; ++m) { const int rl = ai * HALF + wr * 64 + m * 16 + fr; const f32x4 s4 = *(const PG8_LAS f32x4*)(ps + rl * 4);
                const float inv = 1.0f / ((s4[0] + s4[1]) + (s4[2] + s4[3])); const float mr = mx[ai][m], c2 = cr[ai][m];
                bf16_t* rowp = O + (size_t)(row0 + ai * HALF + m * 16) * ldc + col0;
#pragma unroll
                for (int bj = 0; bj < 2; ++bj) { const f32x4 x0 = acc[ai][bj][m][0], x1 = acc[ai][bj][m][1]; u32x4 w;
                    w.x = cvt_pk_bf16(__builtin_amdgcn_exp2f(x0[0] * c2 - mr) * inv, __builtin_amdgcn_exp2f(x0[1] * c2 - mr) * inv); w.y = cvt_pk_bf16(__builtin_amdgcn_exp2f(x0[2] * c2 - mr) * inv, __builtin_amdgcn_exp2f(x0[3] * c2 - mr) * inv);
                    w.z = cvt_pk_bf16(__builtin_amdgcn_exp2f(x1[0] * c2 - mr) * inv, __builtin_amdgcn_exp2f(x1[1] * c2 - mr) * inv); w.w = cvt_pk_bf16(__builtin_amdgcn_exp2f(x1[2] * c2 - mr) * inv, __builtin_amdgcn_exp2f(x1[3] * c2 - mr) * inv);
                    *(u32x4*)(rowp + bj * HALF) = w; } }
        asm volatile("s_waitcnt lgkmcnt(0)" ::: "memory"); __builtin_amdgcn_s_barrier(); asm volatile("" ::: "memory");
    }
};

template <bool BASE_F32> struct EpiResid {
    static constexpr bool PERM = false, AFTER_DRAIN = false;
    const void* base; bf16_t* xn; float* ssqp; int ldc;
    __device__ __forceinline__ void operator()(const f32x4 (&acc)[2][2][4][2], const Unit& u, int wr, int wc, int fr, int fq) const {
        const int row0 = u.pm * BM + wr * 64 + fr, col0 = u.pn * BM + wc * 32 + 4 * fq;
#pragma unroll
        for (int ai = 0; ai < 2; ++ai) {
            f32x4 bf_[4][2][2]; u32x2 bh_[4][2][2];
#pragma unroll
            for (int m = 0; m < 4; ++m) { const size_t off = (size_t)(row0 + ai * HALF + m * 16) * ldc + col0;
#pragma unroll
                for (int bj = 0; bj < 2; ++bj)
#pragma unroll
                    for (int n = 0; n < 2; ++n) { const size_t o2 = off + bj * HALF + n * 16;
                        if (BASE_F32) bf_[m][bj][n] = *(const f32x4*)((const float*)base + o2); else bh_[m][bj][n] = *(const u32x2*)((const bf16_t*)base + o2); } }
#pragma unroll
            for (int m = 0; m < 4; ++m) { const int row = row0 + ai * HALF + m * 16; const size_t off = (size_t)row * ldc + col0; float ss = 0.f;
#pragma unroll
                for (int bj = 0; bj < 2; ++bj)
#pragma unroll
                    for (int n = 0; n < 2; ++n) { const size_t o2 = off + bj * HALF + n * 16; f32x4 b;
                        if (BASE_F32) b = bf_[m][bj][n];
                        else { const u32x2 w = bh_[m][bj][n]; b = (f32x4){__uint_as_float(w.x << 16), __uint_as_float(w.x & 0xffff0000u), __uint_as_float(w.y << 16), __uint_as_float(w.y & 0xffff0000u)}; }
                        const f32x4 v = b + acc[ai][bj][m][n];
                        ss += (v[0] * v[0] + v[1] * v[1]) + (v[2] * v[2] + v[3] * v[3]);
                        u32x2 w2; w2.x = cvt_pk_bf16(v[0], v[1]); w2.y = cvt_pk_bf16(v[2], v[3]); *(u32x2*)(xn + o2) = w2; }
                ss += __shfl_xor(ss, 16); ss += __shfl_xor(ss, 32);
                if (fq == 0) ssqp[(size_t)row * 16 + u.pn * 4 + wc] = ss; }
        }
    }
};

template <class Epi, class Sched, bool ALIGN_EPI, bool SP2, int MODE, int LDA, int LDB, int KK>
__device__ __forceinline__ void gemm_phase(PG8_LAS unsigned char* lds, const Gemm g, const Sched& S, const Epi& E) {
    const int tid = threadIdx.x, wid = __builtin_amdgcn_readfirstlane(tid >> 6), lane = tid & 63, wr = wid >> 2, wc = wid & 3, fr = lane & 15, fq = lane >> 4;
    constexpr int K = KK, nt = K / BK;
    unsigned voffA[2], voffB[2];
#pragma unroll
    for (int i = 0; i < 2; ++i) { int R, C; stage_rc(tid * 16 + i * 8192, R, C); const int Rb = Epi::PERM ? ((R & ~31) + perm32(R & 31)) : R;
        voffA[i] = (unsigned)(R * LDA + C) * 2u; voffB[i] = (unsigned)(Rb * LDB + C) * 2u; }
    const size_t kstep = (size_t)(BK * 2);
    const size_t hstepA = (size_t)HALF * LDA * 2, hstepB = (size_t)HALF * LDB * 2;
    const unsigned ldsw = (unsigned)wid * 1024u;
    const int aoff = lds_byte(wr * 64 + fr, fq * 8), boff = lds_byte(wc * 32 + fr, fq * 8);
#define PG8_SA(b, h) (((b) * 2 + (h)) * HTB)
#define PG8_SB(b, h) ((4 + (b) * 2 + (h)) * HTB)
#define PG8_STAGE(bufoff, gbase, voff) do { _Pragma("unroll") for (int _i = 0; _i < 2; ++_i) \
        __builtin_amdgcn_global_load_lds((const unsigned*)((const char*)(gbase) + (voff)[_i]), (PG8_LAS unsigned*)(lds + (bufoff) + ldsw + _i * 8192), 16, 0, 0); } while (0)
#define PG8_LDA(dst, b, h) do { _Pragma("unroll") for (int m = 0; m < 4; ++m) _Pragma("unroll") for (int k = 0; k < 2; ++k) dst[m][k] = *(const PG8_LAS bf16x8*)(lds + PG8_SA(b, h) + aoff + m * 2048 + k * 1024); } while (0)
#define PG8_LDB(dst, b, h) do { _Pragma("unroll") for (int n = 0; n < 2; ++n) _Pragma("unroll") for (int k = 0; k < 2; ++k) dst[n][k] = *(const PG8_LAS bf16x8*)(lds + PG8_SB(b, h) + boff + n * 2048 + k * 1024); } while (0)
#define PG8_MMA(ai, bj, At, Bt) do { __builtin_amdgcn_s_setprio(1); _Pragma("unroll") for (int m = 0; m < 4; ++m) _Pragma("unroll") for (int n = 0; n < 2; ++n) _Pragma("unroll") for (int k = 0; k < 2; ++k) \
        acc[ai][bj][m][n] = __builtin_amdgcn_mfma_f32_16x16x32_bf16(Bt[n][k], At[m][k], acc[ai][bj][m][n], 0, 0, 0); __builtin_amdgcn_s_setprio(0); } while (0)
#define PG8_WAIT_V(n) asm volatile("s_waitcnt vmcnt(" #n ")" ::: "memory")
#define PG8_WAIT_L(n) asm volatile("s_waitcnt lgkmcnt(" #n ")" ::: "memory")
#define PG8_BAR __builtin_amdgcn_s_barrier()
#define PG8_SCHED __builtin_amdgcn_sched_barrier(0)
    Unit cur, nxt; int ui = 0;
    if (!S.next(0, cur)) return;
    f32x4 acc[2][2][4][2];
#pragma unroll
    for (int a = 0; a < 2; ++a)
#pragma unroll
        for (int b = 0; b < 2; ++b)
#pragma unroll
            for (int m = 0; m < 4; ++m)
#pragma unroll
                for (int n = 0; n < 2; ++n) acc[a][b][m][n] = (f32x4){0.f, 0.f, 0.f, 0.f};
    bf16x8 At[4][2], B0[2][2], B1[2][2];
    const char* cA = (const char*)g.A + a_off<MODE, LDA>(cur); const char* cB = (const char*)g.Bt + b_off<MODE, LDB>(cur);
    S.a_ready(cur);
    if constexpr (SP2) {
        PG8_STAGE(PG8_SB(0, 0), cB, voffB); PG8_STAGE(PG8_SB(0, 1), cB + hstepB, voffB); PG8_STAGE(PG8_SA(0, 0), cA, voffA); PG8_STAGE(PG8_SA(0, 1), cA + hstepA, voffA);
        if (wr == 1) PG8_BAR;
        PG8_WAIT_V(2); PG8_BAR;
        PG8_STAGE(PG8_SB(1, 0), cB + kstep, voffB); PG8_STAGE(PG8_SA(1, 0), cA + kstep, voffA); PG8_STAGE(PG8_SB(1, 1), cB + hstepB + kstep, voffB);
        PG8_WAIT_V(6); PG8_BAR;
    } else {
        PG8_STAGE(PG8_SB(0, 0), cB, voffB); PG8_STAGE(PG8_SA(0, 0), cA, voffA); PG8_STAGE(PG8_SB(0, 1), cB + hstepB, voffB); PG8_STAGE(PG8_SA(0, 1), cA + hstepA, voffA);
        if (wr == 1) PG8_BAR;
        PG8_WAIT_V(4); PG8_BAR;
        PG8_STAGE(PG8_SB(1, 0), cB + kstep, voffB); PG8_STAGE(PG8_SA(1, 0), cA + kstep, voffA); PG8_STAGE(PG8_SB(1, 1), cB + hstepB + kstep, voffB);
        PG8_WAIT_V(6); PG8_BAR;
    }
    for (;;) {
        const bool has_next = S.next(ui + 1, nxt);
        const char* nA = has_next ? (const char*)g.A + a_off<MODE, LDA>(nxt) : cA; const char* nB = has_next ? (const char*)g.Bt + b_off<MODE, LDB>(nxt) : cB;
#pragma nounroll
        for (int t = 0; t < nt; t += 2) {
            const bool last = (t == nt - 2);
            const char* a1 = cA + (size_t)(t + 1) * kstep;
            const char* a2 = last ? nA : cA + (size_t)(t + 2) * kstep; const char* b2 = last ? nB : cB + (size_t)(t + 2) * kstep;
            const char* a3 = a2 + kstep; const char* b3 = b2 + kstep;
            if (last && has_next) S.a_ready(nxt);
            if constexpr (SP2) {
            PG8_LDB(B0, 0, 0); PG8_LDB(B1, 0, 1); PG8_SCHED; PG8_LDA(At, 0, 0); PG8_STAGE(PG8_SA(1, 1), a1 + hstepA, voffA);
            PG8_WAIT_V(8); PG8_WAIT_L(0); PG8_BAR; PG8_MMA(0, 0, At, B0); PG8_MMA(0, 1, At, B1); PG8_BAR; PG8_SCHED;
            PG8_LDA(At, 0, 1); PG8_STAGE(PG8_SB(0, 0), b2, voffB); PG8_STAGE(PG8_SB(0, 1), b2 + hstepB, voffB); PG8_STAGE(PG8_SA(0, 0), a2, voffA);
            PG8_WAIT_V(8); PG8_WAIT_L(0); PG8_BAR; PG8_MMA(1, 0, At, B0); PG8_MMA(1, 1, At, B1); PG8_BAR; PG8_SCHED;
            PG8_LDB(B0, 1, 0); PG8_LDB(B1, 1, 1); PG8_SCHED; PG8_LDA(At, 1, 0); PG8_STAGE(PG8_SA(0, 1), a2 + hstepA, voffA);
            PG8_WAIT_V(8); PG8_WAIT_L(0); PG8_BAR; PG8_MMA(0, 0, At, B0); PG8_MMA(0, 1, At, B1); PG8_BAR; PG8_SCHED;
            PG8_LDA(At, 1, 1); PG8_STAGE(PG8_SB(1, 0), b3, voffB); PG8_STAGE(PG8_SB(1, 1), b3 + hstepB, voffB); PG8_STAGE(PG8_SA(1, 0), a3, voffA);
            PG8_WAIT_V(8); PG8_WAIT_L(0); PG8_BAR; PG8_MMA(1, 0, At, B0); PG8_MMA(1, 1, At, B1); PG8_BAR; PG8_SCHED;
            } else {
            PG8_LDB(B0, 0, 0); PG8_SCHED; PG8_LDA(At, 0, 0); PG8_STAGE(PG8_SA(1, 1), a1 + hstepA, voffA);
            PG8_WAIT_L(8); PG8_BAR; PG8_WAIT_L(0); PG8_MMA(0, 0, At, B0); PG8_BAR; PG8_SCHED;
            PG8_LDB(B1, 0, 1); PG8_STAGE(PG8_SB(0, 0), b2, voffB);
            PG8_BAR; PG8_WAIT_L(0); PG8_MMA(0, 1, At, B1); PG8_BAR;
            PG8_LDA(At, 0, 1); PG8_STAGE(PG8_SA(0, 0), a2, voffA);
            PG8_BAR; PG8_WAIT_L(0); PG8_MMA(1, 0, At, B0); PG8_BAR; PG8_SCHED;
            PG8_STAGE(PG8_SB(0, 1), b2 + hstepB, voffB);
            PG8_WAIT_V(6); PG8_BAR; PG8_MMA(1, 1, At, B1); PG8_BAR;
            PG8_LDB(B0, 1, 0); PG8_SCHED; PG8_LDA(At, 1, 0); PG8_STAGE(PG8_SA(0, 1), a2 + hstepA, voffA);
            PG8_WAIT_L(8); PG8_BAR; PG8_WAIT_L(0); PG8_MMA(0, 0, At, B0); PG8_BAR; PG8_SCHED;
            PG8_LDB(B1, 1, 1); PG8_STAGE(PG8_SB(1, 0), b3, voffB);
            PG8_BAR; PG8_WAIT_L(0); PG8_MMA(0, 1, At, B1); PG8_BAR;
            PG8_LDA(At, 1, 1); PG8_STAGE(PG8_SA(1, 0), a3, voffA);
            PG8_BAR; PG8_WAIT_L(0); PG8_MMA(1, 0, At, B0); PG8_BAR; PG8_SCHED;
            PG8_STAGE(PG8_SB(1, 1), b3 + hstepB, voffB);
            PG8_WAIT_V(6); PG8_BAR; PG8_MMA(1, 1, At, B1); PG8_BAR;
            }
        }
        if constexpr (ALIGN_EPI) { if (wr == 0) PG8_BAR; }
        if constexpr (!Epi::AFTER_DRAIN) { E(acc, cur, wr, wc, fr, fq); S.done(cur); }
        if (!has_next) break;
#pragma unroll
        for (int a = 0; a < 2; ++a)
#pragma unroll
            for (int b = 0; b < 2; ++b)
#pragma unroll
                for (int m = 0; m < 4; ++m)
#pragma unroll
                    for (int n = 0; n < 2; ++n) acc[a][b][m][n] = (f32x4){0.f, 0.f, 0.f, 0.f};
        cur = nxt; cA = nA; cB = nB; ++ui;
        if constexpr (ALIGN_EPI) { if (wr == 1) PG8_BAR; }
    }
    PG8_WAIT_V(0);
    if constexpr (!ALIGN_EPI) { if (wr == 0) PG8_BAR; }
    PG8_BAR;
    if constexpr (Epi::AFTER_DRAIN) { E.fused(acc, cur, wr, wc, fr, fq, lds, wid, lane); S.done(cur); }
#undef PG8_SA
#undef PG8_SB
#undef PG8_STAGE
#undef PG8_LDA
#undef PG8_LDB
#undef PG8_MMA
#undef PG8_WAIT_V
#undef PG8_WAIT_L
#undef PG8_BAR
#undef PG8_SCHED
}
}

#define GAS __attribute__((address_space(1)))
#define LAS __attribute__((address_space(3)))
typedef unsigned short bf16;
typedef unsigned v4u __attribute__((ext_vector_type(4)));
typedef unsigned v2u __attribute__((ext_vector_type(2)));
typedef float f32x4 __attribute__((ext_vector_type(4)));
typedef float f32x2 __attribute__((ext_vector_type(2)));
constexpr int NWAVES = 8, NTHREADS = 512;
constexpr int NB = 8, SEQ = 4096, DM = 1024, MTOK = NB * SEQ, NMEMT = 256, MMEM = NB * NMEMT;
constexpr int DINP = 3600, NPROJ = 3584, DFF = 4096, DHY = 512, DML = 512, NHEAD = 4, DHEAD = 128;
constexpr float EPS = 1e-6f;
constexpr size_t MiB = 1u << 20;
constexpr size_t WS_CTL = 0, CTL_ZERO_BYTES = 1 * MiB;
constexpr size_t WS_WIN = 2 * MiB, WS_WOUT = 9 * MiB, WS_WQ = 11 * MiB, WS_WK = 13 * MiB, WS_WV = 15 * MiB, WS_WO = 17 * MiB, WS_W1 = 19 * MiB, WS_W2 = 27 * MiB;
constexpr size_t WS_MEMN = 35 * MiB, WS_KB = 39 * MiB, WS_VT = 43 * MiB, WS_GATES = 47 * MiB, WS_SSQ = 49 * MiB, WS_HID2 = 51 * MiB;
constexpr size_t WS_GF = 53 * MiB, WS_DEC = 55 * MiB;
constexpr size_t WS_XN = 64 * MiB;
constexpr size_t WS_QF = 64 * MiB, WS_KA = 96 * MiB;
constexpr size_t WS_PROJ = 128 * MiB, PROJ_STRIDE = (size_t)MTOK * 512;
constexpr size_t OUT_FILT = 96 * MiB;
constexpr size_t WS_HSPEC = 384 * MiB;
constexpr size_t WS_YT = 448 * MiB;
constexpr size_t WS_MIXED = 352 * MiB;
constexpr size_t WS_KF = 352 * MiB, WS_VF = 416 * MiB;
constexpr size_t WS_STATES = 128 * MiB;
constexpr size_t WS_SP = 416 * MiB, WS_HID = 192 * MiB;
constexpr size_t WS_MT = 288 * MiB, WS_VWT = 304 * MiB;
constexpr size_t WS_END = 512 * MiB;
constexpr int RING_BYTES = 131072, LDSCTL_OFF = 147456, LDS_BYTES = 163840;

__device__ __forceinline__ float bf2f(unsigned short h) { return __uint_as_float(((unsigned)h) << 16); }
__device__ __forceinline__ unsigned f2bf(float f) { unsigned u = __float_as_uint(f); return (u + 0x7fffu + ((u >> 16) & 1u)) >> 16; }
typedef __bf16 bf16x2_t __attribute__((ext_vector_type(2)));
__device__ __forceinline__ unsigned cvtpk(float lo, float hi) { const f32x2 v = {lo, hi}; const bf16x2_t b = __builtin_convertvector(v, bf16x2_t); return __builtin_bit_cast(unsigned, b); }
__device__ __forceinline__ unsigned pk2(float lo, float hi) { return cvtpk(lo, hi); }
__device__ __forceinline__ float wave_sum(float v) {
#pragma unroll
    for (int o = 1; o < 64; o <<= 1) v += __shfl_xor(v, o);
    return v;
}
#define LDS_WAIT() asm volatile("s_waitcnt lgkmcnt(0)" ::: "memory")
__device__ __forceinline__ float logsig(float x) { return fminf(x, 0.f) - log1pf(expf(-fabsf(x))); }

struct Args { const float* in[30]; float* out; unsigned char* ws; int ph_lo, ph_hi; };

__device__ __forceinline__ void p0_transpose_item(const float* W, int ldw, int K, int nblk, bf16* WT, const float* gain, LAS float* scr, int item, int lane) {
    const int kb = item / nblk, nb = item % nblk, k0 = 64 * kb, n0 = 32 * nb;
#pragma unroll 16
    for (int i = 0; i < 32; ++i) { const int kk = 2 * i + (lane >> 5); float w = W[(size_t)(k0 + kk) * ldw + n0 + (lane & 31)]; if (gain) w *= gain[k0 + kk]; scr[kk * 33 + (lane & 31)] = w; }
    LDS_WAIT(); asm volatile("" ::: "memory");
    const int c = lane & 7;
#pragma unroll
    for (int j = 0; j < 4; ++j) { const int n = (lane >> 3) + 8 * j; const LAS float* s = scr + (8 * c) * 33 + n;
        v4u o; o.x = pk2(s[0 * 33], s[1 * 33]); o.y = pk2(s[2 * 33], s[3 * 33]); o.z = pk2(s[4 * 33], s[5 * 33]); o.w = pk2(s[6 * 33], s[7 * 33]);
        *(v4u*)(WT + (size_t)(n0 + n) * K + k0 + 8 * c) = o; }
    LDS_WAIT(); asm volatile("" ::: "memory");
}

__device__ __forceinline__ void p0_prologue(const Args& a, LAS unsigned char* lds, int G, int vcu) {
    const int tid = threadIdx.x, lane = tid & 63, wave = __builtin_amdgcn_readfirstlane(tid >> 6);
    const int gw = vcu * NWAVES + wave, NGW = G * NWAVES;
    unsigned char* ws = a.ws;
    {
        LAS float* scr = (LAS float*)(lds + wave * 16384);
        constexpr int I_IN = 16 * 112, I_SQ = 16 * 32, I_1 = 16 * 128, I_2 = 64 * 32;
        constexpr int NITEMS = I_IN + 4 * I_SQ + I_1 + I_2;
        for (int it = gw; it < NITEMS; it += NGW) {
            int r = it;
            if (r < I_IN) { p0_transpose_item(a.in[3], DINP, DM, 112, (bf16*)(ws + WS_WIN), a.in[2], scr, r, lane); continue; } r -= I_IN;
            if (r < I_SQ) { const int k0 = 64 * (r / 32); const float* g = (k0 < 512) ? a.in[14] : (a.in[18] - 512);
                            p0_transpose_item(a.in[19], DM, DM, 32, (bf16*)(ws + WS_WOUT), g, scr, r, lane); continue; } r -= I_SQ;
            if (r < I_SQ) { p0_transpose_item(a.in[23], DM, DM, 32, (bf16*)(ws + WS_WK), a.in[21], scr, r, lane); continue; } r -= I_SQ;
            if (r < I_SQ) { p0_transpose_item(a.in[24], DM, DM, 32, (bf16*)(ws + WS_WV), a.in[21], scr, r, lane); continue; } r -= I_SQ;
            if (r < I_SQ) { p0_transpose_item(a.in[25], DM, DM, 32, (bf16*)(ws + WS_WO), nullptr, scr, r, lane); continue; } r -= I_SQ;
            if (r < I_1) { p0_transpose_item(a.in[27], DFF, DM, 128, (bf16*)(ws + WS_W1), a.in[26], scr, r, lane); continue; } r -= I_1;
            p0_transpose_item(a.in[28], DM, DFF, 32, (bf16*)(ws + WS_W2), nullptr, scr, r, lane);
        }
        for (int r = gw; r < DM; r += NGW) { const float g = a.in[20][r]; const f32x4* src = (const f32x4*)(a.in[22] + (size_t)r * DM) + lane;
            unsigned long long* o8 = (unsigned long long*)((bf16*)(ws + WS_WQ) + (size_t)r * DM) + lane;
#pragma unroll
            for (int j = 0; j < 4; ++j) { const f32x4 v = src[64 * j] * g; o8[64 * j] = (unsigned long long)pk2(v[0], v[1]) | ((unsigned long long)pk2(v[2], v[3]) << 32); } }
    }
    __syncthreads();
    LAS float* Wg = (LAS float*)lds;
#pragma unroll 8
    for (int idx = tid; idx < 16 * DM; idx += NTHREADS) { const int k = idx >> 4, j = idx & 15; Wg[j * DM + k] = a.in[2][k] * a.in[3][(size_t)k * DINP + NPROJ + j]; }
    __syncthreads();
    f32x4 nx[4];
    if (gw < MTOK) {
#pragma unroll
        for (int j = 0; j < 4; ++j) nx[j] = ((const f32x4*)(a.in[0] + (size_t)gw * DM) + lane)[64 * j]; }
    for (int m = gw; m < MTOK; m += NGW) {
        f32x4 v[4]; float ss = 0.f;
#pragma unroll
        for (int j = 0; j < 4; ++j) { v[j] = nx[j]; ss += (v[j][0] * v[j][0] + v[j][1] * v[j][1]) + (v[j][2] * v[j][2] + v[j][3] * v[j][3]); }
        if (m + NGW < MTOK) {
#pragma unroll
            for (int j = 0; j < 4; ++j) nx[j] = ((const f32x4*)(a.in[0] + (size_t)(m + NGW) * DM) + lane)[64 * j]; }
        const float rstd = __builtin_amdgcn_rsqf(wave_sum(ss) * (1.0f / DM) + EPS);
        unsigned long long* o8 = (unsigned long long*)((bf16*)(ws + WS_XN) + (size_t)m * DM) + lane;
#pragma unroll
        for (int j = 0; j < 4; ++j) { v[j] = v[j] * rstd; o8[64 * j] = (unsigned long long)pk2(v[j][0], v[j][1]) | ((unsigned long long)pk2(v[j][2], v[j][3]) << 32); }
        float gs[16];
#pragma unroll
        for (int g = 0; g < 16; ++g) { float s = 0.f;
#pragma unroll
            for (int j = 0; j < 4; ++j) { const f32x4 w = *(const LAS f32x4*)(Wg + g * DM + 4 * lane + 256 * j); s += (v[j][0] * w[0] + v[j][1] * w[1]) + (v[j][2] * w[2] + v[j][3] * w[3]); }
            gs[g] = s; if ((g & 3) == 3) asm volatile("" ::: "memory"); }
#pragma unroll
        for (int j = 0; j < 8; ++j) { const bool up = lane & 1; const float send = up ? gs[j] : gs[j + 8], keep = up ? gs[j + 8] : gs[j]; gs[j] = keep + __shfl_xor(send, 1); }
#pragma unroll
        for (int j = 0; j < 4; ++j) { const bool up = lane & 2; const float send = up ? gs[j] : gs[j + 4], keep = up ? gs[j + 4] : gs[j]; gs[j] = keep + __shfl_xor(send, 2); }
#pragma unroll
        for (int j = 0; j < 2; ++j) { const bool up = lane & 4; const float send = up ? gs[j] : gs[j + 2], keep = up ? gs[j + 2] : gs[j]; gs[j] = keep + __shfl_xor(send, 4); }
        { const bool up = lane & 8; const float send = up ? gs[0] : gs[1], keep = up ? gs[1] : gs[0]; gs[0] = keep + __shfl_xor(send, 8); }
        float tot = gs[0]; tot += __shfl_xor(tot, 16); tot += __shfl_xor(tot, 32);
        const int gi = ((lane & 1) << 3) | ((lane & 2) << 1) | ((lane & 4) >> 1) | ((lane & 8) >> 3);
        if (lane < 16) { float gv = tot + a.in[17][gi]; if (gi & 4) gv = logsig(gv); ((float*)(ws + WS_GATES))[(size_t)m * 16 + gi] = gv; }
    }
    for (int m = gw; m < MMEM; m += NGW) {
        const f32x4* xr = (const f32x4*)(a.in[1] + (size_t)m * DM) + lane;
        f32x4 v[4]; float ss = 0.f;
#pragma unroll
        for (int j = 0; j < 4; ++j) { v[j] = xr[64 * j]; ss += (v[j][0] * v[j][0] + v[j][1] * v[j][1]) + (v[j][2] * v[j][2] + v[j][3] * v[j][3]); }
        const float rstd = 1.0f / sqrtf(wave_sum(ss) * (1.0f / DM) + EPS);
        unsigned long long* o8 = (unsigned long long*)((bf16*)(ws + WS_MEMN) + (size_t)m * DM) + lane;
#pragma unroll
        for (int j = 0; j < 4; ++j) { v[j] = v[j] * rstd; o8[64 * j] = (unsigned long long)pk2(v[j][0], v[j][1]) | ((unsigned long long)pk2(v[j][2], v[j][3]) << 32); }
    }
    for (int t = gw; t < SEQ; t += NGW) {
        const float tl = (float)t * (1.0f / (float)(SEQ - 1)), ang = (6.283185307179586f / (float)SEQ) * (float)t;
        const int mb = lane & 15; const float band = 1e-4f + (float)mb * ((15.0f - 1e-4f) / 15.0f); const float ph = band * ang;
        const float zf = (lane & 16) ? -sinf(ph) : cosf(ph);
        float s = tl * a.in[6][lane];
#pragma unroll 8
        for (int i = 0; i < 32; ++i) s += __shfl(zf, i) * a.in[6][(1 + i) * 64 + lane];
        const float h1 = sinf(a.in[8][lane] * (s + a.in[7][lane]));
        float s2 = 0.f;
#pragma unroll 8
        for (int i = 0; i < 64; ++i) s2 += __shfl(h1, i) * a.in[9][i * 64 + lane];
        const float h2 = sinf(a.in[11][lane] * (s2 + a.in[10][lane]));
        ((float*)(ws + WS_HID2))[(size_t)t * 64 + lane] = h2;
    }
}
__device__ __forceinline__ float sigm(float x) { return __builtin_amdgcn_rcpf(1.0f + __builtin_amdgcn_exp2f(x * -1.4426950408889634f)); }
__device__ __forceinline__ float silu(float x) { return x * sigm(x); }

__device__ __forceinline__ void filters_phase(const Args& a, LAS unsigned char* lds, int G, int vcu) {
    const int tid = threadIdx.x, lane = tid & 63, wave = __builtin_amdgcn_readfirstlane(tid >> 6);
    const int gw = vcu * NWAVES + wave, NGW = G * NWAVES;
    const float* hid2 = (const float*)(a.ws + WS_HID2); float* filt = (float*)((unsigned char*)a.out + OUT_FILT);
    LAS float* hs = (LAS float*)(lds + 73728 + wave * 4096);
    for (int item = gw; item < 32 * 256; item += NGW) {
        const int cg = item & 31, tb = item >> 5, t0 = tb * 16, ch = cg * 64 + lane, c = ch & 511;
#pragma unroll
        for (int i = 0; i < 4; ++i) *(LAS f32x4*)(hs + (lane + 64 * i) * 4) = *(const f32x4*)(hid2 + (size_t)t0 * 64 + (lane + 64 * i) * 4);
        LDS_WAIT();
        float acc[16];
#pragma unroll
        for (int i = 0; i < 16; ++i) acc[i] = 0.f;
#pragma nounroll
        for (int j4 = 0; j4 < 16; ++j4) {
            const float w0 = a.in[12][(size_t)(4 * j4 + 0) * 2048 + ch], w1 = a.in[12][(size_t)(4 * j4 + 1) * 2048 + ch], w2 = a.in[12][(size_t)(4 * j4 + 2) * 2048 + ch], w3 = a.in[12][(size_t)(4 * j4 + 3) * 2048 + ch];
#pragma unroll
            for (int i = 0; i < 16; ++i) { const f32x4 h4 = *(const LAS f32x4*)(hs + i * 64 + 4 * j4); acc[i] += (h4[0] * w0 + h4[1] * w1) + (h4[2] * w2 + h4[3] * w3); }
        }
        const float mind = -3.0701134573253944f, maxd = -15.350567286626972f;
        const float ad = fabsf(mind + (float)c * ((maxd - mind) / 511.0f));
        float* dst = filt + (size_t)ch * SEQ + t0;
#pragma unroll
        for (int i4 = 0; i4 < 4; ++i4) { f32x4 o;
#pragma unroll
            for (int e = 0; e < 4; ++e) { const float tl = (float)(t0 + 4 * i4 + e) * (1.0f / (float)(SEQ - 1)); o[e] = acc[4 * i4 + e] * expf(-tl * ad); }
            *(f32x4*)(dst + 4 * i4) = o; }
        LDS_WAIT();
    }
}
__device__ __forceinline__ void softmax_rows(const Args& a, int G, int vcu) {
    const int tid = threadIdx.x, lane = tid & 63, wave = __builtin_amdgcn_readfirstlane(tid >> 6);
    const int gw = vcu * NWAVES + wave, NGW = G * NWAVES;
    bf16* sp = (bf16*)(a.ws + WS_SP);
    for (int m = gw; m < MTOK; m += NGW) {
        v4u* p = (v4u*)(sp + (size_t)m * DM + 16 * lane);
        const v4u r0 = p[0], r1 = p[1];
        float v[16];
        const unsigned w[8] = {r0.x, r0.y, r0.z, r0.w, r1.x, r1.y, r1.z, r1.w};
        float mx = -1e30f;
#pragma unroll
        for (int e = 0; e < 8; ++e) { v[2 * e] = __uint_as_float(w[e] << 16) * 0.0625f; v[2 * e + 1] = __uint_as_float(w[e] & 0xffff0000u) * 0.0625f; mx = fmaxf(mx, fmaxf(v[2 * e], v[2 * e + 1])); }
        mx = fmaxf(mx, __shfl_xor(mx, 1)); mx = fmaxf(mx, __shfl_xor(mx, 2)); mx = fmaxf(mx, __shfl_xor(mx, 4)); mx = fmaxf(mx, __shfl_xor(mx, 8));
        float sum = 0.f;
#pragma unroll
        for (int e = 0; e < 16; ++e) { v[e] = expf(v[e] - mx); sum += v[e]; }
        sum += __shfl_xor(sum, 1); sum += __shfl_xor(sum, 2); sum += __shfl_xor(sum, 4); sum += __shfl_xor(sum, 8);
        const float inv = 1.0f / sum;
        v4u o0, o1;
        o0.x = pk2(v[0] * inv, v[1] * inv); o0.y = pk2(v[2] * inv, v[3] * inv); o0.z = pk2(v[4] * inv, v[5] * inv); o0.w = pk2(v[6] * inv, v[7] * inv);
        o1.x = pk2(v[8] * inv, v[9] * inv); o1.y = pk2(v[10] * inv, v[11] * inv); o1.z = pk2(v[12] * inv, v[13] * inv); o1.w = pk2(v[14] * inv, v[15] * inv);
        p[0] = o0; p[1] = o1;
    }
}
__device__ __forceinline__ void final_norm(const Args& a, int G, int vcu) {
    const int tid = threadIdx.x, lane = tid & 63, wave = __builtin_amdgcn_readfirstlane(tid >> 6);
    const int gw = vcu * NWAVES + wave, NGW = G * NWAVES;
    const bf16* xn = (const bf16*)(a.ws + WS_XN);
    f32x4 g4[4];
#pragma unroll
    for (int j = 0; j < 4; ++j) g4[j] = *((const f32x4*)a.in[29] + 4 * lane + j);
    for (int m = gw; m < MTOK; m += NGW) {
        const v4u* p = (const v4u*)(xn + (size_t)m * DM + 16 * lane);
        const v4u r0 = p[0], r1 = p[1];
        const unsigned w[8] = {r0.x, r0.y, r0.z, r0.w, r1.x, r1.y, r1.z, r1.w};
        float v[16]; float ss = 0.f;
#pragma unroll
        for (int e = 0; e < 8; ++e) { v[2 * e] = __uint_as_float(w[e] << 16); v[2 * e + 1] = __uint_as_float(w[e] & 0xffff0000u); ss += v[2 * e] * v[2 * e] + v[2 * e + 1] * v[2 * e + 1]; }
        const float rstd = __builtin_amdgcn_rsqf(wave_sum(ss) * (1.0f / DM) + EPS);
        f32x4* o = (f32x4*)(a.out + (size_t)m * DM + 16 * lane);
#pragma unroll
        for (int j = 0; j < 4; ++j) o[j] = (f32x4){v[4 * j] * rstd * g4[j][0], v[4 * j + 1] * rstd * g4[j][1], v[4 * j + 2] * rstd * g4[j][2], v[4 * j + 3] * rstd * g4[j][3]};
    }
}
typedef __amdgpu_buffer_rsrc_t rsrc_t;
typedef unsigned u32x2v __attribute__((ext_vector_type(2)));
__device__ __forceinline__ rsrc_t mkrsrc(const void* p, unsigned bytes) { return __builtin_amdgcn_make_buffer_rsrc((void*)p, 0, bytes, 0x00020000); }
__device__ __forceinline__ float bld_bf16(rsrc_t r, unsigned off) { return bf2f(__builtin_amdgcn_raw_buffer_load_b16(r, off, 0, 0)); }
__device__ __forceinline__ float bld_bf16s(rsrc_t r, unsigned off, unsigned soff) { return bf2f(__builtin_amdgcn_raw_buffer_load_b16(r, off, soff, 0)); }
__device__ __forceinline__ float bld_f32(rsrc_t r, unsigned off, unsigned soff = 0) { return __uint_as_float(__builtin_amdgcn_raw_buffer_load_b32(r, off, soff, 0)); }
typedef unsigned u32x4b __attribute__((ext_vector_type(4)));
__device__ __forceinline__ v4u bld128(rsrc_t r, unsigned voff, unsigned soff) { const u32x4b w = __builtin_amdgcn_raw_buffer_load_b128(r, voff, soff, 0); return (v4u){w.x, w.y, w.z, w.w}; }
__device__ __forceinline__ v2u bld64(rsrc_t r, unsigned voff, unsigned soff) { const u32x2v w = __builtin_amdgcn_raw_buffer_load_b64(r, voff, soff, 0); return (v2u){w.x, w.y}; }
typedef short bf16x8 __attribute__((ext_vector_type(8)));
typedef float f32x16 __attribute__((ext_vector_type(16)));
#define MFMA32(a, b, c) __builtin_amdgcn_mfma_f32_32x32x16_bf16((a), (b), (c), 0, 0, 0)
__device__ __forceinline__ int crow(int r, int h) { return (r & 3) + 8 * (r >> 2) + 4 * h; }
__device__ __forceinline__ bf16x8 scale_frag(v4u raw, float s) {
    v4u o;
#pragma unroll
    for (int e = 0; e < 4; ++e) o[e] = cvtpk(__uint_as_float(raw[e] << 16) * s, __uint_as_float(raw[e] & 0xffff0000u) * s);
    return __builtin_bit_cast(bf16x8, o);
}
__device__ __forceinline__ bf16x8 scale_frag8(v4u raw, f32x4 s0, f32x4 s1) {
    v4u o;
    o[0] = cvtpk(__uint_as_float(raw[0] << 16) * s0[0], __uint_as_float(raw[0] & 0xffff0000u) * s0[1]);
    o[1] = cvtpk(__uint_as_float(raw[1] << 16) * s0[2], __uint_as_float(raw[1] & 0xffff0000u) * s0[3]);
    o[2] = cvtpk(__uint_as_float(raw[2] << 16) * s1[0], __uint_as_float(raw[2] & 0xffff0000u) * s1[1]);
    o[3] = cvtpk(__uint_as_float(raw[3] << 16) * s1[2], __uint_as_float(raw[3] & 0xffff0000u) * s1[3]);
    return __builtin_bit_cast(bf16x8, o);
}
struct ScanCtx { f32x16 acc; v4u ar[4]; bf16x8 br[4]; float be, dc; int step; };
struct ScanEnv { const Args* a; LAS unsigned char* lds; int vcu; };
__device__ __forceinline__ void scan_load(ScanCtx& s, const ScanEnv& e, int jq, int lane, int wave) {
    const int cd = e.vcu, chain = cd >> 2, dt = cd & 3, nt = wave, b = chain >> 3, hh = (chain >> 1) & 3, dir = chain & 1;
    const int j_ = dir ? 63 - jq : jq;
    const unsigned char* ws = e.a->ws;
    const rsrc_t rva = mkrsrc((const bf16*)(ws + WS_VF) + (size_t)((b * 4 + hh) * 64) * 8192, 64 * 16384), rkb = mkrsrc((const bf16*)(ws + WS_KF) + (size_t)((b * 4 + hh) * 64) * 8192, 64 * 16384);
    const rsrc_t rgf = mkrsrc((const float*)(ws + WS_GF) + (size_t)b * SEQ * 16, SEQ * 64);
    const unsigned vo = lane * 16 + (nt < 4 ? nt : 0) * 4096, ko = lane * 16 + dt * 4096, go = lane * 64 + (hh * 4 + 2 * dir + 1) * 4;
#pragma unroll
    for (int ks = 0; ks < 4; ++ks) { s.ar[ks] = bld128(rva, vo + ks * 1024, j_ * 16384); s.br[ks] = __builtin_bit_cast(bf16x8, bld128(rkb, ko + ks * 1024, j_ * 16384)); }
    s.be = bld_f32(rgf, go, j_ * 4096); s.dc = ((const float*)(ws + WS_DEC))[(size_t)((b * 4 + hh) * 64 + j_) * 2 + dir];
}
__device__ __forceinline__ void scan_tick(ScanCtx& s, const ScanEnv& e, int lane, int wave) {
    if (wave >= 5 || s.step >= 64) return;
    const int cd = e.vcu, chain = cd >> 2, dt = cd & 3, nt = wave, dir = chain & 1, l31 = lane & 31, h = lane >> 5;
    const int j_ = dir ? 63 - s.step : s.step;
    unsigned char* ws = e.a->ws;
    LAS float* wsc = (LAS float*)(e.lds + 139264 + wave * 256);
    bf16* ST = (bf16*)(ws + WS_STATES); bf16* NV = (bf16*)(ws + WS_STATES + 128 * MiB);
    wsc[lane] = s.be; const float decay = s.dc;
    if (nt < 4) { bf16* sp = ST + ((size_t)(chain * 64 + j_) * 32 + nt * 8 + 2 * dt + (l31 >> 4)) * 512 + (((l31 >> 3) & 1) * 32) * 8 + (l31 & 7);
#pragma unroll
        for (int r = 0; r < 16; ++r) sp[crow(r, h) * 8] = (bf16)(cvtpk(s.acc[r], 0.f) & 0xffffu); }
    else if (h == 0) NV[(size_t)(chain * 64 + j_) * 128 + 32 * dt + l31] = (bf16)(cvtpk(s.acc[0], 0.f) & 0xffffu);
#pragma unroll
    for (int ks = 0; ks < 4; ++ks) { v4u araw = s.ar[ks]; if (nt == 4) { const unsigned w1 = (l31 == 0) ? 0x3f803f80u : 0u; araw = (v4u){w1, w1, w1, w1}; }
        const f32x4 b0 = *(const LAS f32x4*)(wsc + 16 * ks + 4 * h), b1 = *(const LAS f32x4*)(wsc + 16 * ks + 8 + 4 * h);
        s.acc = MFMA32(scale_frag8(araw, b0, b1), s.br[ks], s.acc); }
#pragma unroll
    for (int r = 0; r < 16; ++r) s.acc[r] *= decay;
    s.step += 1;
    scan_load(s, e, s.step < 64 ? s.step : 63, lane, wave);
}
__device__ __forceinline__ void scan_init(ScanCtx& s, const ScanEnv& e, int lane, int wave) {
#pragma unroll
    for (int r = 0; r < 16; ++r) s.acc[r] = 0.f;
    s.step = 0;
    if (wave < 5) scan_load(s, e, 0, lane, wave); else { s.step = 64;
#pragma unroll
        for (int ks = 0; ks < 4; ++ks) { s.ar[ks] = (v4u){0u, 0u, 0u, 0u}; s.br[ks] = __builtin_bit_cast(bf16x8, (v4u){0u, 0u, 0u, 0u}); } s.be = 0.f; s.dc = 0.f; }
}
__device__ __forceinline__ f32x2 cmul(f32x2 a, f32x2 b) { return (f32x2){a.x * b.x - a.y * b.y, a.x * b.y + a.y * b.x}; }
__device__ __forceinline__ f32x2 cmulc(f32x2 a, f32x2 b) { return (f32x2){a.x * b.x + a.y * b.y, a.y * b.x - a.x * b.y}; }
template <bool INV> __device__ __forceinline__ void dft4(f32x2& x0, f32x2& x1, f32x2& x2, f32x2& x3) {
    const f32x2 s02 = x0 + x2, d02 = x0 - x2, s13 = x1 + x3, d13 = x1 - x3;
    const f32x2 jd = INV ? (f32x2){-d13.y, d13.x} : (f32x2){d13.y, -d13.x};
    x0 = s02 + s13; x1 = d02 + jd; x2 = s02 - s13; x3 = d02 - jd;
}
template <bool INV> __device__ __forceinline__ void fft16(f32x2 (&v)[16]) {
    constexpr float C1 = 0.9238795325112867f, S1 = 0.3826834323650898f, R2 = 0.7071067811865476f;
    constexpr float WR[10] = {1.f, C1, R2, S1, 0.f, 0.f, -R2, 0.f, 0.f, -C1};
    constexpr float WI[10] = {0.f, -S1, -R2, -C1, -1.f, 0.f, -R2, 0.f, 0.f, S1};
#pragma unroll
    for (int b = 0; b < 4; ++b) {
        dft4<INV>(v[b], v[4 + b], v[8 + b], v[12 + b]);
#pragma unroll
        for (int c = 1; c < 4; ++c) { if (b == 0) continue; const f32x2 w = {WR[b * c], INV ? -WI[b * c] : WI[b * c]}; v[4 * c + b] = cmul(v[4 * c + b], w); }
    }
    f32x2 o[16];
#pragma unroll
    for (int c = 0; c < 4; ++c) {
        f32x2 y0 = v[4 * c + 0], y1 = v[4 * c + 1], y2 = v[4 * c + 2], y3 = v[4 * c + 3];
        dft4<INV>(y0, y1, y2, y3);
        o[c] = y0; o[c + 4] = y1; o[c + 8] = y2; o[c + 12] = y3;
    }
#pragma unroll
    for (int k = 0; k < 16; ++k) v[k] = o[k];
}
__device__ __forceinline__ f32x2 w32c(int a) {
    constexpr float CR[16] = {1.f, 0.9807852804032304f, 0.9238795325112867f, 0.8314696123025452f, 0.7071067811865476f, 0.5555702330196022f, 0.3826834323650898f, 0.1950903220161283f,
                              0.f, -0.1950903220161283f, -0.3826834323650898f, -0.5555702330196022f, -0.7071067811865476f, -0.8314696123025452f, -0.9238795325112867f, -0.9807852804032304f};
    constexpr float CI[16] = {0.f, -0.1950903220161283f, -0.3826834323650898f, -0.5555702330196022f, -0.7071067811865476f, -0.8314696123025452f, -0.9238795325112867f, -0.9807852804032304f,
                              -1.f, -0.9807852804032304f, -0.9238795325112867f, -0.8314696123025452f, -0.7071067811865476f, -0.5555702330196022f, -0.3826834323650898f, -0.1950903220161283f};
    return (f32x2){CR[a], CI[a]};
}
constexpr int HY_BUF_BYTES = 34816, HY_TW1_OFF = 2 * HY_BUF_BYTES, HY_TW2_OFF = HY_TW1_OFF + 32768;
__device__ __forceinline__ void hy_fwd(LAS f32x2* hb, int half, int u, f32x2 wu, const LAS f32x2* tw1, const LAS f32x2* tw2, f32x2 (&V)[16], ScanCtx& sc, const ScanEnv& se) {
    const int sl_ = threadIdx.x & 63, sw_ = __builtin_amdgcn_readfirstlane(threadIdx.x >> 6);
    const int p1 = u + (u >> 4), p2 = 272 * (u >> 4) + (u & 15), p3 = 17 * u;
#pragma unroll
    for (int k = 0; k < 16; ++k) V[k] = hb[272 * k + p1];
    if (half) {
#pragma unroll
        for (int k = 1; k < 16; ++k) V[k] = cmul(V[k], w32c(k));
    }
    fft16<false>(V);
#pragma unroll
    for (int k = 0; k < 16; ++k) { if (k == 0 && !half) continue; V[k] = cmul(V[k], tw1[k * 256 + u]); }
#pragma unroll
    for (int k = 0; k < 16; ++k) hb[272 * k + p1] = V[k];
    __syncthreads(); scan_tick(sc, se, sl_, sw_);
#pragma unroll
    for (int k = 0; k < 16; ++k) V[k] = hb[p2 + 17 * k];
    fft16<false>(V);
#pragma unroll
    for (int k = 1; k < 16; ++k) V[k] = cmul(V[k], tw2[k * 16 + (u & 15)]);
#pragma unroll
    for (int k = 0; k < 16; ++k) hb[p2 + 17 * k] = V[k];
    __syncthreads(); scan_tick(sc, se, sl_, sw_);
#pragma unroll
    for (int k = 0; k < 16; ++k) V[k] = hb[p3 + k];
    fft16<false>(V);
}
__device__ __forceinline__ void hy_inv(LAS f32x2* hb, int half, int u, f32x2 wu, const LAS f32x2* tw1, const LAS f32x2* tw2, f32x2 (&V)[16], ScanCtx& sc, const ScanEnv& se) {
    const int sl_ = threadIdx.x & 63, sw_ = __builtin_amdgcn_readfirstlane(threadIdx.x >> 6);
    const int p1 = u + (u >> 4), p2 = 272 * (u >> 4) + (u & 15), p3 = 17 * u;
    fft16<true>(V);
#pragma unroll
    for (int k = 1; k < 16; ++k) V[k] = cmulc(V[k], tw2[k * 16 + (u & 15)]);
#pragma unroll
    for (int k = 0; k < 16; ++k) hb[p3 + k] = V[k];
    __syncthreads(); scan_tick(sc, se, sl_, sw_);
#pragma unroll
    for (int k = 0; k < 16; ++k) V[k] = hb[p2 + 17 * k];
    fft16<true>(V);
#pragma unroll
    for (int k = 0; k < 16; ++k) V[k] = cmulc(V[k], tw1[(u >> 4) * 256 + 16 * k + (u & 15)]);
#pragma unroll
    for (int k = 0; k < 16; ++k) hb[p2 + 17 * k] = V[k];
    __syncthreads(); scan_tick(sc, se, sl_, sw_);
#pragma unroll
    for (int k = 0; k < 16; ++k) V[k] = hb[272 * k + p1];
    fft16<true>(V);
    if (half) {
#pragma unroll
        for (int k = 1; k < 16; ++k) V[k] = cmulc(V[k], w32c(k));
    }
#pragma unroll
    for (int k = 0; k < 16; ++k) hb[272 * k + p1] = V[k];
}
__device__ __forceinline__ int hpos(int n) { return n + (n >> 4); }
template <int O> __device__ __forceinline__ void hy_order(const Args& a, LAS f32x2* bufE, LAS f32x2* bufO, LAS f32x2* hb, int half, int u, f32x2 wu, const LAS f32x2* t1, const LAS f32x2* tw2,
                                                          rsrc_t rH, f32x2 (&xin)[8], int c, int b0, float skip, ScanCtx& sc, const ScanEnv& se) {
    const int tid = threadIdx.x;
    const bf16* hyT = (const bf16*)a.out; bf16* yT = (bf16*)(a.ws + WS_YT);
    f32x2 V[16];
    u32x2v hw[16];
#pragma unroll
    for (int k = 0; k < 16; ++k) hw[k] = __builtin_amdgcn_raw_buffer_load_b64(rH, tid * 8, (O * 16 + k) * 4096, 0);
    __syncthreads();
    hy_fwd(hb, half, u, wu, t1, tw2, V, sc, se);
    const rsrc_t rg0 = mkrsrc(hyT + ((size_t)b0 * 1536 + 512 * (O + 1) + c) * SEQ, SEQ * 2), rg1 = mkrsrc(hyT + ((size_t)(b0 + 1) * 1536 + 512 * (O + 1) + c) * SEQ, SEQ * 2);
    unsigned short gw0[8], gw1[8];
#pragma unroll
    for (int i = 0; i < 8; ++i) { gw0[i] = __builtin_amdgcn_raw_buffer_load_b16(rg0, (tid + 512 * i) * 2, 0, 0); gw1[i] = __builtin_amdgcn_raw_buffer_load_b16(rg1, (tid + 512 * i) * 2, 0, 0); }
#pragma unroll
    for (int k = 0; k < 16; ++k) V[k] = cmul(V[k], (f32x2){__uint_as_float(hw[k].x), __uint_as_float(hw[k].y)});
    hy_inv(hb, half, u, wu, t1, tw2, V, sc, se);
    __syncthreads();
    const rsrc_t ry0 = mkrsrc(yT + ((size_t)b0 * 512 + c) * SEQ, SEQ * 2), ry1 = mkrsrc(yT + ((size_t)(b0 + 1) * 512 + c) * SEQ, SEQ * 2);
#pragma unroll
    for (int i = 0; i < 8; ++i) { const int n = tid + 512 * i, p = hpos(n);
        const f32x2 y = (bufE[p] + bufO[p]) * (1.0f / 8192.0f);
        f32x2 r; r.x = bf2f(gw0[i]) * (y.x + skip * xin[i].x); r.y = bf2f(gw1[i]) * (y.y + skip * xin[i].y);
        if (O == 0) { xin[i] = r; bufE[p] = r; bufO[p] = r; }
        else { __builtin_amdgcn_raw_buffer_store_b16((unsigned short)(cvtpk(r.x, 0.f) & 0xffffu), ry0, n * 2, 0, 0); __builtin_amdgcn_raw_buffer_store_b16((unsigned short)(cvtpk(r.y, 0.f) & 0xffffu), ry1, n * 2, 0, 0); } }
}
__device__ __forceinline__ void hyena_fft(const Args& a, LAS unsigned char* lds, int G, int vcu) {
    const int tid = threadIdx.x, half = __builtin_amdgcn_readfirstlane(tid >> 8), u = tid & 255;
    LAS f32x2* bufE = (LAS f32x2*)lds; LAS f32x2* bufO = (LAS f32x2*)(lds + HY_BUF_BYTES);
    LAS f32x2* tw1 = (LAS f32x2*)(lds + HY_TW1_OFF); LAS f32x2* tw2 = (LAS f32x2*)(lds + HY_TW2_OFF);
    LAS f32x2* hb = half ? bufO : bufE;
    LAS f32x2* tw1o = (LAS f32x2*)(lds + HY_TW2_OFF + 2048);
    const LAS f32x2* t1 = half ? tw1o : tw1;
    const bf16* hyT = (const bf16*)a.out; const float* filt = (const float*)((const unsigned char*)a.out + OUT_FILT);
    __syncthreads();
    for (int idx = tid; idx < 4096; idx += NTHREADS) { const int m = (idx & 255) * (idx >> 8); float s, c; sincospif((float)m * (1.0f / 2048.0f), &s, &c); tw1[idx] = (f32x2){c, -s};
        sincospif((float)(2 * m + (idx & 255)) * (1.0f / 4096.0f), &s, &c); tw1o[idx] = (f32x2){c, -s}; }
    if (tid < 256) { const int m = 16 * (tid & 15) * (tid >> 4); float s, c; sincospif((float)m * (1.0f / 2048.0f), &s, &c); tw2[tid] = (f32x2){c, -s}; }
    f32x2 wu; { float s, c; sincospif((float)u * (1.0f / 4096.0f), &s, &c); wu = (f32x2){c, -s}; }
    ScanCtx sc; const ScanEnv se = {&a, lds, vcu};
    { const int sl_ = tid & 63, sw_ = __builtin_amdgcn_readfirstlane(tid >> 6); if (G == 256) scan_init(sc, se, sl_, sw_); else { scan_init(sc, se, sl_, 8); } }
    const rsrc_t rH = mkrsrc(a.ws + WS_HSPEC + (size_t)blockIdx.x * (2 * 16 * NTHREADS * 8), 2 * 16 * NTHREADS * 8);
    for (int c = vcu; c < DHY; c += G) {
#pragma nounroll
        for (int o = 0; o < 2; ++o) {
            const rsrc_t rf = mkrsrc(filt + ((size_t)(o * 2 + 0) * 512 + c) * SEQ, SEQ * 4), rk = mkrsrc(filt + ((size_t)(o * 2 + 1) * 512 + c) * SEQ, SEQ * 4);
            __syncthreads();
#pragma unroll
            for (int i = 0; i < 8; ++i) { const int n = tid + 512 * i, p = hpos(n); const float f = bld_f32(rf, n * 4); float r = bld_f32(rk, (SEQ - n) * 4); r = (n >= 1) ? r : 0.f;
                bufE[p] = (f32x2){f + r, 0.f}; bufO[p] = (f32x2){f - r, 0.f}; }
            __syncthreads();
            f32x2 V[16];
            hy_fwd(hb, half, u, wu, t1, tw2, V, sc, se);
#pragma unroll
            for (int k = 0; k < 16; ++k) { u32x2v w; w.x = __float_as_uint(V[k].x); w.y = __float_as_uint(V[k].y); __builtin_amdgcn_raw_buffer_store_b64(w, rH, tid * 8, (o * 16 + k) * 4096, 0); }
        }
        const float skip0 = a.in[13][c], skip1 = a.in[13][512 + c];
#pragma nounroll
        for (int pr = 0; pr < 4; ++pr) {
            const int b0 = 2 * pr;
            f32x2 xin[8];
            const rsrc_t rv0 = mkrsrc(hyT + ((size_t)b0 * 1536 + c) * SEQ, SEQ * 2), rv1 = mkrsrc(hyT + ((size_t)(b0 + 1) * 1536 + c) * SEQ, SEQ * 2);
            __syncthreads();
#pragma unroll
            for (int i = 0; i < 8; ++i) { const int n = tid + 512 * i, p = hpos(n); xin[i] = (f32x2){bld_bf16(rv0, n * 2), bld_bf16(rv1, n * 2)}; bufE[p] = xin[i]; bufO[p] = xin[i]; }
            hy_order<0>(a, bufE, bufO, hb, half, u, wu, t1, tw2, rH, xin, c, b0, skip0, sc, se);
            hy_order<1>(a, bufE, bufO, hb, half, u, wu, t1, tw2, rH, xin, c, b0, skip1, sc, se);
        }
    }
    { const int sl_ = tid & 63, sw_ = __builtin_amdgcn_readfirstlane(tid >> 6); while (sc.step < 64) scan_tick(sc, se, sl_, sw_); }
    __syncthreads();
}
__device__ __forceinline__ float incl_prefix(float x, int lane) {
#pragma unroll
    for (int d = 1; d < 64; d <<= 1) { const float t = __shfl_up(x, d); if (lane >= d) x += t; }
    return x;
}
__device__ __forceinline__ float incl_suffix(float x, int lane) {
#pragma unroll
    for (int d = 1; d < 64; d <<= 1) { const float t = __shfl_down(x, d); if (lane + d < 64) x += t; }
    return x;
}
__device__ __forceinline__ void gate_factors(const Args& a, int G, int vcu) {
    const int tid = threadIdx.x, lane = tid & 63, wave = __builtin_amdgcn_readfirstlane(tid >> 6);
    const int gw = vcu * NWAVES + wave, NGW = G * NWAVES;
    const float* gates = (const float*)(a.ws + WS_GATES); float* gf = (float*)(a.ws + WS_GF); float* dec = (float*)(a.ws + WS_DEC);
    for (int task = gw; task < NB * NHEAD * 64; task += NGW) {
        const int b = task >> 8, hh = (task >> 6) & 3, j = task & 63; const size_t row = (size_t)b * SEQ + j * 64 + lane;
        const float* gp = gates + row * 16 + hh;
        const float i_f = gp[0], a_f = gp[4], i_b = gp[8], a_b = gp[12];
        const float F = incl_prefix(a_f, lane), Gs = incl_suffix(a_b, lane);
        *(f32x4*)(gf + row * 16 + hh * 4) = (f32x4){expf(F), expf(i_f - F), expf(Gs), expf(i_b - Gs)};
        if (lane == 63) dec[(size_t)task * 2] = expf(F);
        if (lane == 0) dec[(size_t)task * 2 + 1] = expf(Gs);
    }
}
__device__ __forceinline__ void mlstm_scan(const Args& a, LAS unsigned char* lds, int G, int vcu) {
    int tid = threadIdx.x; asm volatile("" : "+v"(tid));
    const int lane = tid & 63, wave = __builtin_amdgcn_readfirstlane(tid >> 6), l31 = lane & 31, h = lane >> 5;
    const int gw = wave * G + vcu, NGW = G * NWAVES;
    LAS float* wsc = (LAS float*)(lds + wave * 1024);
    const bf16* KFp = (const bf16*)(a.ws + WS_KF); const bf16* VFp = (const bf16*)(a.ws + WS_VF);
    const float* gf = (const float*)(a.ws + WS_GF); const float* dec = (const float*)(a.ws + WS_DEC); bf16* ST = (bf16*)(a.ws + WS_STATES); bf16* NV = (bf16*)(a.ws + WS_STATES + 128 * MiB);
    for (int cd = vcu; cd < 64 * 4; cd += G) { if (wave >= 5) break;
        const int chain = cd >> 2, dt = cd & 3, nt = wave;
        const int b = chain >> 3, hh = (chain >> 1) & 3, dir = chain & 1;
        f32x16 acc;
#pragma unroll
        for (int r = 0; r < 16; ++r) acc[r] = 0.f;
        const rsrc_t rva = mkrsrc(VFp + (size_t)((b * 4 + hh) * 64) * 8192, 64 * 16384), rkb = mkrsrc(KFp + (size_t)((b * 4 + hh) * 64) * 8192, 64 * 16384);
        const rsrc_t rgf = mkrsrc(gf + (size_t)b * SEQ * 16, SEQ * 64);
        const unsigned vo = lane * 16 + (nt < 4 ? nt : 0) * 4096, ko = lane * 16 + dt * 4096, go = lane * 64 + (hh * 4 + 2 * dir + 1) * 4;
        const float* dbase = dec + (size_t)((b * 4 + hh) * 64) * 2 + dir;
        const v4u ones = {0x3f803f80u, 0x3f803f80u, 0x3f803f80u, 0x3f803f80u}, zeros = {0u, 0u, 0u, 0u};
        struct Stg { v4u ar[4]; bf16x8 br[4]; float be, dc; };
#define SCAN_LOAD(S, jq) do { const int jc_ = (jq) < 0 ? 0 : ((jq) > 63 ? 63 : (jq)); const int j_ = dir ? 63 - jc_ : jc_; _Pragma("unroll") for (int ks = 0; ks < 4; ++ks) { \
            S.ar[ks] = bld128(rva, vo + ks * 1024, j_ * 16384); S.br[ks] = __builtin_bit_cast(bf16x8, bld128(rkb, ko + ks * 1024, j_ * 16384)); } S.be = bld_f32(rgf, go, j_ * 4096); S.dc = dbase[j_ * 2]; } while (0)
#define SCAN_STEP(S, jq) do { const int j_ = dir ? 63 - (jq) : (jq); \
            wsc[lane] = S.be; const float decay = S.dc; \
            if (nt < 4) { bf16* sp = ST + ((size_t)(chain * 64 + j_) * 32 + nt * 8 + 2 * dt + (l31 >> 4)) * 512 + (((l31 >> 3) & 1) * 32) * 8 + (l31 & 7); \
                _Pragma("unroll") for (int r = 0; r < 16; ++r) sp[crow(r, h) * 8] = (bf16)f2bf(acc[r]); } \
            else if (h == 0) NV[(size_t)(chain * 64 + j_) * 128 + 32 * dt + l31] = (bf16)f2bf(acc[0]);     \
            _Pragma("unroll") for (int ks = 0; ks < 4; ++ks) { v4u araw = S.ar[ks]; if (nt == 4) araw = (l31 == 0) ? ones : zeros; \
                const f32x4 b0 = *(const LAS f32x4*)(wsc + 16 * ks + 4 * h), b1 = *(const LAS f32x4*)(wsc + 16 * ks + 8 + 4 * h); \
                acc = MFMA32(scale_frag8(araw, b0, b1), S.br[ks], acc); } \
            _Pragma("unroll") for (int r = 0; r < 16; ++r) acc[r] *= decay; } while (0)
        Stg s0, s1, s2;
        SCAN_LOAD(s0, 0); SCAN_LOAD(s1, 1);
#pragma nounroll
        for (int jj = 0; jj < 63; jj += 3) {
            SCAN_LOAD(s2, jj + 2); SCAN_STEP(s0, jj);
            SCAN_LOAD(s0, jj + 3); SCAN_STEP(s1, jj + 1);
            SCAN_LOAD(s1, jj + 4); SCAN_STEP(s2, jj + 2);
        }
        SCAN_STEP(s0, 63);
#undef SCAN_LOAD
#undef SCAN_STEP
    }
}
constexpr int ML_WAVE_LDS = 18432, ML_YROW = 136;
__device__ __forceinline__ void mlstm_out(const Args& a, LAS unsigned char* lds, int G, int vcu) {
    int tid = threadIdx.x; asm volatile("" : "+v"(tid));
    const int lane = tid & 63, wave = __builtin_amdgcn_readfirstlane(tid >> 6), l31 = lane & 31, h = lane >> 5;
    const int gw = vcu * NWAVES + wave, NGW = G * NWAVES;
    LAS float* sc = (LAS float*)(lds + wave * ML_WAVE_LDS);
    LAS bf16* ybuf = (LAS bf16*)(lds + wave * ML_WAVE_LDS + 1024); LAS float* rsb = (LAS float*)(lds + wave * ML_WAVE_LDS + 1024 + 32 * ML_YROW * 2);
    LAS float* ivb = rsb + 32;
    LAS v4u* pfl = (LAS v4u*)(lds + wave * ML_WAVE_LDS + 10240) + lane;
    const unsigned char* QFp = a.ws + WS_QF; const unsigned char* KAp = a.ws + WS_KA; const unsigned char* VFp = a.ws + WS_VF;
    const bf16* om = (const bf16*)(a.ws + WS_PROJ) + 6 * PROJ_STRIDE; const float* gf = (const float*)(a.ws + WS_GF);
    const bf16* ST = (const bf16*)(a.ws + WS_STATES); const bf16* NV = (const bf16*)(a.ws + WS_STATES + 128 * MiB); bf16* mixed = (bf16*)(a.ws + WS_MIXED);
    const unsigned lo = lane * 16;
    for (int t4 = vcu * NWAVES; t4 < NB * NHEAD * 64; t4 += NGW)
    for (int rr = 0; rr < 2; ++rr) {
        const int task = t4 + rr * 4 + (wave & 3);
        const int b = task >> 8, hh = (task >> 6) & 3, j = task & 63, t0 = j * 64, row0 = b * SEQ + t0;
        { const f32x4 g4 = *(const f32x4*)(gf + (size_t)(row0 + lane) * 16 + hh * 4);
          sc[lane] = g4[0]; sc[64 + lane] = g4[1]; sc[128 + lane] = g4[2]; sc[192 + lane] = g4[3]; }
        const size_t fo = (size_t)(((b * 4 + hh) * 64 + j)) * 16384;
        const rsrc_t rq = mkrsrc(QFp + fo, 16384), rk = mkrsrc(KAp + fo, 16384), rv = mkrsrc(VFp + fo, 16384);
        const rsrc_t rs0 = mkrsrc(ST + ((size_t)(((b * 4 + hh) * 2 + 0) * 64 + j) * 32) * 512, 32768), rs1 = mkrsrc(ST + ((size_t)(((b * 4 + hh) * 2 + 1) * 64 + j) * 32) * 512, 32768);
        const rsrc_t rn0 = mkrsrc(NV + (size_t)(((b * 4 + hh) * 2 + 0) * 64 + j) * 128, 256), rn1 = mkrsrc(NV + (size_t)(((b * 4 + hh) * 2 + 1) * 64 + j) * 128, 256);
        const unsigned lon = (l31 == 0) ? (unsigned)(16 * h) : 0x40000000u;
        const rsrc_t ro = mkrsrc(om + (size_t)row0 * 512 + hh * 128, 64 * 1024), rm = mkrsrc(mixed + (size_t)row0 * DM + 512 + hh * 128, 64 * 2048);
        {
            const int ti = wave >> 2;
            const int t = 32 * ti + l31;
            v4u qf[8];
#pragma unroll
            for (int ks = 0; ks < 8; ++ks) qf[ks] = bld128(rq, lo, ti * 8192 + 1024 * ks);
            {
                f32x16 X[2];
#pragma unroll
                for (int r = 0; r < 16; ++r) { X[0][r] = 0.f; X[1][r] = 0.f; }
                v4u xa[8], xb[8];
#pragma unroll
                for (int ks = 0; ks < 8; ++ks) { xa[ks] = bld128(rk, lo, 1024 * ks); xb[ks] = bld128(rk, lo, 8192 + 1024 * ks); }
#pragma unroll
                for (int ks = 0; ks < 8; ++ks) { const bf16x8 Bq = __builtin_bit_cast(bf16x8, qf[ks]);
                    X[0] = MFMA32(__builtin_bit_cast(bf16x8, xa[ks]), Bq, X[0]); X[1] = MFMA32(__builtin_bit_cast(bf16x8, xb[ks]), Bq, X[1]); }
                asm volatile("" ::: "memory");
#pragma unroll
                for (int si = 0; si < 2; ++si)
#pragma unroll
                    for (int ss = 0; ss < 2; ++ss) {
                        v4u pf, pb;
#pragma unroll
                        for (int e = 0; e < 4; ++e) { float f2[2], b2[2];
#pragma unroll
                            for (int q2 = 0; q2 < 2; ++q2) { const int r = 8 * ss + 2 * e + q2, s = 32 * si + crow(r, h);
                                const float x = X[si][r], bef = sc[64 + s], beb = sc[192 + s];
                                const float vf = x * bef, vb = x * beb;
                                f2[q2] = (s <= t) ? vf : 0.f; b2[q2] = (s >= t) ? vb : 0.f; }
                            pf[e] = cvtpk(f2[0], f2[1]); pb[e] = cvtpk(b2[0], b2[1]); }
                        pfl[(si * 2 + ss) * 64] = pf; pfl[(4 + si * 2 + ss) * 64] = pb;
                    }
            }
            v4u F[8];
#define ML_COMP(D, RN, VO, SB, SS) do { \
        _Pragma("unroll") for (int ks = 0; ks < 8; ++ks) { D = MFMA32(__builtin_bit_cast(bf16x8, qf[ks]), __builtin_bit_cast(bf16x8, F[ks]), D); F[ks] = bld128(RN, VO, (SB) + (SS) * ks); asm volatile("" ::: "memory"); } } while (0)
#define ML_PV(vf_) do { _Pragma("unroll") for (int r = 0; r < 16; ++r) { df[r] = 0.f; db[r] = 0.f; } \
        _Pragma("unroll") for (int si = 0; si < 2; ++si) _Pragma("unroll") for (int ss = 0; ss < 2; ++ss) { const bf16x8 B_ = __builtin_bit_cast(bf16x8, vf_[si * 2 + ss]); \
            if (si <= ti) df = MFMA32(__builtin_bit_cast(bf16x8, pfl[(si * 2 + ss) * 64]), B_, df); if (si >= ti) db = MFMA32(__builtin_bit_cast(bf16x8, pfl[(4 + si * 2 + ss) * 64]), B_, db); } } while (0)
#pragma unroll
            for (int ks = 0; ks < 8; ++ks) F[ks] = bld128(rn0, lon, 32 * ks);
            asm volatile("" ::: "memory");
            {
                f32x16 df, db; v4u vfr[4];
#pragma unroll
                for (int q4 = 0; q4 < 4; ++q4) { const unsigned w1 = (l31 == 0) ? 0x3f803f80u : 0u; vfr[q4] = (v4u){w1, w1, w1, w1}; }
                ML_PV(vfr);
                ML_COMP(df, rn1, lon, 0, 32);
                ML_COMP(db, rs0, lo, 0, 1024);
#pragma unroll
                for (int r = 0; r < 16; ++r) {
                    if (l31 == 0) { const int tl = crow(r, h); const float af = sc[32 * ti + tl], ab = sc[128 + 32 * ti + tl];
                        ivb[tl] = af * __builtin_amdgcn_rcpf(fmaxf(af * fabsf(df[r]), 1.0f)); ivb[32 + tl] = ab * __builtin_amdgcn_rcpf(fmaxf(ab * fabsf(db[r]), 1.0f)); } }
            }
#pragma nounroll
            for (int nt = 0; nt < 4; ++nt) {
                const int n = 32 * nt + l31;
                f32x16 df, db;
                { v4u vfr[4];
#pragma unroll
                  for (int q4 = 0; q4 < 4; ++q4) vfr[q4] = bld128(rv, lo, nt * 4096 + q4 * 1024);
                  ML_PV(vfr); }
                ML_COMP(df, rs1, lo, nt * 8192, 1024);
                ML_COMP(db, rs0, lo, (nt < 3 ? nt + 1 : 3) * 8192, 1024);
                const unsigned oo = (unsigned)(32 * ti + 4 * h) * 1024 + 2 * n;
#pragma unroll
                for (int r = 0; r < 16; ++r) { const int tl = crow(r, h);
                    const float hv = df[r] * ivb[tl] + db[r] * ivb[32 + tl];
                    const float og = bld_bf16(ro, oo + ((r & 3) + 8 * (r >> 2)) * 1024);
                    const float y = hv * __builtin_amdgcn_rcpf(1.0f + __builtin_amdgcn_exp2f(og * -1.4426950408889634f));
                    ybuf[tl * ML_YROW + n] = (bf16)(cvtpk(y, 0.f) & 0xffffu); }
            }
#undef ML_COMP
#undef ML_PV
#pragma unroll
            for (int i = 0; i < 8; ++i) { const int idx = lane + 64 * i, tl = idx >> 4, ch = idx & 15;
                const v4u w = *(const LAS v4u*)(ybuf + tl * ML_YROW + 8 * ch); float y8[8]; float ss = 0.f;
#pragma unroll
                for (int e = 0; e < 4; ++e) { y8[2 * e] = __uint_as_float(w[e] << 16); y8[2 * e + 1] = __uint_as_float(w[e] & 0xffff0000u); ss += y8[2 * e] * y8[2 * e] + y8[2 * e + 1] * y8[2 * e + 1]; }
                ss += __shfl_xor(ss, 1); ss += __shfl_xor(ss, 2); ss += __shfl_xor(ss, 4); ss += __shfl_xor(ss, 8);
                const float rs = __builtin_amdgcn_rsqf(ss * (1.0f / 128.0f) + EPS);
                u32x4b o;
#pragma unroll
                for (int e = 0; e < 4; ++e) o[e] = cvtpk(y8[2 * e] * rs, y8[2 * e + 1] * rs);
                __builtin_amdgcn_raw_buffer_store_b128(o, rm, (unsigned)(32 * ti + tl) * 2048 + 16 * ch, 0, 0); }
        }
    }
}
constexpr int CV_WAVE_LDS = 8704;
__device__ __forceinline__ void conv_tiles(const Args& a, LAS unsigned char* lds, int G, int vcu, int nlight) {
    const int tid = threadIdx.x, lane = tid & 63, wave = __builtin_amdgcn_readfirstlane(tid >> 6);
    const int gw = vcu * NWAVES + wave, NGW = G * NWAVES;
    LAS unsigned char* raw = lds + wave * CV_WAVE_LDS;
    const bf16* proj = (const bf16*)(a.ws + WS_PROJ);
    const int g8 = lane >> 3, c8 = lane & 7;
    v4u nxt[9];
#define CV_FETCH(it_) do { const int buf_ = (it_) % 6, ct_ = ((it_) / 6) & 7, rt_ = (it_) / 48, b_ = rt_ >> 6, t0_ = (rt_ & 63) * 64; \
        const rsrc_t rs_ = mkrsrc(proj + (size_t)buf_ * PROJ_STRIDE + (size_t)b_ * SEQ * 512 + ct_ * 64, SEQ * 1024); \
        _Pragma("unroll") for (int i = 0; i < 9; ++i) { const int rr = g8 + 8 * i; nxt[i] = bld128(rs_, (unsigned)(t0_ - 1 + rr) * 1024u + c8 * 16, 0); } } while (0)
    const int row_lo = (vcu < nlight) ? vcu * 9 : nlight * 9 + (vcu - nlight) * 13, row_n = (G == 256) ? ((vcu < nlight) ? 9 : 13) : 0;
    if (G != 256) {   }
    int item = (G == 256) ? row_lo * 8 + wave : gw; const int istep = (G == 256) ? 8 : NGW; const int iend = (G == 256) ? (row_lo + row_n) * 8 : 6 * 8 * 512;
    if (item < iend) CV_FETCH(item);
    for (; item < iend; item += istep) {
        const int buf = item % 6, ct = (item / 6) & 7, rt = item / 48, b = rt >> 6, t0 = (rt & 63) * 64;
#pragma unroll
        for (int i = 0; i < 9; ++i) { const int rr = g8 + 8 * i;
            if (rr < 66) *(LAS v4u*)(raw + rr * 128 + c8 * 16) = nxt[i]; }
        if (item + istep < iend) CV_FETCH(item + istep);
        LDS_WAIT();
        if (buf == 3 || buf == 4) {
            const float* cw = a.in[15] + (buf - 3) * 512 + ct * 64 + c8 * 8; const float* cb = a.in[16] + (buf - 3) * 512 + ct * 64 + c8 * 8;
            float w0[8], w1[8], w2[8], bb[8];
#pragma unroll
            for (int e = 0; e < 8; ++e) { w0[e] = cw[e]; w1[e] = cw[1024 + e]; w2[e] = cw[2048 + e]; bb[e] = cb[e]; }
            unsigned char* dst = a.ws + (buf == 3 ? WS_QF : WS_KA) + (size_t)(((b * 4 + (ct >> 1)) * 64 + (rt & 63))) * 16384 + (((ct & 1) * 4 + (c8 >> 1)) * 64 + (c8 & 1) * 32) * 16;
            const float sc = (buf == 3) ? 1.0f : 0.08838834764831845f;
#pragma unroll
            for (int i = 0; i < 8; ++i) { const int r = g8 + 8 * i;
                const v4u x0 = *(const LAS v4u*)(raw + r * 128 + c8 * 16), x1 = *(const LAS v4u*)(raw + (r + 1) * 128 + c8 * 16), x2 = *(const LAS v4u*)(raw + (r + 2) * 128 + c8 * 16);
                v4u o;
#pragma unroll
                for (int e = 0; e < 4; ++e) {
                    const float lo = bb[2 * e] + __uint_as_float(x0[e] << 16) * w0[2 * e] + __uint_as_float(x1[e] << 16) * w1[2 * e] + __uint_as_float(x2[e] << 16) * w2[2 * e];
                    const float hi = bb[2 * e + 1] + __uint_as_float(x0[e] & 0xffff0000u) * w0[2 * e + 1] + __uint_as_float(x1[e] & 0xffff0000u) * w1[2 * e + 1] + __uint_as_float(x2[e] & 0xffff0000u) * w2[2 * e + 1];
                    o[e] = cvtpk(silu(lo) * sc, silu(hi) * sc); }
                *(v4u*)(dst + ((r >> 5) * 8 * 64 + (r & 31)) * 16) = o; }
        }
        if (buf != 3) {
            const LAS bf16* col = (const LAS bf16*)raw + lane;
            float w0 = 0.f, w1 = 1.f, w2 = 0.f, bb = 0.f, sc = 1.f; unsigned char* dstf = nullptr;
            if (buf >= 3) { if (buf == 4) { const int ch = 512 + ct * 64 + lane; w0 = a.in[15][ch]; w1 = a.in[15][1024 + ch]; w2 = a.in[15][2048 + ch]; bb = a.in[16][ch]; sc = 0.08838834764831845f; }
                   const int dd = (ct & 1) * 64 + lane;
                   dstf = a.ws + (buf == 4 ? WS_KF : WS_VF) + (size_t)(((b * 4 + (ct >> 1)) * 64 + (rt & 63))) * 16384 + ((dd >> 5) * 4 * 64 + (dd & 31)) * 16; }
            if (buf < 3) {
                const int cs = lane >> 3, tg = lane & 7;
#pragma unroll
                for (int i = 0; i < 8; ++i) { const int cc = cs + 8 * i, ch = buf * 512 + ct * 64 + cc;
                    const float w0 = a.in[4][ch], w1 = a.in[4][1536 + ch], w2 = a.in[4][3072 + ch], bb = a.in[5][ch];
                    const LAS bf16* col = (const LAS bf16*)raw + cc;
                    float x[10];
#pragma unroll
                    for (int e = 0; e < 10; ++e) x[e] = bf2f(col[(8 * tg + e) * 64]);
                    v4u o;
#pragma unroll
                    for (int e = 0; e < 4; ++e) o[e] = cvtpk(bb + x[2 * e] * w0 + x[2 * e + 1] * w1 + x[2 * e + 2] * w2, bb + x[2 * e + 1] * w0 + x[2 * e + 2] * w1 + x[2 * e + 3] * w2);
                    *(v4u*)((bf16*)a.out + ((size_t)b * 1536 + ch) * SEQ + t0 + 8 * tg) = o; }
            } else {
#pragma unroll
            for (int tg = 0; tg < 8; ++tg) {
                float x[10];
#pragma unroll
                for (int e = 0; e < 10; ++e) x[e] = bf2f(col[(8 * tg + e) * 64]);
                float y[8];
#pragma unroll
                for (int e = 0; e < 8; ++e) { float v = bb + x[e] * w0 + x[e + 1] * w1 + x[e + 2] * w2; if (buf == 4) v = silu(v) * sc; y[e] = v; }
                {
                    unsigned char* pz = dstf + ((tg >> 1) * 64) * 16 + 8 * (tg & 1);
                    *(v2u*)(pz) = (v2u){cvtpk(y[0], y[1]), cvtpk(y[2], y[3])}; *(v2u*)(pz + 32 * 16) = (v2u){cvtpk(y[4], y[5]), cvtpk(y[6], y[7])}; }
            }
            }
        }
        LDS_WAIT();
    }
#undef CV_FETCH
}
__device__ __forceinline__ void hy_mix(const Args& a, int G, int vcu) {
    int tid = threadIdx.x; asm volatile("" : "+v"(tid));
    const int lane = tid & 63, wave = __builtin_amdgcn_readfirstlane(tid >> 6);
    const int gw = vcu * NWAVES + wave, NGW = G * NWAVES;
    const bf16* yT = (const bf16*)(a.ws + WS_YT); bf16* mixed = (bf16*)(a.ws + WS_MIXED);
    for (int item = gw; item < NB * 8 * 64; item += NGW) {
        const int tt = item & 63, g = (item >> 6) & 7, b = item >> 9, t0 = tt * 64;
        const rsrc_t ry = mkrsrc(yT + ((size_t)b * 512 + g * 64) * SEQ + t0, 64 * SEQ * 2);
        float v[64]; float ss = 0.f;
#pragma unroll
        for (int c = 0; c < 64; ++c) { v[c] = bld_bf16s(ry, lane * 2, c * (SEQ * 2)); ss += v[c] * v[c]; }
        const float rs = __builtin_amdgcn_rsqf(ss * (1.0f / 64.0f) + EPS);
        bf16* dst = mixed + (size_t)(b * SEQ + t0 + lane) * DM + g * 64;
#pragma unroll
        for (int i = 0; i < 8; ++i) { v4u o; o.x = cvtpk(v[8 * i] * rs, v[8 * i + 1] * rs); o.y = cvtpk(v[8 * i + 2] * rs, v[8 * i + 3] * rs);
            o.z = cvtpk(v[8 * i + 4] * rs, v[8 * i + 5] * rs); o.w = cvtpk(v[8 * i + 6] * rs, v[8 * i + 7] * rs); *(v4u*)(dst + 8 * i) = o; }
    }
}
typedef GAS unsigned gu32;
#define XB_TMO      128
#define XB_XCNT(j)  (256  + 64 * (j))
#define XB_XSUB(j)  (1280 + 64 * (j))
#define XB_XGEN(j)  (2304 + 64 * (j))
#define XB_TOP      3328
#define XB_TOPGEN   3392
#define XCD_BAR_WORDS 3456
#define XB_SPIN_CAP (1u << 18)

__device__ __forceinline__ unsigned xb_ld(unsigned* p)              { return __hip_atomic_load(p, __ATOMIC_RELAXED, __HIP_MEMORY_SCOPE_AGENT); }
__device__ __forceinline__ unsigned xb_add(unsigned* p, unsigned v) { return __hip_atomic_fetch_add(p, v, __ATOMIC_RELAXED, __HIP_MEMORY_SCOPE_AGENT); }
__device__ __forceinline__ unsigned xb_xcc_id() { return (unsigned)__builtin_amdgcn_s_getreg((3 << 11) | 20) & 0xFu; }
#define XB_SPIN(cond, bar) do { unsigned _sp = 0; while (cond) { __builtin_amdgcn_s_sleep(1); \
    if ((++_sp & 255u) == 0u) { if (xb_ld(&(bar)[XB_TMO])) break; if (_sp > XB_SPIN_CAP) { atomicAdd(&(bar)[XB_TMO], 1u); break; } } } } while (0)

struct XcdBarrier {
    unsigned* bar; unsigned x;
    volatile LAS unsigned* st;
};

__device__ __forceinline__ XcdBarrier xcd_barrier_post(unsigned* bar, volatile LAS unsigned* st) {
    XcdBarrier b; b.bar = bar; b.x = xb_xcc_id(); b.st = st;
    if (threadIdx.x == 0) (void)xb_add(&bar[XB_XCNT(b.x)], 1u);
    return b;
}
__device__ __forceinline__ void xcd_barrier_complete(unsigned* bar, unsigned x, unsigned& nloc, unsigned& nx) {
    const unsigned G = gridDim.x * gridDim.y * gridDim.z;
    unsigned sum, cnt, mine, sp = 0u;
    for (;;) {
        sum = 0u; cnt = 0u; mine = 0u;
#pragma unroll
        for (unsigned j = 0; j < 16; ++j) { const unsigned c = xb_ld(&bar[XB_XCNT(j)]); sum += c; cnt += (c > 0u) ? 1u : 0u; mine = (j == x) ? c : mine; }
        if (sum == G) break;
        __builtin_amdgcn_s_sleep(1);
        if ((++sp & 255u) == 0u) { if (xb_ld(&bar[XB_TMO])) break; if (sp > XB_SPIN_CAP) { atomicAdd(&bar[XB_TMO], 1u); break; } }
    }
    nloc = mine > 0u ? mine : 1u; nx = cnt > 0u ? cnt : 1u;
}

__device__ __forceinline__ void xcd_barrier(const XcdBarrier& b) {
    asm volatile("s_waitcnt vmcnt(0)" ::: "memory");
    __syncthreads();
    if (threadIdx.x == 0) {
        unsigned* bar = b.bar;
        __builtin_amdgcn_s_waitcnt(0);
        unsigned nloc = b.st[0], nx = b.st[1];
        if (nloc == 0u) { xcd_barrier_complete(bar, b.x, nloc, nx); b.st[0] = nloc; b.st[1] = nx; }
        const unsigned old = xb_add(&bar[XB_XSUB(b.x)], 1u);
        const unsigned gen = old / nloc;
        if (old + 1u == (gen + 1u) * nloc) {
            __builtin_amdgcn_fence(__ATOMIC_RELEASE, "agent");
            asm volatile("s_waitcnt vmcnt(0)" ::: "memory");
            const unsigned og = xb_add(&bar[XB_TOP], 1u);
            const unsigned tg = og / nx;
            if (og + 1u == (tg + 1u) * nx) xb_add(&bar[XB_TOPGEN], 1u);
            else XB_SPIN(xb_ld(&bar[XB_TOPGEN]) == tg, bar);
            __builtin_amdgcn_fence(__ATOMIC_ACQUIRE, "agent");
            xb_add(&bar[XB_XGEN(b.x)], 1u);
            asm volatile("s_waitcnt vmcnt(0)" ::: "memory");
        } else {
            XB_SPIN(xb_ld(&bar[XB_XGEN(b.x)]) == gen, bar);
            __builtin_amdgcn_fence(__ATOMIC_ACQUIRE, "agent");
            asm volatile("s_waitcnt vmcnt(0)" ::: "memory");
        }
    }
    __syncthreads();
}

#ifndef MK_ONE_LAUNCH
#define MK_ONE_LAUNCH 1
#endif
constexpr int NPHASE = 14;
#define GEMM_CALL(EPI, MODE, g, S, E) pg8::gemm_phase<EPI, pg8::StaticOrder, true, true, MODE, gLDA, gLDB, gK>(ldsp, g, S, E)
__global__ void __launch_bounds__(NTHREADS, 2) mk_fwd(Args a) {
    extern __shared__ __attribute__((aligned(16))) unsigned char lds_raw[];
    LAS unsigned char* ldsp = (LAS unsigned char*)lds_raw;
    const int G = gridDim.x, bx = blockIdx.x;
    const int vcu = (G % 8 == 0) ? (bx % 8) * (G / 8) + bx / 8 : bx;
    unsigned char* ws = a.ws;
    typedef pg8::bf16_t pb;
#if MK_ONE_LAUNCH
    if (threadIdx.x < 64) ((LAS unsigned*)(ldsp + LDSCTL_OFF))[threadIdx.x] = 0u;
    __syncthreads();
    (void)xcd_barrier_post((unsigned*)(ws + WS_CTL) + 4096, (volatile LAS unsigned*)(ldsp + LDSCTL_OFF) + 8);
#define SEAM(k) do { if (a.ph_hi > 1000000) cg::this_grid().sync();   { XcdBarrier xb_; xb_.bar = (unsigned*)(a.ws + WS_CTL) + 4096; xb_.x = xb_xcc_id(); xb_.st = (volatile LAS unsigned*)(ldsp + LDSCTL_OFF) + 8; xcd_barrier(xb_); } } while (0)
#else
#define SEAM(k) do {} while (0)
#endif
    const int lo = a.ph_lo, hi = a.ph_hi;
#define IN(k) (lo <= (k) && (k) < hi)
#define PH_END(k) do { if (IN((k) + 1)) SEAM(k); } while (0)
#ifndef PROBE_MASK
#define PROBE_MASK 0
#endif
#if (PROBE_MASK >> 0) & 1
#define REP0(...) { __VA_ARGS__ } __syncthreads(); { __VA_ARGS__ }
#else
#define REP0(...) { __VA_ARGS__ }
#endif
#if (PROBE_MASK >> 1) & 1
#define REP1(...) { __VA_ARGS__ } __syncthreads(); { __VA_ARGS__ }
#else
#define REP1(...) { __VA_ARGS__ }
#endif
#if (PROBE_MASK >> 2) & 1
#define REP2(...) { __VA_ARGS__ } __syncthreads(); { __VA_ARGS__ }
#else
#define REP2(...) { __VA_ARGS__ }
#endif
#if (PROBE_MASK >> 3) & 1
#define REP3(...) { __VA_ARGS__ } __syncthreads(); { __VA_ARGS__ }
#else
#define REP3(...) { __VA_ARGS__ }
#endif
#if (PROBE_MASK >> 4) & 1
#define REP4(...) { __VA_ARGS__ } __syncthreads(); { __VA_ARGS__ }
#else
#define REP4(...) { __VA_ARGS__ }
#endif
#if (PROBE_MASK >> 5) & 1
#define REP5(...) { __VA_ARGS__ } __syncthreads(); { __VA_ARGS__ }
#else
#define REP5(...) { __VA_ARGS__ }
#endif
#if (PROBE_MASK >> 6) & 1
#define REP6(...) { __VA_ARGS__ } __syncthreads(); { __VA_ARGS__ }
#else
#define REP6(...) { __VA_ARGS__ }
#endif
#if (PROBE_MASK >> 7) & 1
#define REP7(...) { __VA_ARGS__ } __syncthreads(); { __VA_ARGS__ }
#else
#define REP7(...) { __VA_ARGS__ }
#endif
#if (PROBE_MASK >> 8) & 1
#define REP8(...) { __VA_ARGS__ } __syncthreads(); { __VA_ARGS__ }
#else
#define REP8(...) { __VA_ARGS__ }
#endif
#if (PROBE_MASK >> 9) & 1
#define REP9(...) { __VA_ARGS__ } __syncthreads(); { __VA_ARGS__ }
#else
#define REP9(...) { __VA_ARGS__ }
#endif
#if (PROBE_MASK >> 10) & 1
#define REP10(...) { __VA_ARGS__ } __syncthreads(); { __VA_ARGS__ }
#else
#define REP10(...) { __VA_ARGS__ }
#endif
#if (PROBE_MASK >> 11) & 1
#define REP11(...) { __VA_ARGS__ } __syncthreads(); { __VA_ARGS__ }
#else
#define REP11(...) { __VA_ARGS__ }
#endif
#if (PROBE_MASK >> 12) & 1
#define REP12(...) { __VA_ARGS__ } __syncthreads(); { __VA_ARGS__ }
#else
#define REP12(...) { __VA_ARGS__ }
#endif
    if (IN(0)) { REP0( p0_prologue(a, ldsp, G, vcu); __syncthreads(); ) PH_END(0); }
    if (IN(1)) { REP1(
        { pg8::Gemm g{(const pb*)(ws + WS_XN), (const pb*)(ws + WS_WIN)}; constexpr int gLDA = DM, gLDB = DM, gK = DM; pg8::StaticOrder S; S.init(MTOK, NPROJ, G, bx);
          typedef pg8::EpiBf16S<0, 0> E_t; E_t E{(pb*)(ws + WS_PROJ), 512, 512, PROJ_STRIDE, nullptr, 1.0f}; GEMM_CALL(E_t, 0, g, S, E); }
        ) PH_END(1); }
    if (IN(2)) { REP2(
        if (G != 256 || vcu < 64) {
        { pg8::Gemm g{(const pb*)(ws + WS_MEMN), (const pb*)(ws + WS_WK)}; constexpr int gLDA = DM, gLDB = DM, gK = DM; pg8::StaticOrder S; if (G == 256) { S.init(MMEM, DM, 64, vcu); if (vcu >= 32) S.nwg = 0; } else S.init(MMEM, DM, G, bx);
          typedef pg8::EpiBf16S<0, 0> E_t; E_t E{(pb*)(ws + WS_KB), DM, 0, 0, nullptr, 1.0f}; GEMM_CALL(E_t, 0, g, S, E); }
        { pg8::Gemm g{(const pb*)(ws + WS_MEMN), (const pb*)(ws + WS_WV)}; constexpr int gLDA = DM, gLDB = DM, gK = DM; pg8::StaticOrder S; if (G == 256) { S.init(MMEM, DM, 64, vcu >= 32 ? vcu - 32 : 0); if (vcu < 32) S.nwg = 0; } else S.init(MMEM, DM, G, (bx + G / 2) % G);
          typedef pg8::EpiBf16S<0, 0> E_t; E_t E{(pb*)(ws + WS_VT), DM, 0, 0, nullptr, 1.0f}; GEMM_CALL(E_t, 0, g, S, E); }
        }
        gate_factors(a, G, vcu); filters_phase(a, ldsp, G, vcu); conv_tiles(a, ldsp, G, vcu, 64); ) PH_END(2); }
    if (IN(3)) { REP3(
        { pg8::Gemm g{(const pb*)(ws + WS_KB), (const pb*)(ws + WS_WQ)}; constexpr int gLDA = DM, gLDB = DM, gK = 256; pg8::StaticOrder S; S.init(8 * DM, DM, G / 2, vcu < G / 2 ? vcu : 0); if (vcu >= G / 2) S.nwg = 0;
          typedef pg8::EpiBf16S<0, 0> E_t; E_t E{(pb*)(ws + WS_MT), DM, 0, 0, nullptr, 1.0f}; GEMM_CALL(E_t, 4, g, S, E); }
        { pg8::Gemm g{(const pb*)(ws + WS_WO), (const pb*)(ws + WS_VT)}; constexpr int gLDA = DM, gLDB = DM, gK = 256; pg8::StaticOrder S; S.init(8 * DM, DM, G / 2, vcu >= G / 2 ? vcu - G / 2 : 0); if (vcu < G / 2) S.nwg = 0;
          typedef pg8::EpiBf16S<0, 0> E_t; E_t E{(pb*)(ws + WS_VWT), DM, 0, 0, nullptr, 1.0f}; GEMM_CALL(E_t, 5, g, S, E); }
        hyena_fft(a, ldsp, G, vcu); if (G != 256) mlstm_scan(a, ldsp, G, vcu); ) PH_END(3); }
    if (IN(4)) { REP4( mlstm_out(a, ldsp, G, vcu); hy_mix(a, G, vcu); ) PH_END(4); }
    if (IN(5)) { REP5( pg8::Gemm g{(const pb*)(ws + WS_MIXED), (const pb*)(ws + WS_WOUT)}; constexpr int gLDA = DM, gLDB = DM, gK = DM; pg8::StaticOrder S; S.init(MTOK, DM, G, bx);
          typedef pg8::EpiResid<true> E_t; E_t E{a.in[0], (pb*)(ws + WS_XN), (float*)(ws + WS_SSQ), DM}; GEMM_CALL(E_t, 0, g, S, E); ) PH_END(5); }
    if (IN(6)) { REP6( pg8::Gemm g{(const pb*)(ws + WS_XN), (const pb*)(ws + WS_MT)}; constexpr int gLDA = DM, gLDB = DM, gK = DM; pg8::StaticOrder S; S.init(MTOK, DM, G, bx);
          pg8::EpiSoftmax E{(pb*)(ws + WS_SP), DM, (LAS float*)(ldsp + LDSCTL_OFF + 1024), 0.0625f * 1.4426950408889634f, (const float*)(ws + WS_SSQ)}; GEMM_CALL(pg8::EpiSoftmax, 3, g, S, E); ) PH_END(9); }
    if (IN(10)) { pg8::Gemm g{(const pb*)(ws + WS_SP), (const pb*)(ws + WS_VWT)}; constexpr int gLDA = DM, gLDB = DM, gK = DM; pg8::StaticOrder S; S.init(MTOK, DM, G, bx);
          typedef pg8::EpiResid<false> E_t; E_t E{ws + WS_XN, (pb*)(ws + WS_XN), (float*)(ws + WS_SSQ), DM}; GEMM_CALL(E_t, 3, g, S, E); PH_END(10); }
    if (IN(11)) { REP11( pg8::Gemm g{(const pb*)(ws + WS_XN), (const pb*)(ws + WS_W1)}; constexpr int gLDA = DM, gLDB = DM, gK = DM; pg8::StaticOrder S; S.init(MTOK, DFF, G, bx);
          typedef pg8::EpiBf16S<1, 1> E_t; E_t E{(pb*)(ws + WS_HID), DFF, 0, 0, (const float*)(ws + WS_SSQ), 1.0f}; GEMM_CALL(E_t, 0, g, S, E); ) PH_END(11); }
    if (IN(12)) { REP12( pg8::Gemm g{(const pb*)(ws + WS_HID), (const pb*)(ws + WS_W2)}; constexpr int gLDA = DFF, gLDB = DFF, gK = DFF; pg8::StaticOrder S; S.init(MTOK, DM, G, bx);
          typedef pg8::EpiResid<false> E_t; E_t E{ws + WS_XN, (pb*)(ws + WS_XN), (float*)(ws + WS_SSQ), DM}; GEMM_CALL(E_t, 0, g, S, E); ) PH_END(12); }
    if (IN(13)) { final_norm(a, G, vcu); }
}

extern "C" void kernel_launch(void* const* d_in, const int* in_sizes, int n_in, void* d_out, int out_size, void* d_ws, size_t ws_size, hipStream_t stream) {
    static int grid = 0;
    if (grid == 0) {
        if (n_in != 30 || in_sizes[0] != MTOK * DM || out_size != MTOK * DM || ws_size < WS_END) {
            fprintf(stderr, "kernel_launch: unexpected shapes (n_in %d, in0 %d, out %d, ws %zu); nothing launched\n", n_in, n_in > 0 ? in_sizes[0] : -1, out_size, ws_size); grid = -1; return; }
        int dev = 0, cus = 0, per_cu = 0;
        if (hipGetDevice(&dev) != hipSuccess || hipDeviceGetAttribute(&cus, hipDeviceAttributeMultiprocessorCount, dev) != hipSuccess) { grid = -1; return; }
        if (hipFuncSetAttribute((const void*)mk_fwd, hipFuncAttributeMaxDynamicSharedMemorySize, LDS_BYTES) != hipSuccess) { fprintf(stderr, "kernel_launch: hipFuncSetAttribute failed\n"); grid = -1; return; }
        if (hipOccupancyMaxActiveBlocksPerMultiprocessor(&per_cu, (const void*)mk_fwd, NTHREADS, LDS_BYTES) != hipSuccess || per_cu < 1) { fprintf(stderr, "kernel_launch: occupancy query says %d\n", per_cu); (void)hipGetLastError(); grid = -1; return; }
        grid = cus;
    }
    if (grid < 0) return;
    if (hipMemsetAsync((char*)d_ws + WS_CTL, 0, 65536, stream) != hipSuccess) { fprintf(stderr, "kernel_launch: hipMemsetAsync failed\n"); return; }
    Args a{};
    for (int i = 0; i < 30; ++i) a.in[i] = (const float*)d_in[i];
    a.out = (float*)d_out; a.ws = (unsigned char*)d_ws;
#if MK_ONE_LAUNCH
    a.ph_lo = 0; a.ph_hi = NPHASE;
    void* args[] = {&a};
    hipError_t e = hipLaunchCooperativeKernel((const void*)mk_fwd, dim3(grid), dim3(NTHREADS), args, LDS_BYTES, stream);
    if (e != hipSuccess) fprintf(stderr, "cooperative launch failed: %s (grid %d)\n", hipGetErrorString(e), grid);
#else
    for (int ph = 0; ph < NPHASE; ++ph) { a.ph_lo = ph; a.ph_hi = ph + 1; hipLaunchKernelGGL(mk_fwd, dim3(grid), dim3(NTHREADS), LDS_BYTES, stream, a); }
#endif
}
```

```cpp
#include <hip/hip_runtime.h>
#include <hip/hip_cooperative_groups.h>
#include <cstdio>
#include <cstdint>
namespace cg = cooperative_groups;
namespace pg8 {
#define PG8_LAS __attribute__((address_space(3)))
typedef unsigned short bf16_t;
typedef short bf16x8 __attribute__((ext_vector_type(8)));
typedef float f32x4 __attribute__((ext_vector_type(4)));
typedef unsigned u32x4 __attribute__((ext_vector_type(4)));
constexpr int BM = 256, BK = 64, HALF = 128, HTB = HALF * BK * 2  , STAGE_BYTES = 8 * HTB, NXCD = 8, WGM = 8;

__host__ __device__ __forceinline__ int lds_byte(int r, int c) { const int st = (r >> 4) * 2 + (c >> 5), rr = r & 15, cc = c & 31, ob = rr * 64 + cc * 2; return st * 1024 + (ob ^ (((ob >> 9) & 1) << 5)); }
__host__ __device__ __forceinline__ void stage_rc(int b, int& R, int& C) { const int st = b / 1024, sb = b % 1024, swz = sb ^ (((sb >> 9) & 1) << 5); R = (st >> 1) * 16 + swz / 64; C = (st & 1) * 32 + (swz % 64) / 2; }
__host__ __device__ __forceinline__ int perm32(int rho) { const int n = rho >> 4, i = rho & 15; return 8 * (i >> 2) + 4 * n + (i & 3); }

struct Unit { int pm, pn; };
struct Gemm { const bf16_t* A; const bf16_t* Bt; };
template <int MODE, int LDA> __device__ __forceinline__ size_t a_off(const Unit& u) {
    if (MODE == 0 || MODE == 3) return (size_t)u.pm * BM * LDA * 2;
    if (MODE == 4) return ((size_t)(u.pm >> 2) * BM * LDA + (size_t)(u.pm & 3) * BM) * 2;
    return ((size_t)(u.pm & 3) * BM * LDA + (size_t)u.pn * BM) * 2; }
template <int MODE, int LDB> __device__ __forceinline__ size_t b_off(const Unit& u) {
    if (MODE == 0) return (size_t)u.pn * BM * LDB * 2;
    if (MODE == 3) return ((size_t)(u.pm >> 4) * 1024 + (size_t)u.pn * BM) * LDB * 2;
    if (MODE == 4) return ((size_t)u.pn * BM * LDB + (size_t)(u.pm & 3) * BM) * 2;
    return ((size_t)(u.pm >> 2) * BM * LDB + (size_t)u.pn * BM) * 2; }

struct StaticOrder {
    int nM, nN, nwg, G, c;
    __host__ __device__ void init(int M, int N, int G_, int c_) { nM = M / BM; nN = N / BM; nwg = nM * nN; G = G_; c = c_; }
    __host__ __device__ bool next(int i, Unit& u) const {
        const long L = (long)i * G + c; if (L >= nwg) return false;
        int wgid = (int)L; { const int q = nwg / NXCD, r = nwg % NXCD, xcd = wgid % NXCD, off = wgid / NXCD; wgid = (xcd < r ? xcd * (q + 1) : r * (q + 1) + (xcd - r) * q) + off; }
        const int nig = WGM * nN, gid = wgid / nig, fm = gid * WGM, gsz = (nM - fm) < WGM ? (nM - fm) : WGM;
        u.pm = fm + ((wgid % nig) % gsz); u.pn = (wgid % nig) / gsz; return true;
    }
    __device__ __forceinline__ void a_ready(const Unit&) const {}
    __device__ __forceinline__ void done(const Unit&) const {}
};

__device__ __forceinline__ unsigned cvt_pk_bf16(float lo, float hi) { unsigned r; asm volatile("v_cvt_pk_bf16_f32 %0, %1, %2" : "=v"(r) : "v"(lo), "v"(hi)); return r; }
typedef unsigned u32x2 __attribute__((ext_vector_type(2)));
template <int ROWSCALE, int ACT> struct EpiBf16S {
    static constexpr bool PERM = true, AFTER_DRAIN = false, ROWPRE = (ROWSCALE != 0);
    bf16_t* O; int ldc; int split_cols; size_t split_stride; const float* ssqp; float mul;
    __device__ __forceinline__ void operator()(const f32x4 (&acc)[2][2][4][2], const Unit& u, int wr, int wc, int fr, int fq, const PG8_LAS float* rsl) const {
        const int row0 = u.pm * BM + wr * 64 + fr; int colt = u.pn * BM; bf16_t* base = O;
        if (split_cols) { const int t = colt / split_cols; base += (size_t)t * split_stride; colt -= t * split_cols; }
        const int col0 = colt + wc * 32 + 8 * fq;
#pragma unroll
        for (int ai = 0; ai < 2; ++ai)
#pragma unroll
            for (int m = 0; m < 4; ++m) { const int row = row0 + ai * HALF + m * 16; const float sc = ROWSCALE ? mul * rsl[ai * HALF + wr * 64 + m * 16 + fr] : mul;
                bf16_t* rowp = base + (size_t)row * ldc + col0;
#pragma unroll
                for (int bj = 0; bj < 2; ++bj) { f32x4 v0 = acc[ai][bj][m][0] * sc, v1 = acc[ai][bj][m][1] * sc;
                    if (ACT == 1) {
#pragma unroll
                        for (int e = 0; e < 4; ++e) { const float a0 = fmaxf(v0[e], 0.f), a1 = fmaxf(v1[e], 0.f); v0[e] = a0 * a0; v1[e] = a1 * a1; } }
                    u32x4 w; w.x = cvt_pk_bf16(v0[0], v0[1]); w.y = cvt_pk_bf16(v0[2], v0[3]); w.z = cvt_pk_bf16(v1[0], v1[1]); w.w = cvt_pk_bf16(v1[2], v1[3]);
                    *(u32x4*)(rowp + bj * HALF) = w; } }
    }
};
struct EpiSoftmax {
    static constexpr bool PERM = true, AFTER_DRAIN = false, ROWPRE = true;
    bf16_t* O; int ldc; PG8_LAS float* xl; float c2s; const float* ssqp;
    __device__ __forceinline__ void operator()(const f32x4 (&acc)[2][2][4][2], const Unit& u, int wr, int wc, int fr, int fq, const PG8_LAS float* rsl) const {
        const int row0 = u.pm * BM + wr * 64 + fr, col0 = u.pn * BM + wc * 32 + 8 * fq;
        PG8_LAS float* pm = xl; PG8_LAS float* ps = xl + 1024;
        float mx[2][4], cr[2][4];
#pragma unroll
        for (int ai = 0; ai < 2; ++ai)
#pragma unroll
            for (int m = 0; m < 4; ++m) { float v = -3.0e38f;
#pragma unroll
                for (int bj = 0; bj < 2; ++bj)
#pragma unroll
                    for (int n = 0; n < 2; ++n) { const f32x4 x = acc[ai][bj][m][n]; v = fmaxf(v, fmaxf(fmaxf(x[0], x[1]), fmaxf(x[2], x[3]))); }
                v = fmaxf(v, __shfl_xor(v, 16)); v = fmaxf(v, __shfl_xor(v, 32));
                if (fq == 0) pm[(ai * HALF + wr * 64 + m * 16 + fr) * 4 + wc] = v; }
        asm volatile("s_waitcnt lgkmcnt(0)" ::: "memory"); __builtin_amdgcn_s_barrier(); asm volatile("" ::: "memory");
        float sm[2][4];
#pragma unroll
        for (int ai = 0; ai < 2; ++ai)
#pragma unroll
            for (int m = 0; m < 4; ++m) { const int rl = ai * HALF + wr * 64 + m * 16 + fr; const f32x4 p4 = *(const PG8_LAS f32x4*)(pm + rl * 4);
                const float mxr = fmaxf(fmaxf(p4[0], p4[1]), fmaxf(p4[2], p4[3]));
                const float c2 = c2s * rsl[rl]; cr[ai][m] = c2;
                mx[ai][m] = mxr * c2; float s = 0.f;
#pragma unroll
                for (int bj = 0; bj < 2; ++bj)
#pragma unroll
                    for (int n = 0; n < 2; ++n) { const f32x4 x = acc[ai][bj][m][n];
                        s += (__builtin_amdgcn_exp2f(x[0] * c2 - mx[ai][m]) + __builtin_amdgcn_exp2f(x[1] * c2 - mx[ai][m])) + (__builtin_amdgcn_exp2f(x[2] * c2 - mx[ai][m]) + __builtin_amdgcn_exp2f(x[3] * c2 - mx[ai][m])); }
                s += __shfl_xor(s, 16); s += __shfl_xor(s, 32);
                if (fq == 0) ps[rl * 4 + wc] = s; sm[ai][m] = 0.f; }
        asm volatile("s_waitcnt lgkmcnt(0)" ::: "memory"); __builtin_amdgcn_s_barrier(); asm volatile("" ::: "memory");
#pragma unroll
        for (int ai = 0; ai < 2; ++ai)
#pragma unroll
            for (int m = 0; m < 4; ++m) { const int rl = ai * HALF + wr * 64 + m * 16 + fr; const f32x4 s4 = *(const PG8_LAS f32x4*)(ps + rl * 4);
                const float inv = 1.0f / ((s4[0] + s4[1]) + (s4[2] + s4[3])); const float mr = mx[ai][m], c2 = cr[ai][m];
                bf16_t* rowp = O + (size_t)(row0 + ai * HALF + m * 16) * ldc + col0;
#pragma unroll
                for (int bj = 0; bj < 2; ++bj) { const f32x4 x0 = acc[ai][bj][m][0], x1 = acc[ai][bj][m][1]; u32x4 w;
                    w.x = cvt_pk_bf16(__builtin_amdgcn_exp2f(x0[0] * c2 - mr) * inv, __builtin_amdgcn_exp2f(x0[1] * c2 - mr) * inv); w.y = cvt_pk_bf16(__builtin_amdgcn_exp2f(x0[2] * c2 - mr) * inv, __builtin_amdgcn_exp2f(x0[3] * c2 - mr) * inv);
                    w.z = cvt_pk_bf16(__builtin_amdgcn_exp2f(x1[0] * c2 - mr) * inv, __builtin_amdgcn_exp2f(x1[1] * c2 - mr) * inv); w.w = cvt_pk_bf16(__builtin_amdgcn_exp2f(x1[2] * c2 - mr) * inv, __builtin_amdgcn_exp2f(x1[3] * c2 - mr) * inv);
                    *(u32x4*)(rowp + bj * HALF) = w; } }
        asm volatile("s_waitcnt lgkmcnt(0)" ::: "memory"); __builtin_amdgcn_s_barrier(); asm volatile("" ::: "memory");
    }
};

template <bool BASE_F32> struct EpiResid {
    static constexpr bool PERM = true, AFTER_DRAIN = false, ROWPRE = false;
    const void* base; bf16_t* xn; float* ssqp; int ldc;
    __device__ __forceinline__ void operator()(const f32x4 (&acc)[2][2][4][2], const Unit& u, int wr, int wc, int fr, int fq, const PG8_LAS float*) const {
        const int row0 = u.pm * BM + wr * 64 + fr, col0 = u.pn * BM + wc * 32 + 8 * fq;
#pragma unroll
        for (int ai = 0; ai < 2; ++ai) {
            f32x4 bf_[4][2][2]; u32x4 bh_[4][2];
#pragma unroll
            for (int m = 0; m < 4; ++m) { const size_t off = (size_t)(row0 + ai * HALF + m * 16) * ldc + col0;
#pragma unroll
                for (int bj = 0; bj < 2; ++bj) { const size_t o2 = off + bj * HALF;
                    if (BASE_F32) { bf_[m][bj][0] = *(const f32x4*)((const float*)base + o2); bf_[m][bj][1] = *(const f32x4*)((const float*)base + o2 + 4); } else bh_[m][bj] = *(const u32x4*)((const bf16_t*)base + o2); } }
#pragma unroll
            for (int m = 0; m < 4; ++m) { const int row = row0 + ai * HALF + m * 16; const size_t off = (size_t)row * ldc + col0; float ss = 0.f;
#pragma unroll
                for (int bj = 0; bj < 2; ++bj) { const size_t o2 = off + bj * HALF; f32x4 b0, b1;
                    if (BASE_F32) { b0 = bf_[m][bj][0]; b1 = bf_[m][bj][1]; }
                    else { const u32x4 w = bh_[m][bj]; b0 = (f32x4){__uint_as_float(w.x << 16), __uint_as_float(w.x & 0xffff0000u), __uint_as_float(w.y << 16), __uint_as_float(w.y & 0xffff0000u)};
                           b1 = (f32x4){__uint_as_float(w.z << 16), __uint_as_float(w.z & 0xffff0000u), __uint_as_float(w.w << 16), __uint_as_float(w.w & 0xffff0000u)}; }
                    const f32x4 v0 = b0 + acc[ai][bj][m][0], v1 = b1 + acc[ai][bj][m][1];
                    ss += ((v0[0] * v0[0] + v0[1] * v0[1]) + (v0[2] * v0[2] + v0[3] * v0[3])) + ((v1[0] * v1[0] + v1[1] * v1[1]) + (v1[2] * v1[2] + v1[3] * v1[3]));
                    u32x4 w2; w2.x = cvt_pk_bf16(v0[0], v0[1]); w2.y = cvt_pk_bf16(v0[2], v0[3]); w2.z = cvt_pk_bf16(v1[0], v1[1]); w2.w = cvt_pk_bf16(v1[2], v1[3]); *(u32x4*)(xn + o2) = w2; }
                ss += __shfl_xor(ss, 16); ss += __shfl_xor(ss, 32);
                if (fq == 0) ssqp[(size_t)row * 16 + u.pn * 4 + wc] = ss; }
        }
    }
};

template <class Epi, class Sched, bool ALIGN_EPI, bool SP2, int MODE, int LDA, int LDB, int KK>
__device__ __forceinline__ void gemm_phase(PG8_LAS unsigned char* lds, const Gemm g, const Sched& S, const Epi& E) {
    const int tid = threadIdx.x, wid = __builtin_amdgcn_readfirstlane(tid >> 6), lane = tid & 63, wr = wid >> 2, wc = wid & 3, fr = lane & 15, fq = lane >> 4;
    constexpr int K = KK, nt = K / BK;
    unsigned voffA[2], voffB[2];
#pragma unroll
    for (int i = 0; i < 2; ++i) { int R, C; stage_rc(tid * 16 + i * 8192, R, C); const int Rb = Epi::PERM ? ((R & ~31) + perm32(R & 31)) : R;
        voffA[i] = (unsigned)(R * LDA + C) * 2u; voffB[i] = (unsigned)(Rb * LDB + C) * 2u; }
    PG8_LAS float* rsl = (PG8_LAS float*)(lds + STAGE_BYTES);
    const size_t kstep = (size_t)(BK * 2);
    const size_t hstepA = (size_t)HALF * LDA * 2, hstepB = (size_t)HALF * LDB * 2;
    const unsigned ldsw = (unsigned)wid * 1024u;
    const int aoff = lds_byte(wr * 64 + fr, fq * 8), boff = lds_byte(wc * 32 + fr, fq * 8);
#define PG8_SA(b, h) (((b) * 2 + (h)) * HTB)
#define PG8_SB(b, h) ((4 + (b) * 2 + (h)) * HTB)
#define PG8_STAGE(bufoff, gbase, voff) do { _Pragma("unroll") for (int _i = 0; _i < 2; ++_i) \
        __builtin_amdgcn_global_load_lds((const unsigned*)((const char*)(gbase) + (voff)[_i]), (PG8_LAS unsigned*)(lds + (bufoff) + ldsw + _i * 8192), 16, 0, 0); } while (0)
#define PG8_LDA(dst, b, h) do { _Pragma("unroll") for (int m = 0; m < 4; ++m) _Pragma("unroll") for (int k = 0; k < 2; ++k) dst[m][k] = *(const PG8_LAS bf16x8*)(lds + PG8_SA(b, h) + aoff + m * 2048 + k * 1024); } while (0)
#define PG8_LDB(dst, b, h) do { _Pragma("unroll") for (int n = 0; n < 2; ++n) _Pragma("unroll") for (int k = 0; k < 2; ++k) dst[n][k] = *(const PG8_LAS bf16x8*)(lds + PG8_SB(b, h) + boff + n * 2048 + k * 1024); } while (0)
#define PG8_MMA(ai, bj, At, Bt) do { __builtin_amdgcn_s_setprio(1); _Pragma("unroll") for (int m = 0; m < 4; ++m) _Pragma("unroll") for (int n = 0; n < 2; ++n) _Pragma("unroll") for (int k = 0; k < 2; ++k) \
        acc[ai][bj][m][n] = __builtin_amdgcn_mfma_f32_16x16x32_bf16(Bt[n][k], At[m][k], acc[ai][bj][m][n], 0, 0, 0); __builtin_amdgcn_s_setprio(0); } while (0)
#define PG8_WAIT_V(n) asm volatile("s_waitcnt vmcnt(" #n ")" ::: "memory")
#define PG8_WAIT_L(n) asm volatile("s_waitcnt lgkmcnt(" #n ")" ::: "memory")
#define PG8_BAR __builtin_amdgcn_s_barrier()
#define PG8_SCHED __builtin_amdgcn_sched_barrier(0)
    Unit cur, nxt; int ui = 0; float rps = 0.f; typedef float f32x2 __attribute__((ext_vector_type(2)));
    if (!S.next(0, cur)) return;
    f32x4 acc[2][2][4][2];
#pragma unroll
    for (int a = 0; a < 2; ++a)
#pragma unroll
        for (int b = 0; b < 2; ++b)
#pragma unroll
            for (int m = 0; m < 4; ++m)
#pragma unroll
                for (int n = 0; n < 2; ++n) acc[a][b][m][n] = (f32x4){0.f, 0.f, 0.f, 0.f};
    bf16x8 At[4][2], B0[2][2], B1[2][2];
    const char* cA = (const char*)g.A + a_off<MODE, LDA>(cur); const char* cB = (const char*)g.Bt + b_off<MODE, LDB>(cur);
    S.a_ready(cur);
    if constexpr (SP2) {
        PG8_STAGE(PG8_SB(0, 0), cB, voffB); PG8_STAGE(PG8_SB(0, 1), cB + hstepB, voffB); PG8_STAGE(PG8_SA(0, 0), cA, voffA); PG8_STAGE(PG8_SA(0, 1), cA + hstepA, voffA);
        if (wr == 1) PG8_BAR;
        PG8_WAIT_V(2); PG8_BAR;
        PG8_STAGE(PG8_SB(1, 0), cB + kstep, voffB); PG8_STAGE(PG8_SA(1, 0), cA + kstep, voffA); PG8_STAGE(PG8_SB(1, 1), cB + hstepB + kstep, voffB);
        PG8_WAIT_V(6); PG8_BAR;
    } else {
        PG8_STAGE(PG8_SB(0, 0), cB, voffB); PG8_STAGE(PG8_SA(0, 0), cA, voffA); PG8_STAGE(PG8_SB(0, 1), cB + hstepB, voffB); PG8_STAGE(PG8_SA(0, 1), cA + hstepA, voffA);
        if (wr == 1) PG8_BAR;
        PG8_WAIT_V(4); PG8_BAR;
        PG8_STAGE(PG8_SB(1, 0), cB + kstep, voffB); PG8_STAGE(PG8_SA(1, 0), cA + kstep, voffA); PG8_STAGE(PG8_SB(1, 1), cB + hstepB + kstep, voffB);
        PG8_WAIT_V(6); PG8_BAR;
    }
    for (;;) {
        const bool has_next = S.next(ui + 1, nxt);
        const char* nA = has_next ? (const char*)g.A + a_off<MODE, LDA>(nxt) : cA; const char* nB = has_next ? (const char*)g.Bt + b_off<MODE, LDB>(nxt) : cB;
#pragma nounroll
        for (int t = 0; t < nt; t += 2) {
            const bool last = (t == nt - 2);
            f32x2 rp = {0.f, 0.f};
            if constexpr (Epi::ROWPRE) { if (t < 8) rp = *(const f32x2*)(E.ssqp + (size_t)(cur.pm * BM + (tid >> 1)) * 16 + (tid & 1) * 8 + t); }
            const char* a1 = cA + (size_t)(t + 1) * kstep;
            const char* a2 = last ? nA : cA + (size_t)(t + 2) * kstep; const char* b2 = last ? nB : cB + (size_t)(t + 2) * kstep;
            const char* a3 = a2 + kstep; const char* b3 = b2 + kstep;
            if (last && has_next) S.a_ready(nxt);
            if constexpr (SP2) {
            PG8_LDB(B0, 0, 0); PG8_LDB(B1, 0, 1); PG8_SCHED; PG8_LDA(At, 0, 0); PG8_STAGE(PG8_SA(1, 1), a1 + hstepA, voffA);
            PG8_WAIT_V(8); PG8_WAIT_L(0); PG8_BAR; PG8_MMA(0, 0, At, B0); PG8_MMA(0, 1, At, B1); PG8_BAR; PG8_SCHED;
            PG8_LDA(At, 0, 1); PG8_STAGE(PG8_SB(0, 0), b2, voffB); PG8_STAGE(PG8_SB(0, 1), b2 + hstepB, voffB); PG8_STAGE(PG8_SA(0, 0), a2, voffA);
            PG8_WAIT_V(8); PG8_WAIT_L(0); PG8_BAR; PG8_MMA(1, 0, At, B0); PG8_MMA(1, 1, At, B1); PG8_BAR; PG8_SCHED;
            PG8_LDB(B0, 1, 0); PG8_LDB(B1, 1, 1); PG8_SCHED; PG8_LDA(At, 1, 0); PG8_STAGE(PG8_SA(0, 1), a2 + hstepA, voffA);
            PG8_WAIT_V(8); PG8_WAIT_L(0); PG8_BAR; PG8_MMA(0, 0, At, B0); PG8_MMA(0, 1, At, B1); PG8_BAR; PG8_SCHED;
            PG8_LDA(At, 1, 1); PG8_STAGE(PG8_SB(1, 0), b3, voffB); PG8_STAGE(PG8_SB(1, 1), b3 + hstepB, voffB); PG8_STAGE(PG8_SA(1, 0), a3, voffA);
            PG8_WAIT_V(8); PG8_WAIT_L(0); PG8_BAR; PG8_MMA(1, 0, At, B0); PG8_MMA(1, 1, At, B1); PG8_BAR; PG8_SCHED;
            } else {
            PG8_LDB(B0, 0, 0); PG8_SCHED; PG8_LDA(At, 0, 0); PG8_STAGE(PG8_SA(1, 1), a1 + hstepA, voffA);
            PG8_WAIT_L(8); PG8_BAR; PG8_WAIT_L(0); PG8_MMA(0, 0, At, B0); PG8_BAR; PG8_SCHED;
            PG8_LDB(B1, 0, 1); PG8_STAGE(PG8_SB(0, 0), b2, voffB);
            PG8_BAR; PG8_WAIT_L(0); PG8_MMA(0, 1, At, B1); PG8_BAR;
            PG8_LDA(At, 0, 1); PG8_STAGE(PG8_SA(0, 0), a2, voffA);
            PG8_BAR; PG8_WAIT_L(0); PG8_MMA(1, 0, At, B0); PG8_BAR; PG8_SCHED;
            PG8_STAGE(PG8_SB(0, 1), b2 + hstepB, voffB);
            PG8_WAIT_V(6); PG8_BAR; PG8_MMA(1, 1, At, B1); PG8_BAR;
            PG8_LDB(B0, 1, 0); PG8_SCHED; PG8_LDA(At, 1, 0); PG8_STAGE(PG8_SA(0, 1), a2 + hstepA, voffA);
            PG8_WAIT_L(8); PG8_BAR; PG8_WAIT_L(0); PG8_MMA(0, 0, At, B0); PG8_BAR; PG8_SCHED;
            PG8_LDB(B1, 1, 1); PG8_STAGE(PG8_SB(1, 0), b3, voffB);
            PG8_BAR; PG8_WAIT_L(0); PG8_MMA(0, 1, At, B1); PG8_BAR;
            PG8_LDA(At, 1, 1); PG8_STAGE(PG8_SA(1, 0), a3, voffA);
            PG8_BAR; PG8_WAIT_L(0); PG8_MMA(1, 0, At, B0); PG8_BAR; PG8_SCHED;
            PG8_STAGE(PG8_SB(1, 1), b3 + hstepB, voffB);
            PG8_WAIT_V(6); PG8_BAR; PG8_MMA(1, 1, At, B1); PG8_BAR;
            }
            if constexpr (Epi::ROWPRE) { if (t < 8) { rps += rp.x + rp.y;
                if (t == 6) { float s = rps + __shfl_xor(rps, 1); if (!(tid & 1)) rsl[tid >> 1] = __builtin_amdgcn_rsqf(s * (1.0f / 1024.0f) + 1e-6f); rps = 0.f; } } }
        }
        if constexpr (ALIGN_EPI) { if (wr == 0) PG8_BAR; }
        if constexpr (!Epi::AFTER_DRAIN) { int fr_e = fr, fq_e = fq; asm volatile("" : "+v"(fr_e), "+v"(fq_e));
            E(acc, cur, wr, wc, fr_e, fq_e, rsl); S.done(cur); }
        if (!has_next) break;
#pragma unroll
        for (int a = 0; a < 2; ++a)
#pragma unroll
            for (int b = 0; b < 2; ++b)
#pragma unroll
                for (int m = 0; m < 4; ++m)
#pragma unroll
                    for (int n = 0; n < 2; ++n) acc[a][b][m][n] = (f32x4){0.f, 0.f, 0.f, 0.f};
        cur = nxt; cA = nA; cB = nB; ++ui;
        if constexpr (ALIGN_EPI) { if (wr == 1) PG8_BAR; }
    }
    PG8_WAIT_V(0);
    if constexpr (!ALIGN_EPI) { if (wr == 0) PG8_BAR; }
    PG8_BAR;
    if constexpr (Epi::AFTER_DRAIN) { E.fused(acc, cur, wr, wc, fr, fq, lds, wid, lane); S.done(cur); }
#undef PG8_SA
#undef PG8_SB
#undef PG8_STAGE
#undef PG8_LDA
#undef PG8_LDB
#undef PG8_MMA
#undef PG8_WAIT_V
#undef PG8_WAIT_L
#undef PG8_BAR
#undef PG8_SCHED
}
}

#define GAS __attribute__((address_space(1)))
#define LAS __attribute__((address_space(3)))
typedef unsigned short bf16;
typedef unsigned v4u __attribute__((ext_vector_type(4)));
typedef unsigned v2u __attribute__((ext_vector_type(2)));
typedef float f32x4 __attribute__((ext_vector_type(4)));
typedef float f32x2 __attribute__((ext_vector_type(2)));
constexpr int NWAVES = 8, NTHREADS = 512;
constexpr int NB = 8, SEQ = 4096, DM = 1024, MTOK = NB * SEQ, NMEMT = 256, MMEM = NB * NMEMT;
constexpr int DINP = 3600, NPROJ = 3584, DFF = 4096, DHY = 512, DML = 512, NHEAD = 4, DHEAD = 128;
constexpr float EPS = 1e-6f;
constexpr size_t MiB = 1u << 20;
constexpr size_t WS_CTL = 0, CTL_ZERO_BYTES = 1 * MiB;
constexpr size_t WS_WIN = 2 * MiB, WS_WOUT = 9 * MiB, WS_WQ = 11 * MiB, WS_WK = 13 * MiB, WS_WV = 15 * MiB, WS_WO = 17 * MiB, WS_W1 = 19 * MiB, WS_W2 = 27 * MiB;
constexpr size_t WS_MEMN = 35 * MiB, WS_KB = 39 * MiB, WS_VT = 43 * MiB, WS_GATES = 47 * MiB, WS_SSQ = 49 * MiB, WS_HID2 = 51 * MiB;
constexpr size_t WS_GF = 53 * MiB, WS_DEC = 55 * MiB;
constexpr size_t WS_XN = 64 * MiB;
constexpr size_t WS_QF = 64 * MiB, WS_KA = 96 * MiB;
constexpr size_t WS_PROJ = 128 * MiB, PROJ_STRIDE = (size_t)MTOK * 512;
constexpr size_t OUT_FILT = 96 * MiB;
constexpr size_t WS_HSPEC = 384 * MiB;
constexpr size_t WS_YT = 448 * MiB;
constexpr size_t WS_MIXED = 352 * MiB;
constexpr size_t WS_KF = 352 * MiB, WS_VF = 416 * MiB;
constexpr size_t WS_STATES = 128 * MiB;
constexpr size_t WS_SP = 416 * MiB, WS_HID = 192 * MiB;
constexpr size_t WS_MT = 288 * MiB, WS_VWT = 304 * MiB;
constexpr size_t WS_END = 512 * MiB;
constexpr int RING_BYTES = 131072, LDSCTL_OFF = 147456, LDS_BYTES = 163840;

__device__ __forceinline__ float bf2f(unsigned short h) { return __uint_as_float(((unsigned)h) << 16); }
__device__ __forceinline__ unsigned f2bf(float f) { unsigned u = __float_as_uint(f); return (u + 0x7fffu + ((u >> 16) & 1u)) >> 16; }
typedef __bf16 bf16x2_t __attribute__((ext_vector_type(2)));
__device__ __forceinline__ unsigned cvtpk(float lo, float hi) { const f32x2 v = {lo, hi}; const bf16x2_t b = __builtin_convertvector(v, bf16x2_t); return __builtin_bit_cast(unsigned, b); }
__device__ __forceinline__ unsigned pk2(float lo, float hi) { return cvtpk(lo, hi); }
__device__ __forceinline__ float wave_sum(float v) {
#pragma unroll
    for (int o = 1; o < 64; o <<= 1) v += __shfl_xor(v, o);
    return v;
}
#define LDS_WAIT() asm volatile("s_waitcnt lgkmcnt(0)" ::: "memory")
__device__ __forceinline__ float logsig(float x) { return fminf(x, 0.f) - log1pf(expf(-fabsf(x))); }

struct Args { const float* in[30]; float* out; unsigned char* ws; int ph_lo, ph_hi; };

__device__ __forceinline__ void p0_transpose_item(const float* W, int ldw, int K, int nblk, bf16* WT, const float* gain, LAS float* scr, int item, int lane) {
    const int kb = item / nblk, nb = item % nblk, k0 = 64 * kb, n0 = 32 * nb;
#pragma unroll 16
    for (int i = 0; i < 32; ++i) { const int kk = 2 * i + (lane >> 5); float w = W[(size_t)(k0 + kk) * ldw + n0 + (lane & 31)]; if (gain) w *= gain[k0 + kk]; scr[kk * 33 + (lane & 31)] = w; }
    LDS_WAIT(); asm volatile("" ::: "memory");
    const int c = lane & 7;
#pragma unroll
    for (int j = 0; j < 4; ++j) { const int n = (lane >> 3) + 8 * j; const LAS float* s = scr + (8 * c) * 33 + n;
        v4u o; o.x = pk2(s[0 * 33], s[1 * 33]); o.y = pk2(s[2 * 33], s[3 * 33]); o.z = pk2(s[4 * 33], s[5 * 33]); o.w = pk2(s[6 * 33], s[7 * 33]);
        *(v4u*)(WT + (size_t)(n0 + n) * K + k0 + 8 * c) = o; }
    LDS_WAIT(); asm volatile("" ::: "memory");
}

__device__ __forceinline__ void p0_prologue(const Args& a, LAS unsigned char* lds, int G, int vcu) {
    const int tid = threadIdx.x, lane = tid & 63, wave = __builtin_amdgcn_readfirstlane(tid >> 6);
    const int gw = vcu * NWAVES + wave, NGW = G * NWAVES;
    unsigned char* ws = a.ws;
    {
        LAS float* scr = (LAS float*)(lds + wave * 16384);
        constexpr int I_IN = 16 * 112, I_SQ = 16 * 32, I_1 = 16 * 128, I_2 = 64 * 32;
        constexpr int NITEMS = I_IN + 4 * I_SQ + I_1 + I_2;
        for (int it = gw; it < NITEMS; it += NGW) {
            int r = it;
            if (r < I_IN) { p0_transpose_item(a.in[3], DINP, DM, 112, (bf16*)(ws + WS_WIN), a.in[2], scr, r, lane); continue; } r -= I_IN;
            if (r < I_SQ) { const int k0 = 64 * (r / 32); const float* g = (k0 < 512) ? a.in[14] : (a.in[18] - 512);
                            p0_transpose_item(a.in[19], DM, DM, 32, (bf16*)(ws + WS_WOUT), g, scr, r, lane); continue; } r -= I_SQ;
            if (r < I_SQ) { p0_transpose_item(a.in[23], DM, DM, 32, (bf16*)(ws + WS_WK), a.in[21], scr, r, lane); continue; } r -= I_SQ;
            if (r < I_SQ) { p0_transpose_item(a.in[24], DM, DM, 32, (bf16*)(ws + WS_WV), a.in[21], scr, r, lane); continue; } r -= I_SQ;
            if (r < I_SQ) { p0_transpose_item(a.in[25], DM, DM, 32, (bf16*)(ws + WS_WO), nullptr, scr, r, lane); continue; } r -= I_SQ;
            if (r < I_1) { p0_transpose_item(a.in[27], DFF, DM, 128, (bf16*)(ws + WS_W1), a.in[26], scr, r, lane); continue; } r -= I_1;
            p0_transpose_item(a.in[28], DM, DFF, 32, (bf16*)(ws + WS_W2), nullptr, scr, r, lane);
        }
        for (int r = gw; r < DM; r += NGW) { const float g = a.in[20][r]; const f32x4* src = (const f32x4*)(a.in[22] + (size_t)r * DM) + lane;
            unsigned long long* o8 = (unsigned long long*)((bf16*)(ws + WS_WQ) + (size_t)r * DM) + lane;
#pragma unroll
            for (int j = 0; j < 4; ++j) { const f32x4 v = src[64 * j] * g; o8[64 * j] = (unsigned long long)pk2(v[0], v[1]) | ((unsigned long long)pk2(v[2], v[3]) << 32); } }
    }
    __syncthreads();
    LAS float* Wg = (LAS float*)lds;
#pragma unroll 8
    for (int idx = tid; idx < 16 * DM; idx += NTHREADS) { const int k = idx >> 4, j = idx & 15; Wg[j * DM + k] = a.in[2][k] * a.in[3][(size_t)k * DINP + NPROJ + j]; }
    __syncthreads();
    f32x4 nx[4];
    if (gw < MTOK) {
#pragma unroll
        for (int j = 0; j < 4; ++j) nx[j] = ((const f32x4*)(a.in[0] + (size_t)gw * DM) + lane)[64 * j]; }
    for (int m = gw; m < MTOK; m += NGW) {
        f32x4 v[4]; float ss = 0.f;
#pragma unroll
        for (int j = 0; j < 4; ++j) { v[j] = nx[j]; ss += (v[j][0] * v[j][0] + v[j][1] * v[j][1]) + (v[j][2] * v[j][2] + v[j][3] * v[j][3]); }
        if (m + NGW < MTOK) {
#pragma unroll
            for (int j = 0; j < 4; ++j) nx[j] = ((const f32x4*)(a.in[0] + (size_t)(m + NGW) * DM) + lane)[64 * j]; }
        const float rstd = __builtin_amdgcn_rsqf(wave_sum(ss) * (1.0f / DM) + EPS);
        unsigned long long* o8 = (unsigned long long*)((bf16*)(ws + WS_XN) + (size_t)m * DM) + lane;
#pragma unroll
        for (int j = 0; j < 4; ++j) { v[j] = v[j] * rstd; o8[64 * j] = (unsigned long long)pk2(v[j][0], v[j][1]) | ((unsigned long long)pk2(v[j][2], v[j][3]) << 32); }
        float gs[16];
#pragma unroll
        for (int g = 0; g < 16; ++g) { float s = 0.f;
#pragma unroll
            for (int j = 0; j < 4; ++j) { const f32x4 w = *(const LAS f32x4*)(Wg + g * DM + 4 * lane + 256 * j); s += (v[j][0] * w[0] + v[j][1] * w[1]) + (v[j][2] * w[2] + v[j][3] * w[3]); }
            gs[g] = s; if ((g & 3) == 3) asm volatile("" ::: "memory"); }
#pragma unroll
        for (int j = 0; j < 8; ++j) { const bool up = lane & 1; const float send = up ? gs[j] : gs[j + 8], keep = up ? gs[j + 8] : gs[j]; gs[j] = keep + __shfl_xor(send, 1); }
#pragma unroll
        for (int j = 0; j < 4; ++j) { const bool up = lane & 2; const float send = up ? gs[j] : gs[j + 4], keep = up ? gs[j + 4] : gs[j]; gs[j] = keep + __shfl_xor(send, 2); }
#pragma unroll
        for (int j = 0; j < 2; ++j) { const bool up = lane & 4; const float send = up ? gs[j] : gs[j + 2], keep = up ? gs[j + 2] : gs[j]; gs[j] = keep + __shfl_xor(send, 4); }
        { const bool up = lane & 8; const float send = up ? gs[0] : gs[1], keep = up ? gs[1] : gs[0]; gs[0] = keep + __shfl_xor(send, 8); }
        float tot = gs[0]; tot += __shfl_xor(tot, 16); tot += __shfl_xor(tot, 32);
        const int gi = ((lane & 1) << 3) | ((lane & 2) << 1) | ((lane & 4) >> 1) | ((lane & 8) >> 3);
        if (lane < 16) { float gv = tot + a.in[17][gi]; if (gi & 4) gv = logsig(gv); ((float*)(ws + WS_GATES))[(size_t)m * 16 + gi] = gv; }
    }
    for (int m = gw; m < MMEM; m += NGW) {
        const f32x4* xr = (const f32x4*)(a.in[1] + (size_t)m * DM) + lane;
        f32x4 v[4]; float ss = 0.f;
#pragma unroll
        for (int j = 0; j < 4; ++j) { v[j] = xr[64 * j]; ss += (v[j][0] * v[j][0] + v[j][1] * v[j][1]) + (v[j][2] * v[j][2] + v[j][3] * v[j][3]); }
        const float rstd = 1.0f / sqrtf(wave_sum(ss) * (1.0f / DM) + EPS);
        unsigned long long* o8 = (unsigned long long*)((bf16*)(ws + WS_MEMN) + (size_t)m * DM) + lane;
#pragma unroll
        for (int j = 0; j < 4; ++j) { v[j] = v[j] * rstd; o8[64 * j] = (unsigned long long)pk2(v[j][0], v[j][1]) | ((unsigned long long)pk2(v[j][2], v[j][3]) << 32); }
    }
    for (int t = gw; t < SEQ; t += NGW) {
        const float tl = (float)t * (1.0f / (float)(SEQ - 1)), ang = (6.283185307179586f / (float)SEQ) * (float)t;
        const int mb = lane & 15; const float band = 1e-4f + (float)mb * ((15.0f - 1e-4f) / 15.0f); const float ph = band * ang;
        const float zf = (lane & 16) ? -sinf(ph) : cosf(ph);
        float s = tl * a.in[6][lane];
#pragma unroll 8
        for (int i = 0; i < 32; ++i) s += __shfl(zf, i) * a.in[6][(1 + i) * 64 + lane];
        const float h1 = sinf(a.in[8][lane] * (s + a.in[7][lane]));
        float s2 = 0.f;
#pragma unroll 8
        for (int i = 0; i < 64; ++i) s2 += __shfl(h1, i) * a.in[9][i * 64 + lane];
        const float h2 = sinf(a.in[11][lane] * (s2 + a.in[10][lane]));
        ((float*)(ws + WS_HID2))[(size_t)t * 64 + lane] = h2;
    }
}
__device__ __forceinline__ float sigm(float x) { return __builtin_amdgcn_rcpf(1.0f + __builtin_amdgcn_exp2f(x * -1.4426950408889634f)); }
__device__ __forceinline__ float silu(float x) { return x * sigm(x); }

__device__ __forceinline__ void filters_phase(const Args& a, LAS unsigned char* lds, int G, int vcu) {
    const int tid = threadIdx.x, lane = tid & 63, wave = __builtin_amdgcn_readfirstlane(tid >> 6);
    const int gw = vcu * NWAVES + wave, NGW = G * NWAVES;
    const float* hid2 = (const float*)(a.ws + WS_HID2); float* filt = (float*)((unsigned char*)a.out + OUT_FILT);
    LAS float* hs = (LAS float*)(lds + 73728 + wave * 4096);
    for (int item = gw; item < 32 * 256; item += NGW) {
        const int cg = item & 31, tb = item >> 5, t0 = tb * 16, ch = cg * 64 + lane, c = ch & 511;
#pragma unroll
        for (int i = 0; i < 4; ++i) *(LAS f32x4*)(hs + (lane + 64 * i) * 4) = *(const f32x4*)(hid2 + (size_t)t0 * 64 + (lane + 64 * i) * 4);
        LDS_WAIT();
        float acc[16];
#pragma unroll
        for (int i = 0; i < 16; ++i) acc[i] = 0.f;
#pragma nounroll
        for (int j4 = 0; j4 < 16; ++j4) {
            const float w0 = a.in[12][(size_t)(4 * j4 + 0) * 2048 + ch], w1 = a.in[12][(size_t)(4 * j4 + 1) * 2048 + ch], w2 = a.in[12][(size_t)(4 * j4 + 2) * 2048 + ch], w3 = a.in[12][(size_t)(4 * j4 + 3) * 2048 + ch];
#pragma unroll
            for (int i = 0; i < 16; ++i) { const f32x4 h4 = *(const LAS f32x4*)(hs + i * 64 + 4 * j4); acc[i] += (h4[0] * w0 + h4[1] * w1) + (h4[2] * w2 + h4[3] * w3); }
        }
        const float mind = -3.0701134573253944f, maxd = -15.350567286626972f;
        const float ad = fabsf(mind + (float)c * ((maxd - mind) / 511.0f));
        float* dst = filt + (size_t)ch * SEQ + t0;
#pragma unroll
        for (int i4 = 0; i4 < 4; ++i4) { f32x4 o;
#pragma unroll
            for (int e = 0; e < 4; ++e) { const float tl = (float)(t0 + 4 * i4 + e) * (1.0f / (float)(SEQ - 1)); o[e] = acc[4 * i4 + e] * expf(-tl * ad); }
            *(f32x4*)(dst + 4 * i4) = o; }
        LDS_WAIT();
    }
}
__device__ __forceinline__ void softmax_rows(const Args& a, int G, int vcu) {
    const int tid = threadIdx.x, lane = tid & 63, wave = __builtin_amdgcn_readfirstlane(tid >> 6);
    const int gw = vcu * NWAVES + wave, NGW = G * NWAVES;
    bf16* sp = (bf16*)(a.ws + WS_SP);
    for (int m = gw; m < MTOK; m += NGW) {
        v4u* p = (v4u*)(sp + (size_t)m * DM + 16 * lane);
        const v4u r0 = p[0], r1 = p[1];
        float v[16];
        const unsigned w[8] = {r0.x, r0.y, r0.z, r0.w, r1.x, r1.y, r1.z, r1.w};
        float mx = -1e30f;
#pragma unroll
        for (int e = 0; e < 8; ++e) { v[2 * e] = __uint_as_float(w[e] << 16) * 0.0625f; v[2 * e + 1] = __uint_as_float(w[e] & 0xffff0000u) * 0.0625f; mx = fmaxf(mx, fmaxf(v[2 * e], v[2 * e + 1])); }
        mx = fmaxf(mx, __shfl_xor(mx, 1)); mx = fmaxf(mx, __shfl_xor(mx, 2)); mx = fmaxf(mx, __shfl_xor(mx, 4)); mx = fmaxf(mx, __shfl_xor(mx, 8));
        float sum = 0.f;
#pragma unroll
        for (int e = 0; e < 16; ++e) { v[e] = expf(v[e] - mx); sum += v[e]; }
        sum += __shfl_xor(sum, 1); sum += __shfl_xor(sum, 2); sum += __shfl_xor(sum, 4); sum += __shfl_xor(sum, 8);
        const float inv = 1.0f / sum;
        v4u o0, o1;
        o0.x = pk2(v[0] * inv, v[1] * inv); o0.y = pk2(v[2] * inv, v[3] * inv); o0.z = pk2(v[4] * inv, v[5] * inv); o0.w = pk2(v[6] * inv, v[7] * inv);
        o1.x = pk2(v[8] * inv, v[9] * inv); o1.y = pk2(v[10] * inv, v[11] * inv); o1.z = pk2(v[12] * inv, v[13] * inv); o1.w = pk2(v[14] * inv, v[15] * inv);
        p[0] = o0; p[1] = o1;
    }
}
__device__ __forceinline__ void final_norm(const Args& a, int G, int vcu) {
    const int tid = threadIdx.x, lane = tid & 63, wave = __builtin_amdgcn_readfirstlane(tid >> 6);
    const int gw = vcu * NWAVES + wave, NGW = G * NWAVES;
    const bf16* xn = (const bf16*)(a.ws + WS_XN);
    f32x4 g4[4];
#pragma unroll
    for (int j = 0; j < 4; ++j) g4[j] = *((const f32x4*)a.in[29] + 4 * lane + j);
    for (int m = gw; m < MTOK; m += NGW) {
        const v4u* p = (const v4u*)(xn + (size_t)m * DM + 16 * lane);
        const v4u r0 = p[0], r1 = p[1];
        const unsigned w[8] = {r0.x, r0.y, r0.z, r0.w, r1.x, r1.y, r1.z, r1.w};
        float v[16]; float ss = 0.f;
#pragma unroll
        for (int e = 0; e < 8; ++e) { v[2 * e] = __uint_as_float(w[e] << 16); v[2 * e + 1] = __uint_as_float(w[e] & 0xffff0000u); ss += v[2 * e] * v[2 * e] + v[2 * e + 1] * v[2 * e + 1]; }
        const float rstd = __builtin_amdgcn_rsqf(wave_sum(ss) * (1.0f / DM) + EPS);
        f32x4* o = (f32x4*)(a.out + (size_t)m * DM + 16 * lane);
#pragma unroll
        for (int j = 0; j < 4; ++j) o[j] = (f32x4){v[4 * j] * rstd * g4[j][0], v[4 * j + 1] * rstd * g4[j][1], v[4 * j + 2] * rstd * g4[j][2], v[4 * j + 3] * rstd * g4[j][3]};
    }
}
typedef __amdgpu_buffer_rsrc_t rsrc_t;
typedef unsigned u32x2v __attribute__((ext_vector_type(2)));
__device__ __forceinline__ rsrc_t mkrsrc(const void* p, unsigned bytes) { return __builtin_amdgcn_make_buffer_rsrc((void*)p, 0, bytes, 0x00020000); }
__device__ __forceinline__ float bld_bf16(rsrc_t r, unsigned off) { return bf2f(__builtin_amdgcn_raw_buffer_load_b16(r, off, 0, 0)); }
__device__ __forceinline__ float bld_bf16s(rsrc_t r, unsigned off, unsigned soff) { return bf2f(__builtin_amdgcn_raw_buffer_load_b16(r, off, soff, 0)); }
__device__ __forceinline__ float bld_f32(rsrc_t r, unsigned off, unsigned soff = 0) { return __uint_as_float(__builtin_amdgcn_raw_buffer_load_b32(r, off, soff, 0)); }
typedef unsigned u32x4b __attribute__((ext_vector_type(4)));
__device__ __forceinline__ v4u bld128(rsrc_t r, unsigned voff, unsigned soff) { const u32x4b w = __builtin_amdgcn_raw_buffer_load_b128(r, voff, soff, 0); return (v4u){w.x, w.y, w.z, w.w}; }
__device__ __forceinline__ v2u bld64(rsrc_t r, unsigned voff, unsigned soff) { const u32x2v w = __builtin_amdgcn_raw_buffer_load_b64(r, voff, soff, 0); return (v2u){w.x, w.y}; }
typedef short bf16x8 __attribute__((ext_vector_type(8)));
typedef float f32x16 __attribute__((ext_vector_type(16)));
#define MFMA32(a, b, c) __builtin_amdgcn_mfma_f32_32x32x16_bf16((a), (b), (c), 0, 0, 0)
__device__ __forceinline__ int crow(int r, int h) { return (r & 3) + 8 * (r >> 2) + 4 * h; }
__device__ __forceinline__ bf16x8 scale_frag(v4u raw, float s) {
    v4u o;
#pragma unroll
    for (int e = 0; e < 4; ++e) o[e] = cvtpk(__uint_as_float(raw[e] << 16) * s, __uint_as_float(raw[e] & 0xffff0000u) * s);
    return __builtin_bit_cast(bf16x8, o);
}
__device__ __forceinline__ bf16x8 scale_frag8(v4u raw, f32x4 s0, f32x4 s1) {
    v4u o;
    o[0] = cvtpk(__uint_as_float(raw[0] << 16) * s0[0], __uint_as_float(raw[0] & 0xffff0000u) * s0[1]);
    o[1] = cvtpk(__uint_as_float(raw[1] << 16) * s0[2], __uint_as_float(raw[1] & 0xffff0000u) * s0[3]);
    o[2] = cvtpk(__uint_as_float(raw[2] << 16) * s1[0], __uint_as_float(raw[2] & 0xffff0000u) * s1[1]);
    o[3] = cvtpk(__uint_as_float(raw[3] << 16) * s1[2], __uint_as_float(raw[3] & 0xffff0000u) * s1[3]);
    return __builtin_bit_cast(bf16x8, o);
}
struct ScanCtx { f32x16 acc; v4u ar[4]; bf16x8 br[4]; float be, dc; int step; };
struct ScanEnv { const Args* a; LAS unsigned char* lds; int vcu; };
__device__ __forceinline__ void scan_load(ScanCtx& s, const ScanEnv& e, int jq, int lane, int wave) {
    const int cd = e.vcu, chain = cd >> 2, dt = cd & 3, nt = wave, b = chain >> 3, hh = (chain >> 1) & 3, dir = chain & 1;
    const int j_ = dir ? 63 - jq : jq;
    const unsigned char* ws = e.a->ws;
    const rsrc_t rva = mkrsrc((const bf16*)(ws + WS_VF) + (size_t)((b * 4 + hh) * 64) * 8192, 64 * 16384), rkb = mkrsrc((const bf16*)(ws + WS_KF) + (size_t)((b * 4 + hh) * 64) * 8192, 64 * 16384);
    const rsrc_t rgf = mkrsrc((const float*)(ws + WS_GF) + (size_t)b * SEQ * 16, SEQ * 64);
    const unsigned vo = lane * 16 + (nt < 4 ? nt : 0) * 4096, ko = lane * 16 + dt * 4096, go = lane * 64 + (hh * 4 + 2 * dir + 1) * 4;
#pragma unroll
    for (int ks = 0; ks < 4; ++ks) { s.ar[ks] = bld128(rva, vo + ks * 1024, j_ * 16384); s.br[ks] = __builtin_bit_cast(bf16x8, bld128(rkb, ko + ks * 1024, j_ * 16384)); }
    s.be = bld_f32(rgf, go, j_ * 4096); s.dc = ((const float*)(ws + WS_DEC))[(size_t)((b * 4 + hh) * 64 + j_) * 2 + dir];
}
__device__ __forceinline__ void scan_tick(ScanCtx& s, const ScanEnv& e, int lane, int wave) {
    if (wave >= 5) return;
    if (s.step >= 64) return;
    const int cd = e.vcu, chain = cd >> 2, dt = cd & 3, nt = wave, dir = chain & 1, l31 = lane & 31, h = lane >> 5;
    const int j_ = dir ? 63 - s.step : s.step;
    unsigned char* ws = e.a->ws;
    LAS float* wsc = (LAS float*)(e.lds + 139264 + wave * 256);
    bf16* ST = (bf16*)(ws + WS_STATES); bf16* NV = (bf16*)(ws + WS_STATES + 128 * MiB);
    wsc[lane] = s.be; const float decay = s.dc;
    if (nt < 4) { bf16* sp = ST + ((size_t)(chain * 64 + j_) * 32 + nt * 8 + 2 * dt + (l31 >> 4)) * 512 + (((l31 >> 3) & 1) * 32) * 8 + (l31 & 7);
#pragma unroll
        for (int r = 0; r < 16; ++r) sp[crow(r, h) * 8] = (bf16)(cvtpk(s.acc[r], 0.f) & 0xffffu); }
    else if (h == 0) NV[(size_t)(chain * 64 + j_) * 128 + 32 * dt + l31] = (bf16)(cvtpk(s.acc[0], 0.f) & 0xffffu);
#pragma unroll
    for (int ks = 0; ks < 4; ++ks) { v4u araw = s.ar[ks]; if (nt == 4) { const unsigned w1 = (l31 == 0) ? 0x3f803f80u : 0u; araw = (v4u){w1, w1, w1, w1}; }
        const f32x4 b0 = *(const LAS f32x4*)(wsc + 16 * ks + 4 * h), b1 = *(const LAS f32x4*)(wsc + 16 * ks + 8 + 4 * h);
        s.acc = MFMA32(scale_frag8(araw, b0, b1), s.br[ks], s.acc); }
#pragma unroll
    for (int r = 0; r < 16; ++r) s.acc[r] *= decay;
    s.step += 1;
    scan_load(s, e, s.step < 64 ? s.step : 63, lane, wave);
}
__device__ __forceinline__ void scan_init(ScanCtx& s, const ScanEnv& e, int lane, int wave, bool do_scan) {
#pragma unroll
    for (int r = 0; r < 16; ++r) s.acc[r] = 0.f;
    s.step = 0;
    if (wave < 5 && do_scan) scan_load(s, e, 0, lane, wave); else { s.step = 64;
#pragma unroll
        for (int ks = 0; ks < 4; ++ks) { s.ar[ks] = (v4u){0u, 0u, 0u, 0u}; s.br[ks] = __builtin_bit_cast(bf16x8, (v4u){0u, 0u, 0u, 0u}); } s.be = 0.f; s.dc = 0.f; }
}
__device__ __forceinline__ f32x2 cmul(f32x2 a, f32x2 b) { return (f32x2){a.x * b.x - a.y * b.y, a.x * b.y + a.y * b.x}; }
__device__ __forceinline__ f32x2 cmulc(f32x2 a, f32x2 b) { return (f32x2){a.x * b.x + a.y * b.y, a.y * b.x - a.x * b.y}; }
template <bool INV> __device__ __forceinline__ void dft4(f32x2& x0, f32x2& x1, f32x2& x2, f32x2& x3) {
    const f32x2 s02 = x0 + x2, d02 = x0 - x2, s13 = x1 + x3, d13 = x1 - x3;
    const f32x2 jd = INV ? (f32x2){-d13.y, d13.x} : (f32x2){d13.y, -d13.x};
    x0 = s02 + s13; x1 = d02 + jd; x2 = s02 - s13; x3 = d02 - jd;
}
template <bool INV> __device__ __forceinline__ void fft16(f32x2 (&v)[16]) {
    constexpr float C1 = 0.9238795325112867f, S1 = 0.3826834323650898f, R2 = 0.7071067811865476f;
    constexpr float WR[10] = {1.f, C1, R2, S1, 0.f, 0.f, -R2, 0.f, 0.f, -C1};
    constexpr float WI[10] = {0.f, -S1, -R2, -C1, -1.f, 0.f, -R2, 0.f, 0.f, S1};
#pragma unroll
    for (int b = 0; b < 4; ++b) {
        dft4<INV>(v[b], v[4 + b], v[8 + b], v[12 + b]);
#pragma unroll
        for (int c = 1; c < 4; ++c) { if (b == 0) continue; const f32x2 w = {WR[b * c], INV ? -WI[b * c] : WI[b * c]}; v[4 * c + b] = cmul(v[4 * c + b], w); }
    }
    f32x2 o[16];
#pragma unroll
    for (int c = 0; c < 4; ++c) {
        f32x2 y0 = v[4 * c + 0], y1 = v[4 * c + 1], y2 = v[4 * c + 2], y3 = v[4 * c + 3];
        dft4<INV>(y0, y1, y2, y3);
        o[c] = y0; o[c + 4] = y1; o[c + 8] = y2; o[c + 12] = y3;
    }
#pragma unroll
    for (int k = 0; k < 16; ++k) v[k] = o[k];
}
__device__ __forceinline__ f32x2 w32c(int a) {
    constexpr float CR[16] = {1.f, 0.9807852804032304f, 0.9238795325112867f, 0.8314696123025452f, 0.7071067811865476f, 0.5555702330196022f, 0.3826834323650898f, 0.1950903220161283f,
                              0.f, -0.1950903220161283f, -0.3826834323650898f, -0.5555702330196022f, -0.7071067811865476f, -0.8314696123025452f, -0.9238795325112867f, -0.9807852804032304f};
    constexpr float CI[16] = {0.f, -0.1950903220161283f, -0.3826834323650898f, -0.5555702330196022f, -0.7071067811865476f, -0.8314696123025452f, -0.9238795325112867f, -0.9807852804032304f,
                              -1.f, -0.9807852804032304f, -0.9238795325112867f, -0.8314696123025452f, -0.7071067811865476f, -0.5555702330196022f, -0.3826834323650898f, -0.1950903220161283f};
    return (f32x2){CR[a], CI[a]};
}
constexpr int HY_BUF_BYTES = 34816, HY_TW1_OFF = 2 * HY_BUF_BYTES, HY_TW2_OFF = HY_TW1_OFF + 32768;
__device__ __forceinline__ void hy_fwd(LAS f32x2* hb, int half, int u, f32x2 wu, const LAS f32x2* tw1, const LAS f32x2* tw2, f32x2 (&V)[16], ScanCtx& sc, const ScanEnv& se) {
    const int sl_ = threadIdx.x & 63, sw_ = __builtin_amdgcn_readfirstlane(threadIdx.x >> 6);
    const int p1 = u + (u >> 4), p2 = 272 * (u >> 4) + (u & 15), p3 = 17 * u;
#pragma unroll
    for (int k = 0; k < 16; ++k) V[k] = hb[272 * k + p1];
    if (half) {
#pragma unroll
        for (int k = 1; k < 16; ++k) V[k] = cmul(V[k], w32c(k));
    }
    fft16<false>(V);
#pragma unroll
    for (int k = 0; k < 16; ++k) { if (k == 0 && !half) continue; V[k] = cmul(V[k], tw1[k * 256 + u]); }
#pragma unroll
    for (int k = 0; k < 16; ++k) hb[272 * k + p1] = V[k];
    __syncthreads(); scan_tick(sc, se, sl_, sw_);
#pragma unroll
    for (int k = 0; k < 16; ++k) V[k] = hb[p2 + 17 * k];
    fft16<false>(V);
#pragma unroll
    for (int k = 1; k < 16; ++k) V[k] = cmul(V[k], tw2[k * 16 + (u & 15)]);
#pragma unroll
    for (int k = 0; k < 16; ++k) hb[p2 + 17 * k] = V[k];
    __syncthreads(); scan_tick(sc, se, sl_, sw_);
#pragma unroll
    for (int k = 0; k < 16; ++k) V[k] = hb[p3 + k];
    fft16<false>(V);
}
__device__ __forceinline__ void hy_inv(LAS f32x2* hb, int half, int u, f32x2 wu, const LAS f32x2* tw1, const LAS f32x2* tw2, f32x2 (&V)[16], ScanCtx& sc, const ScanEnv& se) {
    const int sl_ = threadIdx.x & 63, sw_ = __builtin_amdgcn_readfirstlane(threadIdx.x >> 6);
    const int p1 = u + (u >> 4), p2 = 272 * (u >> 4) + (u & 15), p3 = 17 * u;
    fft16<true>(V);
#pragma unroll
    for (int k = 1; k < 16; ++k) V[k] = cmulc(V[k], tw2[k * 16 + (u & 15)]);
#pragma unroll
    for (int k = 0; k < 16; ++k) hb[p3 + k] = V[k];
    __syncthreads(); scan_tick(sc, se, sl_, sw_);
#pragma unroll
    for (int k = 0; k < 16; ++k) V[k] = hb[p2 + 17 * k];
    fft16<true>(V);
#pragma unroll
    for (int k = 0; k < 16; ++k) V[k] = cmulc(V[k], tw1[(u >> 4) * 256 + 16 * k + (u & 15)]);
#pragma unroll
    for (int k = 0; k < 16; ++k) hb[p2 + 17 * k] = V[k];
    __syncthreads(); scan_tick(sc, se, sl_, sw_);
#pragma unroll
    for (int k = 0; k < 16; ++k) V[k] = hb[272 * k + p1];
    fft16<true>(V);
    if (half) {
#pragma unroll
        for (int k = 1; k < 16; ++k) V[k] = cmulc(V[k], w32c(k));
    }
#pragma unroll
    for (int k = 0; k < 16; ++k) hb[272 * k + p1] = V[k];
}
__device__ __forceinline__ int hpos(int n) { return n + (n >> 4); }
template <int O> __device__ __forceinline__ void hy_order(const Args& a, LAS f32x2* bufE, LAS f32x2* bufO, LAS f32x2* hb, int half, int u, f32x2 wu, const LAS f32x2* t1, const LAS f32x2* tw2,
                                                          rsrc_t rH, f32x2 (&xin)[8], int c, int b0, float skip, ScanCtx& sc, const ScanEnv& se) {
    const int tid = threadIdx.x;
    const bf16* hyT = (const bf16*)a.out; bf16* yT = (bf16*)(a.ws + WS_YT);
    f32x2 V[16];
    u32x2v hw[16];
#pragma unroll
    for (int k = 0; k < 16; ++k) hw[k] = __builtin_amdgcn_raw_buffer_load_b64(rH, tid * 8, (O * 16 + k) * 4096, 0);
    __syncthreads();
    hy_fwd(hb, half, u, wu, t1, tw2, V, sc, se);
    const rsrc_t rg0 = mkrsrc(hyT + ((size_t)b0 * 1536 + 512 * (O + 1) + c) * SEQ, SEQ * 2), rg1 = mkrsrc(hyT + ((size_t)(b0 + 1) * 1536 + 512 * (O + 1) + c) * SEQ, SEQ * 2);
    unsigned short gw0[8], gw1[8];
#pragma unroll
    for (int i = 0; i < 8; ++i) { gw0[i] = __builtin_amdgcn_raw_buffer_load_b16(rg0, (tid + 512 * i) * 2, 0, 0); gw1[i] = __builtin_amdgcn_raw_buffer_load_b16(rg1, (tid + 512 * i) * 2, 0, 0); }
#pragma unroll
    for (int k = 0; k < 16; ++k) V[k] = cmul(V[k], (f32x2){__uint_as_float(hw[k].x), __uint_as_float(hw[k].y)});
    hy_inv(hb, half, u, wu, t1, tw2, V, sc, se);
    __syncthreads();
    const rsrc_t ry0 = mkrsrc(yT + ((size_t)b0 * 512 + c) * SEQ, SEQ * 2), ry1 = mkrsrc(yT + ((size_t)(b0 + 1) * 512 + c) * SEQ, SEQ * 2);
#pragma unroll
    for (int i = 0; i < 8; ++i) { const int n = tid + 512 * i, p = hpos(n);
        const f32x2 y = (bufE[p] + bufO[p]) * (1.0f / 8192.0f);
        f32x2 r; r.x = bf2f(gw0[i]) * (y.x + skip * xin[i].x); r.y = bf2f(gw1[i]) * (y.y + skip * xin[i].y);
        if (O == 0) { xin[i] = r; bufE[p] = r; bufO[p] = r; }
        else { __builtin_amdgcn_raw_buffer_store_b16((unsigned short)(cvtpk(r.x, 0.f) & 0xffffu), ry0, n * 2, 0, 0); __builtin_amdgcn_raw_buffer_store_b16((unsigned short)(cvtpk(r.y, 0.f) & 0xffffu), ry1, n * 2, 0, 0); } }
}
__device__ __forceinline__ void hyena_fft(const Args& a, LAS unsigned char* lds, int G, int vcu) {
    const int tid = threadIdx.x, half = __builtin_amdgcn_readfirstlane(tid >> 8), u = tid & 255;
    LAS f32x2* bufE = (LAS f32x2*)lds; LAS f32x2* bufO = (LAS f32x2*)(lds + HY_BUF_BYTES);
    LAS f32x2* tw1 = (LAS f32x2*)(lds + HY_TW1_OFF); LAS f32x2* tw2 = (LAS f32x2*)(lds + HY_TW2_OFF);
    LAS f32x2* hb = half ? bufO : bufE;
    LAS f32x2* tw1o = (LAS f32x2*)(lds + HY_TW2_OFF + 2048);
    const LAS f32x2* t1 = half ? tw1o : tw1;
    const bf16* hyT = (const bf16*)a.out; const float* filt = (const float*)((const unsigned char*)a.out + OUT_FILT);
    __syncthreads();
    for (int idx = tid; idx < 4096; idx += NTHREADS) { const int m = (idx & 255) * (idx >> 8); float s, c; sincospif((float)m * (1.0f / 2048.0f), &s, &c); tw1[idx] = (f32x2){c, -s};
        sincospif((float)(2 * m + (idx & 255)) * (1.0f / 4096.0f), &s, &c); tw1o[idx] = (f32x2){c, -s}; }
    if (tid < 256) { const int m = 16 * (tid & 15) * (tid >> 4); float s, c; sincospif((float)m * (1.0f / 2048.0f), &s, &c); tw2[tid] = (f32x2){c, -s}; }
    f32x2 wu; { float s, c; sincospif((float)u * (1.0f / 4096.0f), &s, &c); wu = (f32x2){c, -s}; }
    ScanCtx sc; const ScanEnv se = {&a, lds, vcu};
    { const int sl_ = tid & 63, sw_ = __builtin_amdgcn_readfirstlane(tid >> 6); scan_init(sc, se, sl_, sw_, G == 256); }
    const rsrc_t rH = mkrsrc(a.ws + WS_HSPEC + (size_t)blockIdx.x * (2 * 16 * NTHREADS * 8), 2 * 16 * NTHREADS * 8);
    for (int c = vcu; c < DHY; c += G) {
#pragma nounroll
        for (int o = 0; o < 2; ++o) {
            const rsrc_t rf = mkrsrc(filt + ((size_t)(o * 2 + 0) * 512 + c) * SEQ, SEQ * 4), rk = mkrsrc(filt + ((size_t)(o * 2 + 1) * 512 + c) * SEQ, SEQ * 4);
            __syncthreads();
#pragma unroll
            for (int i = 0; i < 8; ++i) { const int n = tid + 512 * i, p = hpos(n); const float f = bld_f32(rf, n * 4); float r = bld_f32(rk, (SEQ - n) * 4); r = (n >= 1) ? r : 0.f;
                bufE[p] = (f32x2){f + r, 0.f}; bufO[p] = (f32x2){f - r, 0.f}; }
            __syncthreads();
            f32x2 V[16];
            hy_fwd(hb, half, u, wu, t1, tw2, V, sc, se);
#pragma unroll
            for (int k = 0; k < 16; ++k) { u32x2v w; w.x = __float_as_uint(V[k].x); w.y = __float_as_uint(V[k].y); __builtin_amdgcn_raw_buffer_store_b64(w, rH, tid * 8, (o * 16 + k) * 4096, 0); }
        }
        const float skip0 = a.in[13][c], skip1 = a.in[13][512 + c];
#pragma nounroll
        for (int pr = 0; pr < 4; ++pr) {
            const int b0 = 2 * pr;
            f32x2 xin[8];
            const rsrc_t rv0 = mkrsrc(hyT + ((size_t)b0 * 1536 + c) * SEQ, SEQ * 2), rv1 = mkrsrc(hyT + ((size_t)(b0 + 1) * 1536 + c) * SEQ, SEQ * 2);
            __syncthreads();
#pragma unroll
            for (int i = 0; i < 8; ++i) { const int n = tid + 512 * i, p = hpos(n); xin[i] = (f32x2){bld_bf16(rv0, n * 2), bld_bf16(rv1, n * 2)}; bufE[p] = xin[i]; bufO[p] = xin[i]; }
            hy_order<0>(a, bufE, bufO, hb, half, u, wu, t1, tw2, rH, xin, c, b0, skip0, sc, se);
            hy_order<1>(a, bufE, bufO, hb, half, u, wu, t1, tw2, rH, xin, c, b0, skip1, sc, se);
        }
    }
    { const int sl_ = tid & 63, sw_ = __builtin_amdgcn_readfirstlane(tid >> 6); while (sc.step < 64) scan_tick(sc, se, sl_, sw_); }
    __syncthreads();
}
__device__ __forceinline__ float incl_prefix(float x, int lane) {
#pragma unroll
    for (int d = 1; d < 64; d <<= 1) { const float t = __shfl_up(x, d); if (lane >= d) x += t; }
    return x;
}
__device__ __forceinline__ float incl_suffix(float x, int lane) {
#pragma unroll
    for (int d = 1; d < 64; d <<= 1) { const float t = __shfl_down(x, d); if (lane + d < 64) x += t; }
    return x;
}
__device__ __forceinline__ void gate_factors(const Args& a, int G, int vcu) {
    const int tid = threadIdx.x, lane = tid & 63, wave = __builtin_amdgcn_readfirstlane(tid >> 6);
    const int gw = vcu * NWAVES + wave, NGW = G * NWAVES;
    const float* gates = (const float*)(a.ws + WS_GATES); float* gf = (float*)(a.ws + WS_GF); float* dec = (float*)(a.ws + WS_DEC);
    for (int task = gw; task < NB * NHEAD * 64; task += NGW) {
        const int b = task >> 8, hh = (task >> 6) & 3, j = task & 63; const size_t row = (size_t)b * SEQ + j * 64 + lane;
        const float* gp = gates + row * 16 + hh;
        const float i_f = gp[0], a_f = gp[4], i_b = gp[8], a_b = gp[12];
        const float F = incl_prefix(a_f, lane), Gs = incl_suffix(a_b, lane);
        *(f32x4*)(gf + row * 16 + hh * 4) = (f32x4){expf(F), expf(i_f - F), expf(Gs), expf(i_b - Gs)};
        if (lane == 63) dec[(size_t)task * 2] = expf(F);
        if (lane == 0) dec[(size_t)task * 2 + 1] = expf(Gs);
    }
}
__device__ __forceinline__ void mlstm_scan(const Args& a, LAS unsigned char* lds, int G, int vcu) {
    int tid = threadIdx.x; asm volatile("" : "+v"(tid));
    const int lane = tid & 63, wave = __builtin_amdgcn_readfirstlane(tid >> 6), l31 = lane & 31, h = lane >> 5;
    const int gw = wave * G + vcu, NGW = G * NWAVES;
    LAS float* wsc = (LAS float*)(lds + wave * 1024);
    const bf16* KFp = (const bf16*)(a.ws + WS_KF); const bf16* VFp = (const bf16*)(a.ws + WS_VF);
    const float* gf = (const float*)(a.ws + WS_GF); const float* dec = (const float*)(a.ws + WS_DEC); bf16* ST = (bf16*)(a.ws + WS_STATES); bf16* NV = (bf16*)(a.ws + WS_STATES + 128 * MiB);
    for (int cd = vcu; cd < 64 * 4; cd += G) { if (wave >= 5) break;
        const int chain = cd >> 2, dt = cd & 3, nt = wave;
        const int b = chain >> 3, hh = (chain >> 1) & 3, dir = chain & 1;
        f32x16 acc;
#pragma unroll
        for (int r = 0; r < 16; ++r) acc[r] = 0.f;
        const rsrc_t rva = mkrsrc(VFp + (size_t)((b * 4 + hh) * 64) * 8192, 64 * 16384), rkb = mkrsrc(KFp + (size_t)((b * 4 + hh) * 64) * 8192, 64 * 16384);
        const rsrc_t rgf = mkrsrc(gf + (size_t)b * SEQ * 16, SEQ * 64);
        const unsigned vo = lane * 16 + (nt < 4 ? nt : 0) * 4096, ko = lane * 16 + dt * 4096, go = lane * 64 + (hh * 4 + 2 * dir + 1) * 4;
        const float* dbase = dec + (size_t)((b * 4 + hh) * 64) * 2 + dir;
        const v4u ones = {0x3f803f80u, 0x3f803f80u, 0x3f803f80u, 0x3f803f80u}, zeros = {0u, 0u, 0u, 0u};
        struct Stg { v4u ar[4]; bf16x8 br[4]; float be, dc; };
#define SCAN_LOAD(S, jq) do { const int jc_ = (jq) < 0 ? 0 : ((jq) > 63 ? 63 : (jq)); const int j_ = dir ? 63 - jc_ : jc_; _Pragma("unroll") for (int ks = 0; ks < 4; ++ks) { \
            S.ar[ks] = bld128(rva, vo + ks * 1024, j_ * 16384); S.br[ks] = __builtin_bit_cast(bf16x8, bld128(rkb, ko + ks * 1024, j_ * 16384)); } S.be = bld_f32(rgf, go, j_ * 4096); S.dc = dbase[j_ * 2]; } while (0)
#define SCAN_STEP(S, jq) do { const int j_ = dir ? 63 - (jq) : (jq); \
            wsc[lane] = S.be; const float decay = S.dc; \
            if (nt < 4) { bf16* sp = ST + ((size_t)(chain * 64 + j_) * 32 + nt * 8 + 2 * dt + (l31 >> 4)) * 512 + (((l31 >> 3) & 1) * 32) * 8 + (l31 & 7); \
                _Pragma("unroll") for (int r = 0; r < 16; ++r) sp[crow(r, h) * 8] = (bf16)f2bf(acc[r]); } \
            else if (h == 0) NV[(size_t)(chain * 64 + j_) * 128 + 32 * dt + l31] = (bf16)f2bf(acc[0]);     \
            _Pragma("unroll") for (int ks = 0; ks < 4; ++ks) { v4u araw = S.ar[ks]; if (nt == 4) araw = (l31 == 0) ? ones : zeros; \
                const f32x4 b0 = *(const LAS f32x4*)(wsc + 16 * ks + 4 * h), b1 = *(const LAS f32x4*)(wsc + 16 * ks + 8 + 4 * h); \
                acc = MFMA32(scale_frag8(araw, b0, b1), S.br[ks], acc); } \
            _Pragma("unroll") for (int r = 0; r < 16; ++r) acc[r] *= decay; } while (0)
        Stg s0, s1, s2;
        SCAN_LOAD(s0, 0); SCAN_LOAD(s1, 1);
#pragma nounroll
        for (int jj = 0; jj < 63; jj += 3) {
            SCAN_LOAD(s2, jj + 2); SCAN_STEP(s0, jj);
            SCAN_LOAD(s0, jj + 3); SCAN_STEP(s1, jj + 1);
            SCAN_LOAD(s1, jj + 4); SCAN_STEP(s2, jj + 2);
        }
        SCAN_STEP(s0, 63);
#undef SCAN_LOAD
#undef SCAN_STEP
    }
}
constexpr int ML_WAVE_LDS = 18432, ML_YROW = 136;
__device__ __forceinline__ void mlstm_out(const Args& a, LAS unsigned char* lds, int G, int vcu) {
    int tid = threadIdx.x; asm volatile("" : "+v"(tid));
    const int lane = tid & 63, wave = __builtin_amdgcn_readfirstlane(tid >> 6), l31 = lane & 31, h = lane >> 5;
    const int gw = vcu * NWAVES + wave, NGW = G * NWAVES;
    LAS float* sc = (LAS float*)(lds + wave * ML_WAVE_LDS);
    LAS bf16* ybuf = (LAS bf16*)(lds + wave * ML_WAVE_LDS + 1024); LAS float* rsb = (LAS float*)(lds + wave * ML_WAVE_LDS + 1024 + 32 * ML_YROW * 2);
    LAS float* ivb = rsb + 32;
    LAS v4u* pfl = (LAS v4u*)(lds + wave * ML_WAVE_LDS + 10240) + lane;
    const unsigned char* QFp = a.ws + WS_QF; const unsigned char* KAp = a.ws + WS_KA; const unsigned char* VFp = a.ws + WS_VF;
    const bf16* om = (const bf16*)(a.ws + WS_PROJ) + 6 * PROJ_STRIDE; const float* gf = (const float*)(a.ws + WS_GF);
    const bf16* ST = (const bf16*)(a.ws + WS_STATES); const bf16* NV = (const bf16*)(a.ws + WS_STATES + 128 * MiB); bf16* mixed = (bf16*)(a.ws + WS_MIXED);
    const unsigned lo = lane * 16;
    for (int t4 = vcu * NWAVES; t4 < NB * NHEAD * 64; t4 += NGW)
    for (int rr = 0; rr < 2; ++rr) {
        const int task = t4 + rr * 4 + (wave & 3);
        const int b = task >> 8, hh = (task >> 6) & 3, j = task & 63, t0 = j * 64, row0 = b * SEQ + t0;
        { const f32x4 g4 = *(const f32x4*)(gf + (size_t)(row0 + lane) * 16 + hh * 4);
          sc[lane] = g4[0]; sc[64 + lane] = g4[1]; sc[128 + lane] = g4[2]; sc[192 + lane] = g4[3]; }
        const size_t fo = (size_t)(((b * 4 + hh) * 64 + j)) * 16384;
        const rsrc_t rq = mkrsrc(QFp + fo, 16384), rk = mkrsrc(KAp + fo, 16384), rv = mkrsrc(VFp + fo, 16384);
        const rsrc_t rs0 = mkrsrc(ST + ((size_t)(((b * 4 + hh) * 2 + 0) * 64 + j) * 32) * 512, 32768), rs1 = mkrsrc(ST + ((size_t)(((b * 4 + hh) * 2 + 1) * 64 + j) * 32) * 512, 32768);
        const rsrc_t rn0 = mkrsrc(NV + (size_t)(((b * 4 + hh) * 2 + 0) * 64 + j) * 128, 256), rn1 = mkrsrc(NV + (size_t)(((b * 4 + hh) * 2 + 1) * 64 + j) * 128, 256);
        const unsigned lon = (l31 == 0) ? (unsigned)(16 * h) : 0x40000000u;
        const rsrc_t ro = mkrsrc(om + (size_t)row0 * 512 + hh * 128, 64 * 1024), rm = mkrsrc(mixed + (size_t)row0 * DM + 512 + hh * 128, 64 * 2048);
        {
            const int ti = wave >> 2;
            const int t = 32 * ti + l31;
            v4u qf[8];
#pragma unroll
            for (int ks = 0; ks < 8; ++ks) qf[ks] = bld128(rq, lo, ti * 8192 + 1024 * ks);
            {
                f32x16 X[2];
#pragma unroll
                for (int r = 0; r < 16; ++r) { X[0][r] = 0.f; X[1][r] = 0.f; }
                v4u xa[8], xb[8];
#pragma unroll
                for (int ks = 0; ks < 8; ++ks) { xa[ks] = bld128(rk, lo, 1024 * ks); xb[ks] = bld128(rk, lo, 8192 + 1024 * ks); }
#pragma unroll
                for (int ks = 0; ks < 8; ++ks) { const bf16x8 Bq = __builtin_bit_cast(bf16x8, qf[ks]);
                    X[0] = MFMA32(__builtin_bit_cast(bf16x8, xa[ks]), Bq, X[0]); X[1] = MFMA32(__builtin_bit_cast(bf16x8, xb[ks]), Bq, X[1]); }
                asm volatile("" ::: "memory");
#pragma unroll
                for (int si = 0; si < 2; ++si)
#pragma unroll
                    for (int ss = 0; ss < 2; ++ss) {
                        v4u pf, pb;
#pragma unroll
                        for (int e = 0; e < 4; ++e) { float f2[2], b2[2];
#pragma unroll
                            for (int q2 = 0; q2 < 2; ++q2) { const int r = 8 * ss + 2 * e + q2, s = 32 * si + crow(r, h);
                                const float x = X[si][r], bef = sc[64 + s], beb = sc[192 + s];
                                const float vf = x * bef, vb = x * beb;
                                f2[q2] = (s <= t) ? vf : 0.f; b2[q2] = (s >= t) ? vb : 0.f; }
                            pf[e] = cvtpk(f2[0], f2[1]); pb[e] = cvtpk(b2[0], b2[1]); }
                        pfl[(si * 2 + ss) * 64] = pf; pfl[(4 + si * 2 + ss) * 64] = pb;
                    }
            }
            v4u F[8];
#define ML_COMP(D, RN, VO, SB, SS) do { \
        _Pragma("unroll") for (int ks = 0; ks < 8; ++ks) { D = MFMA32(__builtin_bit_cast(bf16x8, qf[ks]), __builtin_bit_cast(bf16x8, F[ks]), D); F[ks] = bld128(RN, VO, (SB) + (SS) * ks); asm volatile("" ::: "memory"); } } while (0)
#define ML_PV(vf_) do { _Pragma("unroll") for (int r = 0; r < 16; ++r) { df[r] = 0.f; db[r] = 0.f; } \
        _Pragma("unroll") for (int si = 0; si < 2; ++si) _Pragma("unroll") for (int ss = 0; ss < 2; ++ss) { const bf16x8 B_ = __builtin_bit_cast(bf16x8, vf_[si * 2 + ss]); \
            if (si <= ti) df = MFMA32(__builtin_bit_cast(bf16x8, pfl[(si * 2 + ss) * 64]), B_, df); if (si >= ti) db = MFMA32(__builtin_bit_cast(bf16x8, pfl[(4 + si * 2 + ss) * 64]), B_, db); } } while (0)
#pragma unroll
            for (int ks = 0; ks < 8; ++ks) F[ks] = bld128(rn0, lon, 32 * ks);
            asm volatile("" ::: "memory");
            {
                f32x16 df, db; v4u vfr[4];
#pragma unroll
                for (int q4 = 0; q4 < 4; ++q4) { const unsigned w1 = (l31 == 0) ? 0x3f803f80u : 0u; vfr[q4] = (v4u){w1, w1, w1, w1}; }
                ML_PV(vfr);
                ML_COMP(df, rn1, lon, 0, 32);
                ML_COMP(db, rs0, lo, 0, 1024);
#pragma unroll
                for (int r = 0; r < 16; ++r) {
                    if (l31 == 0) { const int tl = crow(r, h); const float af = sc[32 * ti + tl], ab = sc[128 + 32 * ti + tl];
                        ivb[tl] = af * __builtin_amdgcn_rcpf(fmaxf(af * fabsf(df[r]), 1.0f)); ivb[32 + tl] = ab * __builtin_amdgcn_rcpf(fmaxf(ab * fabsf(db[r]), 1.0f)); } }
            }
#pragma nounroll
            for (int nt = 0; nt < 4; ++nt) {
                const int n = 32 * nt + l31;
                f32x16 df, db;
                { v4u vfr[4];
#pragma unroll
                  for (int q4 = 0; q4 < 4; ++q4) vfr[q4] = bld128(rv, lo, nt * 4096 + q4 * 1024);
                  ML_PV(vfr); }
                ML_COMP(df, rs1, lo, nt * 8192, 1024);
                ML_COMP(db, rs0, lo, (nt < 3 ? nt + 1 : 3) * 8192, 1024);
                const unsigned oo = (unsigned)(32 * ti + 4 * h) * 1024 + 2 * n;
#pragma unroll
                for (int r = 0; r < 16; ++r) { const int tl = crow(r, h);
                    const float hv = df[r] * ivb[tl] + db[r] * ivb[32 + tl];
                    const float og = bld_bf16(ro, oo + ((r & 3) + 8 * (r >> 2)) * 1024);
                    const float y = hv * __builtin_amdgcn_rcpf(1.0f + __builtin_amdgcn_exp2f(og * -1.4426950408889634f));
                    ybuf[tl * ML_YROW + n] = (bf16)(cvtpk(y, 0.f) & 0xffffu); }
            }
#undef ML_COMP
#undef ML_PV
#pragma unroll
            for (int i = 0; i < 8; ++i) { const int idx = lane + 64 * i, tl = idx >> 4, ch = idx & 15;
                const v4u w = *(const LAS v4u*)(ybuf + tl * ML_YROW + 8 * ch); float y8[8]; float ss = 0.f;
#pragma unroll
                for (int e = 0; e < 4; ++e) { y8[2 * e] = __uint_as_float(w[e] << 16); y8[2 * e + 1] = __uint_as_float(w[e] & 0xffff0000u); ss += y8[2 * e] * y8[2 * e] + y8[2 * e + 1] * y8[2 * e + 1]; }
                ss += __shfl_xor(ss, 1); ss += __shfl_xor(ss, 2); ss += __shfl_xor(ss, 4); ss += __shfl_xor(ss, 8);
                const float rs = __builtin_amdgcn_rsqf(ss * (1.0f / 128.0f) + EPS);
                u32x4b o;
#pragma unroll
                for (int e = 0; e < 4; ++e) o[e] = cvtpk(y8[2 * e] * rs, y8[2 * e + 1] * rs);
                __builtin_amdgcn_raw_buffer_store_b128(o, rm, (unsigned)(32 * ti + tl) * 2048 + 16 * ch, 0, 0); }
        }
    }
}
constexpr int CV_WAVE_LDS = 8704;
__device__ __forceinline__ void conv_tiles(const Args& a, LAS unsigned char* lds, int G, int vcu, int nlight) {
    const int tid = threadIdx.x, lane = tid & 63, wave = __builtin_amdgcn_readfirstlane(tid >> 6);
    const int gw = vcu * NWAVES + wave, NGW = G * NWAVES;
    LAS unsigned char* raw = lds + wave * CV_WAVE_LDS;
    const bf16* proj = (const bf16*)(a.ws + WS_PROJ);
    const int g8 = lane >> 3, c8 = lane & 7;
    v4u nxt[9];
#define CV_FETCH(it_) do { const int buf_ = (it_) % 6, ct_ = ((it_) / 6) & 7, rt_ = (it_) / 48, b_ = rt_ >> 6, t0_ = (rt_ & 63) * 64; \
        const rsrc_t rs_ = mkrsrc(proj + (size_t)buf_ * PROJ_STRIDE + (size_t)b_ * SEQ * 512 + ct_ * 64, SEQ * 1024); \
        _Pragma("unroll") for (int i = 0; i < 9; ++i) { const int rr = g8 + 8 * i; nxt[i] = bld128(rs_, (unsigned)(t0_ - 1 + rr) * 1024u + c8 * 16, 0); } } while (0)
    const int row_lo = (vcu < nlight) ? vcu * 9 : nlight * 9 + (vcu - nlight) * 13, row_n = (G == 256) ? ((vcu < nlight) ? 9 : 13) : 0;
    if (G != 256) {   }
    int item = (G == 256) ? row_lo * 8 + wave : gw; const int istep = (G == 256) ? 8 : NGW; const int iend = (G == 256) ? (row_lo + row_n) * 8 : 6 * 8 * 512;
    if (item < iend) CV_FETCH(item);
    for (; item < iend; item += istep) {
        const int buf = item % 6, ct = (item / 6) & 7, rt = item / 48, b = rt >> 6, t0 = (rt & 63) * 64;
#pragma unroll
        for (int i = 0; i < 9; ++i) { const int rr = g8 + 8 * i;
            if (rr < 66) *(LAS v4u*)(raw + rr * 128 + c8 * 16) = nxt[i]; }
        if (item + istep < iend) CV_FETCH(item + istep);
        LDS_WAIT();
        if (buf == 3 || buf == 4) {
            const float* cw = a.in[15] + (buf - 3) * 512 + ct * 64 + c8 * 8; const float* cb = a.in[16] + (buf - 3) * 512 + ct * 64 + c8 * 8;
            float w0[8], w1[8], w2[8], bb[8];
#pragma unroll
            for (int e = 0; e < 8; ++e) { w0[e] = cw[e]; w1[e] = cw[1024 + e]; w2[e] = cw[2048 + e]; bb[e] = cb[e]; }
            unsigned char* dst = a.ws + (buf == 3 ? WS_QF : WS_KA) + (size_t)(((b * 4 + (ct >> 1)) * 64 + (rt & 63))) * 16384 + (((ct & 1) * 4 + (c8 >> 1)) * 64 + (c8 & 1) * 32) * 16;
            const float sc = (buf == 3) ? 1.0f : 0.08838834764831845f;
#pragma unroll
            for (int i = 0; i < 8; ++i) { const int r = g8 + 8 * i;
                const v4u x0 = *(const LAS v4u*)(raw + r * 128 + c8 * 16), x1 = *(const LAS v4u*)(raw + (r + 1) * 128 + c8 * 16), x2 = *(const LAS v4u*)(raw + (r + 2) * 128 + c8 * 16);
                v4u o;
#pragma unroll
                for (int e = 0; e < 4; ++e) {
                    const float lo = bb[2 * e] + __uint_as_float(x0[e] << 16) * w0[2 * e] + __uint_as_float(x1[e] << 16) * w1[2 * e] + __uint_as_float(x2[e] << 16) * w2[2 * e];
                    const float hi = bb[2 * e + 1] + __uint_as_float(x0[e] & 0xffff0000u) * w0[2 * e + 1] + __uint_as_float(x1[e] & 0xffff0000u) * w1[2 * e + 1] + __uint_as_float(x2[e] & 0xffff0000u) * w2[2 * e + 1];
                    o[e] = cvtpk(silu(lo) * sc, silu(hi) * sc); }
                *(v4u*)(dst + ((r >> 5) * 8 * 64 + (r & 31)) * 16) = o; }
        }
        if (buf != 3) {
            const LAS bf16* col = (const LAS bf16*)raw + lane;
            float w0 = 0.f, w1 = 1.f, w2 = 0.f, bb = 0.f, sc = 1.f; unsigned char* dstf = nullptr;
            if (buf >= 3) { if (buf == 4) { const int ch = 512 + ct * 64 + lane; w0 = a.in[15][ch]; w1 = a.in[15][1024 + ch]; w2 = a.in[15][2048 + ch]; bb = a.in[16][ch]; sc = 0.08838834764831845f; }
                   const int dd = (ct & 1) * 64 + lane;
                   dstf = a.ws + (buf == 4 ? WS_KF : WS_VF) + (size_t)(((b * 4 + (ct >> 1)) * 64 + (rt & 63))) * 16384 + ((dd >> 5) * 4 * 64 + (dd & 31)) * 16; }
            if (buf < 3) {
                const int cs = lane >> 3, tg = lane & 7;
#pragma unroll
                for (int i = 0; i < 8; ++i) { const int cc = cs + 8 * i, ch = buf * 512 + ct * 64 + cc;
                    const float w0 = a.in[4][ch], w1 = a.in[4][1536 + ch], w2 = a.in[4][3072 + ch], bb = a.in[5][ch];
                    const LAS bf16* col = (const LAS bf16*)raw + cc;
                    float x[10];
#pragma unroll
                    for (int e = 0; e < 10; ++e) x[e] = bf2f(col[(8 * tg + e) * 64]);
                    v4u o;
#pragma unroll
                    for (int e = 0; e < 4; ++e) o[e] = cvtpk(bb + x[2 * e] * w0 + x[2 * e + 1] * w1 + x[2 * e + 2] * w2, bb + x[2 * e + 1] * w0 + x[2 * e + 2] * w1 + x[2 * e + 3] * w2);
                    *(v4u*)((bf16*)a.out + ((size_t)b * 1536 + ch) * SEQ + t0 + 8 * tg) = o; }
            } else {
#pragma unroll
            for (int tg = 0; tg < 8; ++tg) {
                float x[10];
#pragma unroll
                for (int e = 0; e < 10; ++e) x[e] = bf2f(col[(8 * tg + e) * 64]);
                float y[8];
#pragma unroll
                for (int e = 0; e < 8; ++e) { float v = bb + x[e] * w0 + x[e + 1] * w1 + x[e + 2] * w2; if (buf == 4) v = silu(v) * sc; y[e] = v; }
                {
                    unsigned char* pz = dstf + ((tg >> 1) * 64) * 16 + 8 * (tg & 1);
                    *(v2u*)(pz) = (v2u){cvtpk(y[0], y[1]), cvtpk(y[2], y[3])}; *(v2u*)(pz + 32 * 16) = (v2u){cvtpk(y[4], y[5]), cvtpk(y[6], y[7])}; }
            }
            }
        }
        LDS_WAIT();
    }
#undef CV_FETCH
}
__device__ __forceinline__ void hy_mix(const Args& a, int G, int vcu) {
    int tid = threadIdx.x; asm volatile("" : "+v"(tid));
    const int lane = tid & 63, wave = __builtin_amdgcn_readfirstlane(tid >> 6);
    const int gw = vcu * NWAVES + wave, NGW = G * NWAVES;
    const bf16* yT = (const bf16*)(a.ws + WS_YT); bf16* mixed = (bf16*)(a.ws + WS_MIXED);
    for (int item = gw; item < NB * 8 * 64; item += NGW) {
        const int tt = item & 63, g = (item >> 6) & 7, b = item >> 9, t0 = tt * 64;
        const rsrc_t ry = mkrsrc(yT + ((size_t)b * 512 + g * 64) * SEQ + t0, 64 * SEQ * 2);
        float v[64]; float ss = 0.f;
#pragma unroll
        for (int c = 0; c < 64; ++c) { v[c] = bld_bf16s(ry, lane * 2, c * (SEQ * 2)); ss += v[c] * v[c]; }
        const float rs = __builtin_amdgcn_rsqf(ss * (1.0f / 64.0f) + EPS);
        bf16* dst = mixed + (size_t)(b * SEQ + t0 + lane) * DM + g * 64;
#pragma unroll
        for (int i = 0; i < 8; ++i) { v4u o; o.x = cvtpk(v[8 * i] * rs, v[8 * i + 1] * rs); o.y = cvtpk(v[8 * i + 2] * rs, v[8 * i + 3] * rs);
            o.z = cvtpk(v[8 * i + 4] * rs, v[8 * i + 5] * rs); o.w = cvtpk(v[8 * i + 6] * rs, v[8 * i + 7] * rs); *(v4u*)(dst + 8 * i) = o; }
    }
}
typedef GAS unsigned gu32;
#define XB_TMO      128
#define XB_XCNT(j)  (256  + 64 * (j))
#define XB_XSUB(j)  (1280 + 64 * (j))
#define XB_XGEN(j)  (2304 + 64 * (j))
#define XB_TOP      3328
#define XB_TOPGEN   3392
#define XCD_BAR_WORDS 3456
#define XB_SPIN_CAP (1u << 18)

__device__ __forceinline__ unsigned xb_ld(unsigned* p)              { return __hip_atomic_load(p, __ATOMIC_RELAXED, __HIP_MEMORY_SCOPE_AGENT); }
__device__ __forceinline__ unsigned xb_add(unsigned* p, unsigned v) { return __hip_atomic_fetch_add(p, v, __ATOMIC_RELAXED, __HIP_MEMORY_SCOPE_AGENT); }
__device__ __forceinline__ unsigned xb_xcc_id() { return (unsigned)__builtin_amdgcn_s_getreg((3 << 11) | 20) & 0xFu; }
#define XB_SPIN(cond, bar) do { unsigned _sp = 0; while (cond) { __builtin_amdgcn_s_sleep(1); \
    if ((++_sp & 255u) == 0u) { if (xb_ld(&(bar)[XB_TMO])) break; if (_sp > XB_SPIN_CAP) { atomicAdd(&(bar)[XB_TMO], 1u); break; } } } } while (0)

struct XcdBarrier {
    unsigned* bar; unsigned x;
    volatile LAS unsigned* st;
};

__device__ __forceinline__ XcdBarrier xcd_barrier_post(unsigned* bar, volatile LAS unsigned* st) {
    XcdBarrier b; b.bar = bar; b.x = xb_xcc_id(); b.st = st;
    if (threadIdx.x == 0) (void)xb_add(&bar[XB_XCNT(b.x)], 1u);
    return b;
}
__device__ __forceinline__ void xcd_barrier_complete(unsigned* bar, unsigned x, unsigned& nloc, unsigned& nx) {
    const unsigned G = gridDim.x * gridDim.y * gridDim.z;
    unsigned sum, cnt, mine, sp = 0u;
    for (;;) {
        sum = 0u; cnt = 0u; mine = 0u;
#pragma unroll
        for (unsigned j = 0; j < 16; ++j) { const unsigned c = xb_ld(&bar[XB_XCNT(j)]); sum += c; cnt += (c > 0u) ? 1u : 0u; mine = (j == x) ? c : mine; }
        if (sum == G) break;
        __builtin_amdgcn_s_sleep(1);
        if ((++sp & 255u) == 0u) { if (xb_ld(&bar[XB_TMO])) break; if (sp > XB_SPIN_CAP) { atomicAdd(&bar[XB_TMO], 1u); break; } }
    }
    nloc = mine > 0u ? mine : 1u; nx = cnt > 0u ? cnt : 1u;
}

__device__ __forceinline__ void xcd_barrier(const XcdBarrier& b) {
    asm volatile("s_waitcnt vmcnt(0)" ::: "memory");
    __syncthreads();
    if (threadIdx.x == 0) {
        unsigned* bar = b.bar;
        __builtin_amdgcn_s_waitcnt(0);
        unsigned nloc = b.st[0], nx = b.st[1];
        if (nloc == 0u) { xcd_barrier_complete(bar, b.x, nloc, nx); b.st[0] = nloc; b.st[1] = nx; }
        const unsigned old = xb_add(&bar[XB_XSUB(b.x)], 1u);
        const unsigned gen = old / nloc;
        if (old + 1u == (gen + 1u) * nloc) {
            __builtin_amdgcn_fence(__ATOMIC_RELEASE, "agent");
            asm volatile("s_waitcnt vmcnt(0)" ::: "memory");
            const unsigned og = xb_add(&bar[XB_TOP], 1u);
            const unsigned tg = og / nx;
            if (og + 1u == (tg + 1u) * nx) xb_add(&bar[XB_TOPGEN], 1u);
            else XB_SPIN(xb_ld(&bar[XB_TOPGEN]) == tg, bar);
            __builtin_amdgcn_fence(__ATOMIC_ACQUIRE, "agent");
            xb_add(&bar[XB_XGEN(b.x)], 1u);
            asm volatile("s_waitcnt vmcnt(0)" ::: "memory");
        } else {
            XB_SPIN(xb_ld(&bar[XB_XGEN(b.x)]) == gen, bar);
            __builtin_amdgcn_fence(__ATOMIC_ACQUIRE, "agent");
            asm volatile("s_waitcnt vmcnt(0)" ::: "memory");
        }
    }
    __syncthreads();
}

#ifndef MK_ONE_LAUNCH
#define MK_ONE_LAUNCH 1
#endif
#ifndef PROBE_NULL
#define PROBE_NULL 0
#endif
struct EpiNull { static constexpr bool PERM = true, AFTER_DRAIN = false, ROWPRE = false;
    __device__ __forceinline__ void operator()(const pg8::f32x4 (&acc)[2][2][4][2], const pg8::Unit& u, int wr, int wc, int fr, int fq, const PG8_LAS float*) const {
#pragma unroll
        for (int i = 0; i < 32; ++i) asm volatile("" :: "v"(acc[i >> 4][(i >> 3) & 1][(i >> 1) & 3][i & 1])); } };
struct EpiFix { static constexpr bool PERM = true, AFTER_DRAIN = false, ROWPRE = false; pg8::bf16_t* O; int rb;
    __device__ __forceinline__ void operator()(const pg8::f32x4 (&acc)[2][2][4][2], const pg8::Unit& u, int wr, int wc, int fr, int fq, const PG8_LAS float*) const {
        const int row0 = rb * 256 + wr * 64 + fr, col0 = wc * 32 + 8 * fq;
#pragma unroll
        for (int ai = 0; ai < 2; ++ai)
#pragma unroll
            for (int m = 0; m < 4; ++m) { pg8::bf16_t* rowp = O + (size_t)(row0 + ai * 128 + m * 16) * 256 + col0;
#pragma unroll
                for (int bj = 0; bj < 2; ++bj) { pg8::f32x4 v0 = acc[ai][bj][m][0], v1 = acc[ai][bj][m][1];
#pragma unroll
                    for (int e = 0; e < 4; ++e) { const float a0 = fmaxf(v0[e], 0.f), a1 = fmaxf(v1[e], 0.f); v0[e] = a0 * a0; v1[e] = a1 * a1; }
                    pg8::u32x4 w; w.x = pg8::cvt_pk_bf16(v0[0], v0[1]); w.y = pg8::cvt_pk_bf16(v0[2], v0[3]); w.z = pg8::cvt_pk_bf16(v1[0], v1[1]); w.w = pg8::cvt_pk_bf16(v1[2], v1[3]);
                    *(pg8::u32x4*)(rowp + bj * 128) = w; } } } };
struct EpiLd { static constexpr bool PERM = true, AFTER_DRAIN = false, ROWPRE = false; const float* ssqp;
    __device__ __forceinline__ void operator()(const pg8::f32x4 (&acc)[2][2][4][2], const pg8::Unit& u, int wr, int wc, int fr, int fq, const PG8_LAS float*) const {
        const int row0 = u.pm * 256 + wr * 64 + fr;
#pragma unroll
        for (int ai = 0; ai < 2; ++ai)
#pragma unroll
            for (int m = 0; m < 4; ++m) { const int row = row0 + ai * 128 + m * 16; const pg8::f32x4* p = (const pg8::f32x4*)(ssqp + (size_t)row * 16); const pg8::f32x4 a = p[0], b = p[1], c = p[2], d = p[3];
                const float s = ((a[0] + a[1]) + (a[2] + a[3])) + ((b[0] + b[1]) + (b[2] + b[3])) + ((c[0] + c[1]) + (c[2] + c[3])) + ((d[0] + d[1]) + (d[2] + d[3]));
                const float sc = __builtin_amdgcn_rsqf(s * (1.0f / 1024.0f) + 1e-6f);
#pragma unroll
                for (int bj = 0; bj < 2; ++bj) { const pg8::f32x4 v0 = acc[ai][bj][m][0] * sc, v1 = acc[ai][bj][m][1] * sc; asm volatile("" :: "v"(v0), "v"(v1)); } } } };
constexpr int NPHASE = 14;
#define GEMM_CALL(EPI, MODE, g, S, E) pg8::gemm_phase<EPI, pg8::StaticOrder, true, true, MODE, gLDA, gLDB, gK>(ldsp, g, S, E)
__global__ void __launch_bounds__(NTHREADS, 2) mk_fwd(Args a) {
    extern __shared__ __attribute__((aligned(16))) unsigned char lds_raw[];
    LAS unsigned char* ldsp = (LAS unsigned char*)lds_raw;
    const int G = gridDim.x, bx = blockIdx.x;
    const int vcu = (G % 8 == 0) ? (bx % 8) * (G / 8) + bx / 8 : bx;
    unsigned char* ws = a.ws;
    typedef pg8::bf16_t pb;
#if MK_ONE_LAUNCH
    if (threadIdx.x < 64) ((LAS unsigned*)(ldsp + LDSCTL_OFF))[threadIdx.x] = 0u;
    __syncthreads();
    (void)xcd_barrier_post((unsigned*)(ws + WS_CTL) + 4096, (volatile LAS unsigned*)(ldsp + LDSCTL_OFF) + 8);
#define SEAM(k) do { if (a.ph_hi > 1000000) cg::this_grid().sync();   { XcdBarrier xb_; xb_.bar = (unsigned*)(a.ws + WS_CTL) + 4096; xb_.x = xb_xcc_id(); xb_.st = (volatile LAS unsigned*)(ldsp + LDSCTL_OFF) + 8; xcd_barrier(xb_); } } while (0)
#else
#define SEAM(k) do {} while (0)
#endif
    const int lo = a.ph_lo, hi = a.ph_hi;
#define IN(k) (lo <= (k) && (k) < hi)
#define PH_END(k) do { if (IN((k) + 1)) SEAM(k); } while (0)
#ifndef PROBE_MASK
#define PROBE_MASK 0
#endif
#if (PROBE_MASK >> 0) & 1
#define REP0(...) { __VA_ARGS__ } __syncthreads(); { __VA_ARGS__ }
#else
#define REP0(...) { __VA_ARGS__ }
#endif
#if (PROBE_MASK >> 1) & 1
#define REP1(...) { __VA_ARGS__ } __syncthreads(); { __VA_ARGS__ }
#else
#define REP1(...) { __VA_ARGS__ }
#endif
#if (PROBE_MASK >> 2) & 1
#define REP2(...) { __VA_ARGS__ } __syncthreads(); { __VA_ARGS__ }
#else
#define REP2(...) { __VA_ARGS__ }
#endif
#if (PROBE_MASK >> 3) & 1
#define REP3(...) { __VA_ARGS__ } __syncthreads(); { __VA_ARGS__ }
#else
#define REP3(...) { __VA_ARGS__ }
#endif
#if (PROBE_MASK >> 4) & 1
#define REP4(...) { __VA_ARGS__ } __syncthreads(); { __VA_ARGS__ }
#else
#define REP4(...) { __VA_ARGS__ }
#endif
#if (PROBE_MASK >> 5) & 1
#define REP5(...) { __VA_ARGS__ } __syncthreads(); { __VA_ARGS__ }
#else
#define REP5(...) { __VA_ARGS__ }
#endif
#if (PROBE_MASK >> 6) & 1
#define REP6(...) { __VA_ARGS__ } __syncthreads(); { __VA_ARGS__ }
#else
#define REP6(...) { __VA_ARGS__ }
#endif
#if (PROBE_MASK >> 7) & 1
#define REP7(...) { __VA_ARGS__ } __syncthreads(); { __VA_ARGS__ }
#else
#define REP7(...) { __VA_ARGS__ }
#endif
#if (PROBE_MASK >> 8) & 1
#define REP8(...) { __VA_ARGS__ } __syncthreads(); { __VA_ARGS__ }
#else
#define REP8(...) { __VA_ARGS__ }
#endif
#if (PROBE_MASK >> 9) & 1
#define REP9(...) { __VA_ARGS__ } __syncthreads(); { __VA_ARGS__ }
#else
#define REP9(...) { __VA_ARGS__ }
#endif
#if (PROBE_MASK >> 10) & 1
#define REP10(...) { __VA_ARGS__ } __syncthreads(); { __VA_ARGS__ }
#else
#define REP10(...) { __VA_ARGS__ }
#endif
#if (PROBE_MASK >> 11) & 1
#define REP11(...) { __VA_ARGS__ } __syncthreads(); { __VA_ARGS__ }
#else
#define REP11(...) { __VA_ARGS__ }
#endif
#if (PROBE_MASK >> 12) & 1
#define REP12(...) { __VA_ARGS__ } __syncthreads(); { __VA_ARGS__ }
#else
#define REP12(...) { __VA_ARGS__ }
#endif
    if (IN(0)) { REP0( p0_prologue(a, ldsp, G, vcu); __syncthreads(); ) PH_END(0); }
#if PROBE_NULL & 16
    if (IN(1)) { pg8::Gemm g{(const pb*)(ws + WS_XN), (const pb*)(ws + WS_WIN)}; constexpr int gLDA = DM, gLDB = DM, gK = DM; pg8::StaticOrder S; S.init(MTOK, NPROJ, G, bx); EpiNull E; GEMM_CALL(EpiNull, 0, g, S, E); __syncthreads(); }
#endif
    if (IN(1)) { REP1(
        { pg8::Gemm g{(const pb*)(ws + WS_XN), (const pb*)(ws + WS_WIN)}; constexpr int gLDA = DM, gLDB = DM, gK = DM; pg8::StaticOrder S; S.init(MTOK, NPROJ, G, bx);
          typedef pg8::EpiBf16S<0, 0> E_t; E_t E{(pb*)(ws + WS_PROJ), 512, 512, PROJ_STRIDE, nullptr, 1.0f}; GEMM_CALL(E_t, 0, g, S, E); }
        ) PH_END(1); }
    if (IN(2)) { REP2(
        if (G != 256 || vcu < 64) {
        { pg8::Gemm g{(const pb*)(ws + WS_MEMN), (const pb*)(ws + WS_WK)}; constexpr int gLDA = DM, gLDB = DM, gK = DM; pg8::StaticOrder S; if (G == 256) { S.init(MMEM, DM, 64, vcu); if (vcu >= 32) S.nwg = 0; } else S.init(MMEM, DM, G, bx);
          typedef pg8::EpiBf16S<0, 0> E_t; E_t E{(pb*)(ws + WS_KB), DM, 0, 0, nullptr, 1.0f}; GEMM_CALL(E_t, 0, g, S, E); }
        { pg8::Gemm g{(const pb*)(ws + WS_MEMN), (const pb*)(ws + WS_WV)}; constexpr int gLDA = DM, gLDB = DM, gK = DM; pg8::StaticOrder S; if (G == 256) { S.init(MMEM, DM, 64, vcu >= 32 ? vcu - 32 : 0); if (vcu < 32) S.nwg = 0; } else S.init(MMEM, DM, G, (bx + G / 2) % G);
          typedef pg8::EpiBf16S<0, 0> E_t; E_t E{(pb*)(ws + WS_VT), DM, 0, 0, nullptr, 1.0f}; GEMM_CALL(E_t, 0, g, S, E); }
        }
        gate_factors(a, G, vcu); filters_phase(a, ldsp, G, vcu); conv_tiles(a, ldsp, G, vcu, 64); ) PH_END(2); }
    if (IN(3)) { REP3(
        { pg8::Gemm g{(const pb*)(ws + WS_KB), (const pb*)(ws + WS_WQ)}; constexpr int gLDA = DM, gLDB = DM, gK = 256; pg8::StaticOrder S; S.init(8 * DM, DM, G / 2, vcu < G / 2 ? vcu : 0); if (vcu >= G / 2) S.nwg = 0;
          typedef pg8::EpiBf16S<0, 0> E_t; E_t E{(pb*)(ws + WS_MT), DM, 0, 0, nullptr, 1.0f}; GEMM_CALL(E_t, 4, g, S, E); }
        { pg8::Gemm g{(const pb*)(ws + WS_WO), (const pb*)(ws + WS_VT)}; constexpr int gLDA = DM, gLDB = DM, gK = 256; pg8::StaticOrder S; S.init(8 * DM, DM, G / 2, vcu >= G / 2 ? vcu - G / 2 : 0); if (vcu < G / 2) S.nwg = 0;
          typedef pg8::EpiBf16S<0, 0> E_t; E_t E{(pb*)(ws + WS_VWT), DM, 0, 0, nullptr, 1.0f}; GEMM_CALL(E_t, 5, g, S, E); }
        hyena_fft(a, ldsp, G, vcu); if (G != 256) mlstm_scan(a, ldsp, G, vcu); ) PH_END(3); }
    if (IN(4)) { REP4( mlstm_out(a, ldsp, G, vcu); hy_mix(a, G, vcu); ) PH_END(4); }
    if (IN(5)) { REP5( pg8::Gemm g{(const pb*)(ws + WS_MIXED), (const pb*)(ws + WS_WOUT)}; constexpr int gLDA = DM, gLDB = DM, gK = DM; pg8::StaticOrder S; S.init(MTOK, DM, G, bx);
          typedef pg8::EpiResid<true> E_t; E_t E{a.in[0], (pb*)(ws + WS_XN), (float*)(ws + WS_SSQ), DM}; GEMM_CALL(E_t, 0, g, S, E); ) PH_END(5); }
    if (IN(6)) { REP6( pg8::Gemm g{(const pb*)(ws + WS_XN), (const pb*)(ws + WS_MT)}; constexpr int gLDA = DM, gLDB = DM, gK = DM; pg8::StaticOrder S; S.init(MTOK, DM, G, bx);
          pg8::EpiSoftmax E{(pb*)(ws + WS_SP), DM, (LAS float*)(ldsp + LDSCTL_OFF + 1024), 0.0625f * 1.4426950408889634f, (const float*)(ws + WS_SSQ)}; GEMM_CALL(pg8::EpiSoftmax, 3, g, S, E); ) PH_END(9); }
    if (IN(10)) { pg8::Gemm g{(const pb*)(ws + WS_SP), (const pb*)(ws + WS_VWT)}; constexpr int gLDA = DM, gLDB = DM, gK = DM; pg8::StaticOrder S; S.init(MTOK, DM, G, bx);
          typedef pg8::EpiResid<false> E_t; E_t E{ws + WS_XN, (pb*)(ws + WS_XN), (float*)(ws + WS_SSQ), DM}; GEMM_CALL(E_t, 3, g, S, E); PH_END(10); }
#if PROBE_NULL & 1
    if (IN(11)) { pg8::Gemm g{(const pb*)(ws + WS_XN), (const pb*)(ws + WS_W1)}; constexpr int gLDA = DM, gLDB = DM, gK = DM; pg8::StaticOrder S; S.init(MTOK, DFF, G, bx); EpiNull E; GEMM_CALL(EpiNull, 0, g, S, E); __syncthreads(); }
#endif
#if PROBE_NULL & 4
    if (IN(11)) { pg8::Gemm g{(const pb*)(ws + WS_XN), (const pb*)(ws + WS_W1)}; constexpr int gLDA = DM, gLDB = DM, gK = DM; pg8::StaticOrder S; S.init(MTOK, DFF, G, bx); EpiFix E{(pb*)(ws + WS_YT), (bx >> 1) & 127}; GEMM_CALL(EpiFix, 0, g, S, E); __syncthreads(); }
#endif
#if PROBE_NULL & 8
    if (IN(11)) { pg8::Gemm g{(const pb*)(ws + WS_XN), (const pb*)(ws + WS_W1)}; constexpr int gLDA = DM, gLDB = DM, gK = DM; pg8::StaticOrder S; S.init(MTOK, DFF, G, bx); EpiLd E{(const float*)(ws + WS_SSQ)}; GEMM_CALL(EpiLd, 0, g, S, E); __syncthreads(); }
#endif
#if PROBE_NULL & 2
    if (IN(12)) { pg8::Gemm g{(const pb*)(ws + WS_HID), (const pb*)(ws + WS_W2)}; constexpr int gLDA = DFF, gLDB = DFF, gK = DFF; pg8::StaticOrder S; S.init(MTOK, DM, G, bx); EpiNull E; GEMM_CALL(EpiNull, 0, g, S, E); __syncthreads(); }
#endif
    if (IN(11)) { REP11( pg8::Gemm g{(const pb*)(ws + WS_XN), (const pb*)(ws + WS_W1)}; constexpr int gLDA = DM, gLDB = DM, gK = DM; pg8::StaticOrder S; S.init(MTOK, DFF, G, bx);
          typedef pg8::EpiBf16S<1, 1> E_t; E_t E{(pb*)(ws + WS_HID), DFF, 0, 0, (const float*)(ws + WS_SSQ), 1.0f}; GEMM_CALL(E_t, 0, g, S, E); ) PH_END(11); }
    if (IN(12)) { REP12( pg8::Gemm g{(const pb*)(ws + WS_HID), (const pb*)(ws + WS_W2)}; constexpr int gLDA = DFF, gLDB = DFF, gK = DFF; pg8::StaticOrder S; S.init(MTOK, DM, G, bx);
          typedef pg8::EpiResid<false> E_t; E_t E{ws + WS_XN, (pb*)(ws + WS_XN), (float*)(ws + WS_SSQ), DM}; GEMM_CALL(E_t, 0, g, S, E); ) PH_END(12); }
    if (IN(13)) { final_norm(a, G, vcu); }
}

extern "C" void kernel_launch(void* const* d_in, const int* in_sizes, int n_in, void* d_out, int out_size, void* d_ws, size_t ws_size, hipStream_t stream) {
    static int grid = 0;
    if (grid == 0) {
        if (n_in != 30 || in_sizes[0] != MTOK * DM || out_size != MTOK * DM || ws_size < WS_END) {
            fprintf(stderr, "kernel_launch: unexpected shapes (n_in %d, in0 %d, out %d, ws %zu); nothing launched\n", n_in, n_in > 0 ? in_sizes[0] : -1, out_size, ws_size); grid = -1; return; }
        int dev = 0, cus = 0, per_cu = 0;
        if (hipGetDevice(&dev) != hipSuccess || hipDeviceGetAttribute(&cus, hipDeviceAttributeMultiprocessorCount, dev) != hipSuccess) { grid = -1; return; }
        if (hipFuncSetAttribute((const void*)mk_fwd, hipFuncAttributeMaxDynamicSharedMemorySize, LDS_BYTES) != hipSuccess) { fprintf(stderr, "kernel_launch: hipFuncSetAttribute failed\n"); grid = -1; return; }
        if (hipOccupancyMaxActiveBlocksPerMultiprocessor(&per_cu, (const void*)mk_fwd, NTHREADS, LDS_BYTES) != hipSuccess || per_cu < 1) { fprintf(stderr, "kernel_launch: occupancy query says %d\n", per_cu); (void)hipGetLastError(); grid = -1; return; }
        grid = cus;
    }
    if (grid < 0) return;
    if (hipMemsetAsync((char*)d_ws + WS_CTL, 0, 65536, stream) != hipSuccess) { fprintf(stderr, "kernel_launch: hipMemsetAsync failed\n"); return; }
    Args a{};
    for (int i = 0; i < 30; ++i) a.in[i] = (const float*)d_in[i];
    a.out = (float*)d_out; a.ws = (unsigned char*)d_ws;
#if MK_ONE_LAUNCH
    a.ph_lo = 0; a.ph_hi = NPHASE;
    void* args[] = {&a};
    hipError_t e = hipLaunchCooperativeKernel((const void*)mk_fwd, dim3(grid), dim3(NTHREADS), args, LDS_BYTES, stream);
    if (e != hipSuccess) fprintf(stderr, "cooperative launch failed: %s (grid %d)\n", hipGetErrorString(e), grid);
#else
    for (int ph = 0; ph < NPHASE; ++ph) { a.ph_lo = ph; a.ph_hi = ph + 1; hipLaunchKernelGGL(mk_fwd, dim3(grid), dim3(NTHREADS), LDS_BYTES, stream, a); }
#endif
}
```

```cpp
#include <hip/hip_runtime.h>
#include <hip/hip_cooperative_groups.h>
#include <cstdio>
#include <cstdint>
namespace cg = cooperative_groups;
namespace pg8 {
#define PG8_LAS __attribute__((address_space(3)))
typedef unsigned short bf16_t;
typedef short bf16x8 __attribute__((ext_vector_type(8)));
typedef float f32x4 __attribute__((ext_vector_type(4)));
typedef unsigned u32x4 __attribute__((ext_vector_type(4)));
constexpr int BM = 256, BK = 64, HALF = 128, HTB = HALF * BK * 2  , STAGE_BYTES = 8 * HTB, NXCD = 8, WGM = 8;

__host__ __device__ __forceinline__ int lds_byte(int r, int c) { const int st = (r >> 4) * 2 + (c >> 5), rr = r & 15, cc = c & 31, ob = rr * 64 + cc * 2; return st * 1024 + (ob ^ (((ob >> 9) & 1) << 5)); }
__host__ __device__ __forceinline__ void stage_rc(int b, int& R, int& C) { const int st = b / 1024, sb = b % 1024, swz = sb ^ (((sb >> 9) & 1) << 5); R = (st >> 1) * 16 + swz / 64; C = (st & 1) * 32 + (swz % 64) / 2; }
__host__ __device__ __forceinline__ int perm32(int rho) { const int n = rho >> 4, i = rho & 15; return 8 * (i >> 2) + 4 * n + (i & 3); }

struct Unit { int pm, pn; };
struct Gemm { const bf16_t* A; const bf16_t* Bt; };
template <int MODE, int LDA> __device__ __forceinline__ size_t a_off(const Unit& u) {
    if (MODE == 0 || MODE == 3) return (size_t)u.pm * BM * LDA * 2;
    if (MODE == 4) return ((size_t)(u.pm >> 2) * BM * LDA + (size_t)(u.pm & 3) * BM) * 2;
    return ((size_t)(u.pm & 3) * BM * LDA + (size_t)u.pn * BM) * 2; }
template <int MODE, int LDB> __device__ __forceinline__ size_t b_off(const Unit& u) {
    if (MODE == 0) return (size_t)u.pn * BM * LDB * 2;
    if (MODE == 3) return ((size_t)(u.pm >> 4) * 1024 + (size_t)u.pn * BM) * LDB * 2;
    if (MODE == 4) return ((size_t)u.pn * BM * LDB + (size_t)(u.pm & 3) * BM) * 2;
    return ((size_t)(u.pm >> 2) * BM * LDB + (size_t)u.pn * BM) * 2; }

struct StaticOrder {
    int nM, nN, nwg, G, c;
    __host__ __device__ void init(int M, int N, int G_, int c_) { nM = M / BM; nN = N / BM; nwg = nM * nN; G = G_; c = c_; }
    __host__ __device__ bool next(int i, Unit& u) const {
        const long L = (long)i * G + c; if (L >= nwg) return false;
        int wgid = (int)L; { const int q = nwg / NXCD, r = nwg % NXCD, xcd = wgid % NXCD, off = wgid / NXCD; wgid = (xcd < r ? xcd * (q + 1) : r * (q + 1) + (xcd - r) * q) + off; }
        const int nig = WGM * nN, gid = wgid / nig, fm = gid * WGM, gsz = (nM - fm) < WGM ? (nM - fm) : WGM;
        u.pm = fm + ((wgid % nig) % gsz); u.pn = (wgid % nig) / gsz; return true;
    }
    __device__ __forceinline__ void a_ready(const Unit&) const {}
    __device__ __forceinline__ void done(const Unit&) const {}
};

__device__ __forceinline__ unsigned cvt_pk_bf16(float lo, float hi) { unsigned r; asm volatile("v_cvt_pk_bf16_f32 %0, %1, %2" : "=v"(r) : "v"(lo), "v"(hi)); return r; }
typedef unsigned u32x2 __attribute__((ext_vector_type(2)));
template <int ROWSCALE, int ACT> struct EpiBf16S {
    static constexpr bool PERM = true, AFTER_DRAIN = false, ROWPRE = (ROWSCALE != 0);
    bf16_t* O; int ldc; int split_cols; size_t split_stride; const float* ssqp; float mul;
    __device__ __forceinline__ void operator()(const f32x4 (&acc)[2][2][4][2], const Unit& u, int wr, int wc, int fr, int fq, const PG8_LAS float* rsl) const {
        const int row0 = u.pm * BM + wr * 64 + fr; int colt = u.pn * BM; bf16_t* base = O;
        if (split_cols) { const int t = colt / split_cols; base += (size_t)t * split_stride; colt -= t * split_cols; }
        const int col0 = colt + wc * 32 + 8 * fq;
#pragma unroll
        for (int ai = 0; ai < 2; ++ai)
#pragma unroll
            for (int m = 0; m < 4; ++m) { const int row = row0 + ai * HALF + m * 16; const float sc = ROWSCALE ? mul * rsl[ai * HALF + wr * 64 + m * 16 + fr] : mul;
                bf16_t* rowp = base + (size_t)row * ldc + col0;
#pragma unroll
                for (int bj = 0; bj < 2; ++bj) { f32x4 v0 = acc[ai][bj][m][0] * sc, v1 = acc[ai][bj][m][1] * sc;
                    if (ACT == 1) {
#pragma unroll
                        for (int e = 0; e < 4; ++e) { const float a0 = fmaxf(v0[e], 0.f), a1 = fmaxf(v1[e], 0.f); v0[e] = a0 * a0; v1[e] = a1 * a1; } }
                    u32x4 w; w.x = cvt_pk_bf16(v0[0], v0[1]); w.y = cvt_pk_bf16(v0[2], v0[3]); w.z = cvt_pk_bf16(v1[0], v1[1]); w.w = cvt_pk_bf16(v1[2], v1[3]);
                    *(u32x4*)(rowp + bj * HALF) = w; } }
    }
};
struct EpiSoftmax {
    static constexpr bool PERM = true, AFTER_DRAIN = false, ROWPRE = true;
    bf16_t* O; int ldc; PG8_LAS float* xl; float c2s; const float* ssqp;
    __device__ __forceinline__ void operator()(const f32x4 (&acc)[2][2][4][2], const Unit& u, int wr, int wc, int fr, int fq, const PG8_LAS float* rsl) const {
        const int row0 = u.pm * BM + wr * 64 + fr, col0 = u.pn * BM + wc * 32 + 8 * fq;
        PG8_LAS float* pm = xl; PG8_LAS float* ps = xl + 1024;
        float mx[2][4], cr[2][4];
#pragma unroll
        for (int ai = 0; ai < 2; ++ai)
#pragma unroll
            for (int m = 0; m < 4; ++m) { float v = -3.0e38f;
#pragma unroll
                for (int bj = 0; bj < 2; ++bj)
#pragma unroll
                    for (int n = 0; n < 2; ++n) { const f32x4 x = acc[ai][bj][m][n]; v = fmaxf(v, fmaxf(fmaxf(x[0], x[1]), fmaxf(x[2], x[3]))); }
                v = fmaxf(v, __shfl_xor(v, 16)); v = fmaxf(v, __shfl_xor(v, 32));
                if (fq == 0) pm[(ai * HALF + wr * 64 + m * 16 + fr) * 4 + wc] = v; }
        asm volatile("s_waitcnt lgkmcnt(0)" ::: "memory"); __builtin_amdgcn_s_barrier(); asm volatile("" ::: "memory");
        float sm[2][4];
#pragma unroll
        for (int ai = 0; ai < 2; ++ai)
#pragma unroll
            for (int m = 0; m < 4; ++m) { const int rl = ai * HALF + wr * 64 + m * 16 + fr; const f32x4 p4 = *(const PG8_LAS f32x4*)(pm + rl * 4);
                const float mxr = fmaxf(fmaxf(p4[0], p4[1]), fmaxf(p4[2], p4[3]));
                const float c2 = c2s * rsl[rl]; cr[ai][m] = c2;
                mx[ai][m] = mxr * c2; float s = 0.f;
#pragma unroll
                for (int bj = 0; bj < 2; ++bj)
#pragma unroll
                    for (int n = 0; n < 2; ++n) { const f32x4 x = acc[ai][bj][m][n];
                        s += (__builtin_amdgcn_exp2f(x[0] * c2 - mx[ai][m]) + __builtin_amdgcn_exp2f(x[1] * c2 - mx[ai][m])) + (__builtin_amdgcn_exp2f(x[2] * c2 - mx[ai][m]) + __builtin_amdgcn_exp2f(x[3] * c2 - mx[ai][m])); }
                s += __shfl_xor(s, 16); s += __shfl_xor(s, 32);
                if (fq == 0) ps[rl * 4 + wc] = s; sm[ai][m] = 0.f; }
        asm volatile("s_waitcnt lgkmcnt(0)" ::: "memory"); __builtin_amdgcn_s_barrier(); asm volatile("" ::: "memory");
#pragma unroll
        for (int ai = 0; ai < 2; ++ai)
#pragma unroll
            for (int m = 0; m < 4; ++m) { const int rl = ai * HALF + wr * 64 + m * 16 + fr; const f32x4 s4 = *(const PG8_LAS f32x4*)(ps + rl * 4);
                const float inv = 1.0f / ((s4[0] + s4[1]) + (s4[2] + s4[3])); const float mr = mx[ai][m], c2 = cr[ai][m];
                bf16_t* rowp = O + (size_t)(row0 + ai * HALF + m * 16) * ldc + col0;
#pragma unroll
                for (int bj = 0; bj < 2; ++bj) { const f32x4 x0 = acc[ai][bj][m][0], x1 = acc[ai][bj][m][1]; u32x4 w;
                    w.x = cvt_pk_bf16(__builtin_amdgcn_exp2f(x0[0] * c2 - mr) * inv, __builtin_amdgcn_exp2f(x0[1] * c2 - mr) * inv); w.y = cvt_pk_bf16(__builtin_amdgcn_exp2f(x0[2] * c2 - mr) * inv, __builtin_amdgcn_exp2f(x0[3] * c2 - mr) * inv);
                    w.z = cvt_pk_bf16(__builtin_amdgcn_exp2f(x1[0] * c2 - mr) * inv, __builtin_amdgcn_exp2f(x1[1] * c2 - mr) * inv); w.w = cvt_pk_bf16(__builtin_amdgcn_exp2f(x1[2] * c2 - mr) * inv, __builtin_amdgcn_exp2f(x1[3] * c2 - mr) * inv);
                    *(u32x4*)(rowp + bj * HALF) = w; } }
        asm volatile("s_waitcnt lgkmcnt(0)" ::: "memory"); __builtin_amdgcn_s_barrier(); asm volatile("" ::: "memory");
    }
};

template <bool BASE_F32> struct EpiResid {
    static constexpr bool PERM = true, AFTER_DRAIN = false, ROWPRE = false;
    const void* base; bf16_t* xn; float* ssqp; int ldc;
    __device__ __forceinline__ void operator()(const f32x4 (&acc)[2][2][4][2], const Unit& u, int wr, int wc, int fr, int fq, const PG8_LAS float*) const {
        const int row0 = u.pm * BM + wr * 64 + fr, col0 = u.pn * BM + wc * 32 + 8 * fq;
#pragma unroll
        for (int ai = 0; ai < 2; ++ai) {
            f32x4 bf_[4][2][2]; u32x4 bh_[4][2];
#pragma unroll
            for (int m = 0; m < 4; ++m) { const size_t off = (size_t)(row0 + ai * HALF + m * 16) * ldc + col0;
#pragma unroll
                for (int bj = 0; bj < 2; ++bj) { const size_t o2 = off + bj * HALF;
                    if (BASE_F32) { bf_[m][bj][0] = *(const f32x4*)((const float*)base + o2); bf_[m][bj][1] = *(const f32x4*)((const float*)base + o2 + 4); } else bh_[m][bj] = *(const u32x4*)((const bf16_t*)base + o2); } }
#pragma unroll
            for (int m = 0; m < 4; ++m) { const int row = row0 + ai * HALF + m * 16; const size_t off = (size_t)row * ldc + col0; float ss = 0.f;
#pragma unroll
                for (int bj = 0; bj < 2; ++bj) { const size_t o2 = off + bj * HALF; f32x4 b0, b1;
                    if (BASE_F32) { b0 = bf_[m][bj][0]; b1 = bf_[m][bj][1]; }
                    else { const u32x4 w = bh_[m][bj]; b0 = (f32x4){__uint_as_float(w.x << 16), __uint_as_float(w.x & 0xffff0000u), __uint_as_float(w.y << 16), __uint_as_float(w.y & 0xffff0000u)};
                           b1 = (f32x4){__uint_as_float(w.z << 16), __uint_as_float(w.z & 0xffff0000u), __uint_as_float(w.w << 16), __uint_as_float(w.w & 0xffff0000u)}; }
                    const f32x4 v0 = b0 + acc[ai][bj][m][0], v1 = b1 + acc[ai][bj][m][1];
                    ss += ((v0[0] * v0[0] + v0[1] * v0[1]) + (v0[2] * v0[2] + v0[3] * v0[3])) + ((v1[0] * v1[0] + v1[1] * v1[1]) + (v1[2] * v1[2] + v1[3] * v1[3]));
                    u32x4 w2; w2.x = cvt_pk_bf16(v0[0], v0[1]); w2.y = cvt_pk_bf16(v0[2], v0[3]); w2.z = cvt_pk_bf16(v1[0], v1[1]); w2.w = cvt_pk_bf16(v1[2], v1[3]); *(u32x4*)(xn + o2) = w2; }
                ss += __shfl_xor(ss, 16); ss += __shfl_xor(ss, 32);
                if (fq == 0) ssqp[(size_t)row * 16 + u.pn * 4 + wc] = ss; }
        }
    }
};

template <class Epi, class Sched, bool ALIGN_EPI, bool SP2, int MODE, int LDA, int LDB, int KK>
__device__ __forceinline__ void gemm_phase(PG8_LAS unsigned char* lds, const Gemm g, const Sched& S, const Epi& E) {
    const int tid = threadIdx.x, wid = __builtin_amdgcn_readfirstlane(tid >> 6), lane = tid & 63, wr = wid >> 2, wc = wid & 3, fr = lane & 15, fq = lane >> 4;
    constexpr int K = KK, nt = K / BK;
    unsigned voffA[2], voffB[2];
#pragma unroll
    for (int i = 0; i < 2; ++i) { int R, C; stage_rc(tid * 16 + i * 8192, R, C); const int Rb = Epi::PERM ? ((R & ~31) + perm32(R & 31)) : R;
        voffA[i] = (unsigned)(R * LDA + C) * 2u; voffB[i] = (unsigned)(Rb * LDB + C) * 2u; }
    PG8_LAS float* rsl = (PG8_LAS float*)(lds + STAGE_BYTES);
    const size_t kstep = (size_t)(BK * 2);
    const size_t hstepA = (size_t)HALF * LDA * 2, hstepB = (size_t)HALF * LDB * 2;
    const unsigned ldsw = (unsigned)wid * 1024u;
    const int aoff = lds_byte(wr * 64 + fr, fq * 8), boff = lds_byte(wc * 32 + fr, fq * 8);
#define PG8_SA(b, h) (((b) * 2 + (h)) * HTB)
#define PG8_SB(b, h) ((4 + (b) * 2 + (h)) * HTB)
#define PG8_STAGE(bufoff, gbase, voff) do { _Pragma("unroll") for (int _i = 0; _i < 2; ++_i) \
        __builtin_amdgcn_global_load_lds((const unsigned*)((const char*)(gbase) + (voff)[_i]), (PG8_LAS unsigned*)(lds + (bufoff) + ldsw + _i * 8192), 16, 0, 0); } while (0)
#define PG8_LDA(dst, b, h) do { _Pragma("unroll") for (int m = 0; m < 4; ++m) _Pragma("unroll") for (int k = 0; k < 2; ++k) dst[m][k] = *(const PG8_LAS bf16x8*)(lds + PG8_SA(b, h) + aoff + m * 2048 + k * 1024); } while (0)
#define PG8_LDB(dst, b, h) do { _Pragma("unroll") for (int n = 0; n < 2; ++n) _Pragma("unroll") for (int k = 0; k < 2; ++k) dst[n][k] = *(const PG8_LAS bf16x8*)(lds + PG8_SB(b, h) + boff + n * 2048 + k * 1024); } while (0)
#define PG8_MMA(ai, bj, At, Bt) do { __builtin_amdgcn_s_setprio(1); _Pragma("unroll") for (int m = 0; m < 4; ++m) _Pragma("unroll") for (int n = 0; n < 2; ++n) _Pragma("unroll") for (int k = 0; k < 2; ++k) \
        acc[ai][bj][m][n] = __builtin_amdgcn_mfma_f32_16x16x32_bf16(Bt[n][k], At[m][k], acc[ai][bj][m][n], 0, 0, 0); __builtin_amdgcn_s_setprio(0); } while (0)
#define PG8_WAIT_V(n) asm volatile("s_waitcnt vmcnt(" #n ")" ::: "memory")
#define PG8_WAIT_L(n) asm volatile("s_waitcnt lgkmcnt(" #n ")" ::: "memory")
#define PG8_BAR __builtin_amdgcn_s_barrier()
#define PG8_SCHED __builtin_amdgcn_sched_barrier(0)
    Unit cur, nxt; int ui = 0; float rps = 0.f; typedef float f32x2 __attribute__((ext_vector_type(2)));
    if (!S.next(0, cur)) return;
    f32x4 acc[2][2][4][2];
#pragma unroll
    for (int a = 0; a < 2; ++a)
#pragma unroll
        for (int b = 0; b < 2; ++b)
#pragma unroll
            for (int m = 0; m < 4; ++m)
#pragma unroll
                for (int n = 0; n < 2; ++n) acc[a][b][m][n] = (f32x4){0.f, 0.f, 0.f, 0.f};
    bf16x8 At[4][2], B0[2][2], B1[2][2];
    const char* cA = (const char*)g.A + a_off<MODE, LDA>(cur); const char* cB = (const char*)g.Bt + b_off<MODE, LDB>(cur);
    S.a_ready(cur);
    if constexpr (SP2) {
        PG8_STAGE(PG8_SB(0, 0), cB, voffB); PG8_STAGE(PG8_SB(0, 1), cB + hstepB, voffB); PG8_STAGE(PG8_SA(0, 0), cA, voffA); PG8_STAGE(PG8_SA(0, 1), cA + hstepA, voffA);
        if (wr == 1) PG8_BAR;
        PG8_WAIT_V(2); PG8_BAR;
        PG8_STAGE(PG8_SB(1, 0), cB + kstep, voffB); PG8_STAGE(PG8_SA(1, 0), cA + kstep, voffA); PG8_STAGE(PG8_SB(1, 1), cB + hstepB + kstep, voffB);
        PG8_WAIT_V(6); PG8_BAR;
    } else {
        PG8_STAGE(PG8_SB(0, 0), cB, voffB); PG8_STAGE(PG8_SA(0, 0), cA, voffA); PG8_STAGE(PG8_SB(0, 1), cB + hstepB, voffB); PG8_STAGE(PG8_SA(0, 1), cA + hstepA, voffA);
        if (wr == 1) PG8_BAR;
        PG8_WAIT_V(4); PG8_BAR;
        PG8_STAGE(PG8_SB(1, 0), cB + kstep, voffB); PG8_STAGE(PG8_SA(1, 0), cA + kstep, voffA); PG8_STAGE(PG8_SB(1, 1), cB + hstepB + kstep, voffB);
        PG8_WAIT_V(6); PG8_BAR;
    }
    for (;;) {
        const bool has_next = S.next(ui + 1, nxt);
        const char* nA = has_next ? (const char*)g.A + a_off<MODE, LDA>(nxt) : cA; const char* nB = has_next ? (const char*)g.Bt + b_off<MODE, LDB>(nxt) : cB;
#pragma nounroll
        for (int t = 0; t < nt; t += 2) {
            const bool last = (t == nt - 2);
            f32x2 rp = {0.f, 0.f};
            if constexpr (Epi::ROWPRE) { if (t < 8) rp = *(const f32x2*)(E.ssqp + (size_t)(cur.pm * BM + (tid >> 1)) * 16 + (tid & 1) * 8 + t); }
            const char* a1 = cA + (size_t)(t + 1) * kstep;
            const char* a2 = last ? nA : cA + (size_t)(t + 2) * kstep; const char* b2 = last ? nB : cB + (size_t)(t + 2) * kstep;
            const char* a3 = a2 + kstep; const char* b3 = b2 + kstep;
            if (last && has_next) S.a_ready(nxt);
            if constexpr (SP2) {
            PG8_LDB(B0, 0, 0); PG8_LDB(B1, 0, 1); PG8_SCHED; PG8_LDA(At, 0, 0); PG8_STAGE(PG8_SA(1, 1), a1 + hstepA, voffA);
            PG8_WAIT_V(8); PG8_WAIT_L(0); PG8_BAR; PG8_MMA(0, 0, At, B0); PG8_MMA(0, 1, At, B1); PG8_BAR; PG8_SCHED;
            PG8_LDA(At, 0, 1); PG8_STAGE(PG8_SB(0, 0), b2, voffB); PG8_STAGE(PG8_SB(0, 1), b2 + hstepB, voffB); PG8_STAGE(PG8_SA(0, 0), a2, voffA);
            PG8_WAIT_V(8); PG8_WAIT_L(0); PG8_BAR; PG8_MMA(1, 0, At, B0); PG8_MMA(1, 1, At, B1); PG8_BAR; PG8_SCHED;
            PG8_LDB(B0, 1, 0); PG8_LDB(B1, 1, 1); PG8_SCHED; PG8_LDA(At, 1, 0); PG8_STAGE(PG8_SA(0, 1), a2 + hstepA, voffA);
            PG8_WAIT_V(8); PG8_WAIT_L(0); PG8_BAR; PG8_MMA(0, 0, At, B0); PG8_MMA(0, 1, At, B1); PG8_BAR; PG8_SCHED;
            PG8_LDA(At, 1, 1); PG8_STAGE(PG8_SB(1, 0), b3, voffB); PG8_STAGE(PG8_SB(1, 1), b3 + hstepB, voffB); PG8_STAGE(PG8_SA(1, 0), a3, voffA);
            PG8_WAIT_V(8); PG8_WAIT_L(0); PG8_BAR; PG8_MMA(1, 0, At, B0); PG8_MMA(1, 1, At, B1); PG8_BAR; PG8_SCHED;
            } else {
            PG8_LDB(B0, 0, 0); PG8_SCHED; PG8_LDA(At, 0, 0); PG8_STAGE(PG8_SA(1, 1), a1 + hstepA, voffA);
            PG8_WAIT_L(8); PG8_BAR; PG8_WAIT_L(0); PG8_MMA(0, 0, At, B0); PG8_BAR; PG8_SCHED;
            PG8_LDB(B1, 0, 1); PG8_STAGE(PG8_SB(0, 0), b2, voffB);
            PG8_BAR; PG8_WAIT_L(0); PG8_MMA(0, 1, At, B1); PG8_BAR;
            PG8_LDA(At, 0, 1); PG8_STAGE(PG8_SA(0, 0), a2, voffA);
            PG8_BAR; PG8_WAIT_L(0); PG8_MMA(1, 0, At, B0); PG8_BAR; PG8_SCHED;
            PG8_STAGE(PG8_SB(0, 1), b2 + hstepB, voffB);
            PG8_WAIT_V(6); PG8_BAR; PG8_MMA(1, 1, At, B1); PG8_BAR;
            PG8_LDB(B0, 1, 0); PG8_SCHED; PG8_LDA(At, 1, 0); PG8_STAGE(PG8_SA(0, 1), a2 + hstepA, voffA);
            PG8_WAIT_L(8); PG8_BAR; PG8_WAIT_L(0); PG8_MMA(0, 0, At, B0); PG8_BAR; PG8_SCHED;
            PG8_LDB(B1, 1, 1); PG8_STAGE(PG8_SB(1, 0), b3, voffB);
            PG8_BAR; PG8_WAIT_L(0); PG8_MMA(0, 1, At, B1); PG8_BAR;
            PG8_LDA(At, 1, 1); PG8_STAGE(PG8_SA(1, 0), a3, voffA);
            PG8_BAR; PG8_WAIT_L(0); PG8_MMA(1, 0, At, B0); PG8_BAR; PG8_SCHED;
            PG8_STAGE(PG8_SB(1, 1), b3 + hstepB, voffB);
            PG8_WAIT_V(6); PG8_BAR; PG8_MMA(1, 1, At, B1); PG8_BAR;
            }
            if constexpr (Epi::ROWPRE) { if (t < 8) { rps += rp.x + rp.y;
                if (t == 6) { float s = rps + __shfl_xor(rps, 1); if (!(tid & 1)) rsl[tid >> 1] = __builtin_amdgcn_rsqf(s * (1.0f / 1024.0f) + 1e-6f); rps = 0.f; } } }
        }
        if constexpr (ALIGN_EPI) { if (wr == 0) PG8_BAR; }
        if constexpr (!Epi::AFTER_DRAIN) { int fr_e = fr, fq_e = fq; asm volatile("" : "+v"(fr_e), "+v"(fq_e));
            E(acc, cur, wr, wc, fr_e, fq_e, rsl); S.done(cur); }
        if (!has_next) break;
#pragma unroll
        for (int a = 0; a < 2; ++a)
#pragma unroll
            for (int b = 0; b < 2; ++b)
#pragma unroll
                for (int m = 0; m < 4; ++m)
#pragma unroll
                    for (int n = 0; n < 2; ++n) acc[a][b][m][n] = (f32x4){0.f, 0.f, 0.f, 0.f};
        cur = nxt; cA = nA; cB = nB; ++ui;
        if constexpr (ALIGN_EPI) { if (wr == 1) PG8_BAR; }
    }
    PG8_WAIT_V(0);
    if constexpr (!ALIGN_EPI) { if (wr == 0) PG8_BAR; }
    PG8_BAR;
    if constexpr (Epi::AFTER_DRAIN) { E.fused(acc, cur, wr, wc, fr, fq, lds, wid, lane); S.done(cur); }
#undef PG8_SA
#undef PG8_SB
#undef PG8_STAGE
#undef PG8_LDA
#undef PG8_LDB
#undef PG8_MMA
#undef PG8_WAIT_V
#undef PG8_WAIT_L
#undef PG8_BAR
#undef PG8_SCHED
}
}

#define GAS __attribute__((address_space(1)))
#define LAS __attribute__((address_space(3)))
typedef unsigned short bf16;
typedef unsigned v4u __attribute__((ext_vector_type(4)));
typedef unsigned v2u __attribute__((ext_vector_type(2)));
typedef float f32x4 __attribute__((ext_vector_type(4)));
typedef float f32x2 __attribute__((ext_vector_type(2)));
constexpr int NWAVES = 8, NTHREADS = 512;
constexpr int NB = 8, SEQ = 4096, DM = 1024, MTOK = NB * SEQ, NMEMT = 256, MMEM = NB * NMEMT;
constexpr int DINP = 3600, NPROJ = 3584, DFF = 4096, DHY = 512, DML = 512, NHEAD = 4, DHEAD = 128;
constexpr float EPS = 1e-6f;
constexpr size_t MiB = 1u << 20;
constexpr size_t WS_CTL = 0, CTL_ZERO_BYTES = 1 * MiB;
constexpr size_t WS_WIN = 2 * MiB, WS_WOUT = 9 * MiB, WS_WQ = 11 * MiB, WS_WK = 13 * MiB, WS_WV = 15 * MiB, WS_WO = 17 * MiB, WS_W1 = 19 * MiB, WS_W2 = 27 * MiB;
constexpr size_t WS_MEMN = 35 * MiB, WS_KB = 39 * MiB, WS_VT = 43 * MiB, WS_GATES = 47 * MiB, WS_SSQ = 49 * MiB, WS_HID2 = 51 * MiB;
constexpr size_t WS_GF = 53 * MiB, WS_DEC = 55 * MiB;
constexpr size_t WS_XN = 64 * MiB;
constexpr size_t WS_QF = 64 * MiB, WS_KA = 96 * MiB;
constexpr size_t WS_PROJ = 128 * MiB, PROJ_STRIDE = (size_t)MTOK * 512;
constexpr size_t OUT_FILT = 96 * MiB;
constexpr size_t WS_HSPEC = 384 * MiB;
constexpr size_t WS_YT = 448 * MiB;
constexpr size_t WS_MIXED = 352 * MiB;
constexpr size_t WS_KF = 352 * MiB, WS_VF = 416 * MiB;
constexpr size_t WS_STATES = 128 * MiB;
constexpr size_t WS_SP = 416 * MiB, WS_HID = 192 * MiB;
constexpr size_t WS_MT = 288 * MiB, WS_VWT = 304 * MiB;
constexpr size_t WS_END = 512 * MiB;
constexpr int RING_BYTES = 131072, LDSCTL_OFF = 147456, LDS_BYTES = 163840;

__device__ __forceinline__ float bf2f(unsigned short h) { return __uint_as_float(((unsigned)h) << 16); }
__device__ __forceinline__ unsigned f2bf(float f) { unsigned u = __float_as_uint(f); return (u + 0x7fffu + ((u >> 16) & 1u)) >> 16; }
typedef __bf16 bf16x2_t __attribute__((ext_vector_type(2)));
__device__ __forceinline__ unsigned cvtpk(float lo, float hi) { const f32x2 v = {lo, hi}; const bf16x2_t b = __builtin_convertvector(v, bf16x2_t); return __builtin_bit_cast(unsigned, b); }
__device__ __forceinline__ unsigned pk2(float lo, float hi) { return cvtpk(lo, hi); }
__device__ __forceinline__ float wave_sum(float v) {
#pragma unroll
    for (int o = 1; o < 64; o <<= 1) v += __shfl_xor(v, o);
    return v;
}
#define LDS_WAIT() asm volatile("s_waitcnt lgkmcnt(0)" ::: "memory")
__device__ __forceinline__ float logsig(float x) { return fminf(x, 0.f) - log1pf(expf(-fabsf(x))); }

struct Args { const float* in[30]; float* out; unsigned char* ws; int ph_lo, ph_hi; };

typedef __amdgpu_buffer_rsrc_t rsrc_t;
typedef unsigned u32x2v __attribute__((ext_vector_type(2)));
__device__ __forceinline__ rsrc_t mkrsrc(const void* p, unsigned bytes) { return __builtin_amdgcn_make_buffer_rsrc((void*)p, 0, bytes, 0x00020000); }
__device__ __forceinline__ float bld_bf16(rsrc_t r, unsigned off) { return bf2f(__builtin_amdgcn_raw_buffer_load_b16(r, off, 0, 0)); }
__device__ __forceinline__ float bld_bf16s(rsrc_t r, unsigned off, unsigned soff) { return bf2f(__builtin_amdgcn_raw_buffer_load_b16(r, off, soff, 0)); }
__device__ __forceinline__ float bld_f32(rsrc_t r, unsigned off, unsigned soff = 0) { return __uint_as_float(__builtin_amdgcn_raw_buffer_load_b32(r, off, soff, 0)); }
typedef unsigned u32x4b __attribute__((ext_vector_type(4)));
__device__ __forceinline__ v4u bld128(rsrc_t r, unsigned voff, unsigned soff) { const u32x4b w = __builtin_amdgcn_raw_buffer_load_b128(r, voff, soff, 0); return (v4u){w.x, w.y, w.z, w.w}; }
__device__ __forceinline__ v2u bld64(rsrc_t r, unsigned voff, unsigned soff) { const u32x2v w = __builtin_amdgcn_raw_buffer_load_b64(r, voff, soff, 0); return (v2u){w.x, w.y}; }
#ifndef ECHO_SEL
#define ECHO_SEL 0
#endif
#define ECHO_BEGIN(k) unsigned long long echo_t0_##k = 0; if (ECHO_SEL == (k)) echo_t0_##k = __builtin_amdgcn_s_memrealtime();
#define ECHO_END(k) if (ECHO_SEL == (k)) { const unsigned long long t1_ = __builtin_amdgcn_s_memrealtime(), d_ = t1_ - echo_t0_##k; while (__builtin_amdgcn_s_memrealtime() - t1_ < d_) __builtin_amdgcn_s_sleep(8); }
#define P0_DISPATCH(it_, BODY) do { int r = (it_); constexpr int I_IN = 16 * 112, I_SQ = 16 * 32, I_1 = 16 * 128; \
    if (r < I_IN) { constexpr int ldw = DINP, K = DM, nblk = 112, GSPLIT = 0; const float* W = a.in[3]; bf16* WT = (bf16*)(ws + WS_WIN); const float* g = a.in[2]; BODY } \
    else if ((r -= I_IN) < I_SQ) { constexpr int ldw = DM, K = DM, nblk = 32, GSPLIT = 1; const float* W = a.in[19]; bf16* WT = (bf16*)(ws + WS_WOUT); const float* g = a.in[14]; BODY } \
    else if ((r -= I_SQ) < I_SQ) { constexpr int ldw = DM, K = DM, nblk = 32, GSPLIT = 0; const float* W = a.in[23]; bf16* WT = (bf16*)(ws + WS_WK); const float* g = a.in[21]; BODY } \
    else if ((r -= I_SQ) < I_SQ) { constexpr int ldw = DM, K = DM, nblk = 32, GSPLIT = 0; const float* W = a.in[24]; bf16* WT = (bf16*)(ws + WS_WV); const float* g = a.in[21]; BODY } \
    else if ((r -= I_SQ) < I_SQ) { constexpr int ldw = DM, K = DM, nblk = 32, GSPLIT = 0; const float* W = a.in[25]; bf16* WT = (bf16*)(ws + WS_WO); const float* g = nullptr; BODY } \
    else if ((r -= I_SQ) < I_1) { constexpr int ldw = DFF, K = DM, nblk = 128, GSPLIT = 0; const float* W = a.in[27]; bf16* WT = (bf16*)(ws + WS_W1); const float* g = a.in[26]; BODY } \
    else { r -= I_1; constexpr int ldw = DM, K = DFF, nblk = 32, GSPLIT = 0; const float* W = a.in[28]; bf16* WT = (bf16*)(ws + WS_W2); const float* g = nullptr; BODY } } while (0)
#define P0_FETCH_BODY { const int kb = r / nblk, nb = r - kb * nblk, k0 = 64 * kb, n0 = 32 * nb; (void)WT; (void)K; \
    const rsrc_t rs = mkrsrc(W + (size_t)k0 * ldw + n0, (unsigned)(64 * ldw * 4)); const unsigned vo = (unsigned)((lane >> 3) * ldw + (lane & 7) * 4) * 4u; \
    _Pragma("unroll") for (int i = 0; i < 8; ++i) buf[i] = __builtin_bit_cast(f32x4, bld128(rs, vo, (unsigned)(i * 8 * ldw * 4))); \
    if (g) { const float* gg = (GSPLIT && k0 >= 512) ? a.in[18] - 512 : g; g0 = *(const f32x4*)(gg + k0 + 8 * (lane & 7)); g1 = *(const f32x4*)(gg + k0 + 8 * (lane & 7) + 4); } else { g0 = (f32x4){1.f, 1.f, 1.f, 1.f}; g1 = g0; } }
#define P0_STORE_BODY { const int kb = r / nblk, nb = r - kb * nblk, k0 = 64 * kb, n0 = 32 * nb; (void)W; (void)g; (void)ldw; (void)GSPLIT; \
    _Pragma("unroll") for (int j = 0; j < 4; ++j) *(v4u*)(WT + (size_t)(n0 + (lane >> 3) + 8 * j) * K + k0 + 8 * (lane & 7)) = ov[j]; }
__device__ __forceinline__ void p0_prologue(const Args& a, LAS unsigned char* lds, int G, int vcu) {
    const int tid = threadIdx.x, lane = tid & 63, wave = __builtin_amdgcn_readfirstlane(tid >> 6);
    const int gw = vcu * NWAVES + wave, NGW = G * NWAVES;
    unsigned char* ws = a.ws;
    ECHO_BEGIN(1)
    {
        LAS float* scr = (LAS float*)(lds + wave * 16384);
        constexpr int I_IN = 16 * 112, I_SQ = 16 * 32, I_1 = 16 * 128, I_2 = 64 * 32;
        constexpr int NITEMS = I_IN + 4 * I_SQ + I_1 + I_2;
        f32x4 buf[8], g0, g1;
        if (gw < NITEMS) P0_DISPATCH(gw, P0_FETCH_BODY);
        for (int it = gw; it < NITEMS; it += NGW) {
#pragma unroll
            for (int i = 0; i < 8; ++i) { LAS float* d = scr + (i * 8 + (lane >> 3)) * 33 + (lane & 7) * 4; d[0] = buf[i][0]; d[1] = buf[i][1]; d[2] = buf[i][2]; d[3] = buf[i][3]; }
            const f32x4 c0 = g0, c1 = g1;
            if (it + NGW < NITEMS) P0_DISPATCH(it + NGW, P0_FETCH_BODY);
            LDS_WAIT(); asm volatile("" ::: "memory");
            const int c = lane & 7; v4u ov[4];
#pragma unroll
            for (int j = 0; j < 4; ++j) { const int n = (lane >> 3) + 8 * j; const LAS float* s = scr + (8 * c) * 33 + n;
                ov[j].x = pk2(s[0 * 33] * c0[0], s[1 * 33] * c0[1]); ov[j].y = pk2(s[2 * 33] * c0[2], s[3 * 33] * c0[3]); ov[j].z = pk2(s[4 * 33] * c1[0], s[5 * 33] * c1[1]); ov[j].w = pk2(s[6 * 33] * c1[2], s[7 * 33] * c1[3]); }
            P0_DISPATCH(it, P0_STORE_BODY);
            LDS_WAIT(); asm volatile("" ::: "memory");
        }
        for (int r = gw; r < DM; r += NGW) { const float g = a.in[20][r]; const f32x4* src = (const f32x4*)(a.in[22] + (size_t)r * DM) + lane;
            unsigned long long* o8 = (unsigned long long*)((bf16*)(ws + WS_WQ) + (size_t)r * DM) + lane;
#pragma unroll
            for (int j = 0; j < 4; ++j) { const f32x4 v = src[64 * j] * g; o8[64 * j] = (unsigned long long)pk2(v[0], v[1]) | ((unsigned long long)pk2(v[2], v[3]) << 32); } }
    }
    ECHO_END(1)
    ECHO_BEGIN(2)
    __syncthreads();
    LAS float* Wg = (LAS float*)lds;
#pragma unroll
    for (int idx = tid; idx < 4 * DM; idx += NTHREADS) { const int k = idx >> 2, jq = idx & 3;
        const f32x4 w = *(const f32x4*)(a.in[3] + (size_t)k * DINP + NPROJ + 4 * jq) * a.in[2][k];
        Wg[(4 * jq + 0) * DM + k] = w[0]; Wg[(4 * jq + 1) * DM + k] = w[1]; Wg[(4 * jq + 2) * DM + k] = w[2]; Wg[(4 * jq + 3) * DM + k] = w[3]; }
    __syncthreads();
    ECHO_END(2)
    ECHO_BEGIN(3)
    {
    f32x4 nx[4], ny[4];
    const rsrc_t rx = mkrsrc(a.in[0], (unsigned)((size_t)MTOK * DM * 4));
#pragma unroll
    for (int j = 0; j < 4; ++j) { nx[j] = __builtin_bit_cast(f32x4, bld128(rx, (unsigned)gw * (DM * 4) + lane * 16 + j * 1024, 0)); ny[j] = __builtin_bit_cast(f32x4, bld128(rx, (unsigned)(gw + NGW) * (DM * 4) + lane * 16 + j * 1024, 0)); }
    for (int m = gw; m < MTOK; m += NGW) {
        f32x4 v[4]; float ss = 0.f;
#pragma unroll
        for (int j = 0; j < 4; ++j) { v[j] = nx[j]; nx[j] = ny[j]; ss += (v[j][0] * v[j][0] + v[j][1] * v[j][1]) + (v[j][2] * v[j][2] + v[j][3] * v[j][3]); }
#pragma unroll
        for (int j = 0; j < 4; ++j) ny[j] = __builtin_bit_cast(f32x4, bld128(rx, (unsigned)(m + 2 * NGW) * (DM * 4) + lane * 16 + j * 1024, 0));
        const float rstd = __builtin_amdgcn_rsqf(wave_sum(ss) * (1.0f / DM) + EPS);
        unsigned long long* o8 = (unsigned long long*)((bf16*)(ws + WS_XN) + (size_t)m * DM) + lane;
#pragma unroll
        for (int j = 0; j < 4; ++j) { v[j] = v[j] * rstd; o8[64 * j] = (unsigned long long)pk2(v[j][0], v[j][1]) | ((unsigned long long)pk2(v[j][2], v[j][3]) << 32); }
        float gs[16];
#pragma unroll
        for (int g = 0; g < 16; ++g) { float s = 0.f;
#pragma unroll
            for (int j = 0; j < 4; ++j) { const f32x4 w = *(const LAS f32x4*)(Wg + g * DM + 4 * lane + 256 * j); s += (v[j][0] * w[0] + v[j][1] * w[1]) + (v[j][2] * w[2] + v[j][3] * w[3]); }
            gs[g] = s; if ((g & 3) == 3) asm volatile("" ::: "memory"); }
#pragma unroll
        for (int j = 0; j < 8; ++j) { const bool up = lane & 1; const float send = up ? gs[j] : gs[j + 8], keep = up ? gs[j + 8] : gs[j]; gs[j] = keep + __shfl_xor(send, 1); }
#pragma unroll
        for (int j = 0; j < 4; ++j) { const bool up = lane & 2; const float send = up ? gs[j] : gs[j + 4], keep = up ? gs[j + 4] : gs[j]; gs[j] = keep + __shfl_xor(send, 2); }
#pragma unroll
        for (int j = 0; j < 2; ++j) { const bool up = lane & 4; const float send = up ? gs[j] : gs[j + 2], keep = up ? gs[j + 2] : gs[j]; gs[j] = keep + __shfl_xor(send, 4); }
        { const bool up = lane & 8; const float send = up ? gs[0] : gs[1], keep = up ? gs[1] : gs[0]; gs[0] = keep + __shfl_xor(send, 8); }
        float tot = gs[0]; tot += __shfl_xor(tot, 16); tot += __shfl_xor(tot, 32);
        const int gi = ((lane & 1) << 3) | ((lane & 2) << 1) | ((lane & 4) >> 1) | ((lane & 8) >> 3);
        if (lane < 16) { float gv = tot + a.in[17][gi]; if (gi & 4) gv = logsig(gv); ((float*)(ws + WS_GATES))[(size_t)m * 16 + gi] = gv; }
    }
    }
    ECHO_END(3)
    ECHO_BEGIN(4)
    for (int m = gw; m < MMEM; m += NGW) {
        const f32x4* xr = (const f32x4*)(a.in[1] + (size_t)m * DM) + lane;
        f32x4 v[4]; float ss = 0.f;
#pragma unroll
        for (int j = 0; j < 4; ++j) { v[j] = xr[64 * j]; ss += (v[j][0] * v[j][0] + v[j][1] * v[j][1]) + (v[j][2] * v[j][2] + v[j][3] * v[j][3]); }
        const float rstd = 1.0f / sqrtf(wave_sum(ss) * (1.0f / DM) + EPS);
        unsigned long long* o8 = (unsigned long long*)((bf16*)(ws + WS_MEMN) + (size_t)m * DM) + lane;
#pragma unroll
        for (int j = 0; j < 4; ++j) { v[j] = v[j] * rstd; o8[64 * j] = (unsigned long long)pk2(v[j][0], v[j][1]) | ((unsigned long long)pk2(v[j][2], v[j][3]) << 32); }
    }
    ECHO_END(4)
    ECHO_BEGIN(5)
    {
        float w6[33], w9[64];
#pragma unroll
        for (int i = 0; i < 33; ++i) w6[i] = a.in[6][i * 64 + lane];
#pragma unroll
        for (int i = 0; i < 64; ++i) w9[i] = a.in[9][i * 64 + lane];
        const float b7 = a.in[7][lane], f8 = a.in[8][lane], b10 = a.in[10][lane], f11 = a.in[11][lane];
        for (int t = gw; t < SEQ; t += NGW) {
            const float tl = (float)t * (1.0f / (float)(SEQ - 1)), ang = (6.283185307179586f / (float)SEQ) * (float)t;
            const int mb = lane & 15; const float band = 1e-4f + (float)mb * ((15.0f - 1e-4f) / 15.0f); const float ph = band * ang;
            const float zf = (lane & 16) ? -sinf(ph) : cosf(ph);
            float s = tl * w6[0];
#pragma unroll
            for (int i = 0; i < 32; ++i) s += __builtin_bit_cast(float, __builtin_amdgcn_readlane(__builtin_bit_cast(int, zf), i)) * w6[1 + i];
            const float h1 = sinf(f8 * (s + b7));
            float s2 = 0.f;
#pragma unroll
            for (int i = 0; i < 64; ++i) s2 += __builtin_bit_cast(float, __builtin_amdgcn_readlane(__builtin_bit_cast(int, h1), i)) * w9[i];
            const float h2 = sinf(f11 * (s2 + b10));
            ((float*)(ws + WS_HID2))[(size_t)t * 64 + lane] = h2;
        }
    }
    ECHO_END(5)
}
__device__ __forceinline__ float sigm(float x) { return __builtin_amdgcn_rcpf(1.0f + __builtin_amdgcn_exp2f(x * -1.4426950408889634f)); }
__device__ __forceinline__ float silu(float x) { return x * sigm(x); }

__device__ __forceinline__ void filters_phase(const Args& a, LAS unsigned char* lds, int G, int vcu) {
    const int tid = threadIdx.x, lane = tid & 63, wave = __builtin_amdgcn_readfirstlane(tid >> 6);
    const int gw = vcu * NWAVES + wave, NGW = G * NWAVES;
    const float* hid2 = (const float*)(a.ws + WS_HID2); float* filt = (float*)((unsigned char*)a.out + OUT_FILT);
    LAS float* hs = (LAS float*)(lds + 73728 + wave * 4096);
    for (int item = gw; item < 32 * 256; item += NGW) {
        const int cg = item & 31, tb = item >> 5, t0 = tb * 16, ch = cg * 64 + lane, c = ch & 511;
#pragma unroll
        for (int i = 0; i < 4; ++i) *(LAS f32x4*)(hs + (lane + 64 * i) * 4) = *(const f32x4*)(hid2 + (size_t)t0 * 64 + (lane + 64 * i) * 4);
        LDS_WAIT();
        float acc[16];
#pragma unroll
        for (int i = 0; i < 16; ++i) acc[i] = 0.f;
#pragma nounroll
        for (int j4 = 0; j4 < 16; ++j4) {
            const float w0 = a.in[12][(size_t)(4 * j4 + 0) * 2048 + ch], w1 = a.in[12][(size_t)(4 * j4 + 1) * 2048 + ch], w2 = a.in[12][(size_t)(4 * j4 + 2) * 2048 + ch], w3 = a.in[12][(size_t)(4 * j4 + 3) * 2048 + ch];
#pragma unroll
            for (int i = 0; i < 16; ++i) { const f32x4 h4 = *(const LAS f32x4*)(hs + i * 64 + 4 * j4); acc[i] += (h4[0] * w0 + h4[1] * w1) + (h4[2] * w2 + h4[3] * w3); }
        }
        const float mind = -3.0701134573253944f, maxd = -15.350567286626972f;
        const float ad = fabsf(mind + (float)c * ((maxd - mind) / 511.0f));
        float* dst = filt + (size_t)ch * SEQ + t0;
#pragma unroll
        for (int i4 = 0; i4 < 4; ++i4) { f32x4 o;
#pragma unroll
            for (int e = 0; e < 4; ++e) { const float tl = (float)(t0 + 4 * i4 + e) * (1.0f / (float)(SEQ - 1)); o[e] = acc[4 * i4 + e] * expf(-tl * ad); }
            *(f32x4*)(dst + 4 * i4) = o; }
        LDS_WAIT();
    }
}
__device__ __forceinline__ void softmax_rows(const Args& a, int G, int vcu) {
    const int tid = threadIdx.x, lane = tid & 63, wave = __builtin_amdgcn_readfirstlane(tid >> 6);
    const int gw = vcu * NWAVES + wave, NGW = G * NWAVES;
    bf16* sp = (bf16*)(a.ws + WS_SP);
    for (int m = gw; m < MTOK; m += NGW) {
        v4u* p = (v4u*)(sp + (size_t)m * DM + 16 * lane);
        const v4u r0 = p[0], r1 = p[1];
        float v[16];
        const unsigned w[8] = {r0.x, r0.y, r0.z, r0.w, r1.x, r1.y, r1.z, r1.w};
        float mx = -1e30f;
#pragma unroll
        for (int e = 0; e < 8; ++e) { v[2 * e] = __uint_as_float(w[e] << 16) * 0.0625f; v[2 * e + 1] = __uint_as_float(w[e] & 0xffff0000u) * 0.0625f; mx = fmaxf(mx, fmaxf(v[2 * e], v[2 * e + 1])); }
        mx = fmaxf(mx, __shfl_xor(mx, 1)); mx = fmaxf(mx, __shfl_xor(mx, 2)); mx = fmaxf(mx, __shfl_xor(mx, 4)); mx = fmaxf(mx, __shfl_xor(mx, 8));
        float sum = 0.f;
#pragma unroll
        for (int e = 0; e < 16; ++e) { v[e] = expf(v[e] - mx); sum += v[e]; }
        sum += __shfl_xor(sum, 1); sum += __shfl_xor(sum, 2); sum += __shfl_xor(sum, 4); sum += __shfl_xor(sum, 8);
        const float inv = 1.0f / sum;
        v4u o0, o1;
        o0.x = pk2(v[0] * inv, v[1] * inv); o0.y = pk2(v[2] * inv, v[3] * inv); o0.z = pk2(v[4] * inv, v[5] * inv); o0.w = pk2(v[6] * inv, v[7] * inv);
        o1.x = pk2(v[8] * inv, v[9] * inv); o1.y = pk2(v[10] * inv, v[11] * inv); o1.z = pk2(v[12] * inv, v[13] * inv); o1.w = pk2(v[14] * inv, v[15] * inv);
        p[0] = o0; p[1] = o1;
    }
}
__device__ __forceinline__ void final_norm(const Args& a, int G, int vcu) {
    const int tid = threadIdx.x, lane = tid & 63, wave = __builtin_amdgcn_readfirstlane(tid >> 6);
    const int gw = vcu * NWAVES + wave, NGW = G * NWAVES;
    const bf16* xn = (const bf16*)(a.ws + WS_XN);
    f32x4 g4[4];
#pragma unroll
    for (int j = 0; j < 4; ++j) g4[j] = *((const f32x4*)a.in[29] + 4 * lane + j);
    for (int m = gw; m < MTOK; m += NGW) {
        const v4u* p = (const v4u*)(xn + (size_t)m * DM + 16 * lane);
        const v4u r0 = p[0], r1 = p[1];
        const unsigned w[8] = {r0.x, r0.y, r0.z, r0.w, r1.x, r1.y, r1.z, r1.w};
        float v[16]; float ss = 0.f;
#pragma unroll
        for (int e = 0; e < 8; ++e) { v[2 * e] = __uint_as_float(w[e] << 16); v[2 * e + 1] = __uint_as_float(w[e] & 0xffff0000u); ss += v[2 * e] * v[2 * e] + v[2 * e + 1] * v[2 * e + 1]; }
        const float rstd = __builtin_amdgcn_rsqf(wave_sum(ss) * (1.0f / DM) + EPS);
        f32x4* o = (f32x4*)(a.out + (size_t)m * DM + 16 * lane);
#pragma unroll
        for (int j = 0; j < 4; ++j) o[j] = (f32x4){v[4 * j] * rstd * g4[j][0], v[4 * j + 1] * rstd * g4[j][1], v[4 * j + 2] * rstd * g4[j][2], v[4 * j + 3] * rstd * g4[j][3]};
    }
}
typedef short bf16x8 __attribute__((ext_vector_type(8)));
typedef float f32x16 __attribute__((ext_vector_type(16)));
#define MFMA32(a, b, c) __builtin_amdgcn_mfma_f32_32x32x16_bf16((a), (b), (c), 0, 0, 0)
__device__ __forceinline__ int crow(int r, int h) { return (r & 3) + 8 * (r >> 2) + 4 * h; }
__device__ __forceinline__ bf16x8 scale_frag(v4u raw, float s) {
    v4u o;
#pragma unroll
    for (int e = 0; e < 4; ++e) o[e] = cvtpk(__uint_as_float(raw[e] << 16) * s, __uint_as_float(raw[e] & 0xffff0000u) * s);
    return __builtin_bit_cast(bf16x8, o);
}
__device__ __forceinline__ bf16x8 scale_frag8(v4u raw, f32x4 s0, f32x4 s1) {
    v4u o;
    o[0] = cvtpk(__uint_as_float(raw[0] << 16) * s0[0], __uint_as_float(raw[0] & 0xffff0000u) * s0[1]);
    o[1] = cvtpk(__uint_as_float(raw[1] << 16) * s0[2], __uint_as_float(raw[1] & 0xffff0000u) * s0[3]);
    o[2] = cvtpk(__uint_as_float(raw[2] << 16) * s1[0], __uint_as_float(raw[2] & 0xffff0000u) * s1[1]);
    o[3] = cvtpk(__uint_as_float(raw[3] << 16) * s1[2], __uint_as_float(raw[3] & 0xffff0000u) * s1[3]);
    return __builtin_bit_cast(bf16x8, o);
}
struct ScanCtx { f32x16 acc; v4u ar[4]; bf16x8 br[4]; float be, dc; int step; };
struct ScanEnv { const Args* a; LAS unsigned char* lds; int vcu; };
__device__ __forceinline__ void scan_load(ScanCtx& s, const ScanEnv& e, int jq, int lane, int wave) {
    const int cd = e.vcu, chain = cd >> 2, dt = cd & 3, nt = wave, b = chain >> 3, hh = (chain >> 1) & 3, dir = chain & 1;
    const int j_ = dir ? 63 - jq : jq;
    const unsigned char* ws = e.a->ws;
    const rsrc_t rva = mkrsrc((const bf16*)(ws + WS_VF) + (size_t)((b * 4 + hh) * 64) * 8192, 64 * 16384), rkb = mkrsrc((const bf16*)(ws + WS_KF) + (size_t)((b * 4 + hh) * 64) * 8192, 64 * 16384);
    const rsrc_t rgf = mkrsrc((const float*)(ws + WS_GF) + (size_t)b * SEQ * 16, SEQ * 64);
    const unsigned vo = lane * 16 + (nt < 4 ? nt : 0) * 4096, ko = lane * 16 + dt * 4096, go = lane * 64 + (hh * 4 + 2 * dir + 1) * 4;
#pragma unroll
    for (int ks = 0; ks < 4; ++ks) { s.ar[ks] = bld128(rva, vo + ks * 1024, j_ * 16384); s.br[ks] = __builtin_bit_cast(bf16x8, bld128(rkb, ko + ks * 1024, j_ * 16384)); }
    s.be = bld_f32(rgf, go, j_ * 4096); s.dc = ((const float*)(ws + WS_DEC))[(size_t)((b * 4 + hh) * 64 + j_) * 2 + dir];
}
__device__ __forceinline__ void scan_tick(ScanCtx& s, const ScanEnv& e, int lane, int wave) {
    if (wave >= 5) return;
    if (s.step >= 64) return;
    const int cd = e.vcu, chain = cd >> 2, dt = cd & 3, nt = wave, dir = chain & 1, l31 = lane & 31, h = lane >> 5;
    const int j_ = dir ? 63 - s.step : s.step;
    unsigned char* ws = e.a->ws;
    LAS float* wsc = (LAS float*)(e.lds + 139264 + wave * 256);
    bf16* ST = (bf16*)(ws + WS_STATES); bf16* NV = (bf16*)(ws + WS_STATES + 128 * MiB);
    wsc[lane] = s.be; const float decay = s.dc;
    if (nt < 4) { bf16* sp = ST + ((size_t)(chain * 64 + j_) * 32 + nt * 8 + 2 * dt + (l31 >> 4)) * 512 + (((l31 >> 3) & 1) * 32) * 8 + (l31 & 7);
#pragma unroll
        for (int r = 0; r < 16; ++r) sp[crow(r, h) * 8] = (bf16)(cvtpk(s.acc[r], 0.f) & 0xffffu); }
    else if (h == 0) NV[(size_t)(chain * 64 + j_) * 128 + 32 * dt + l31] = (bf16)(cvtpk(s.acc[0], 0.f) & 0xffffu);
#pragma unroll
    for (int ks = 0; ks < 4; ++ks) { v4u araw = s.ar[ks]; if (nt == 4) { const unsigned w1 = (l31 == 0) ? 0x3f803f80u : 0u; araw = (v4u){w1, w1, w1, w1}; }
        const f32x4 b0 = *(const LAS f32x4*)(wsc + 16 * ks + 4 * h), b1 = *(const LAS f32x4*)(wsc + 16 * ks + 8 + 4 * h);
        s.acc = MFMA32(scale_frag8(araw, b0, b1), s.br[ks], s.acc); }
#pragma unroll
    for (int r = 0; r < 16; ++r) s.acc[r] *= decay;
    s.step += 1;
    scan_load(s, e, s.step < 64 ? s.step : 63, lane, wave);
}
__device__ __forceinline__ void scan_init(ScanCtx& s, const ScanEnv& e, int lane, int wave, bool do_scan) {
#pragma unroll
    for (int r = 0; r < 16; ++r) s.acc[r] = 0.f;
    s.step = 0;
    if (wave < 5 && do_scan) scan_load(s, e, 0, lane, wave); else { s.step = 64;
#pragma unroll
        for (int ks = 0; ks < 4; ++ks) { s.ar[ks] = (v4u){0u, 0u, 0u, 0u}; s.br[ks] = __builtin_bit_cast(bf16x8, (v4u){0u, 0u, 0u, 0u}); } s.be = 0.f; s.dc = 0.f; }
}
__device__ __forceinline__ f32x2 cmul(f32x2 a, f32x2 b) { return (f32x2){a.x * b.x - a.y * b.y, a.x * b.y + a.y * b.x}; }
__device__ __forceinline__ f32x2 cmulc(f32x2 a, f32x2 b) { return (f32x2){a.x * b.x + a.y * b.y, a.y * b.x - a.x * b.y}; }
template <bool INV> __device__ __forceinline__ void dft4(f32x2& x0, f32x2& x1, f32x2& x2, f32x2& x3) {
    const f32x2 s02 = x0 + x2, d02 = x0 - x2, s13 = x1 + x3, d13 = x1 - x3;
    const f32x2 jd = INV ? (f32x2){-d13.y, d13.x} : (f32x2){d13.y, -d13.x};
    x0 = s02 + s13; x1 = d02 + jd; x2 = s02 - s13; x3 = d02 - jd;
}
template <bool INV> __device__ __forceinline__ void fft16(f32x2 (&v)[16]) {
    constexpr float C1 = 0.9238795325112867f, S1 = 0.3826834323650898f, R2 = 0.7071067811865476f;
    constexpr float WR[10] = {1.f, C1, R2, S1, 0.f, 0.f, -R2, 0.f, 0.f, -C1};
    constexpr float WI[10] = {0.f, -S1, -R2, -C1, -1.f, 0.f, -R2, 0.f, 0.f, S1};
#pragma unroll
    for (int b = 0; b < 4; ++b) {
        dft4<INV>(v[b], v[4 + b], v[8 + b], v[12 + b]);
#pragma unroll
        for (int c = 1; c < 4; ++c) { if (b == 0) continue; const f32x2 w = {WR[b * c], INV ? -WI[b * c] : WI[b * c]}; v[4 * c + b] = cmul(v[4 * c + b], w); }
    }
    f32x2 o[16];
#pragma unroll
    for (int c = 0; c < 4; ++c) {
        f32x2 y0 = v[4 * c + 0], y1 = v[4 * c + 1], y2 = v[4 * c + 2], y3 = v[4 * c + 3];
        dft4<INV>(y0, y1, y2, y3);
        o[c] = y0; o[c + 4] = y1; o[c + 8] = y2; o[c + 12] = y3;
    }
#pragma unroll
    for (int k = 0; k < 16; ++k) v[k] = o[k];
}
__device__ __forceinline__ f32x2 w32c(int a) {
    constexpr float CR[16] = {1.f, 0.9807852804032304f, 0.9238795325112867f, 0.8314696123025452f, 0.7071067811865476f, 0.5555702330196022f, 0.3826834323650898f, 0.1950903220161283f,
                              0.f, -0.1950903220161283f, -0.3826834323650898f, -0.5555702330196022f, -0.7071067811865476f, -0.8314696123025452f, -0.9238795325112867f, -0.9807852804032304f};
    constexpr float CI[16] = {0.f, -0.1950903220161283f, -0.3826834323650898f, -0.5555702330196022f, -0.7071067811865476f, -0.8314696123025452f, -0.9238795325112867f, -0.9807852804032304f,
                              -1.f, -0.9807852804032304f, -0.9238795325112867f, -0.8314696123025452f, -0.7071067811865476f, -0.5555702330196022f, -0.3826834323650898f, -0.1950903220161283f};
    return (f32x2){CR[a], CI[a]};
}
constexpr int HY_BUF_BYTES = 34816, HY_TW1_OFF = 2 * HY_BUF_BYTES, HY_TW2_OFF = HY_TW1_OFF + 32768;
__device__ __forceinline__ void hy_fwd(LAS f32x2* hb, int half, int u, f32x2 wu, const LAS f32x2* tw1, const LAS f32x2* tw2, f32x2 (&V)[16], ScanCtx& sc, const ScanEnv& se) {
    const int sl_ = threadIdx.x & 63, sw_ = __builtin_amdgcn_readfirstlane(threadIdx.x >> 6);
    const int p1 = u + (u >> 4), p2 = 272 * (u >> 4) + (u & 15), p3 = 17 * u;
#pragma unroll
    for (int k = 0; k < 16; ++k) V[k] = hb[272 * k + p1];
    if (half) {
#pragma unroll
        for (int k = 1; k < 16; ++k) V[k] = cmul(V[k], w32c(k));
    }
    fft16<false>(V);
#pragma unroll
    for (int k = 0; k < 16; ++k) { if (k == 0 && !half) continue; V[k] = cmul(V[k], tw1[k * 256 + u]); }
#pragma unroll
    for (int k = 0; k < 16; ++k) hb[272 * k + p1] = V[k];
    __syncthreads(); scan_tick(sc, se, sl_, sw_);
#pragma unroll
    for (int k = 0; k < 16; ++k) V[k] = hb[p2 + 17 * k];
    fft16<false>(V);
#pragma unroll
    for (int k = 1; k < 16; ++k) V[k] = cmul(V[k], tw2[k * 16 + (u & 15)]);
#pragma unroll
    for (int k = 0; k < 16; ++k) hb[p2 + 17 * k] = V[k];
    __syncthreads(); scan_tick(sc, se, sl_, sw_);
#pragma unroll
    for (int k = 0; k < 16; ++k) V[k] = hb[p3 + k];
    fft16<false>(V);
}
__device__ __forceinline__ void hy_inv(LAS f32x2* hb, int half, int u, f32x2 wu, const LAS f32x2* tw1, const LAS f32x2* tw2, f32x2 (&V)[16], ScanCtx& sc, const ScanEnv& se) {
    const int sl_ = threadIdx.x & 63, sw_ = __builtin_amdgcn_readfirstlane(threadIdx.x >> 6);
    const int p1 = u + (u >> 4), p2 = 272 * (u >> 4) + (u & 15), p3 = 17 * u;
    fft16<true>(V);
#pragma unroll
    for (int k = 1; k < 16; ++k) V[k] = cmulc(V[k], tw2[k * 16 + (u & 15)]);
#pragma unroll
    for (int k = 0; k < 16; ++k) hb[p3 + k] = V[k];
    __syncthreads(); scan_tick(sc, se, sl_, sw_);
#pragma unroll
    for (int k = 0; k < 16; ++k) V[k] = hb[p2 + 17 * k];
    fft16<true>(V);
#pragma unroll
    for (int k = 0; k < 16; ++k) V[k] = cmulc(V[k], tw1[(u >> 4) * 256 + 16 * k + (u & 15)]);
#pragma unroll
    for (int k = 0; k < 16; ++k) hb[p2 + 17 * k] = V[k];
    __syncthreads(); scan_tick(sc, se, sl_, sw_);
#pragma unroll
    for (int k = 0; k < 16; ++k) V[k] = hb[272 * k + p1];
    fft16<true>(V);
    if (half) {
#pragma unroll
        for (int k = 1; k < 16; ++k) V[k] = cmulc(V[k], w32c(k));
    }
#pragma unroll
    for (int k = 0; k < 16; ++k) hb[272 * k + p1] = V[k];
}
__device__ __forceinline__ int hpos(int n) { return n + (n >> 4); }
template <int O> __device__ __forceinline__ void hy_order(const Args& a, LAS f32x2* bufE, LAS f32x2* bufO, LAS f32x2* hb, int half, int u, f32x2 wu, const LAS f32x2* t1, const LAS f32x2* tw2,
                                                          rsrc_t rH, f32x2 (&xin)[8], int c, int b0, float skip, ScanCtx& sc, const ScanEnv& se) {
    const int tid = threadIdx.x;
    const bf16* hyT = (const bf16*)a.out; bf16* yT = (bf16*)(a.ws + WS_YT);
    f32x2 V[16];
    u32x2v hw[16];
#pragma unroll
    for (int k = 0; k < 16; ++k) hw[k] = __builtin_amdgcn_raw_buffer_load_b64(rH, tid * 8, (O * 16 + k) * 4096, 0);
    __syncthreads();
    hy_fwd(hb, half, u, wu, t1, tw2, V, sc, se);
    const rsrc_t rg0 = mkrsrc(hyT + ((size_t)b0 * 1536 + 512 * (O + 1) + c) * SEQ, SEQ * 2), rg1 = mkrsrc(hyT + ((size_t)(b0 + 1) * 1536 + 512 * (O + 1) + c) * SEQ, SEQ * 2);
    unsigned short gw0[8], gw1[8];
#pragma unroll
    for (int i = 0; i < 8; ++i) { gw0[i] = __builtin_amdgcn_raw_buffer_load_b16(rg0, (tid + 512 * i) * 2, 0, 0); gw1[i] = __builtin_amdgcn_raw_buffer_load_b16(rg1, (tid + 512 * i) * 2, 0, 0); }
#pragma unroll
    for (int k = 0; k < 16; ++k) V[k] = cmul(V[k], (f32x2){__uint_as_float(hw[k].x), __uint_as_float(hw[k].y)});
    hy_inv(hb, half, u, wu, t1, tw2, V, sc, se);
    __syncthreads();
    const rsrc_t ry0 = mkrsrc(yT + ((size_t)b0 * 512 + c) * SEQ, SEQ * 2), ry1 = mkrsrc(yT + ((size_t)(b0 + 1) * 512 + c) * SEQ, SEQ * 2);
#pragma unroll
    for (int i = 0; i < 8; ++i) { const int n = tid + 512 * i, p = hpos(n);
        const f32x2 y = (bufE[p] + bufO[p]) * (1.0f / 8192.0f);
        f32x2 r; r.x = bf2f(gw0[i]) * (y.x + skip * xin[i].x); r.y = bf2f(gw1[i]) * (y.y + skip * xin[i].y);
        if (O == 0) { xin[i] = r; bufE[p] = r; bufO[p] = r; }
        else { __builtin_amdgcn_raw_buffer_store_b16((unsigned short)(cvtpk(r.x, 0.f) & 0xffffu), ry0, n * 2, 0, 0); __builtin_amdgcn_raw_buffer_store_b16((unsigned short)(cvtpk(r.y, 0.f) & 0xffffu), ry1, n * 2, 0, 0); } }
}
__device__ __forceinline__ void hyena_fft(const Args& a, LAS unsigned char* lds, int G, int vcu) {
    const int tid = threadIdx.x, half = __builtin_amdgcn_readfirstlane(tid >> 8), u = tid & 255;
    LAS f32x2* bufE = (LAS f32x2*)lds; LAS f32x2* bufO = (LAS f32x2*)(lds + HY_BUF_BYTES);
    LAS f32x2* tw1 = (LAS f32x2*)(lds + HY_TW1_OFF); LAS f32x2* tw2 = (LAS f32x2*)(lds + HY_TW2_OFF);
    LAS f32x2* hb = half ? bufO : bufE;
    LAS f32x2* tw1o = (LAS f32x2*)(lds + HY_TW2_OFF + 2048);
    const LAS f32x2* t1 = half ? tw1o : tw1;
    const bf16* hyT = (const bf16*)a.out; const float* filt = (const float*)((const unsigned char*)a.out + OUT_FILT);
    __syncthreads();
    for (int idx = tid; idx < 4096; idx += NTHREADS) { const int m = (idx & 255) * (idx >> 8); float s, c; sincospif((float)m * (1.0f / 2048.0f), &s, &c); tw1[idx] = (f32x2){c, -s};
        sincospif((float)(2 * m + (idx & 255)) * (1.0f / 4096.0f), &s, &c); tw1o[idx] = (f32x2){c, -s}; }
    if (tid < 256) { const int m = 16 * (tid & 15) * (tid >> 4); float s, c; sincospif((float)m * (1.0f / 2048.0f), &s, &c); tw2[tid] = (f32x2){c, -s}; }
    f32x2 wu; { float s, c; sincospif((float)u * (1.0f / 4096.0f), &s, &c); wu = (f32x2){c, -s}; }
    ScanCtx sc; const ScanEnv se = {&a, lds, vcu};
    { const int sl_ = tid & 63, sw_ = __builtin_amdgcn_readfirstlane(tid >> 6); scan_init(sc, se, sl_, sw_, G == 256); }
    const rsrc_t rH = mkrsrc(a.ws + WS_HSPEC + (size_t)blockIdx.x * (2 * 16 * NTHREADS * 8), 2 * 16 * NTHREADS * 8);
    for (int c = vcu; c < DHY; c += G) {
#pragma nounroll
        for (int o = 0; o < 2; ++o) {
            const rsrc_t rf = mkrsrc(filt + ((size_t)(o * 2 + 0) * 512 + c) * SEQ, SEQ * 4), rk = mkrsrc(filt + ((size_t)(o * 2 + 1) * 512 + c) * SEQ, SEQ * 4);
            __syncthreads();
#pragma unroll
            for (int i = 0; i < 8; ++i) { const int n = tid + 512 * i, p = hpos(n); const float f = bld_f32(rf, n * 4); float r = bld_f32(rk, (SEQ - n) * 4); r = (n >= 1) ? r : 0.f;
                bufE[p] = (f32x2){f + r, 0.f}; bufO[p] = (f32x2){f - r, 0.f}; }
            __syncthreads();
            f32x2 V[16];
            hy_fwd(hb, half, u, wu, t1, tw2, V, sc, se);
#pragma unroll
            for (int k = 0; k < 16; ++k) { u32x2v w; w.x = __float_as_uint(V[k].x); w.y = __float_as_uint(V[k].y); __builtin_amdgcn_raw_buffer_store_b64(w, rH, tid * 8, (o * 16 + k) * 4096, 0); }
        }
        const float skip0 = a.in[13][c], skip1 = a.in[13][512 + c];
#pragma nounroll
        for (int pr = 0; pr < 4; ++pr) {
            const int b0 = 2 * pr;
            f32x2 xin[8];
            const rsrc_t rv0 = mkrsrc(hyT + ((size_t)b0 * 1536 + c) * SEQ, SEQ * 2), rv1 = mkrsrc(hyT + ((size_t)(b0 + 1) * 1536 + c) * SEQ, SEQ * 2);
            __syncthreads();
#pragma unroll
            for (int i = 0; i < 8; ++i) { const int n = tid + 512 * i, p = hpos(n); xin[i] = (f32x2){bld_bf16(rv0, n * 2), bld_bf16(rv1, n * 2)}; bufE[p] = xin[i]; bufO[p] = xin[i]; }
            hy_order<0>(a, bufE, bufO, hb, half, u, wu, t1, tw2, rH, xin, c, b0, skip0, sc, se);
            hy_order<1>(a, bufE, bufO, hb, half, u, wu, t1, tw2, rH, xin, c, b0, skip1, sc, se);
        }
    }
    { const int sl_ = tid & 63, sw_ = __builtin_amdgcn_readfirstlane(tid >> 6); while (sc.step < 64) scan_tick(sc, se, sl_, sw_); }
    __syncthreads();
}
__device__ __forceinline__ float incl_prefix(float x, int lane) {
#pragma unroll
    for (int d = 1; d < 64; d <<= 1) { const float t = __shfl_up(x, d); if (lane >= d) x += t; }
    return x;
}
__device__ __forceinline__ float incl_suffix(float x, int lane) {
#pragma unroll
    for (int d = 1; d < 64; d <<= 1) { const float t = __shfl_down(x, d); if (lane + d < 64) x += t; }
    return x;
}
__device__ __forceinline__ void gate_factors(const Args& a, int G, int vcu) {
    const int tid = threadIdx.x, lane = tid & 63, wave = __builtin_amdgcn_readfirstlane(tid >> 6);
    const int gw = vcu * NWAVES + wave, NGW = G * NWAVES;
    const float* gates = (const float*)(a.ws + WS_GATES); float* gf = (float*)(a.ws + WS_GF); float* dec = (float*)(a.ws + WS_DEC);
    for (int task = gw; task < NB * NHEAD * 64; task += NGW) {
        const int b = task >> 8, hh = (task >> 6) & 3, j = task & 63; const size_t row = (size_t)b * SEQ + j * 64 + lane;
        const float* gp = gates + row * 16 + hh;
        const float i_f = gp[0], a_f = gp[4], i_b = gp[8], a_b = gp[12];
        const float F = incl_prefix(a_f, lane), Gs = incl_suffix(a_b, lane);
        *(f32x4*)(gf + row * 16 + hh * 4) = (f32x4){expf(F), expf(i_f - F), expf(Gs), expf(i_b - Gs)};
        if (lane == 63) dec[(size_t)task * 2] = expf(F);
        if (lane == 0) dec[(size_t)task * 2 + 1] = expf(Gs);
    }
}
__device__ __forceinline__ void mlstm_scan(const Args& a, LAS unsigned char* lds, int G, int vcu) {
    int tid = threadIdx.x; asm volatile("" : "+v"(tid));
    const int lane = tid & 63, wave = __builtin_amdgcn_readfirstlane(tid >> 6), l31 = lane & 31, h = lane >> 5;
    const int gw = wave * G + vcu, NGW = G * NWAVES;
    LAS float* wsc = (LAS float*)(lds + wave * 1024);
    const bf16* KFp = (const bf16*)(a.ws + WS_KF); const bf16* VFp = (const bf16*)(a.ws + WS_VF);
    const float* gf = (const float*)(a.ws + WS_GF); const float* dec = (const float*)(a.ws + WS_DEC); bf16* ST = (bf16*)(a.ws + WS_STATES); bf16* NV = (bf16*)(a.ws + WS_STATES + 128 * MiB);
    for (int cd = vcu; cd < 64 * 4; cd += G) { if (wave >= 5) break;
        const int chain = cd >> 2, dt = cd & 3, nt = wave;
        const int b = chain >> 3, hh = (chain >> 1) & 3, dir = chain & 1;
        f32x16 acc;
#pragma unroll
        for (int r = 0; r < 16; ++r) acc[r] = 0.f;
        const rsrc_t rva = mkrsrc(VFp + (size_t)((b * 4 + hh) * 64) * 8192, 64 * 16384), rkb = mkrsrc(KFp + (size_t)((b * 4 + hh) * 64) * 8192, 64 * 16384);
        const rsrc_t rgf = mkrsrc(gf + (size_t)b * SEQ * 16, SEQ * 64);
        const unsigned vo = lane * 16 + (nt < 4 ? nt : 0) * 4096, ko = lane * 16 + dt * 4096, go = lane * 64 + (hh * 4 + 2 * dir + 1) * 4;
        const float* dbase = dec + (size_t)((b * 4 + hh) * 64) * 2 + dir;
        const v4u ones = {0x3f803f80u, 0x3f803f80u, 0x3f803f80u, 0x3f803f80u}, zeros = {0u, 0u, 0u, 0u};
        struct Stg { v4u ar[4]; bf16x8 br[4]; float be, dc; };
#define SCAN_LOAD(S, jq) do { const int jc_ = (jq) < 0 ? 0 : ((jq) > 63 ? 63 : (jq)); const int j_ = dir ? 63 - jc_ : jc_; _Pragma("unroll") for (int ks = 0; ks < 4; ++ks) { \
            S.ar[ks] = bld128(rva, vo + ks * 1024, j_ * 16384); S.br[ks] = __builtin_bit_cast(bf16x8, bld128(rkb, ko + ks * 1024, j_ * 16384)); } S.be = bld_f32(rgf, go, j_ * 4096); S.dc = dbase[j_ * 2]; } while (0)
#define SCAN_STEP(S, jq) do { const int j_ = dir ? 63 - (jq) : (jq); \
            wsc[lane] = S.be; const float decay = S.dc; \
            if (nt < 4) { bf16* sp = ST + ((size_t)(chain * 64 + j_) * 32 + nt * 8 + 2 * dt + (l31 >> 4)) * 512 + (((l31 >> 3) & 1) * 32) * 8 + (l31 & 7); \
                _Pragma("unroll") for (int r = 0; r < 16; ++r) sp[crow(r, h) * 8] = (bf16)f2bf(acc[r]); } \
            else if (h == 0) NV[(size_t)(chain * 64 + j_) * 128 + 32 * dt + l31] = (bf16)f2bf(acc[0]);     \
            _Pragma("unroll") for (int ks = 0; ks < 4; ++ks) { v4u araw = S.ar[ks]; if (nt == 4) araw = (l31 == 0) ? ones : zeros; \
                const f32x4 b0 = *(const LAS f32x4*)(wsc + 16 * ks + 4 * h), b1 = *(const LAS f32x4*)(wsc + 16 * ks + 8 + 4 * h); \
                acc = MFMA32(scale_frag8(araw, b0, b1), S.br[ks], acc); } \
            _Pragma("unroll") for (int r = 0; r < 16; ++r) acc[r] *= decay; } while (0)
        Stg s0, s1, s2;
        SCAN_LOAD(s0, 0); SCAN_LOAD(s1, 1);
#pragma nounroll
        for (int jj = 0; jj < 63; jj += 3) {
            SCAN_LOAD(s2, jj + 2); SCAN_STEP(s0, jj);
            SCAN_LOAD(s0, jj + 3); SCAN_STEP(s1, jj + 1);
            SCAN_LOAD(s1, jj + 4); SCAN_STEP(s2, jj + 2);
        }
        SCAN_STEP(s0, 63);
#undef SCAN_LOAD
#undef SCAN_STEP
    }
}
constexpr int ML_WAVE_LDS = 18432, ML_YROW = 136;
__device__ __forceinline__ void mlstm_out(const Args& a, LAS unsigned char* lds, int G, int vcu) {
    int tid = threadIdx.x; asm volatile("" : "+v"(tid));
    const int lane = tid & 63, wave = __builtin_amdgcn_readfirstlane(tid >> 6), l31 = lane & 31, h = lane >> 5;
    const int gw = vcu * NWAVES + wave, NGW = G * NWAVES;
    LAS float* sc = (LAS float*)(lds + wave * ML_WAVE_LDS);
    LAS bf16* ybuf = (LAS bf16*)(lds + wave * ML_WAVE_LDS + 1024); LAS float* rsb = (LAS float*)(lds + wave * ML_WAVE_LDS + 1024 + 32 * ML_YROW * 2);
    LAS float* ivb = rsb + 32;
    LAS v4u* pfl = (LAS v4u*)(lds + wave * ML_WAVE_LDS + 10240) + lane;
    const unsigned char* QFp = a.ws + WS_QF; const unsigned char* KAp = a.ws + WS_KA; const unsigned char* VFp = a.ws + WS_VF;
    const bf16* om = (const bf16*)(a.ws + WS_PROJ) + 6 * PROJ_STRIDE; const float* gf = (const float*)(a.ws + WS_GF);
    const bf16* ST = (const bf16*)(a.ws + WS_STATES); const bf16* NV = (const bf16*)(a.ws + WS_STATES + 128 * MiB); bf16* mixed = (bf16*)(a.ws + WS_MIXED);
    const unsigned lo = lane * 16;
    for (int t4 = vcu * NWAVES; t4 < NB * NHEAD * 64; t4 += NGW)
    for (int rr = 0; rr < 2; ++rr) {
        const int task = t4 + rr * 4 + (wave & 3);
        const int b = task >> 8, hh = (task >> 6) & 3, j = task & 63, t0 = j * 64, row0 = b * SEQ + t0;
        { const f32x4 g4 = *(const f32x4*)(gf + (size_t)(row0 + lane) * 16 + hh * 4);
          sc[lane] = g4[0]; sc[64 + lane] = g4[1]; sc[128 + lane] = g4[2]; sc[192 + lane] = g4[3]; }
        const size_t fo = (size_t)(((b * 4 + hh) * 64 + j)) * 16384;
        const rsrc_t rq = mkrsrc(QFp + fo, 16384), rk = mkrsrc(KAp + fo, 16384), rv = mkrsrc(VFp + fo, 16384);
        const rsrc_t rs0 = mkrsrc(ST + ((size_t)(((b * 4 + hh) * 2 + 0) * 64 + j) * 32) * 512, 32768), rs1 = mkrsrc(ST + ((size_t)(((b * 4 + hh) * 2 + 1) * 64 + j) * 32) * 512, 32768);
        const rsrc_t rn0 = mkrsrc(NV + (size_t)(((b * 4 + hh) * 2 + 0) * 64 + j) * 128, 256), rn1 = mkrsrc(NV + (size_t)(((b * 4 + hh) * 2 + 1) * 64 + j) * 128, 256);
        const unsigned lon = (l31 == 0) ? (unsigned)(16 * h) : 0x40000000u;
        const rsrc_t ro = mkrsrc(om + (size_t)row0 * 512 + hh * 128, 64 * 1024), rm = mkrsrc(mixed + (size_t)row0 * DM + 512 + hh * 128, 64 * 2048);
        {
            const int ti = wave >> 2;
            const int t = 32 * ti + l31;
            v4u qf[8];
#pragma unroll
            for (int ks = 0; ks < 8; ++ks) qf[ks] = bld128(rq, lo, ti * 8192 + 1024 * ks);
            {
                f32x16 X[2];
#pragma unroll
                for (int r = 0; r < 16; ++r) { X[0][r] = 0.f; X[1][r] = 0.f; }
                v4u xa[8], xb[8];
#pragma unroll
                for (int ks = 0; ks < 8; ++ks) { xa[ks] = bld128(rk, lo, 1024 * ks); xb[ks] = bld128(rk, lo, 8192 + 1024 * ks); }
#pragma unroll
                for (int ks = 0; ks < 8; ++ks) { const bf16x8 Bq = __builtin_bit_cast(bf16x8, qf[ks]);
                    X[0] = MFMA32(__builtin_bit_cast(bf16x8, xa[ks]), Bq, X[0]); X[1] = MFMA32(__builtin_bit_cast(bf16x8, xb[ks]), Bq, X[1]); }
                asm volatile("" ::: "memory");
#pragma unroll
                for (int si = 0; si < 2; ++si)
#pragma unroll
                    for (int ss = 0; ss < 2; ++ss) {
                        v4u pf, pb;
#pragma unroll
                        for (int e = 0; e < 4; ++e) { float f2[2], b2[2];
#pragma unroll
                            for (int q2 = 0; q2 < 2; ++q2) { const int r = 8 * ss + 2 * e + q2, s = 32 * si + crow(r, h);
                                const float x = X[si][r], bef = sc[64 + s], beb = sc[192 + s];
                                const float vf = x * bef, vb = x * beb;
                                f2[q2] = (s <= t) ? vf : 0.f; b2[q2] = (s >= t) ? vb : 0.f; }
                            pf[e] = cvtpk(f2[0], f2[1]); pb[e] = cvtpk(b2[0], b2[1]); }
                        pfl[(si * 2 + ss) * 64] = pf; pfl[(4 + si * 2 + ss) * 64] = pb;
                    }
            }
            v4u F[8];
#define ML_COMP(D, RN, VO, SB, SS) do { \
        _Pragma("unroll") for (int ks = 0; ks < 8; ++ks) { D = MFMA32(__builtin_bit_cast(bf16x8, qf[ks]), __builtin_bit_cast(bf16x8, F[ks]), D); F[ks] = bld128(RN, VO, (SB) + (SS) * ks); asm volatile("" ::: "memory"); } } while (0)
#define ML_PV(vf_) do { _Pragma("unroll") for (int r = 0; r < 16; ++r) { df[r] = 0.f; db[r] = 0.f; } \
        _Pragma("unroll") for (int si = 0; si < 2; ++si) _Pragma("unroll") for (int ss = 0; ss < 2; ++ss) { const bf16x8 B_ = __builtin_bit_cast(bf16x8, vf_[si * 2 + ss]); \
            if (si <= ti) df = MFMA32(__builtin_bit_cast(bf16x8, pfl[(si * 2 + ss) * 64]), B_, df); if (si >= ti) db = MFMA32(__builtin_bit_cast(bf16x8, pfl[(4 + si * 2 + ss) * 64]), B_, db); } } while (0)
#pragma unroll
            for (int ks = 0; ks < 8; ++ks) F[ks] = bld128(rn0, lon, 32 * ks);
            asm volatile("" ::: "memory");
            {
                f32x16 df, db; v4u vfr[4];
#pragma unroll
                for (int q4 = 0; q4 < 4; ++q4) { const unsigned w1 = (l31 == 0) ? 0x3f803f80u : 0u; vfr[q4] = (v4u){w1, w1, w1, w1}; }
                ML_PV(vfr);
                ML_COMP(df, rn1, lon, 0, 32);
                ML_COMP(db, rs0, lo, 0, 1024);
#pragma unroll
                for (int r = 0; r < 16; ++r) {
                    if (l31 == 0) { const int tl = crow(r, h); const float af = sc[32 * ti + tl], ab = sc[128 + 32 * ti + tl];
                        ivb[tl] = af * __builtin_amdgcn_rcpf(fmaxf(af * fabsf(df[r]), 1.0f)); ivb[32 + tl] = ab * __builtin_amdgcn_rcpf(fmaxf(ab * fabsf(db[r]), 1.0f)); } }
            }
#pragma nounroll
            for (int nt = 0; nt < 4; ++nt) {
                const int n = 32 * nt + l31;
                f32x16 df, db;
                { v4u vfr[4];
#pragma unroll
                  for (int q4 = 0; q4 < 4; ++q4) vfr[q4] = bld128(rv, lo, nt * 4096 + q4 * 1024);
                  ML_PV(vfr); }
                ML_COMP(df, rs1, lo, nt * 8192, 1024);
                ML_COMP(db, rs0, lo, (nt < 3 ? nt + 1 : 3) * 8192, 1024);
                const unsigned oo = (unsigned)(32 * ti + 4 * h) * 1024 + 2 * n;
#pragma unroll
                for (int r = 0; r < 16; ++r) { const int tl = crow(r, h);
                    const float hv = df[r] * ivb[tl] + db[r] * ivb[32 + tl];
                    const float og = bld_bf16(ro, oo + ((r & 3) + 8 * (r >> 2)) * 1024);
                    const float y = hv * __builtin_amdgcn_rcpf(1.0f + __builtin_amdgcn_exp2f(og * -1.4426950408889634f));
                    ybuf[tl * ML_YROW + n] = (bf16)(cvtpk(y, 0.f) & 0xffffu); }
            }
#undef ML_COMP
#undef ML_PV
#pragma unroll
            for (int i = 0; i < 8; ++i) { const int idx = lane + 64 * i, tl = idx >> 4, ch = idx & 15;
                const v4u w = *(const LAS v4u*)(ybuf + tl * ML_YROW + 8 * ch); float y8[8]; float ss = 0.f;
#pragma unroll
                for (int e = 0; e < 4; ++e) { y8[2 * e] = __uint_as_float(w[e] << 16); y8[2 * e + 1] = __uint_as_float(w[e] & 0xffff0000u); ss += y8[2 * e] * y8[2 * e] + y8[2 * e + 1] * y8[2 * e + 1]; }
                ss += __shfl_xor(ss, 1); ss += __shfl_xor(ss, 2); ss += __shfl_xor(ss, 4); ss += __shfl_xor(ss, 8);
                const float rs = __builtin_amdgcn_rsqf(ss * (1.0f / 128.0f) + EPS);
                u32x4b o;
#pragma unroll
                for (int e = 0; e < 4; ++e) o[e] = cvtpk(y8[2 * e] * rs, y8[2 * e + 1] * rs);
                __builtin_amdgcn_raw_buffer_store_b128(o, rm, (unsigned)(32 * ti + tl) * 2048 + 16 * ch, 0, 0); }
        }
    }
}
constexpr int CV_WAVE_LDS = 8704;
__device__ __forceinline__ void conv_tiles(const Args& a, LAS unsigned char* lds, int G, int vcu, int nlight) {
    const int tid = threadIdx.x, lane = tid & 63, wave = __builtin_amdgcn_readfirstlane(tid >> 6);
    const int gw = vcu * NWAVES + wave, NGW = G * NWAVES;
    LAS unsigned char* raw = lds + wave * CV_WAVE_LDS;
    const bf16* proj = (const bf16*)(a.ws + WS_PROJ);
    const int g8 = lane >> 3, c8 = lane & 7;
    v4u nxt[9];
#define CV_FETCH(it_) do { const int buf_ = (it_) % 6, ct_ = ((it_) / 6) & 7, rt_ = (it_) / 48, b_ = rt_ >> 6, t0_ = (rt_ & 63) * 64; \
        const rsrc_t rs_ = mkrsrc(proj + (size_t)buf_ * PROJ_STRIDE + (size_t)b_ * SEQ * 512 + ct_ * 64, SEQ * 1024); \
        _Pragma("unroll") for (int i = 0; i < 9; ++i) { const int rr = g8 + 8 * i; nxt[i] = bld128(rs_, (unsigned)(t0_ - 1 + rr) * 1024u + c8 * 16, 0); } } while (0)
    const int row_lo = (vcu < nlight) ? vcu * 9 : nlight * 9 + (vcu - nlight) * 13, row_n = (G == 256) ? ((vcu < nlight) ? 9 : 13) : 0;
    if (G != 256) {   }
    int item = (G == 256) ? row_lo * 8 + wave : gw; const int istep = (G == 256) ? 8 : NGW; const int iend = (G == 256) ? (row_lo + row_n) * 8 : 6 * 8 * 512;
    if (item < iend) CV_FETCH(item);
    for (; item < iend; item += istep) {
        const int buf = item % 6, ct = (item / 6) & 7, rt = item / 48, b = rt >> 6, t0 = (rt & 63) * 64;
#pragma unroll
        for (int i = 0; i < 9; ++i) { const int rr = g8 + 8 * i;
            if (rr < 66) *(LAS v4u*)(raw + rr * 128 + c8 * 16) = nxt[i]; }
        if (item + istep < iend) CV_FETCH(item + istep);
        LDS_WAIT();
        if (buf == 3 || buf == 4) {
            const float* cw = a.in[15] + (buf - 3) * 512 + ct * 64 + c8 * 8; const float* cb = a.in[16] + (buf - 3) * 512 + ct * 64 + c8 * 8;
            float w0[8], w1[8], w2[8], bb[8];
#pragma unroll
            for (int e = 0; e < 8; ++e) { w0[e] = cw[e]; w1[e] = cw[1024 + e]; w2[e] = cw[2048 + e]; bb[e] = cb[e]; }
            unsigned char* dst = a.ws + (buf == 3 ? WS_QF : WS_KA) + (size_t)(((b * 4 + (ct >> 1)) * 64 + (rt & 63))) * 16384 + (((ct & 1) * 4 + (c8 >> 1)) * 64 + (c8 & 1) * 32) * 16;
            const float sc = (buf == 3) ? 1.0f : 0.08838834764831845f;
#pragma unroll
            for (int i = 0; i < 8; ++i) { const int r = g8 + 8 * i;
                const v4u x0 = *(const LAS v4u*)(raw + r * 128 + c8 * 16), x1 = *(const LAS v4u*)(raw + (r + 1) * 128 + c8 * 16), x2 = *(const LAS v4u*)(raw + (r + 2) * 128 + c8 * 16);
                v4u o;
#pragma unroll
                for (int e = 0; e < 4; ++e) {
                    const float lo = bb[2 * e] + __uint_as_float(x0[e] << 16) * w0[2 * e] + __uint_as_float(x1[e] << 16) * w1[2 * e] + __uint_as_float(x2[e] << 16) * w2[2 * e];
                    const float hi = bb[2 * e + 1] + __uint_as_float(x0[e] & 0xffff0000u) * w0[2 * e + 1] + __uint_as_float(x1[e] & 0xffff0000u) * w1[2 * e + 1] + __uint_as_float(x2[e] & 0xffff0000u) * w2[2 * e + 1];
                    o[e] = cvtpk(silu(lo) * sc, silu(hi) * sc); }
                *(v4u*)(dst + ((r >> 5) * 8 * 64 + (r & 31)) * 16) = o; }
        }
        if (buf != 3) {
            const LAS bf16* col = (const LAS bf16*)raw + lane;
            float w0 = 0.f, w1 = 1.f, w2 = 0.f, bb = 0.f, sc = 1.f; unsigned char* dstf = nullptr;
            if (buf >= 3) { if (buf == 4) { const int ch = 512 + ct * 64 + lane; w0 = a.in[15][ch]; w1 = a.in[15][1024 + ch]; w2 = a.in[15][2048 + ch]; bb = a.in[16][ch]; sc = 0.08838834764831845f; }
                   const int dd = (ct & 1) * 64 + lane;
                   dstf = a.ws + (buf == 4 ? WS_KF : WS_VF) + (size_t)(((b * 4 + (ct >> 1)) * 64 + (rt & 63))) * 16384 + ((dd >> 5) * 4 * 64 + (dd & 31)) * 16; }
            if (buf < 3) {
                const int cs = lane >> 3, tg = lane & 7;
#pragma unroll
                for (int i = 0; i < 8; ++i) { const int cc = cs + 8 * i, ch = buf * 512 + ct * 64 + cc;
                    const float w0 = a.in[4][ch], w1 = a.in[4][1536 + ch], w2 = a.in[4][3072 + ch], bb = a.in[5][ch];
                    const LAS bf16* col = (const LAS bf16*)raw + cc;
                    float x[10];
#pragma unroll
                    for (int e = 0; e < 10; ++e) x[e] = bf2f(col[(8 * tg + e) * 64]);
                    v4u o;
#pragma unroll
                    for (int e = 0; e < 4; ++e) o[e] = cvtpk(bb + x[2 * e] * w0 + x[2 * e + 1] * w1 + x[2 * e + 2] * w2, bb + x[2 * e + 1] * w0 + x[2 * e + 2] * w1 + x[2 * e + 3] * w2);
                    *(v4u*)((bf16*)a.out + ((size_t)b * 1536 + ch) * SEQ + t0 + 8 * tg) = o; }
            } else {
#pragma unroll
            for (int tg = 0; tg < 8; ++tg) {
                float x[10];
#pragma unroll
                for (int e = 0; e < 10; ++e) x[e] = bf2f(col[(8 * tg + e) * 64]);
                float y[8];
#pragma unroll
                for (int e = 0; e < 8; ++e) { float v = bb + x[e] * w0 + x[e + 1] * w1 + x[e + 2] * w2; if (buf == 4) v = silu(v) * sc; y[e] = v; }
                {
                    unsigned char* pz = dstf + ((tg >> 1) * 64) * 16 + 8 * (tg & 1);
                    *(v2u*)(pz) = (v2u){cvtpk(y[0], y[1]), cvtpk(y[2], y[3])}; *(v2u*)(pz + 32 * 16) = (v2u){cvtpk(y[4], y[5]), cvtpk(y[6], y[7])}; }
            }
            }
        }
        LDS_WAIT();
    }
#undef CV_FETCH
}
__device__ __forceinline__ void hy_mix(const Args& a, int G, int vcu) {
    int tid = threadIdx.x; asm volatile("" : "+v"(tid));
    const int lane = tid & 63, wave = __builtin_amdgcn_readfirstlane(tid >> 6);
    const int gw = vcu * NWAVES + wave, NGW = G * NWAVES;
    const bf16* yT = (const bf16*)(a.ws + WS_YT); bf16* mixed = (bf16*)(a.ws + WS_MIXED);
    for (int item = gw; item < NB * 8 * 64; item += NGW) {
        const int tt = item & 63, g = (item >> 6) & 7, b = item >> 9, t0 = tt * 64;
        const rsrc_t ry = mkrsrc(yT + ((size_t)b * 512 + g * 64) * SEQ + t0, 64 * SEQ * 2);
        float v[64]; float ss = 0.f;
#pragma unroll
        for (int c = 0; c < 64; ++c) { v[c] = bld_bf16s(ry, lane * 2, c * (SEQ * 2)); ss += v[c] * v[c]; }
        const float rs = __builtin_amdgcn_rsqf(ss * (1.0f / 64.0f) + EPS);
        bf16* dst = mixed + (size_t)(b * SEQ + t0 + lane) * DM + g * 64;
#pragma unroll
        for (int i = 0; i < 8; ++i) { v4u o; o.x = cvtpk(v[8 * i] * rs, v[8 * i + 1] * rs); o.y = cvtpk(v[8 * i + 2] * rs, v[8 * i + 3] * rs);
            o.z = cvtpk(v[8 * i + 4] * rs, v[8 * i + 5] * rs); o.w = cvtpk(v[8 * i + 6] * rs, v[8 * i + 7] * rs); *(v4u*)(dst + 8 * i) = o; }
    }
}
typedef GAS unsigned gu32;
#define XB_TMO      128
#define XB_XCNT(j)  (256  + 64 * (j))
#define XB_XSUB(j)  (1280 + 64 * (j))
#define XB_XGEN(j)  (2304 + 64 * (j))
#define XB_TOP      3328
#define XB_TOPGEN   3392
#define XCD_BAR_WORDS 3456
#define XB_SPIN_CAP (1u << 18)

__device__ __forceinline__ unsigned xb_ld(unsigned* p)              { return __hip_atomic_load(p, __ATOMIC_RELAXED, __HIP_MEMORY_SCOPE_AGENT); }
__device__ __forceinline__ unsigned xb_add(unsigned* p, unsigned v) { return __hip_atomic_fetch_add(p, v, __ATOMIC_RELAXED, __HIP_MEMORY_SCOPE_AGENT); }
__device__ __forceinline__ unsigned xb_xcc_id() { return (unsigned)__builtin_amdgcn_s_getreg((3 << 11) | 20) & 0xFu; }
#define XB_SPIN(cond, bar) do { unsigned _sp = 0; while (cond) { __builtin_amdgcn_s_sleep(1); \
    if ((++_sp & 255u) == 0u) { if (xb_ld(&(bar)[XB_TMO])) break; if (_sp > XB_SPIN_CAP) { atomicAdd(&(bar)[XB_TMO], 1u); break; } } } } while (0)

struct XcdBarrier {
    unsigned* bar; unsigned x;
    volatile LAS unsigned* st;
};

__device__ __forceinline__ XcdBarrier xcd_barrier_post(unsigned* bar, volatile LAS unsigned* st) {
    XcdBarrier b; b.bar = bar; b.x = xb_xcc_id(); b.st = st;
    if (threadIdx.x == 0) (void)xb_add(&bar[XB_XCNT(b.x)], 1u);
    return b;
}
__device__ __forceinline__ void xcd_barrier_complete(unsigned* bar, unsigned x, unsigned& nloc, unsigned& nx) {
    const unsigned G = gridDim.x * gridDim.y * gridDim.z;
    unsigned sum, cnt, mine, sp = 0u;
    for (;;) {
        sum = 0u; cnt = 0u; mine = 0u;
#pragma unroll
        for (unsigned j = 0; j < 16; ++j) { const unsigned c = xb_ld(&bar[XB_XCNT(j)]); sum += c; cnt += (c > 0u) ? 1u : 0u; mine = (j == x) ? c : mine; }
        if (sum == G) break;
        __builtin_amdgcn_s_sleep(1);
        if ((++sp & 255u) == 0u) { if (xb_ld(&bar[XB_TMO])) break; if (sp > XB_SPIN_CAP) { atomicAdd(&bar[XB_TMO], 1u); break; } }
    }
    nloc = mine > 0u ? mine : 1u; nx = cnt > 0u ? cnt : 1u;
}

__device__ __forceinline__ void xcd_barrier(const XcdBarrier& b) {
    asm volatile("s_waitcnt vmcnt(0)" ::: "memory");
    __syncthreads();
    if (threadIdx.x == 0) {
        unsigned* bar = b.bar;
        __builtin_amdgcn_s_waitcnt(0);
        unsigned nloc = b.st[0], nx = b.st[1];
        if (nloc == 0u) { xcd_barrier_complete(bar, b.x, nloc, nx); b.st[0] = nloc; b.st[1] = nx; }
        const unsigned old = xb_add(&bar[XB_XSUB(b.x)], 1u);
        const unsigned gen = old / nloc;
        if (old + 1u == (gen + 1u) * nloc) {
            __builtin_amdgcn_fence(__ATOMIC_RELEASE, "agent");
            asm volatile("s_waitcnt vmcnt(0)" ::: "memory");
            const unsigned og = xb_add(&bar[XB_TOP], 1u);
            const unsigned tg = og / nx;
            if (og + 1u == (tg + 1u) * nx) xb_add(&bar[XB_TOPGEN], 1u);
            else XB_SPIN(xb_ld(&bar[XB_TOPGEN]) == tg, bar);
            __builtin_amdgcn_fence(__ATOMIC_ACQUIRE, "agent");
            xb_add(&bar[XB_XGEN(b.x)], 1u);
            asm volatile("s_waitcnt vmcnt(0)" ::: "memory");
        } else {
            XB_SPIN(xb_ld(&bar[XB_XGEN(b.x)]) == gen, bar);
            __builtin_amdgcn_fence(__ATOMIC_ACQUIRE, "agent");
            asm volatile("s_waitcnt vmcnt(0)" ::: "memory");
        }
    }
    __syncthreads();
}

#ifndef MK_ONE_LAUNCH
#define MK_ONE_LAUNCH 1
#endif
#ifndef PROBE_NULL
#define PROBE_NULL 0
#endif
struct EpiNull { static constexpr bool PERM = true, AFTER_DRAIN = false, ROWPRE = false;
    __device__ __forceinline__ void operator()(const pg8::f32x4 (&acc)[2][2][4][2], const pg8::Unit& u, int wr, int wc, int fr, int fq, const PG8_LAS float*) const {
#pragma unroll
        for (int i = 0; i < 32; ++i) asm volatile("" :: "v"(acc[i >> 4][(i >> 3) & 1][(i >> 1) & 3][i & 1])); } };
struct EpiFix { static constexpr bool PERM = true, AFTER_DRAIN = false, ROWPRE = false; pg8::bf16_t* O; int rb;
    __device__ __forceinline__ void operator()(const pg8::f32x4 (&acc)[2][2][4][2], const pg8::Unit& u, int wr, int wc, int fr, int fq, const PG8_LAS float*) const {
        const int row0 = rb * 256 + wr * 64 + fr, col0 = wc * 32 + 8 * fq;
#pragma unroll
        for (int ai = 0; ai < 2; ++ai)
#pragma unroll
            for (int m = 0; m < 4; ++m) { pg8::bf16_t* rowp = O + (size_t)(row0 + ai * 128 + m * 16) * 256 + col0;
#pragma unroll
                for (int bj = 0; bj < 2; ++bj) { pg8::f32x4 v0 = acc[ai][bj][m][0], v1 = acc[ai][bj][m][1];
#pragma unroll
                    for (int e = 0; e < 4; ++e) { const float a0 = fmaxf(v0[e], 0.f), a1 = fmaxf(v1[e], 0.f); v0[e] = a0 * a0; v1[e] = a1 * a1; }
                    pg8::u32x4 w; w.x = pg8::cvt_pk_bf16(v0[0], v0[1]); w.y = pg8::cvt_pk_bf16(v0[2], v0[3]); w.z = pg8::cvt_pk_bf16(v1[0], v1[1]); w.w = pg8::cvt_pk_bf16(v1[2], v1[3]);
                    *(pg8::u32x4*)(rowp + bj * 128) = w; } } } };
struct EpiLd { static constexpr bool PERM = true, AFTER_DRAIN = false, ROWPRE = false; const float* ssqp;
    __device__ __forceinline__ void operator()(const pg8::f32x4 (&acc)[2][2][4][2], const pg8::Unit& u, int wr, int wc, int fr, int fq, const PG8_LAS float*) const {
        const int row0 = u.pm * 256 + wr * 64 + fr;
#pragma unroll
        for (int ai = 0; ai < 2; ++ai)
#pragma unroll
            for (int m = 0; m < 4; ++m) { const int row = row0 + ai * 128 + m * 16; const pg8::f32x4* p = (const pg8::f32x4*)(ssqp + (size_t)row * 16); const pg8::f32x4 a = p[0], b = p[1], c = p[2], d = p[3];
                const float s = ((a[0] + a[1]) + (a[2] + a[3])) + ((b[0] + b[1]) + (b[2] + b[3])) + ((c[0] + c[1]) + (c[2] + c[3])) + ((d[0] + d[1]) + (d[2] + d[3]));
                const float sc = __builtin_amdgcn_rsqf(s * (1.0f / 1024.0f) + 1e-6f);
#pragma unroll
                for (int bj = 0; bj < 2; ++bj) { const pg8::f32x4 v0 = acc[ai][bj][m][0] * sc, v1 = acc[ai][bj][m][1] * sc; asm volatile("" :: "v"(v0), "v"(v1)); } } } };
constexpr int NPHASE = 14;
#define GEMM_CALL(EPI, MODE, g, S, E) pg8::gemm_phase<EPI, pg8::StaticOrder, true, true, MODE, gLDA, gLDB, gK>(ldsp, g, S, E)
__global__ void __launch_bounds__(NTHREADS, 2) mk_fwd(Args a) {
    extern __shared__ __attribute__((aligned(16))) unsigned char lds_raw[];
    LAS unsigned char* ldsp = (LAS unsigned char*)lds_raw;
    const int G = gridDim.x, bx = blockIdx.x;
    const int vcu = (G % 8 == 0) ? (bx % 8) * (G / 8) + bx / 8 : bx;
    unsigned char* ws = a.ws;
    typedef pg8::bf16_t pb;
#if MK_ONE_LAUNCH
    if (threadIdx.x < 64) ((LAS unsigned*)(ldsp + LDSCTL_OFF))[threadIdx.x] = 0u;
    __syncthreads();
    (void)xcd_barrier_post((unsigned*)(ws + WS_CTL) + 4096, (volatile LAS unsigned*)(ldsp + LDSCTL_OFF) + 8);
#define SEAM(k) do { if (a.ph_hi > 1000000) cg::this_grid().sync();   { XcdBarrier xb_; xb_.bar = (unsigned*)(a.ws + WS_CTL) + 4096; xb_.x = xb_xcc_id(); xb_.st = (volatile LAS unsigned*)(ldsp + LDSCTL_OFF) + 8; xcd_barrier(xb_); } } while (0)
#else
#define SEAM(k) do {} while (0)
#endif
    const int lo = a.ph_lo, hi = a.ph_hi;
#define IN(k) (lo <= (k) && (k) < hi)
#define PH_END(k) do { if (IN((k) + 1)) SEAM(k); } while (0)
#ifndef PROBE_MASK
#define PROBE_MASK 0
#endif
#if (PROBE_MASK >> 0) & 1
#define REP0(...) { __VA_ARGS__ } __syncthreads(); { __VA_ARGS__ }
#else
#define REP0(...) { __VA_ARGS__ }
#endif
#if (PROBE_MASK >> 1) & 1
#define REP1(...) { __VA_ARGS__ } __syncthreads(); { __VA_ARGS__ }
#else
#define REP1(...) { __VA_ARGS__ }
#endif
#if (PROBE_MASK >> 2) & 1
#define REP2(...) { __VA_ARGS__ } __syncthreads(); { __VA_ARGS__ }
#else
#define REP2(...) { __VA_ARGS__ }
#endif
#if (PROBE_MASK >> 3) & 1
#define REP3(...) { __VA_ARGS__ } __syncthreads(); { __VA_ARGS__ }
#else
#define REP3(...) { __VA_ARGS__ }
#endif
#if (PROBE_MASK >> 4) & 1
#define REP4(...) { __VA_ARGS__ } __syncthreads(); { __VA_ARGS__ }
#else
#define REP4(...) { __VA_ARGS__ }
#endif
#if (PROBE_MASK >> 5) & 1
#define REP5(...) { __VA_ARGS__ } __syncthreads(); { __VA_ARGS__ }
#else
#define REP5(...) { __VA_ARGS__ }
#endif
#if (PROBE_MASK >> 6) & 1
#define REP6(...) { __VA_ARGS__ } __syncthreads(); { __VA_ARGS__ }
#else
#define REP6(...) { __VA_ARGS__ }
#endif
#if (PROBE_MASK >> 7) & 1
#define REP7(...) { __VA_ARGS__ } __syncthreads(); { __VA_ARGS__ }
#else
#define REP7(...) { __VA_ARGS__ }
#endif
#if (PROBE_MASK >> 8) & 1
#define REP8(...) { __VA_ARGS__ } __syncthreads(); { __VA_ARGS__ }
#else
#define REP8(...) { __VA_ARGS__ }
#endif
#if (PROBE_MASK >> 9) & 1
#define REP9(...) { __VA_ARGS__ } __syncthreads(); { __VA_ARGS__ }
#else
#define REP9(...) { __VA_ARGS__ }
#endif
#if (PROBE_MASK >> 10) & 1
#define REP10(...) { __VA_ARGS__ } __syncthreads(); { __VA_ARGS__ }
#else
#define REP10(...) { __VA_ARGS__ }
#endif
#if (PROBE_MASK >> 11) & 1
#define REP11(...) { __VA_ARGS__ } __syncthreads(); { __VA_ARGS__ }
#else
#define REP11(...) { __VA_ARGS__ }
#endif
#if (PROBE_MASK >> 12) & 1
#define REP12(...) { __VA_ARGS__ } __syncthreads(); { __VA_ARGS__ }
#else
#define REP12(...) { __VA_ARGS__ }
#endif
    if (IN(0)) { REP0( p0_prologue(a, ldsp, G, vcu); __syncthreads(); ) PH_END(0); }
#if PROBE_NULL & 16
    if (IN(1)) { pg8::Gemm g{(const pb*)(ws + WS_XN), (const pb*)(ws + WS_WIN)}; constexpr int gLDA = DM, gLDB = DM, gK = DM; pg8::StaticOrder S; S.init(MTOK, NPROJ, G, bx); EpiNull E; GEMM_CALL(EpiNull, 0, g, S, E); __syncthreads(); }
#endif
    if (IN(1)) { REP1(
        { pg8::Gemm g{(const pb*)(ws + WS_XN), (const pb*)(ws + WS_WIN)}; constexpr int gLDA = DM, gLDB = DM, gK = DM; pg8::StaticOrder S; S.init(MTOK, NPROJ, G, bx);
          typedef pg8::EpiBf16S<0, 0> E_t; E_t E{(pb*)(ws + WS_PROJ), 512, 512, PROJ_STRIDE, nullptr, 1.0f}; GEMM_CALL(E_t, 0, g, S, E); }
        ) PH_END(1); }
    if (IN(2)) { REP2(
        if (G != 256 || vcu < 64) {
        { pg8::Gemm g{(const pb*)(ws + WS_MEMN), (const pb*)(ws + WS_WK)}; constexpr int gLDA = DM, gLDB = DM, gK = DM; pg8::StaticOrder S; if (G == 256) { S.init(MMEM, DM, 64, vcu); if (vcu >= 32) S.nwg = 0; } else S.init(MMEM, DM, G, bx);
          typedef pg8::EpiBf16S<0, 0> E_t; E_t E{(pb*)(ws + WS_KB), DM, 0, 0, nullptr, 1.0f}; GEMM_CALL(E_t, 0, g, S, E); }
        { pg8::Gemm g{(const pb*)(ws + WS_MEMN), (const pb*)(ws + WS_WV)}; constexpr int gLDA = DM, gLDB = DM, gK = DM; pg8::StaticOrder S; if (G == 256) { S.init(MMEM, DM, 64, vcu >= 32 ? vcu - 32 : 0); if (vcu < 32) S.nwg = 0; } else S.init(MMEM, DM, G, (bx + G / 2) % G);
          typedef pg8::EpiBf16S<0, 0> E_t; E_t E{(pb*)(ws + WS_VT), DM, 0, 0, nullptr, 1.0f}; GEMM_CALL(E_t, 0, g, S, E); }
        }
        gate_factors(a, G, vcu); filters_phase(a, ldsp, G, vcu); conv_tiles(a, ldsp, G, vcu, 64); ) PH_END(2); }
    if (IN(3)) { REP3(
        { pg8::Gemm g{(const pb*)(ws + WS_KB), (const pb*)(ws + WS_WQ)}; constexpr int gLDA = DM, gLDB = DM, gK = 256; pg8::StaticOrder S; S.init(8 * DM, DM, G / 2, vcu < G / 2 ? vcu : 0); if (vcu >= G / 2) S.nwg = 0;
          typedef pg8::EpiBf16S<0, 0> E_t; E_t E{(pb*)(ws + WS_MT), DM, 0, 0, nullptr, 1.0f}; GEMM_CALL(E_t, 4, g, S, E); }
        { pg8::Gemm g{(const pb*)(ws + WS_WO), (const pb*)(ws + WS_VT)}; constexpr int gLDA = DM, gLDB = DM, gK = 256; pg8::StaticOrder S; S.init(8 * DM, DM, G / 2, vcu >= G / 2 ? vcu - G / 2 : 0); if (vcu < G / 2) S.nwg = 0;
          typedef pg8::EpiBf16S<0, 0> E_t; E_t E{(pb*)(ws + WS_VWT), DM, 0, 0, nullptr, 1.0f}; GEMM_CALL(E_t, 5, g, S, E); }
        hyena_fft(a, ldsp, G, vcu); if (G != 256) mlstm_scan(a, ldsp, G, vcu); ) PH_END(3); }
    if (IN(4)) { REP4( mlstm_out(a, ldsp, G, vcu); hy_mix(a, G, vcu); ) PH_END(4); }
    if (IN(5)) { REP5( pg8::Gemm g{(const pb*)(ws + WS_MIXED), (const pb*)(ws + WS_WOUT)}; constexpr int gLDA = DM, gLDB = DM, gK = DM; pg8::StaticOrder S; S.init(MTOK, DM, G, bx);
          typedef pg8::EpiResid<true> E_t; E_t E{a.in[0], (pb*)(ws + WS_XN), (float*)(ws + WS_SSQ), DM}; GEMM_CALL(E_t, 0, g, S, E); ) PH_END(5); }
    if (IN(6)) { REP6( pg8::Gemm g{(const pb*)(ws + WS_XN), (const pb*)(ws + WS_MT)}; constexpr int gLDA = DM, gLDB = DM, gK = DM; pg8::StaticOrder S; S.init(MTOK, DM, G, bx);
          pg8::EpiSoftmax E{(pb*)(ws + WS_SP), DM, (LAS float*)(ldsp + LDSCTL_OFF + 1024), 0.0625f * 1.4426950408889634f, (const float*)(ws + WS_SSQ)}; GEMM_CALL(pg8::EpiSoftmax, 3, g, S, E); ) PH_END(9); }
    if (IN(10)) { pg8::Gemm g{(const pb*)(ws + WS_SP), (const pb*)(ws + WS_VWT)}; constexpr int gLDA = DM, gLDB = DM, gK = DM; pg8::StaticOrder S; S.init(MTOK, DM, G, bx);
          typedef pg8::EpiResid<false> E_t; E_t E{ws + WS_XN, (pb*)(ws + WS_XN), (float*)(ws + WS_SSQ), DM}; GEMM_CALL(E_t, 3, g, S, E); PH_END(10); }
#if PROBE_NULL & 1
    if (IN(11)) { pg8::Gemm g{(const pb*)(ws + WS_XN), (const pb*)(ws + WS_W1)}; constexpr int gLDA = DM, gLDB = DM, gK = DM; pg8::StaticOrder S; S.init(MTOK, DFF, G, bx); EpiNull E; GEMM_CALL(EpiNull, 0, g, S, E); __syncthreads(); }
#endif
#if PROBE_NULL & 4
    if (IN(11)) { pg8::Gemm g{(const pb*)(ws + WS_XN), (const pb*)(ws + WS_W1)}; constexpr int gLDA = DM, gLDB = DM, gK = DM; pg8::StaticOrder S; S.init(MTOK, DFF, G, bx); EpiFix E{(pb*)(ws + WS_YT), (bx >> 1) & 127}; GEMM_CALL(EpiFix, 0, g, S, E); __syncthreads(); }
#endif
#if PROBE_NULL & 8
    if (IN(11)) { pg8::Gemm g{(const pb*)(ws + WS_XN), (const pb*)(ws + WS_W1)}; constexpr int gLDA = DM, gLDB = DM, gK = DM; pg8::StaticOrder S; S.init(MTOK, DFF, G, bx); EpiLd E{(const float*)(ws + WS_SSQ)}; GEMM_CALL(EpiLd, 0, g, S, E); __syncthreads(); }
#endif
#if PROBE_NULL & 2
    if (IN(12)) { pg8::Gemm g{(const pb*)(ws + WS_HID), (const pb*)(ws + WS_W2)}; constexpr int gLDA = DFF, gLDB = DFF, gK = DFF; pg8::StaticOrder S; S.init(MTOK, DM, G, bx); EpiNull E; GEMM_CALL(EpiNull, 0, g, S, E); __syncthreads(); }
#endif
    if (IN(11)) { REP11( pg8::Gemm g{(const pb*)(ws + WS_XN), (const pb*)(ws + WS_W1)}; constexpr int gLDA = DM, gLDB = DM, gK = DM; pg8::StaticOrder S; S.init(MTOK, DFF, G, bx);
          typedef pg8::EpiBf16S<1, 1> E_t; E_t E{(pb*)(ws + WS_HID), DFF, 0, 0, (const float*)(ws + WS_SSQ), 1.0f}; GEMM_CALL(E_t, 0, g, S, E); ) PH_END(11); }
    if (IN(12)) { REP12( pg8::Gemm g{(const pb*)(ws + WS_HID), (const pb*)(ws + WS_W2)}; constexpr int gLDA = DFF, gLDB = DFF, gK = DFF; pg8::StaticOrder S; S.init(MTOK, DM, G, bx);
          typedef pg8::EpiResid<false> E_t; E_t E{ws + WS_XN, (pb*)(ws + WS_XN), (float*)(ws + WS_SSQ), DM}; GEMM_CALL(E_t, 0, g, S, E); ) PH_END(12); }
    if (IN(13)) { final_norm(a, G, vcu); }
}

extern "C" void kernel_launch(void* const* d_in, const int* in_sizes, int n_in, void* d_out, int out_size, void* d_ws, size_t ws_size, hipStream_t stream) {
    static int grid = 0;
    if (grid == 0) {
        if (n_in != 30 || in_sizes[0] != MTOK * DM || out_size != MTOK * DM || ws_size < WS_END) {
            fprintf(stderr, "kernel_launch: unexpected shapes (n_in %d, in0 %d, out %d, ws %zu); nothing launched\n", n_in, n_in > 0 ? in_sizes[0] : -1, out_size, ws_size); grid = -1; return; }
        int dev = 0, cus = 0, per_cu = 0;
        if (hipGetDevice(&dev) != hipSuccess || hipDeviceGetAttribute(&cus, hipDeviceAttributeMultiprocessorCount, dev) != hipSuccess) { grid = -1; return; }
        if (hipFuncSetAttribute((const void*)mk_fwd, hipFuncAttributeMaxDynamicSharedMemorySize, LDS_BYTES) != hipSuccess) { fprintf(stderr, "kernel_launch: hipFuncSetAttribute failed\n"); grid = -1; return; }
        if (hipOccupancyMaxActiveBlocksPerMultiprocessor(&per_cu, (const void*)mk_fwd, NTHREADS, LDS_BYTES) != hipSuccess || per_cu < 1) { fprintf(stderr, "kernel_launch: occupancy query says %d\n", per_cu); (void)hipGetLastError(); grid = -1; return; }
        grid = cus;
    }
    if (grid < 0) return;
    if (hipMemsetAsync((char*)d_ws + WS_CTL, 0, 65536, stream) != hipSuccess) { fprintf(stderr, "kernel_launch: hipMemsetAsync failed\n"); return; }
    Args a{};
    for (int i = 0; i < 30; ++i) a.in[i] = (const float*)d_in[i];
    a.out = (float*)d_out; a.ws = (unsigned char*)d_ws;
#if MK_ONE_LAUNCH
    a.ph_lo = 0; a.ph_hi = NPHASE;
    void* args[] = {&a};
    hipError_t e = hipLaunchCooperativeKernel((const void*)mk_fwd, dim3(grid), dim3(NTHREADS), args, LDS_BYTES, stream);
    if (e != hipSuccess) fprintf(stderr, "cooperative launch failed: %s (grid %d)\n", hipGetErrorString(e), grid);
#else
    for (int ph = 0; ph < NPHASE; ++ph) { a.ph_lo = ph; a.ph_hi = ph + 1; hipLaunchKernelGGL(mk_fwd, dim3(grid), dim3(NTHREADS), LDS_BYTES, stream, a); }
#endif
}
```

```cpp
#include <hip/hip_runtime.h>
#include <hip/hip_cooperative_groups.h>
#include <cstdio>
#include <cstdint>
namespace cg = cooperative_groups;
#ifndef ECHO_SEL
#define ECHO_SEL 0
#endif
#define ECHO_BEGIN(k) unsigned long long echo_t0_##k = 0; if (ECHO_SEL == (k)) echo_t0_##k = __builtin_amdgcn_s_memrealtime();
#define ECHO_END(k) if (ECHO_SEL == (k)) { const unsigned long long t1_ = __builtin_amdgcn_s_memrealtime(), d_ = t1_ - echo_t0_##k; while (__builtin_amdgcn_s_memrealtime() - t1_ < d_) __builtin_amdgcn_s_sleep(8); }
namespace pg8 {
#define PG8_LAS __attribute__((address_space(3)))
typedef unsigned short bf16_t;
typedef short bf16x8 __attribute__((ext_vector_type(8)));
typedef float f32x4 __attribute__((ext_vector_type(4)));
typedef unsigned u32x4 __attribute__((ext_vector_type(4)));
constexpr int BM = 256, BK = 64, HALF = 128, HTB = HALF * BK * 2  , STAGE_BYTES = 8 * HTB, NXCD = 8, WGM = 8;

__host__ __device__ __forceinline__ int lds_byte(int r, int c) { const int st = (r >> 4) * 2 + (c >> 5), rr = r & 15, cc = c & 31, ob = rr * 64 + cc * 2; return st * 1024 + (ob ^ (((ob >> 9) & 1) << 5)); }
__host__ __device__ __forceinline__ void stage_rc(int b, int& R, int& C) { const int st = b / 1024, sb = b % 1024, swz = sb ^ (((sb >> 9) & 1) << 5); R = (st >> 1) * 16 + swz / 64; C = (st & 1) * 32 + (swz % 64) / 2; }
__host__ __device__ __forceinline__ int perm32(int rho) { const int n = rho >> 4, i = rho & 15; return 8 * (i >> 2) + 4 * n + (i & 3); }

struct Unit { int pm, pn; };
struct Gemm { const bf16_t* A; const bf16_t* Bt; };
template <int MODE, int LDA> __device__ __forceinline__ size_t a_off(const Unit& u) {
    if (MODE == 0 || MODE == 3) return (size_t)u.pm * BM * LDA * 2;
    if (MODE == 4) return ((size_t)(u.pm >> 2) * BM * LDA + (size_t)(u.pm & 3) * BM) * 2;
    return ((size_t)(u.pm & 3) * BM * LDA + (size_t)u.pn * BM) * 2; }
template <int MODE, int LDB> __device__ __forceinline__ size_t b_off(const Unit& u) {
    if (MODE == 0) return (size_t)u.pn * BM * LDB * 2;
    if (MODE == 3) return ((size_t)(u.pm >> 4) * 1024 + (size_t)u.pn * BM) * LDB * 2;
    if (MODE == 4) return ((size_t)u.pn * BM * LDB + (size_t)(u.pm & 3) * BM) * 2;
    return ((size_t)(u.pm >> 2) * BM * LDB + (size_t)u.pn * BM) * 2; }

struct StaticOrder {
    int nM, nN, nwg, G, c;
    __host__ __device__ void init(int M, int N, int G_, int c_) { nM = M / BM; nN = N / BM; nwg = nM * nN; G = G_; c = c_; }
    __host__ __device__ bool next(int i, Unit& u) const {
        const long L = (long)i * G + c; if (L >= nwg) return false;
        int wgid = (int)L; { const int q = nwg / NXCD, r = nwg % NXCD, xcd = wgid % NXCD, off = wgid / NXCD; wgid = (xcd < r ? xcd * (q + 1) : r * (q + 1) + (xcd - r) * q) + off; }
        const int nig = WGM * nN, gid = wgid / nig, fm = gid * WGM, gsz = (nM - fm) < WGM ? (nM - fm) : WGM;
        u.pm = fm + ((wgid % nig) % gsz); u.pn = (wgid % nig) / gsz; return true;
    }
    __device__ __forceinline__ void a_ready(const Unit&) const {}
    __device__ __forceinline__ void done(const Unit&) const {}
};

__device__ __forceinline__ unsigned cvt_pk_bf16(float lo, float hi) { unsigned r; asm volatile("v_cvt_pk_bf16_f32 %0, %1, %2" : "=v"(r) : "v"(lo), "v"(hi)); return r; }
typedef unsigned u32x2 __attribute__((ext_vector_type(2)));
template <int ROWSCALE, int ACT> struct EpiBf16S {
    static constexpr bool PERM = true, AFTER_DRAIN = false, ROWPRE = (ROWSCALE != 0);
    bf16_t* O; int ldc; int split_cols; size_t split_stride; const float* ssqp; float mul;
    __device__ __forceinline__ void operator()(const f32x4 (&acc)[2][2][4][2], const Unit& u, int wr, int wc, int fr, int fq, const PG8_LAS float* rsl) const {
        const int row0 = u.pm * BM + wr * 64 + fr; int colt = u.pn * BM; bf16_t* base = O;
        if (split_cols) { const int t = colt / split_cols; base += (size_t)t * split_stride; colt -= t * split_cols; }
        const int col0 = colt + wc * 64 + 8 * fq;
#pragma unroll
        for (int ai = 0; ai < 2; ++ai)
#pragma unroll
            for (int m = 0; m < 4; ++m) { const int row = row0 + ai * HALF + m * 16; const float sc = ROWSCALE ? mul * rsl[ai * HALF + wr * 64 + m * 16 + fr] : mul;
                bf16_t* rowp = base + (size_t)row * ldc + col0;
#pragma unroll
                for (int bj = 0; bj < 2; ++bj) { f32x4 v0 = acc[ai][bj][m][0] * sc, v1 = acc[ai][bj][m][1] * sc;
                    if (ACT == 1) {
#pragma unroll
                        for (int e = 0; e < 4; ++e) { const float a0 = fmaxf(v0[e], 0.f), a1 = fmaxf(v1[e], 0.f); v0[e] = a0 * a0; v1[e] = a1 * a1; } }
                    u32x4 w; w.x = cvt_pk_bf16(v0[0], v0[1]); w.y = cvt_pk_bf16(v0[2], v0[3]); w.z = cvt_pk_bf16(v1[0], v1[1]); w.w = cvt_pk_bf16(v1[2], v1[3]);
                    *(u32x4*)(rowp + bj * 32) = w; } }
    }
};
struct EpiSoftmax {
    static constexpr bool PERM = true, AFTER_DRAIN = false, ROWPRE = true;
    bf16_t* O; int ldc; PG8_LAS float* xl; float c2s; const float* ssqp;
    __device__ __forceinline__ void operator()(const f32x4 (&acc)[2][2][4][2], const Unit& u, int wr, int wc, int fr, int fq, const PG8_LAS float* rsl) const {
        const int row0 = u.pm * BM + wr * 64 + fr, col0 = u.pn * BM + wc * 64 + 8 * fq;
        PG8_LAS float* pm = xl; PG8_LAS float* ps = xl + 1024;
        float mx[2][4], cr[2][4];
#pragma unroll
        for (int ai = 0; ai < 2; ++ai)
#pragma unroll
            for (int m = 0; m < 4; ++m) { float v = -3.0e38f;
#pragma unroll
                for (int bj = 0; bj < 2; ++bj)
#pragma unroll
                    for (int n = 0; n < 2; ++n) { const f32x4 x = acc[ai][bj][m][n]; v = fmaxf(v, fmaxf(fmaxf(x[0], x[1]), fmaxf(x[2], x[3]))); }
                v = fmaxf(v, __shfl_xor(v, 16)); v = fmaxf(v, __shfl_xor(v, 32));
                if (fq == 0) pm[(ai * HALF + wr * 64 + m * 16 + fr) * 4 + wc] = v; }
        asm volatile("s_waitcnt lgkmcnt(0)" ::: "memory"); __builtin_amdgcn_s_barrier(); asm volatile("" ::: "memory");
        float sm[2][4];
#pragma unroll
        for (int ai = 0; ai < 2; ++ai)
#pragma unroll
            for (int m = 0; m < 4; ++m) { const int rl = ai * HALF + wr * 64 + m * 16 + fr; const f32x4 p4 = *(const PG8_LAS f32x4*)(pm + rl * 4);
                const float mxr = fmaxf(fmaxf(p4[0], p4[1]), fmaxf(p4[2], p4[3]));
                const float c2 = c2s * rsl[rl]; cr[ai][m] = c2;
                mx[ai][m] = mxr * c2; float s = 0.f;
#pragma unroll
                for (int bj = 0; bj < 2; ++bj)
#pragma unroll
                    for (int n = 0; n < 2; ++n) { const f32x4 x = acc[ai][bj][m][n];
                        s += (__builtin_amdgcn_exp2f(x[0] * c2 - mx[ai][m]) + __builtin_amdgcn_exp2f(x[1] * c2 - mx[ai][m])) + (__builtin_amdgcn_exp2f(x[2] * c2 - mx[ai][m]) + __builtin_amdgcn_exp2f(x[3] * c2 - mx[ai][m])); }
                s += __shfl_xor(s, 16); s += __shfl_xor(s, 32);
                if (fq == 0) ps[rl * 4 + wc] = s; sm[ai][m] = 0.f; }
        asm volatile("s_waitcnt lgkmcnt(0)" ::: "memory"); __builtin_amdgcn_s_barrier(); asm volatile("" ::: "memory");
#pragma unroll
        for (int ai = 0; ai < 2; ++ai)
#pragma unroll
            for (int m = 0; m < 4; ++m) { const int rl = ai * HALF + wr * 64 + m * 16 + fr; const f32x4 s4 = *(const PG8_LAS f32x4*)(ps + rl * 4);
                const float inv = 1.0f / ((s4[0] + s4[1]) + (s4[2] + s4[3])); const float mr = mx[ai][m], c2 = cr[ai][m];
                bf16_t* rowp = O + (size_t)(row0 + ai * HALF + m * 16) * ldc + col0;
#pragma unroll
                for (int bj = 0; bj < 2; ++bj) { const f32x4 x0 = acc[ai][bj][m][0], x1 = acc[ai][bj][m][1]; u32x4 w;
                    w.x = cvt_pk_bf16(__builtin_amdgcn_exp2f(x0[0] * c2 - mr) * inv, __builtin_amdgcn_exp2f(x0[1] * c2 - mr) * inv); w.y = cvt_pk_bf16(__builtin_amdgcn_exp2f(x0[2] * c2 - mr) * inv, __builtin_amdgcn_exp2f(x0[3] * c2 - mr) * inv);
                    w.z = cvt_pk_bf16(__builtin_amdgcn_exp2f(x1[0] * c2 - mr) * inv, __builtin_amdgcn_exp2f(x1[1] * c2 - mr) * inv); w.w = cvt_pk_bf16(__builtin_amdgcn_exp2f(x1[2] * c2 - mr) * inv, __builtin_amdgcn_exp2f(x1[3] * c2 - mr) * inv);
                    *(u32x4*)(rowp + bj * 32) = w; } }
        asm volatile("s_waitcnt lgkmcnt(0)" ::: "memory"); __builtin_amdgcn_s_barrier(); asm volatile("" ::: "memory");
    }
};

template <bool BASE_F32> struct EpiResid {
    static constexpr bool PERM = true, AFTER_DRAIN = false, ROWPRE = false;
    const void* base; bf16_t* xn; float* ssqp; int ldc;
    __device__ __forceinline__ void operator()(const f32x4 (&acc)[2][2][4][2], const Unit& u, int wr, int wc, int fr, int fq, const PG8_LAS float*) const {
        const int row0 = u.pm * BM + wr * 64 + fr, col0 = u.pn * BM + wc * 64 + 8 * fq;
#pragma unroll
        for (int ai = 0; ai < 2; ++ai) {
            f32x4 bf_[4][2][2]; u32x4 bh_[4][2];
#pragma unroll
            for (int m = 0; m < 4; ++m) { const size_t off = (size_t)(row0 + ai * HALF + m * 16) * ldc + col0;
#pragma unroll
                for (int bj = 0; bj < 2; ++bj) { const size_t o2 = off + bj * 32;
                    if (BASE_F32) { bf_[m][bj][0] = *(const f32x4*)((const float*)base + o2); bf_[m][bj][1] = *(const f32x4*)((const float*)base + o2 + 4); } else bh_[m][bj] = *(const u32x4*)((const bf16_t*)base + o2); } }
#pragma unroll
            for (int m = 0; m < 4; ++m) { const int row = row0 + ai * HALF + m * 16; const size_t off = (size_t)row * ldc + col0; float ss = 0.f;
#pragma unroll
                for (int bj = 0; bj < 2; ++bj) { const size_t o2 = off + bj * 32; f32x4 b0, b1;
                    if (BASE_F32) { b0 = bf_[m][bj][0]; b1 = bf_[m][bj][1]; }
                    else { const u32x4 w = bh_[m][bj]; b0 = (f32x4){__uint_as_float(w.x << 16), __uint_as_float(w.x & 0xffff0000u), __uint_as_float(w.y << 16), __uint_as_float(w.y & 0xffff0000u)};
                           b1 = (f32x4){__uint_as_float(w.z << 16), __uint_as_float(w.z & 0xffff0000u), __uint_as_float(w.w << 16), __uint_as_float(w.w & 0xffff0000u)}; }
                    const f32x4 v0 = b0 + acc[ai][bj][m][0], v1 = b1 + acc[ai][bj][m][1];
                    ss += ((v0[0] * v0[0] + v0[1] * v0[1]) + (v0[2] * v0[2] + v0[3] * v0[3])) + ((v1[0] * v1[0] + v1[1] * v1[1]) + (v1[2] * v1[2] + v1[3] * v1[3]));
                    u32x4 w2; w2.x = cvt_pk_bf16(v0[0], v0[1]); w2.y = cvt_pk_bf16(v0[2], v0[3]); w2.z = cvt_pk_bf16(v1[0], v1[1]); w2.w = cvt_pk_bf16(v1[2], v1[3]); *(u32x4*)(xn + o2) = w2; }
                ss += __shfl_xor(ss, 16); ss += __shfl_xor(ss, 32);
                if (fq == 0) ssqp[(size_t)row * 16 + u.pn * 4 + wc] = ss; }
        }
    }
};

template <class Epi, class Sched, bool ALIGN_EPI, bool SP2, int MODE, int LDA, int LDB, int KK>
__device__ __forceinline__ void gemm_phase(PG8_LAS unsigned char* lds, const Gemm g, const Sched& S, const Epi& E) {
    const int tid = threadIdx.x, wid = __builtin_amdgcn_readfirstlane(tid >> 6), lane = tid & 63, wr = wid >> 2, wc = wid & 3, fr = lane & 15, fq = lane >> 4;
    constexpr int K = KK, nt = K / BK;
    unsigned voffA[2], voffB[2];
#pragma unroll
    for (int i = 0; i < 2; ++i) { int R, C; stage_rc(tid * 16 + i * 8192, R, C); const int Rb = (R >> 5) * 64 + perm32(R & 31);
        voffA[i] = (unsigned)(R * LDA + C) * 2u; voffB[i] = (unsigned)(Rb * LDB + C) * 2u; }
    PG8_LAS float* rsl = (PG8_LAS float*)(lds + STAGE_BYTES);
    const size_t kstep = (size_t)(BK * 2);
    const size_t hstepA = (size_t)HALF * LDA * 2, hstepB = (size_t)32 * LDB * 2;
    const unsigned ldsw = (unsigned)wid * 1024u;
    const int aoff = lds_byte(wr * 64 + fr, fq * 8), boff = lds_byte(wc * 32 + fr, fq * 8);
#define PG8_SA(b, h) (((b) * 2 + (h)) * HTB)
#define PG8_SB(b, h) ((4 + (b) * 2 + (h)) * HTB)
#define PG8_STAGE(bufoff, gbase, voff) do { _Pragma("unroll") for (int _i = 0; _i < 2; ++_i) \
        __builtin_amdgcn_global_load_lds((const unsigned*)((const char*)(gbase) + (voff)[_i]), (PG8_LAS unsigned*)(lds + (bufoff) + ldsw + _i * 8192), 16, 0, 0); } while (0)
#define PG8_LDA(dst, b, h) do { _Pragma("unroll") for (int m = 0; m < 4; ++m) _Pragma("unroll") for (int k = 0; k < 2; ++k) dst[m][k] = *(const PG8_LAS bf16x8*)(lds + PG8_SA(b, h) + aoff + m * 2048 + k * 1024); } while (0)
#define PG8_LDB(dst, b, h) do { _Pragma("unroll") for (int n = 0; n < 2; ++n) _Pragma("unroll") for (int k = 0; k < 2; ++k) dst[n][k] = *(const PG8_LAS bf16x8*)(lds + PG8_SB(b, h) + boff + n * 2048 + k * 1024); } while (0)
#define PG8_MMA(ai, bj, At, Bt) do { __builtin_amdgcn_s_setprio(1); _Pragma("unroll") for (int m = 0; m < 4; ++m) _Pragma("unroll") for (int n = 0; n < 2; ++n) _Pragma("unroll") for (int k = 0; k < 2; ++k) \
        acc[ai][bj][m][n] = __builtin_amdgcn_mfma_f32_16x16x32_bf16(Bt[n][k], At[m][k], acc[ai][bj][m][n], 0, 0, 0); __builtin_amdgcn_s_setprio(0); } while (0)
#define PG8_WAIT_V(n) asm volatile("s_waitcnt vmcnt(" #n ")" ::: "memory")
#define PG8_WAIT_L(n) asm volatile("s_waitcnt lgkmcnt(" #n ")" ::: "memory")
#define PG8_BAR __builtin_amdgcn_s_barrier()
#define PG8_SCHED __builtin_amdgcn_sched_barrier(0)
    Unit cur, nxt; int ui = 0; float rps = 0.f; typedef float f32x2 __attribute__((ext_vector_type(2))); const unsigned rpvo = (unsigned)((tid >> 1) * 16 + (tid & 1) * 8) * 4u;
    if (!S.next(0, cur)) return;
    f32x4 acc[2][2][4][2];
#pragma unroll
    for (int a = 0; a < 2; ++a)
#pragma unroll
        for (int b = 0; b < 2; ++b)
#pragma unroll
            for (int m = 0; m < 4; ++m)
#pragma unroll
                for (int n = 0; n < 2; ++n) acc[a][b][m][n] = (f32x4){0.f, 0.f, 0.f, 0.f};
    bf16x8 At[4][2], B0[2][2], B1[2][2];
    const char* cA = (const char*)g.A + a_off<MODE, LDA>(cur); const char* cB = (const char*)g.Bt + b_off<MODE, LDB>(cur);
    S.a_ready(cur);
    if constexpr (SP2) {
        PG8_STAGE(PG8_SB(0, 0), cB, voffB); PG8_STAGE(PG8_SB(0, 1), cB + hstepB, voffB); PG8_STAGE(PG8_SA(0, 0), cA, voffA); PG8_STAGE(PG8_SA(0, 1), cA + hstepA, voffA);
        if (wr == 1) PG8_BAR;
        PG8_WAIT_V(2); PG8_BAR;
        PG8_STAGE(PG8_SB(1, 0), cB + kstep, voffB); PG8_STAGE(PG8_SA(1, 0), cA + kstep, voffA); PG8_STAGE(PG8_SB(1, 1), cB + hstepB + kstep, voffB);
        PG8_WAIT_V(6); PG8_BAR;
    } else {
        PG8_STAGE(PG8_SB(0, 0), cB, voffB); PG8_STAGE(PG8_SA(0, 0), cA, voffA); PG8_STAGE(PG8_SB(0, 1), cB + hstepB, voffB); PG8_STAGE(PG8_SA(0, 1), cA + hstepA, voffA);
        if (wr == 1) PG8_BAR;
        PG8_WAIT_V(4); PG8_BAR;
        PG8_STAGE(PG8_SB(1, 0), cB + kstep, voffB); PG8_STAGE(PG8_SA(1, 0), cA + kstep, voffA); PG8_STAGE(PG8_SB(1, 1), cB + hstepB + kstep, voffB);
        PG8_WAIT_V(6); PG8_BAR;
    }
    for (;;) {
        const bool has_next = S.next(ui + 1, nxt);
        const char* nA = has_next ? (const char*)g.A + a_off<MODE, LDA>(nxt) : cA; const char* nB = has_next ? (const char*)g.Bt + b_off<MODE, LDB>(nxt) : cB;
#pragma nounroll
        for (int t = 0; t < nt; t += 2) {
            const bool last = (t == nt - 2);
            f32x2 rp = {0.f, 0.f};
            if constexpr (Epi::ROWPRE) { if (t < 8) { const float* rpb = E.ssqp + (size_t)cur.pm * (BM * 16) + t; asm volatile("global_load_dwordx2 %0, %1, %2" : "=v"(rp) : "v"(rpvo), "s"(rpb) : "memory"); } }
            const char* a1 = cA + (size_t)(t + 1) * kstep;
            const char* a2 = last ? nA : cA + (size_t)(t + 2) * kstep; const char* b2 = last ? nB : cB + (size_t)(t + 2) * kstep;
            const char* a3 = a2 + kstep; const char* b3 = b2 + kstep;
            if (last && has_next) S.a_ready(nxt);
            if constexpr (SP2) {
            PG8_LDB(B0, 0, 0); PG8_LDB(B1, 0, 1); PG8_SCHED; PG8_LDA(At, 0, 0); PG8_STAGE(PG8_SA(1, 1), a1 + hstepA, voffA);
            PG8_WAIT_V(8); PG8_WAIT_L(0); PG8_BAR; PG8_MMA(0, 0, At, B0); PG8_MMA(0, 1, At, B1); PG8_BAR; PG8_SCHED;
            PG8_LDA(At, 0, 1); PG8_STAGE(PG8_SB(0, 0), b2, voffB); PG8_STAGE(PG8_SB(0, 1), b2 + hstepB, voffB); PG8_STAGE(PG8_SA(0, 0), a2, voffA);
            PG8_WAIT_V(8); PG8_WAIT_L(0); PG8_BAR; PG8_MMA(1, 0, At, B0); PG8_MMA(1, 1, At, B1); PG8_BAR; PG8_SCHED;
            PG8_LDB(B0, 1, 0); PG8_LDB(B1, 1, 1); PG8_SCHED; PG8_LDA(At, 1, 0); PG8_STAGE(PG8_SA(0, 1), a2 + hstepA, voffA);
            PG8_WAIT_V(8); PG8_WAIT_L(0); PG8_BAR; PG8_MMA(0, 0, At, B0); PG8_MMA(0, 1, At, B1); PG8_BAR; PG8_SCHED;
            PG8_LDA(At, 1, 1); PG8_STAGE(PG8_SB(1, 0), b3, voffB); PG8_STAGE(PG8_SB(1, 1), b3 + hstepB, voffB); PG8_STAGE(PG8_SA(1, 0), a3, voffA);
            PG8_WAIT_V(8); PG8_WAIT_L(0); PG8_BAR; PG8_MMA(1, 0, At, B0); PG8_MMA(1, 1, At, B1); PG8_BAR; PG8_SCHED;
            } else {
            PG8_LDB(B0, 0, 0); PG8_SCHED; PG8_LDA(At, 0, 0); PG8_STAGE(PG8_SA(1, 1), a1 + hstepA, voffA);
            PG8_WAIT_L(8); PG8_BAR; PG8_WAIT_L(0); PG8_MMA(0, 0, At, B0); PG8_BAR; PG8_SCHED;
            PG8_LDB(B1, 0, 1); PG8_STAGE(PG8_SB(0, 0), b2, voffB);
            PG8_BAR; PG8_WAIT_L(0); PG8_MMA(0, 1, At, B1); PG8_BAR;
            PG8_LDA(At, 0, 1); PG8_STAGE(PG8_SA(0, 0), a2, voffA);
            PG8_BAR; PG8_WAIT_L(0); PG8_MMA(1, 0, At, B0); PG8_BAR; PG8_SCHED;
            PG8_STAGE(PG8_SB(0, 1), b2 + hstepB, voffB);
            PG8_WAIT_V(6); PG8_BAR; PG8_MMA(1, 1, At, B1); PG8_BAR;
            PG8_LDB(B0, 1, 0); PG8_SCHED; PG8_LDA(At, 1, 0); PG8_STAGE(PG8_SA(0, 1), a2 + hstepA, voffA);
            PG8_WAIT_L(8); PG8_BAR; PG8_WAIT_L(0); PG8_MMA(0, 0, At, B0); PG8_BAR; PG8_SCHED;
            PG8_LDB(B1, 1, 1); PG8_STAGE(PG8_SB(1, 0), b3, voffB);
            PG8_BAR; PG8_WAIT_L(0); PG8_MMA(0, 1, At, B1); PG8_BAR;
            PG8_LDA(At, 1, 1); PG8_STAGE(PG8_SA(1, 0), a3, voffA);
            PG8_BAR; PG8_WAIT_L(0); PG8_MMA(1, 0, At, B0); PG8_BAR; PG8_SCHED;
            PG8_STAGE(PG8_SB(1, 1), b3 + hstepB, voffB);
            PG8_WAIT_V(6); PG8_BAR; PG8_MMA(1, 1, At, B1); PG8_BAR;
            }
            if constexpr (Epi::ROWPRE) { if (t < 8) { asm volatile("" : "+v"(rp)); rps += rp.x + rp.y;
                if (t == 6) { float s = rps + __shfl_xor(rps, 1); if (!(tid & 1)) rsl[tid >> 1] = __builtin_amdgcn_rsqf(s * (1.0f / 1024.0f) + 1e-6f); rps = 0.f; } } }
        }
        if constexpr (ALIGN_EPI) { if (wr == 0) PG8_BAR; }
        if constexpr (!Epi::AFTER_DRAIN) { int fr_e = fr, fq_e = fq; asm volatile("" : "+v"(fr_e), "+v"(fq_e));
            { ECHO_BEGIN(20) E(acc, cur, wr, wc, fr_e, fq_e, rsl); ECHO_END(20) } S.done(cur); }
        if (!has_next) break;
#pragma unroll
        for (int a = 0; a < 2; ++a)
#pragma unroll
            for (int b = 0; b < 2; ++b)
#pragma unroll
                for (int m = 0; m < 4; ++m)
#pragma unroll
                    for (int n = 0; n < 2; ++n) acc[a][b][m][n] = (f32x4){0.f, 0.f, 0.f, 0.f};
        cur = nxt; cA = nA; cB = nB; ++ui;
        if constexpr (ALIGN_EPI) { if (wr == 1) PG8_BAR; }
    }
    PG8_WAIT_V(0);
    if constexpr (!ALIGN_EPI) { if (wr == 0) PG8_BAR; }
    PG8_BAR;
    if constexpr (Epi::AFTER_DRAIN) { E.fused(acc, cur, wr, wc, fr, fq, lds, wid, lane); S.done(cur); }
#undef PG8_SA
#undef PG8_SB
#undef PG8_STAGE
#undef PG8_LDA
#undef PG8_LDB
#undef PG8_MMA
#undef PG8_WAIT_V
#undef PG8_WAIT_L
#undef PG8_BAR
#undef PG8_SCHED
}
}

#define GAS __attribute__((address_space(1)))
#define LAS __attribute__((address_space(3)))
typedef unsigned short bf16;
typedef unsigned v4u __attribute__((ext_vector_type(4)));
typedef unsigned v2u __attribute__((ext_vector_type(2)));
typedef float f32x4 __attribute__((ext_vector_type(4)));
typedef float f32x2 __attribute__((ext_vector_type(2)));
constexpr int NWAVES = 8, NTHREADS = 512;
constexpr int NB = 8, SEQ = 4096, DM = 1024, MTOK = NB * SEQ, NMEMT = 256, MMEM = NB * NMEMT;
constexpr int DINP = 3600, NPROJ = 3584, DFF = 4096, DHY = 512, DML = 512, NHEAD = 4, DHEAD = 128;
constexpr float EPS = 1e-6f;
constexpr size_t MiB = 1u << 20;
constexpr size_t WS_CTL = 0, CTL_ZERO_BYTES = 1 * MiB;
constexpr size_t WS_WIN = 2 * MiB, WS_WOUT = 9 * MiB, WS_WQ = 11 * MiB, WS_WK = 13 * MiB, WS_WV = 15 * MiB, WS_WO = 17 * MiB, WS_W1 = 19 * MiB, WS_W2 = 27 * MiB;
constexpr size_t WS_MEMN = 35 * MiB, WS_KB = 39 * MiB, WS_VT = 43 * MiB, WS_GATES = 47 * MiB, WS_SSQ = 49 * MiB, WS_HID2 = 51 * MiB;
constexpr size_t WS_GF = 53 * MiB, WS_DEC = 55 * MiB;
constexpr size_t WS_XN = 64 * MiB;
constexpr size_t WS_QF = 64 * MiB, WS_KA = 96 * MiB;
constexpr size_t WS_PROJ = 128 * MiB, PROJ_STRIDE = (size_t)MTOK * 512;
constexpr size_t OUT_FILT = 96 * MiB;
constexpr size_t WS_HSPEC = 384 * MiB;
constexpr size_t WS_YT = 448 * MiB;
constexpr size_t WS_MIXED = 352 * MiB;
constexpr size_t WS_KF = 352 * MiB, WS_VF = 416 * MiB;
constexpr size_t WS_STATES = 128 * MiB;
constexpr size_t WS_SP = 416 * MiB, WS_HID = 192 * MiB;
constexpr size_t WS_MT = 288 * MiB, WS_VWT = 304 * MiB;
constexpr size_t WS_END = 512 * MiB;
constexpr int RING_BYTES = 131072, LDSCTL_OFF = 147456, LDS_BYTES = 163840;

__device__ __forceinline__ float bf2f(unsigned short h) { return __uint_as_float(((unsigned)h) << 16); }
__device__ __forceinline__ unsigned f2bf(float f) { unsigned u = __float_as_uint(f); return (u + 0x7fffu + ((u >> 16) & 1u)) >> 16; }
typedef __bf16 bf16x2_t __attribute__((ext_vector_type(2)));
__device__ __forceinline__ unsigned cvtpk(float lo, float hi) { const f32x2 v = {lo, hi}; const bf16x2_t b = __builtin_convertvector(v, bf16x2_t); return __builtin_bit_cast(unsigned, b); }
__device__ __forceinline__ unsigned pk2(float lo, float hi) { return cvtpk(lo, hi); }
__device__ __forceinline__ float wave_sum(float v) {
#pragma unroll
    for (int o = 1; o < 64; o <<= 1) v += __shfl_xor(v, o);
    return v;
}
#define LDS_WAIT() asm volatile("s_waitcnt lgkmcnt(0)" ::: "memory")
__device__ __forceinline__ float logsig(float x) { return fminf(x, 0.f) - log1pf(expf(-fabsf(x))); }

struct Args { const float* in[30]; float* out; unsigned char* ws; int ph_lo, ph_hi; };

typedef __amdgpu_buffer_rsrc_t rsrc_t;
typedef unsigned u32x2v __attribute__((ext_vector_type(2)));
__device__ __forceinline__ rsrc_t mkrsrc(const void* p, unsigned bytes) { return __builtin_amdgcn_make_buffer_rsrc((void*)p, 0, bytes, 0x00020000); }
__device__ __forceinline__ float bld_bf16(rsrc_t r, unsigned off) { return bf2f(__builtin_amdgcn_raw_buffer_load_b16(r, off, 0, 0)); }
__device__ __forceinline__ float bld_bf16s(rsrc_t r, unsigned off, unsigned soff) { return bf2f(__builtin_amdgcn_raw_buffer_load_b16(r, off, soff, 0)); }
__device__ __forceinline__ float bld_f32(rsrc_t r, unsigned off, unsigned soff = 0) { return __uint_as_float(__builtin_amdgcn_raw_buffer_load_b32(r, off, soff, 0)); }
typedef unsigned u32x4b __attribute__((ext_vector_type(4)));
__device__ __forceinline__ v4u bld128(rsrc_t r, unsigned voff, unsigned soff) { const u32x4b w = __builtin_amdgcn_raw_buffer_load_b128(r, voff, soff, 0); return (v4u){w.x, w.y, w.z, w.w}; }
__device__ __forceinline__ v2u bld64(rsrc_t r, unsigned voff, unsigned soff) { const u32x2v w = __builtin_amdgcn_raw_buffer_load_b64(r, voff, soff, 0); return (v2u){w.x, w.y}; }
#define P0_DISPATCH(it_, BODY) do { int r = (it_); constexpr int I_IN = 16 * 112, I_SQ = 16 * 32, I_1 = 16 * 128; \
    if (r < I_IN) { constexpr int ldw = DINP, K = DM, nblk = 112, GSPLIT = 0; const float* W = a.in[3]; bf16* WT = (bf16*)(ws + WS_WIN); const float* g = a.in[2]; BODY } \
    else if ((r -= I_IN) < I_SQ) { constexpr int ldw = DM, K = DM, nblk = 32, GSPLIT = 1; const float* W = a.in[19]; bf16* WT = (bf16*)(ws + WS_WOUT); const float* g = a.in[14]; BODY } \
    else if ((r -= I_SQ) < I_SQ) { constexpr int ldw = DM, K = DM, nblk = 32, GSPLIT = 0; const float* W = a.in[23]; bf16* WT = (bf16*)(ws + WS_WK); const float* g = a.in[21]; BODY } \
    else if ((r -= I_SQ) < I_SQ) { constexpr int ldw = DM, K = DM, nblk = 32, GSPLIT = 0; const float* W = a.in[24]; bf16* WT = (bf16*)(ws + WS_WV); const float* g = a.in[21]; BODY } \
    else if ((r -= I_SQ) < I_SQ) { constexpr int ldw = DM, K = DM, nblk = 32, GSPLIT = 0; const float* W = a.in[25]; bf16* WT = (bf16*)(ws + WS_WO); const float* g = nullptr; BODY } \
    else if ((r -= I_SQ) < I_1) { constexpr int ldw = DFF, K = DM, nblk = 128, GSPLIT = 0; const float* W = a.in[27]; bf16* WT = (bf16*)(ws + WS_W1); const float* g = a.in[26]; BODY } \
    else { r -= I_1; constexpr int ldw = DM, K = DFF, nblk = 32, GSPLIT = 0; const float* W = a.in[28]; bf16* WT = (bf16*)(ws + WS_W2); const float* g = nullptr; BODY } } while (0)
#define P0_FETCH_BODY { const int kb = r / nblk, nb = r - kb * nblk, k0 = 64 * kb, n0 = 32 * nb; (void)WT; (void)K; \
    const rsrc_t rs = mkrsrc(W + (size_t)k0 * ldw + n0, (unsigned)(64 * ldw * 4)); const unsigned vo = (unsigned)((lane >> 3) * ldw + (lane & 7) * 4) * 4u; \
    _Pragma("unroll") for (int i = 0; i < 8; ++i) buf[i] = __builtin_bit_cast(f32x4, bld128(rs, vo, (unsigned)(i * 8 * ldw * 4))); \
    if (g) { const float* gg = (GSPLIT && k0 >= 512) ? a.in[18] - 512 : g; g0 = *(const f32x4*)(gg + k0 + 8 * (lane & 7)); g1 = *(const f32x4*)(gg + k0 + 8 * (lane & 7) + 4); } else { g0 = (f32x4){1.f, 1.f, 1.f, 1.f}; g1 = g0; } }
#define P0_STORE_BODY { const int kb = r / nblk, nb = r - kb * nblk, k0 = 64 * kb, n0 = 32 * nb; (void)W; (void)g; (void)ldw; (void)GSPLIT; \
    _Pragma("unroll") for (int j = 0; j < 4; ++j) *(v4u*)(WT + (size_t)(n0 + (lane >> 3) + 8 * j) * K + k0 + 8 * (lane & 7)) = ov[j]; }
__device__ __forceinline__ void p0_prologue(const Args& a, LAS unsigned char* lds, int G, int vcu) {
    const int tid = threadIdx.x, lane = tid & 63, wave = __builtin_amdgcn_readfirstlane(tid >> 6);
    const int gw = vcu * NWAVES + wave, NGW = G * NWAVES;
    unsigned char* ws = a.ws;
#ifdef P0_TOUCH
    {
        const int g = vcu * NTHREADS + tid; float tv = 0.f;
        if (g < MTOK) tv = a.in[0][(size_t)g * DM] + ((const float*)a.out)[(size_t)g * DM];
        asm volatile("" :: "v"(tv));
    }
#endif
    ECHO_BEGIN(1)
    {
        LAS float* scr = (LAS float*)(lds + wave * 16384);
        constexpr int I_IN = 16 * 112, I_SQ = 16 * 32, I_1 = 16 * 128, I_2 = 64 * 32;
        constexpr int NITEMS = I_IN + 4 * I_SQ + I_1 + I_2;
        f32x4 buf[8], g0, g1;
        if (gw < NITEMS) P0_DISPATCH(gw, P0_FETCH_BODY);
        for (int it = gw; it < NITEMS; it += NGW) {
#pragma unroll
            for (int i = 0; i < 8; ++i) { LAS float* d = scr + (i * 8 + (lane >> 3)) * 33 + (lane & 7) * 4; d[0] = buf[i][0]; d[1] = buf[i][1]; d[2] = buf[i][2]; d[3] = buf[i][3]; }
            const f32x4 c0 = g0, c1 = g1;
            if (it + NGW < NITEMS) P0_DISPATCH(it + NGW, P0_FETCH_BODY);
            LDS_WAIT(); asm volatile("" ::: "memory");
            const int c = lane & 7; v4u ov[4];
#pragma unroll
            for (int j = 0; j < 4; ++j) { const int n = (lane >> 3) + 8 * j; const LAS float* s = scr + (8 * c) * 33 + n;
                ov[j].x = pk2(s[0 * 33] * c0[0], s[1 * 33] * c0[1]); ov[j].y = pk2(s[2 * 33] * c0[2], s[3 * 33] * c0[3]); ov[j].z = pk2(s[4 * 33] * c1[0], s[5 * 33] * c1[1]); ov[j].w = pk2(s[6 * 33] * c1[2], s[7 * 33] * c1[3]); }
            P0_DISPATCH(it, P0_STORE_BODY);
            LDS_WAIT(); asm volatile("" ::: "memory");
        }
        for (int r = gw; r < DM; r += NGW) { const float g = a.in[20][r]; const f32x4* src = (const f32x4*)(a.in[22] + (size_t)r * DM) + lane;
            unsigned long long* o8 = (unsigned long long*)((bf16*)(ws + WS_WQ) + (size_t)r * DM) + lane;
#pragma unroll
            for (int j = 0; j < 4; ++j) { const f32x4 v = src[64 * j] * g; o8[64 * j] = (unsigned long long)pk2(v[0], v[1]) | ((unsigned long long)pk2(v[2], v[3]) << 32); } }
    }
    ECHO_END(1)
    ECHO_BEGIN(2)
    __syncthreads();
    LAS v4u* frag = (LAS v4u*)lds;
#pragma unroll
    for (int e = tid; e < 32 * 64; e += NTHREADS) { const int jj = e >> 6, l = e & 63, n = l & 15, k0 = 32 * jj + 8 * (l >> 4);
        const f32x4 ga = *(const f32x4*)(a.in[2] + k0), gb = *(const f32x4*)(a.in[2] + k0 + 4); float w[8];
#pragma unroll
        for (int i = 0; i < 8; ++i) w[i] = a.in[3][(size_t)(k0 + i) * DINP + NPROJ + n] * (i < 4 ? ga[i & 3] : gb[i & 3]);
        v4u hi, lo;
#pragma unroll
        for (int i = 0; i < 4; ++i) { hi[i] = cvtpk(w[2 * i], w[2 * i + 1]); lo[i] = cvtpk(w[2 * i] - __uint_as_float(hi[i] << 16), w[2 * i + 1] - __uint_as_float(hi[i] & 0xffff0000u)); }
        frag[(jj * 2 + 0) * 64 + l] = hi; frag[(jj * 2 + 1) * 64 + l] = lo; }
    __syncthreads();
    ECHO_END(2)
    ECHO_BEGIN(3)
    {
        const int r = lane & 15, kq = lane >> 4;
        for (int blk = gw; blk < MTOK / 16; blk += NGW) {
            const int R0 = blk * 16;
            const rsrc_t rx = mkrsrc(a.in[0] + (size_t)R0 * DM, 16 * DM * 4);
            const unsigned vo = (unsigned)(r * DM + 8 * kq) * 4u;
            bf16* xo = (bf16*)(ws + WS_XN) + (size_t)(R0 + r) * DM + 8 * kq;
            f32x4 acc = {0.f, 0.f, 0.f, 0.f}; float ss = 0.f;
            f32x4 bA[8][2], bB[8][2];
#define P0_XLOAD(B_, jb) _Pragma("unroll") for (int q = 0; q < 8; ++q) { B_[q][0] = __builtin_bit_cast(f32x4, bld128(rx, vo, (unsigned)((jb) + q) * 128u)); B_[q][1] = __builtin_bit_cast(f32x4, bld128(rx, vo + 16u, (unsigned)((jb) + q) * 128u)); }
#define P0_XPROC(B_, jb) _Pragma("unroll") for (int q = 0; q < 8; ++q) { asm volatile("" ::: "memory"); const f32x4 xa = B_[q][0], xb = B_[q][1]; \
                ss += ((xa[0] * xa[0] + xa[1] * xa[1]) + (xa[2] * xa[2] + xa[3] * xa[3])) + ((xb[0] * xb[0] + xb[1] * xb[1]) + (xb[2] * xb[2] + xb[3] * xb[3])); \
                v4u hi, lo; \
                hi[0] = cvtpk(xa[0], xa[1]); hi[1] = cvtpk(xa[2], xa[3]); hi[2] = cvtpk(xb[0], xb[1]); hi[3] = cvtpk(xb[2], xb[3]); \
                lo[0] = cvtpk(xa[0] - __uint_as_float(hi[0] << 16), xa[1] - __uint_as_float(hi[0] & 0xffff0000u)); lo[1] = cvtpk(xa[2] - __uint_as_float(hi[1] << 16), xa[3] - __uint_as_float(hi[1] & 0xffff0000u)); \
                lo[2] = cvtpk(xb[0] - __uint_as_float(hi[2] << 16), xb[1] - __uint_as_float(hi[2] & 0xffff0000u)); lo[3] = cvtpk(xb[2] - __uint_as_float(hi[3] << 16), xb[3] - __uint_as_float(hi[3] & 0xffff0000u)); \
                *(v4u*)(xo + 32 * ((jb) + q)) = hi; \
                const pg8::bf16x8 wh = __builtin_bit_cast(pg8::bf16x8, frag[(((jb) + q) * 2 + 0) * 64 + lane]), wl = __builtin_bit_cast(pg8::bf16x8, frag[(((jb) + q) * 2 + 1) * 64 + lane]); \
                acc = __builtin_amdgcn_mfma_f32_16x16x32_bf16(__builtin_bit_cast(pg8::bf16x8, hi), wh, acc, 0, 0, 0); \
                acc = __builtin_amdgcn_mfma_f32_16x16x32_bf16(__builtin_bit_cast(pg8::bf16x8, lo), wh, acc, 0, 0, 0); \
                acc = __builtin_amdgcn_mfma_f32_16x16x32_bf16(__builtin_bit_cast(pg8::bf16x8, hi), wl, acc, 0, 0, 0); }
            P0_XLOAD(bA, 0) P0_XLOAD(bB, 8)
            P0_XPROC(bA, 0) P0_XLOAD(bA, 16)
            P0_XPROC(bB, 8) P0_XLOAD(bB, 24)
            P0_XPROC(bA, 16) P0_XPROC(bB, 24)
#undef P0_XLOAD
#undef P0_XPROC
            ss += __shfl_xor(ss, 16); ss += __shfl_xor(ss, 32);
            *(f32x4*)((float*)(ws + WS_SSQ) + (size_t)(R0 + r) * 16 + 4 * kq) = (f32x4){kq == 0 ? ss : 0.f, 0.f, 0.f, 0.f};
            const float rstd = __builtin_amdgcn_rsqf(ss * (1.0f / DM) + EPS);
            const float bias = a.in[17][r];
#pragma unroll
            for (int i = 0; i < 4; ++i) { float gv = acc[i] * __shfl(rstd, 4 * kq + i) + bias; if (r & 4) gv = logsig(gv); ((float*)(ws + WS_GATES))[(size_t)(R0 + 4 * kq + i) * 16 + r] = gv; }
        }
    }
    ECHO_END(3)
    ECHO_BEGIN(4)
    for (int m = gw; m < MMEM; m += NGW) {
        const f32x4* xr = (const f32x4*)(a.in[1] + (size_t)m * DM) + lane;
        f32x4 v[4]; float ss = 0.f;
#pragma unroll
        for (int j = 0; j < 4; ++j) { v[j] = xr[64 * j]; ss += (v[j][0] * v[j][0] + v[j][1] * v[j][1]) + (v[j][2] * v[j][2] + v[j][3] * v[j][3]); }
        const float rstd = 1.0f / sqrtf(wave_sum(ss) * (1.0f / DM) + EPS);
        unsigned long long* o8 = (unsigned long long*)((bf16*)(ws + WS_MEMN) + (size_t)m * DM) + lane;
#pragma unroll
        for (int j = 0; j < 4; ++j) { v[j] = v[j] * rstd; o8[64 * j] = (unsigned long long)pk2(v[j][0], v[j][1]) | ((unsigned long long)pk2(v[j][2], v[j][3]) << 32); }
    }
    ECHO_END(4)
    ECHO_BEGIN(5)
    {
        float w6[33], w9[64];
#pragma unroll
        for (int i = 0; i < 33; ++i) w6[i] = a.in[6][i * 64 + lane];
#pragma unroll
        for (int i = 0; i < 64; ++i) w9[i] = a.in[9][i * 64 + lane];
        const float b7 = a.in[7][lane], f8 = a.in[8][lane], b10 = a.in[10][lane], f11 = a.in[11][lane];
        for (int t = gw; t < SEQ; t += NGW) {
            const float tl = (float)t * (1.0f / (float)(SEQ - 1)), ang = (6.283185307179586f / (float)SEQ) * (float)t;
            const int mb = lane & 15; const float band = 1e-4f + (float)mb * ((15.0f - 1e-4f) / 15.0f); const float ph = band * ang;
            const float zf = (lane & 16) ? -sinf(ph) : cosf(ph);
            float s = tl * w6[0];
#pragma unroll
            for (int i = 0; i < 32; ++i) s += __builtin_bit_cast(float, __builtin_amdgcn_readlane(__builtin_bit_cast(int, zf), i)) * w6[1 + i];
            const float h1 = sinf(f8 * (s + b7));
            float s2 = 0.f;
#pragma unroll
            for (int i = 0; i < 64; ++i) s2 += __builtin_bit_cast(float, __builtin_amdgcn_readlane(__builtin_bit_cast(int, h1), i)) * w9[i];
            const float h2 = sinf(f11 * (s2 + b10));
            ((float*)(ws + WS_HID2))[(size_t)t * 64 + lane] = h2;
        }
    }
    ECHO_END(5)
}
__device__ __forceinline__ float sigm(float x) { return __builtin_amdgcn_rcpf(1.0f + __builtin_amdgcn_exp2f(x * -1.4426950408889634f)); }
__device__ __forceinline__ float silu(float x) { return x * sigm(x); }

__device__ __forceinline__ void filters_phase(const Args& a, LAS unsigned char* lds, int G, int vcu) {
    const int tid = threadIdx.x, lane = tid & 63, wave = __builtin_amdgcn_readfirstlane(tid >> 6);
    const int gw = vcu * NWAVES + wave, NGW = G * NWAVES;
    const float* hid2 = (const float*)(a.ws + WS_HID2); float* filt = (float*)((unsigned char*)a.out + OUT_FILT);
    LAS float* hs = (LAS float*)(lds + 73728 + wave * 4096);
    for (int item = gw; item < 32 * 256; item += NGW) {
        const int cg = item & 31, tb = item >> 5, t0 = tb * 16, ch = cg * 64 + lane, c = ch & 511;
#pragma unroll
        for (int i = 0; i < 4; ++i) *(LAS f32x4*)(hs + (lane + 64 * i) * 4) = *(const f32x4*)(hid2 + (size_t)t0 * 64 + (lane + 64 * i) * 4);
        LDS_WAIT();
        float acc[16];
#pragma unroll
        for (int i = 0; i < 16; ++i) acc[i] = 0.f;
#pragma nounroll
        for (int j4 = 0; j4 < 16; ++j4) {
            const float w0 = a.in[12][(size_t)(4 * j4 + 0) * 2048 + ch], w1 = a.in[12][(size_t)(4 * j4 + 1) * 2048 + ch], w2 = a.in[12][(size_t)(4 * j4 + 2) * 2048 + ch], w3 = a.in[12][(size_t)(4 * j4 + 3) * 2048 + ch];
#pragma unroll
            for (int i = 0; i < 16; ++i) { const f32x4 h4 = *(const LAS f32x4*)(hs + i * 64 + 4 * j4); acc[i] += (h4[0] * w0 + h4[1] * w1) + (h4[2] * w2 + h4[3] * w3); }
        }
        const float mind = -3.0701134573253944f, maxd = -15.350567286626972f;
        const float ad = fabsf(mind + (float)c * ((maxd - mind) / 511.0f));
        float* dst = filt + (size_t)ch * SEQ + t0;
#pragma unroll
        for (int i4 = 0; i4 < 4; ++i4) { f32x4 o;
#pragma unroll
            for (int e = 0; e < 4; ++e) { const float tl = (float)(t0 + 4 * i4 + e) * (1.0f / (float)(SEQ - 1)); o[e] = acc[4 * i4 + e] * expf(-tl * ad); }
            *(f32x4*)(dst + 4 * i4) = o; }
        LDS_WAIT();
    }
}
__device__ __forceinline__ void softmax_rows(const Args& a, int G, int vcu) {
    const int tid = threadIdx.x, lane = tid & 63, wave = __builtin_amdgcn_readfirstlane(tid >> 6);
    const int gw = vcu * NWAVES + wave, NGW = G * NWAVES;
    bf16* sp = (bf16*)(a.ws + WS_SP);
    for (int m = gw; m < MTOK; m += NGW) {
        v4u* p = (v4u*)(sp + (size_t)m * DM + 16 * lane);
        const v4u r0 = p[0], r1 = p[1];
        float v[16];
        const unsigned w[8] = {r0.x, r0.y, r0.z, r0.w, r1.x, r1.y, r1.z, r1.w};
        float mx = -1e30f;
#pragma unroll
        for (int e = 0; e < 8; ++e) { v[2 * e] = __uint_as_float(w[e] << 16) * 0.0625f; v[2 * e + 1] = __uint_as_float(w[e] & 0xffff0000u) * 0.0625f; mx = fmaxf(mx, fmaxf(v[2 * e], v[2 * e + 1])); }
        mx = fmaxf(mx, __shfl_xor(mx, 1)); mx = fmaxf(mx, __shfl_xor(mx, 2)); mx = fmaxf(mx, __shfl_xor(mx, 4)); mx = fmaxf(mx, __shfl_xor(mx, 8));
        float sum = 0.f;
#pragma unroll
        for (int e = 0; e < 16; ++e) { v[e] = expf(v[e] - mx); sum += v[e]; }
        sum += __shfl_xor(sum, 1); sum += __shfl_xor(sum, 2); sum += __shfl_xor(sum, 4); sum += __shfl_xor(sum, 8);
        const float inv = 1.0f / sum;
        v4u o0, o1;
        o0.x = pk2(v[0] * inv, v[1] * inv); o0.y = pk2(v[2] * inv, v[3] * inv); o0.z = pk2(v[4] * inv, v[5] * inv); o0.w = pk2(v[6] * inv, v[7] * inv);
        o1.x = pk2(v[8] * inv, v[9] * inv); o1.y = pk2(v[10] * inv, v[11] * inv); o1.z = pk2(v[12] * inv, v[13] * inv); o1.w = pk2(v[14] * inv, v[15] * inv);
        p[0] = o0; p[1] = o1;
    }
}
__device__ __forceinline__ void final_norm(const Args& a, int G, int vcu) {
    const int tid = threadIdx.x, lane = tid & 63, wave = __builtin_amdgcn_readfirstlane(tid >> 6);
    const int gw = vcu * NWAVES + wave, NGW = G * NWAVES;
    const bf16* xn = (const bf16*)(a.ws + WS_XN);
    f32x4 g4[4];
#pragma unroll
    for (int j = 0; j < 4; ++j) g4[j] = *((const f32x4*)a.in[29] + 4 * lane + j);
    for (int m = gw; m < MTOK; m += NGW) {
        const v4u* p = (const v4u*)(xn + (size_t)m * DM + 16 * lane);
        const v4u r0 = p[0], r1 = p[1];
        const unsigned w[8] = {r0.x, r0.y, r0.z, r0.w, r1.x, r1.y, r1.z, r1.w};
        float v[16]; float ss = 0.f;
#pragma unroll
        for (int e = 0; e < 8; ++e) { v[2 * e] = __uint_as_float(w[e] << 16); v[2 * e + 1] = __uint_as_float(w[e] & 0xffff0000u); ss += v[2 * e] * v[2 * e] + v[2 * e + 1] * v[2 * e + 1]; }
        const float rstd = __builtin_amdgcn_rsqf(wave_sum(ss) * (1.0f / DM) + EPS);
        f32x4* o = (f32x4*)(a.out + (size_t)m * DM + 16 * lane);
#pragma unroll
        for (int j = 0; j < 4; ++j) o[j] = (f32x4){v[4 * j] * rstd * g4[j][0], v[4 * j + 1] * rstd * g4[j][1], v[4 * j + 2] * rstd * g4[j][2], v[4 * j + 3] * rstd * g4[j][3]};
    }
}
typedef short bf16x8 __attribute__((ext_vector_type(8)));
typedef float f32x16 __attribute__((ext_vector_type(16)));
#define MFMA32(a, b, c) __builtin_amdgcn_mfma_f32_32x32x16_bf16((a), (b), (c), 0, 0, 0)
__device__ __forceinline__ int crow(int r, int h) { return (r & 3) + 8 * (r >> 2) + 4 * h; }
__device__ __forceinline__ bf16x8 scale_frag(v4u raw, float s) {
    v4u o;
#pragma unroll
    for (int e = 0; e < 4; ++e) o[e] = cvtpk(__uint_as_float(raw[e] << 16) * s, __uint_as_float(raw[e] & 0xffff0000u) * s);
    return __builtin_bit_cast(bf16x8, o);
}
__device__ __forceinline__ bf16x8 scale_frag8(v4u raw, f32x4 s0, f32x4 s1) {
    v4u o;
    o[0] = cvtpk(__uint_as_float(raw[0] << 16) * s0[0], __uint_as_float(raw[0] & 0xffff0000u) * s0[1]);
    o[1] = cvtpk(__uint_as_float(raw[1] << 16) * s0[2], __uint_as_float(raw[1] & 0xffff0000u) * s0[3]);
    o[2] = cvtpk(__uint_as_float(raw[2] << 16) * s1[0], __uint_as_float(raw[2] & 0xffff0000u) * s1[1]);
    o[3] = cvtpk(__uint_as_float(raw[3] << 16) * s1[2], __uint_as_float(raw[3] & 0xffff0000u) * s1[3]);
    return __builtin_bit_cast(bf16x8, o);
}
struct ScanCtx { f32x16 acc; v4u ar[4]; bf16x8 br[4]; float be, dc; int step; };
struct ScanEnv { const Args* a; LAS unsigned char* lds; int vcu; };
__device__ __forceinline__ void scan_load(ScanCtx& s, const ScanEnv& e, int jq, int lane, int wave) {
    const int cd = e.vcu, chain = cd >> 2, dt = cd & 3, nt = wave, b = chain >> 3, hh = (chain >> 1) & 3, dir = chain & 1;
    const int j_ = dir ? 63 - jq : jq;
    const unsigned char* ws = e.a->ws;
    const rsrc_t rva = mkrsrc((const bf16*)(ws + WS_VF) + (size_t)((b * 4 + hh) * 64) * 8192, 64 * 16384), rkb = mkrsrc((const bf16*)(ws + WS_KF) + (size_t)((b * 4 + hh) * 64) * 8192, 64 * 16384);
    const rsrc_t rgf = mkrsrc((const float*)(ws + WS_GF) + (size_t)b * SEQ * 16, SEQ * 64);
    const unsigned vo = lane * 16 + (nt < 4 ? nt : 0) * 4096, ko = lane * 16 + dt * 4096, go = lane * 64 + (hh * 4 + 2 * dir + 1) * 4;
#pragma unroll
    for (int ks = 0; ks < 4; ++ks) { s.ar[ks] = bld128(rva, vo + ks * 1024, j_ * 16384); s.br[ks] = __builtin_bit_cast(bf16x8, bld128(rkb, ko + ks * 1024, j_ * 16384)); }
    s.be = bld_f32(rgf, go, j_ * 4096); s.dc = ((const float*)(ws + WS_DEC))[(size_t)((b * 4 + hh) * 64 + j_) * 2 + dir];
}
__device__ __forceinline__ void scan_tick(ScanCtx& s, const ScanEnv& e, int lane, int wave) {
    if (wave >= 5) return;
    if (s.step >= 64) return;
    const int cd = e.vcu, chain = cd >> 2, dt = cd & 3, nt = wave, dir = chain & 1, l31 = lane & 31, h = lane >> 5;
    const int j_ = dir ? 63 - s.step : s.step;
    unsigned char* ws = e.a->ws;
    LAS float* wsc = (LAS float*)(e.lds + 139264 + wave * 256);
    bf16* ST = (bf16*)(ws + WS_STATES); bf16* NV = (bf16*)(ws + WS_STATES + 128 * MiB);
    wsc[lane] = s.be; const float decay = s.dc;
    if (nt < 4) {
        LAS unsigned short* tb = (LAS unsigned short*)(e.lds + LDSCTL_OFF + 1024 + wave * 2048) + (l31 >> 4) * 512 + (((l31 >> 3) & 1) * 32) * 8 + (l31 & 7);
#pragma unroll
        for (int r = 0; r < 16; ++r) tb[crow(r, h) * 8] = (unsigned short)(cvtpk(s.acc[r], 0.f) & 0xffffu);
        const LAS v4u* tr = (const LAS v4u*)(e.lds + LDSCTL_OFF + 1024 + wave * 2048) + lane;
        const v4u f0 = tr[0], f1 = tr[64];
        v4u* sp = (v4u*)(ST + ((size_t)(chain * 64 + j_) * 32 + nt * 8 + 2 * dt) * 512) + lane;
        sp[0] = f0; sp[64] = f1; }
    else if (h == 0) NV[(size_t)(chain * 64 + j_) * 128 + 32 * dt + l31] = (bf16)(cvtpk(s.acc[0], 0.f) & 0xffffu);
#pragma unroll
    for (int ks = 0; ks < 4; ++ks) { v4u araw = s.ar[ks]; if (nt == 4) { const unsigned w1 = (l31 == 0) ? 0x3f803f80u : 0u; araw = (v4u){w1, w1, w1, w1}; }
        const f32x4 b0 = *(const LAS f32x4*)(wsc + 16 * ks + 4 * h), b1 = *(const LAS f32x4*)(wsc + 16 * ks + 8 + 4 * h);
        s.acc = MFMA32(scale_frag8(araw, b0, b1), s.br[ks], s.acc); }
#pragma unroll
    for (int r = 0; r < 16; ++r) s.acc[r] *= decay;
    s.step += 1;
    scan_load(s, e, s.step < 64 ? s.step : 63, lane, wave);
}
__device__ __forceinline__ void scan_init(ScanCtx& s, const ScanEnv& e, int lane, int wave, bool do_scan) {
#pragma unroll
    for (int r = 0; r < 16; ++r) s.acc[r] = 0.f;
    s.step = 0;
    if (wave < 5 && do_scan) scan_load(s, e, 0, lane, wave); else { s.step = 64;
#pragma unroll
        for (int ks = 0; ks < 4; ++ks) { s.ar[ks] = (v4u){0u, 0u, 0u, 0u}; s.br[ks] = __builtin_bit_cast(bf16x8, (v4u){0u, 0u, 0u, 0u}); } s.be = 0.f; s.dc = 0.f; }
}
__device__ __forceinline__ f32x2 cmul(f32x2 a, f32x2 b) { return (f32x2){a.x * b.x - a.y * b.y, a.x * b.y + a.y * b.x}; }
__device__ __forceinline__ f32x2 cmulc(f32x2 a, f32x2 b) { return (f32x2){a.x * b.x + a.y * b.y, a.y * b.x - a.x * b.y}; }
template <bool INV> __device__ __forceinline__ void dft4(f32x2& x0, f32x2& x1, f32x2& x2, f32x2& x3) {
    const f32x2 s02 = x0 + x2, d02 = x0 - x2, s13 = x1 + x3, d13 = x1 - x3;
    const f32x2 jd = INV ? (f32x2){-d13.y, d13.x} : (f32x2){d13.y, -d13.x};
    x0 = s02 + s13; x1 = d02 + jd; x2 = s02 - s13; x3 = d02 - jd;
}
template <bool INV> __device__ __forceinline__ void fft16(f32x2 (&v)[16]) {
    constexpr float C1 = 0.9238795325112867f, S1 = 0.3826834323650898f, R2 = 0.7071067811865476f;
    constexpr float WR[10] = {1.f, C1, R2, S1, 0.f, 0.f, -R2, 0.f, 0.f, -C1};
    constexpr float WI[10] = {0.f, -S1, -R2, -C1, -1.f, 0.f, -R2, 0.f, 0.f, S1};
#pragma unroll
    for (int b = 0; b < 4; ++b) {
        dft4<INV>(v[b], v[4 + b], v[8 + b], v[12 + b]);
#pragma unroll
        for (int c = 1; c < 4; ++c) { if (b == 0) continue; const f32x2 w = {WR[b * c], INV ? -WI[b * c] : WI[b * c]}; v[4 * c + b] = cmul(v[4 * c + b], w); }
    }
    f32x2 o[16];
#pragma unroll
    for (int c = 0; c < 4; ++c) {
        f32x2 y0 = v[4 * c + 0], y1 = v[4 * c + 1], y2 = v[4 * c + 2], y3 = v[4 * c + 3];
        dft4<INV>(y0, y1, y2, y3);
        o[c] = y0; o[c + 4] = y1; o[c + 8] = y2; o[c + 12] = y3;
    }
#pragma unroll
    for (int k = 0; k < 16; ++k) v[k] = o[k];
}
__device__ __forceinline__ f32x2 w32c(int a) {
    constexpr float CR[16] = {1.f, 0.9807852804032304f, 0.9238795325112867f, 0.8314696123025452f, 0.7071067811865476f, 0.5555702330196022f, 0.3826834323650898f, 0.1950903220161283f,
                              0.f, -0.1950903220161283f, -0.3826834323650898f, -0.5555702330196022f, -0.7071067811865476f, -0.8314696123025452f, -0.9238795325112867f, -0.9807852804032304f};
    constexpr float CI[16] = {0.f, -0.1950903220161283f, -0.3826834323650898f, -0.5555702330196022f, -0.7071067811865476f, -0.8314696123025452f, -0.9238795325112867f, -0.9807852804032304f,
                              -1.f, -0.9807852804032304f, -0.9238795325112867f, -0.8314696123025452f, -0.7071067811865476f, -0.5555702330196022f, -0.3826834323650898f, -0.1950903220161283f};
    return (f32x2){CR[a], CI[a]};
}
constexpr int HY_BUF_BYTES = 34816, HY_TW1_OFF = 2 * HY_BUF_BYTES, HY_TW2_OFF = HY_TW1_OFF + 32768;
__device__ __forceinline__ void hy_fwd(LAS f32x2* hb, int half, int u, f32x2 wu, const LAS f32x2* tw1, const LAS f32x2* tw2, f32x2 (&V)[16], ScanCtx& sc, const ScanEnv& se) {
    const int sl_ = threadIdx.x & 63, sw_ = __builtin_amdgcn_readfirstlane(threadIdx.x >> 6);
    const int p1 = u + (u >> 4), p2 = 272 * (u >> 4) + (u & 15), p3 = 17 * u;
#pragma unroll
    for (int k = 0; k < 16; ++k) V[k] = hb[272 * k + p1];
    if (half) {
#pragma unroll
        for (int k = 1; k < 16; ++k) V[k] = cmul(V[k], w32c(k));
    }
    fft16<false>(V);
#pragma unroll
    for (int k = 0; k < 16; ++k) { if (k == 0 && !half) continue; V[k] = cmul(V[k], tw1[k * 256 + u]); }
#pragma unroll
    for (int k = 0; k < 16; ++k) hb[272 * k + p1] = V[k];
    __syncthreads(); scan_tick(sc, se, sl_, sw_);
#pragma unroll
    for (int k = 0; k < 16; ++k) V[k] = hb[p2 + 17 * k];
    fft16<false>(V);
#pragma unroll
    for (int k = 1; k < 16; ++k) V[k] = cmul(V[k], tw2[k * 16 + (u & 15)]);
#pragma unroll
    for (int k = 0; k < 16; ++k) hb[p2 + 17 * k] = V[k];
    __syncthreads(); scan_tick(sc, se, sl_, sw_);
#pragma unroll
    for (int k = 0; k < 16; ++k) V[k] = hb[p3 + k];
    fft16<false>(V);
}
__device__ __forceinline__ void hy_inv(LAS f32x2* hb, int half, int u, f32x2 wu, const LAS f32x2* tw1, const LAS f32x2* tw2, f32x2 (&V)[16], ScanCtx& sc, const ScanEnv& se) {
    const int sl_ = threadIdx.x & 63, sw_ = __builtin_amdgcn_readfirstlane(threadIdx.x >> 6);
    const int p1 = u + (u >> 4), p2 = 272 * (u >> 4) + (u & 15), p3 = 17 * u;
    fft16<true>(V);
#pragma unroll
    for (int k = 1; k < 16; ++k) V[k] = cmulc(V[k], tw2[k * 16 + (u & 15)]);
#pragma unroll
    for (int k = 0; k < 16; ++k) hb[p3 + k] = V[k];
    __syncthreads(); scan_tick(sc, se, sl_, sw_);
#pragma unroll
    for (int k = 0; k < 16; ++k) V[k] = hb[p2 + 17 * k];
    fft16<true>(V);
#pragma unroll
    for (int k = 0; k < 16; ++k) V[k] = cmulc(V[k], tw1[(u >> 4) * 256 + 16 * k + (u & 15)]);
#pragma unroll
    for (int k = 0; k < 16; ++k) hb[p2 + 17 * k] = V[k];
    __syncthreads(); scan_tick(sc, se, sl_, sw_);
#pragma unroll
    for (int k = 0; k < 16; ++k) V[k] = hb[272 * k + p1];
    fft16<true>(V);
    if (half) {
#pragma unroll
        for (int k = 1; k < 16; ++k) V[k] = cmulc(V[k], w32c(k));
    }
#pragma unroll
    for (int k = 0; k < 16; ++k) hb[272 * k + p1] = V[k];
}
__device__ __forceinline__ int hpos(int n) { return n + (n >> 4); }
template <int O> __device__ __forceinline__ void hy_order(const Args& a, LAS f32x2* bufE, LAS f32x2* bufO, LAS f32x2* hb, int half, int u, f32x2 wu, const LAS f32x2* t1, const LAS f32x2* tw2,
                                                          rsrc_t rH, f32x2 (&xin)[8], int c, int b0, float skip, ScanCtx& sc, const ScanEnv& se) {
    const int tid = threadIdx.x;
    const bf16* hyT = (const bf16*)a.out; bf16* yT = (bf16*)(a.ws + WS_YT);
    f32x2 V[16];
    u32x2v hw[16];
#pragma unroll
    for (int k = 0; k < 16; ++k) hw[k] = __builtin_amdgcn_raw_buffer_load_b64(rH, tid * 8, (O * 16 + k) * 4096, 0);
    __syncthreads();
    hy_fwd(hb, half, u, wu, t1, tw2, V, sc, se);
    const rsrc_t rg0 = mkrsrc(hyT + ((size_t)b0 * 1536 + 512 * (O + 1) + c) * SEQ, SEQ * 2), rg1 = mkrsrc(hyT + ((size_t)(b0 + 1) * 1536 + 512 * (O + 1) + c) * SEQ, SEQ * 2);
    unsigned short gw0[8], gw1[8];
#pragma unroll
    for (int i = 0; i < 8; ++i) { gw0[i] = __builtin_amdgcn_raw_buffer_load_b16(rg0, (tid + 512 * i) * 2, 0, 0); gw1[i] = __builtin_amdgcn_raw_buffer_load_b16(rg1, (tid + 512 * i) * 2, 0, 0); }
#pragma unroll
    for (int k = 0; k < 16; ++k) V[k] = cmul(V[k], (f32x2){__uint_as_float(hw[k].x), __uint_as_float(hw[k].y)});
    hy_inv(hb, half, u, wu, t1, tw2, V, sc, se);
    __syncthreads();
    const rsrc_t ry0 = mkrsrc(yT + ((size_t)b0 * 512 + c) * SEQ, SEQ * 2), ry1 = mkrsrc(yT + ((size_t)(b0 + 1) * 512 + c) * SEQ, SEQ * 2);
#pragma unroll
    for (int i = 0; i < 8; ++i) { const int n = tid + 512 * i, p = hpos(n);
        const f32x2 y = (bufE[p] + bufO[p]) * (1.0f / 8192.0f);
        f32x2 r; r.x = bf2f(gw0[i]) * (y.x + skip * xin[i].x); r.y = bf2f(gw1[i]) * (y.y + skip * xin[i].y);
        if (O == 0) { xin[i] = r; bufE[p] = r; bufO[p] = r; }
        else { __builtin_amdgcn_raw_buffer_store_b16((unsigned short)(cvtpk(r.x, 0.f) & 0xffffu), ry0, n * 2, 0, 0); __builtin_amdgcn_raw_buffer_store_b16((unsigned short)(cvtpk(r.y, 0.f) & 0xffffu), ry1, n * 2, 0, 0); } }
}
__device__ __forceinline__ void hyena_fft(const Args& a, LAS unsigned char* lds, int G, int vcu) {
    const int tid = threadIdx.x, half = __builtin_amdgcn_readfirstlane(tid >> 8), u = tid & 255;
    LAS f32x2* bufE = (LAS f32x2*)lds; LAS f32x2* bufO = (LAS f32x2*)(lds + HY_BUF_BYTES);
    LAS f32x2* tw1 = (LAS f32x2*)(lds + HY_TW1_OFF); LAS f32x2* tw2 = (LAS f32x2*)(lds + HY_TW2_OFF);
    LAS f32x2* hb = half ? bufO : bufE;
    LAS f32x2* tw1o = (LAS f32x2*)(lds + HY_TW2_OFF + 2048);
    const LAS f32x2* t1 = half ? tw1o : tw1;
    const bf16* hyT = (const bf16*)a.out; const float* filt = (const float*)((const unsigned char*)a.out + OUT_FILT);
    __syncthreads();
    for (int idx = tid; idx < 4096; idx += NTHREADS) { const int m = (idx & 255) * (idx >> 8); float s, c; sincospif((float)m * (1.0f / 2048.0f), &s, &c); tw1[idx] = (f32x2){c, -s};
        sincospif((float)(2 * m + (idx & 255)) * (1.0f / 4096.0f), &s, &c); tw1o[idx] = (f32x2){c, -s}; }
    if (tid < 256) { const int m = 16 * (tid & 15) * (tid >> 4); float s, c; sincospif((float)m * (1.0f / 2048.0f), &s, &c); tw2[tid] = (f32x2){c, -s}; }
    f32x2 wu; { float s, c; sincospif((float)u * (1.0f / 4096.0f), &s, &c); wu = (f32x2){c, -s}; }
    ScanCtx sc; const ScanEnv se = {&a, lds, vcu};
    { const int sl_ = tid & 63, sw_ = __builtin_amdgcn_readfirstlane(tid >> 6); scan_init(sc, se, sl_, sw_, G == 256); }
    const rsrc_t rH = mkrsrc(a.ws + WS_HSPEC + (size_t)blockIdx.x * (2 * 16 * NTHREADS * 8), 2 * 16 * NTHREADS * 8);
    for (int c = vcu; c < DHY; c += G) {
#pragma nounroll
        for (int o = 0; o < 2; ++o) {
            const rsrc_t rf = mkrsrc(filt + ((size_t)(o * 2 + 0) * 512 + c) * SEQ, SEQ * 4), rk = mkrsrc(filt + ((size_t)(o * 2 + 1) * 512 + c) * SEQ, SEQ * 4);
            __syncthreads();
#pragma unroll
            for (int i = 0; i < 8; ++i) { const int n = tid + 512 * i, p = hpos(n); const float f = bld_f32(rf, n * 4); float r = bld_f32(rk, (SEQ - n) * 4); r = (n >= 1) ? r : 0.f;
                bufE[p] = (f32x2){f + r, 0.f}; bufO[p] = (f32x2){f - r, 0.f}; }
            __syncthreads();
            f32x2 V[16];
            hy_fwd(hb, half, u, wu, t1, tw2, V, sc, se);
#pragma unroll
            for (int k = 0; k < 16; ++k) { u32x2v w; w.x = __float_as_uint(V[k].x); w.y = __float_as_uint(V[k].y); __builtin_amdgcn_raw_buffer_store_b64(w, rH, tid * 8, (o * 16 + k) * 4096, 0); }
        }
        const float skip0 = a.in[13][c], skip1 = a.in[13][512 + c];
#pragma nounroll
        for (int pr = 0; pr < 4; ++pr) {
            const int b0 = 2 * pr;
            f32x2 xin[8];
            const rsrc_t rv0 = mkrsrc(hyT + ((size_t)b0 * 1536 + c) * SEQ, SEQ * 2), rv1 = mkrsrc(hyT + ((size_t)(b0 + 1) * 1536 + c) * SEQ, SEQ * 2);
            __syncthreads();
#pragma unroll
            for (int i = 0; i < 8; ++i) { const int n = tid + 512 * i, p = hpos(n); xin[i] = (f32x2){bld_bf16(rv0, n * 2), bld_bf16(rv1, n * 2)}; bufE[p] = xin[i]; bufO[p] = xin[i]; }
            hy_order<0>(a, bufE, bufO, hb, half, u, wu, t1, tw2, rH, xin, c, b0, skip0, sc, se);
            hy_order<1>(a, bufE, bufO, hb, half, u, wu, t1, tw2, rH, xin, c, b0, skip1, sc, se);
        }
    }
    { const int sl_ = tid & 63, sw_ = __builtin_amdgcn_readfirstlane(tid >> 6); while (sc.step < 64) scan_tick(sc, se, sl_, sw_); }
    __syncthreads();
}
__device__ __forceinline__ float incl_prefix(float x, int lane) {
#pragma unroll
    for (int d = 1; d < 64; d <<= 1) { const float t = __shfl_up(x, d); if (lane >= d) x += t; }
    return x;
}
__device__ __forceinline__ float incl_suffix(float x, int lane) {
#pragma unroll
    for (int d = 1; d < 64; d <<= 1) { const float t = __shfl_down(x, d); if (lane + d < 64) x += t; }
    return x;
}
__device__ __forceinline__ void gate_factors(const Args& a, int G, int vcu) {
    const int tid = threadIdx.x, lane = tid & 63, wave = __builtin_amdgcn_readfirstlane(tid >> 6);
    const int gw = vcu * NWAVES + wave, NGW = G * NWAVES;
    const float* gates = (const float*)(a.ws + WS_GATES); float* gf = (float*)(a.ws + WS_GF); float* dec = (float*)(a.ws + WS_DEC);
    for (int task = gw; task < NB * NHEAD * 64; task += NGW) {
        const int b = task >> 8, hh = (task >> 6) & 3, j = task & 63; const size_t row = (size_t)b * SEQ + j * 64 + lane;
        const float* gp = gates + row * 16 + hh;
        const float i_f = gp[0], a_f = gp[4], i_b = gp[8], a_b = gp[12];
        const float F = incl_prefix(a_f, lane), Gs = incl_suffix(a_b, lane);
        *(f32x4*)(gf + row * 16 + hh * 4) = (f32x4){expf(F), expf(i_f - F), expf(Gs), expf(i_b - Gs)};
        if (lane == 63) dec[(size_t)task * 2] = expf(F);
        if (lane == 0) dec[(size_t)task * 2 + 1] = expf(Gs);
    }
}
__device__ __forceinline__ void mlstm_scan(const Args& a, LAS unsigned char* lds, int G, int vcu) {
    int tid = threadIdx.x; asm volatile("" : "+v"(tid));
    const int lane = tid & 63, wave = __builtin_amdgcn_readfirstlane(tid >> 6), l31 = lane & 31, h = lane >> 5;
    const int gw = wave * G + vcu, NGW = G * NWAVES;
    LAS float* wsc = (LAS float*)(lds + wave * 1024);
    const bf16* KFp = (const bf16*)(a.ws + WS_KF); const bf16* VFp = (const bf16*)(a.ws + WS_VF);
    const float* gf = (const float*)(a.ws + WS_GF); const float* dec = (const float*)(a.ws + WS_DEC); bf16* ST = (bf16*)(a.ws + WS_STATES); bf16* NV = (bf16*)(a.ws + WS_STATES + 128 * MiB);
    for (int cd = vcu; cd < 64 * 4; cd += G) { if (wave >= 5) break;
        const int chain = cd >> 2, dt = cd & 3, nt = wave;
        const int b = chain >> 3, hh = (chain >> 1) & 3, dir = chain & 1;
        f32x16 acc;
#pragma unroll
        for (int r = 0; r < 16; ++r) acc[r] = 0.f;
        const rsrc_t rva = mkrsrc(VFp + (size_t)((b * 4 + hh) * 64) * 8192, 64 * 16384), rkb = mkrsrc(KFp + (size_t)((b * 4 + hh) * 64) * 8192, 64 * 16384);
        const rsrc_t rgf = mkrsrc(gf + (size_t)b * SEQ * 16, SEQ * 64);
        const unsigned vo = lane * 16 + (nt < 4 ? nt : 0) * 4096, ko = lane * 16 + dt * 4096, go = lane * 64 + (hh * 4 + 2 * dir + 1) * 4;
        const float* dbase = dec + (size_t)((b * 4 + hh) * 64) * 2 + dir;
        const v4u ones = {0x3f803f80u, 0x3f803f80u, 0x3f803f80u, 0x3f803f80u}, zeros = {0u, 0u, 0u, 0u};
        struct Stg { v4u ar[4]; bf16x8 br[4]; float be, dc; };
#define SCAN_LOAD(S, jq) do { const int jc_ = (jq) < 0 ? 0 : ((jq) > 63 ? 63 : (jq)); const int j_ = dir ? 63 - jc_ : jc_; _Pragma("unroll") for (int ks = 0; ks < 4; ++ks) { \
            S.ar[ks] = bld128(rva, vo + ks * 1024, j_ * 16384); S.br[ks] = __builtin_bit_cast(bf16x8, bld128(rkb, ko + ks * 1024, j_ * 16384)); } S.be = bld_f32(rgf, go, j_ * 4096); S.dc = dbase[j_ * 2]; } while (0)
#define SCAN_STEP(S, jq) do { const int j_ = dir ? 63 - (jq) : (jq); \
            wsc[lane] = S.be; const float decay = S.dc; \
            if (nt < 4) { bf16* sp = ST + ((size_t)(chain * 64 + j_) * 32 + nt * 8 + 2 * dt + (l31 >> 4)) * 512 + (((l31 >> 3) & 1) * 32) * 8 + (l31 & 7); \
                _Pragma("unroll") for (int r = 0; r < 16; ++r) sp[crow(r, h) * 8] = (bf16)f2bf(acc[r]); } \
            else if (h == 0) NV[(size_t)(chain * 64 + j_) * 128 + 32 * dt + l31] = (bf16)f2bf(acc[0]);     \
            _Pragma("unroll") for (int ks = 0; ks < 4; ++ks) { v4u araw = S.ar[ks]; if (nt == 4) araw = (l31 == 0) ? ones : zeros; \
                const f32x4 b0 = *(const LAS f32x4*)(wsc + 16 * ks + 4 * h), b1 = *(const LAS f32x4*)(wsc + 16 * ks + 8 + 4 * h); \
                acc = MFMA32(scale_frag8(araw, b0, b1), S.br[ks], acc); } \
            _Pragma("unroll") for (int r = 0; r < 16; ++r) acc[r] *= decay; } while (0)
        Stg s0, s1, s2;
        SCAN_LOAD(s0, 0); SCAN_LOAD(s1, 1);
#pragma nounroll
        for (int jj = 0; jj < 63; jj += 3) {
            SCAN_LOAD(s2, jj + 2); SCAN_STEP(s0, jj);
            SCAN_LOAD(s0, jj + 3); SCAN_STEP(s1, jj + 1);
            SCAN_LOAD(s1, jj + 4); SCAN_STEP(s2, jj + 2);
        }
        SCAN_STEP(s0, 63);
#undef SCAN_LOAD
#undef SCAN_STEP
    }
}
constexpr int ML_WAVE_LDS = 18432, ML_YROW = 136;
__device__ __forceinline__ void mlstm_out(const Args& a, LAS unsigned char* lds, int G, int vcu) {
    int tid = threadIdx.x; asm volatile("" : "+v"(tid));
    const int lane = tid & 63, wave = __builtin_amdgcn_readfirstlane(tid >> 6), l31 = lane & 31, h = lane >> 5;
    const int gw = vcu * NWAVES + wave, NGW = G * NWAVES;
    LAS float* sc = (LAS float*)(lds + wave * ML_WAVE_LDS);
    LAS bf16* ybuf = (LAS bf16*)(lds + wave * ML_WAVE_LDS + 1024); LAS float* rsb = (LAS float*)(lds + wave * ML_WAVE_LDS + 1024 + 32 * ML_YROW * 2);
    LAS float* ivb = rsb + 32;
    LAS v4u* pfl = (LAS v4u*)(lds + wave * ML_WAVE_LDS + 10240) + lane;
    const unsigned char* QFp = a.ws + WS_QF; const unsigned char* KAp = a.ws + WS_KA; const unsigned char* VFp = a.ws + WS_VF;
    const bf16* om = (const bf16*)(a.ws + WS_PROJ) + 6 * PROJ_STRIDE; const float* gf = (const float*)(a.ws + WS_GF);
    const bf16* ST = (const bf16*)(a.ws + WS_STATES); const bf16* NV = (const bf16*)(a.ws + WS_STATES + 128 * MiB); bf16* mixed = (bf16*)(a.ws + WS_MIXED);
    const unsigned lo = lane * 16;
    for (int t4 = vcu * NWAVES; t4 < NB * NHEAD * 64; t4 += NGW)
    for (int rr = 0; rr < 2; ++rr) {
        const int task = t4 + rr * 4 + (wave & 3);
        const int b = task >> 8, hh = (task >> 6) & 3, j = task & 63, t0 = j * 64, row0 = b * SEQ + t0;
        { const f32x4 g4 = *(const f32x4*)(gf + (size_t)(row0 + lane) * 16 + hh * 4);
          sc[lane] = g4[0]; sc[64 + lane] = g4[1]; sc[128 + lane] = g4[2]; sc[192 + lane] = g4[3]; }
        const size_t fo = (size_t)(((b * 4 + hh) * 64 + j)) * 16384;
        const rsrc_t rq = mkrsrc(QFp + fo, 16384), rk = mkrsrc(KAp + fo, 16384), rv = mkrsrc(VFp + fo, 16384);
        const rsrc_t rs0 = mkrsrc(ST + ((size_t)(((b * 4 + hh) * 2 + 0) * 64 + j) * 32) * 512, 32768), rs1 = mkrsrc(ST + ((size_t)(((b * 4 + hh) * 2 + 1) * 64 + j) * 32) * 512, 32768);
        const rsrc_t rn0 = mkrsrc(NV + (size_t)(((b * 4 + hh) * 2 + 0) * 64 + j) * 128, 256), rn1 = mkrsrc(NV + (size_t)(((b * 4 + hh) * 2 + 1) * 64 + j) * 128, 256);
        const unsigned lon = (l31 == 0) ? (unsigned)(16 * h) : 0x40000000u;
        const rsrc_t ro = mkrsrc(om + (size_t)row0 * 512 + hh * 128, 64 * 1024), rm = mkrsrc(mixed + (size_t)row0 * DM + 512 + hh * 128, 64 * 2048);
        {
            const int ti = wave >> 2;
            const int t = 32 * ti + l31;
            v4u qf[8];
#pragma unroll
            for (int ks = 0; ks < 8; ++ks) qf[ks] = bld128(rq, lo, ti * 8192 + 1024 * ks);
            {
                f32x16 X[2];
#pragma unroll
                for (int r = 0; r < 16; ++r) { X[0][r] = 0.f; X[1][r] = 0.f; }
                v4u xa[8], xb[8];
#pragma unroll
                for (int ks = 0; ks < 8; ++ks) { xa[ks] = bld128(rk, lo, 1024 * ks); xb[ks] = bld128(rk, lo, 8192 + 1024 * ks); }
#pragma unroll
                for (int ks = 0; ks < 8; ++ks) { const bf16x8 Bq = __builtin_bit_cast(bf16x8, qf[ks]);
                    X[0] = MFMA32(__builtin_bit_cast(bf16x8, xa[ks]), Bq, X[0]); X[1] = MFMA32(__builtin_bit_cast(bf16x8, xb[ks]), Bq, X[1]); }
                asm volatile("" ::: "memory");
#pragma unroll
                for (int si = 0; si < 2; ++si)
#pragma unroll
                    for (int ss = 0; ss < 2; ++ss) {
                        v4u pf, pb;
#pragma unroll
                        for (int e = 0; e < 4; ++e) { float f2[2], b2[2];
#pragma unroll
                            for (int q2 = 0; q2 < 2; ++q2) { const int r = 8 * ss + 2 * e + q2, s = 32 * si + crow(r, h);
                                const float x = X[si][r], bef = sc[64 + s], beb = sc[192 + s];
                                const float vf = x * bef, vb = x * beb;
                                f2[q2] = (s <= t) ? vf : 0.f; b2[q2] = (s >= t) ? vb : 0.f; }
                            pf[e] = cvtpk(f2[0], f2[1]); pb[e] = cvtpk(b2[0], b2[1]); }
                        pfl[(si * 2 + ss) * 64] = pf; pfl[(4 + si * 2 + ss) * 64] = pb;
                    }
            }
            v4u F[8];
#define ML_COMP(D, RN, VO, SB, SS) do { \
        _Pragma("unroll") for (int ks = 0; ks < 8; ++ks) { D = MFMA32(__builtin_bit_cast(bf16x8, qf[ks]), __builtin_bit_cast(bf16x8, F[ks]), D); F[ks] = bld128(RN, VO, (SB) + (SS) * ks); asm volatile("" ::: "memory"); } } while (0)
#define ML_PV(vf_) do { _Pragma("unroll") for (int r = 0; r < 16; ++r) { df[r] = 0.f; db[r] = 0.f; } \
        _Pragma("unroll") for (int si = 0; si < 2; ++si) _Pragma("unroll") for (int ss = 0; ss < 2; ++ss) { const bf16x8 B_ = __builtin_bit_cast(bf16x8, vf_[si * 2 + ss]); \
            if (si <= ti) df = MFMA32(__builtin_bit_cast(bf16x8, pfl[(si * 2 + ss) * 64]), B_, df); if (si >= ti) db = MFMA32(__builtin_bit_cast(bf16x8, pfl[(4 + si * 2 + ss) * 64]), B_, db); } } while (0)
#pragma unroll
            for (int ks = 0; ks < 8; ++ks) F[ks] = bld128(rn0, lon, 32 * ks);
            asm volatile("" ::: "memory");
            {
                f32x16 df, db; v4u vfr[4];
#pragma unroll
                for (int q4 = 0; q4 < 4; ++q4) { const unsigned w1 = (l31 == 0) ? 0x3f803f80u : 0u; vfr[q4] = (v4u){w1, w1, w1, w1}; }
                ML_PV(vfr);
                ML_COMP(df, rn1, lon, 0, 32);
                ML_COMP(db, rs0, lo, 0, 1024);
#pragma unroll
                for (int r = 0; r < 16; ++r) {
                    if (l31 == 0) { const int tl = crow(r, h); const float af = sc[32 * ti + tl], ab = sc[128 + 32 * ti + tl];
                        ivb[tl] = af * __builtin_amdgcn_rcpf(fmaxf(af * fabsf(df[r]), 1.0f)); ivb[32 + tl] = ab * __builtin_amdgcn_rcpf(fmaxf(ab * fabsf(db[r]), 1.0f)); } }
            }
#pragma nounroll
            for (int nt = 0; nt < 4; ++nt) {
                const int n = 32 * nt + l31;
                f32x16 df, db;
                { v4u vfr[4];
#pragma unroll
                  for (int q4 = 0; q4 < 4; ++q4) vfr[q4] = bld128(rv, lo, nt * 4096 + q4 * 1024);
                  ML_PV(vfr); }
                ML_COMP(df, rs1, lo, nt * 8192, 1024);
                ML_COMP(db, rs0, lo, (nt < 3 ? nt + 1 : 3) * 8192, 1024);
                const unsigned oo = (unsigned)(32 * ti + 4 * h) * 1024 + 2 * n;
#pragma unroll
                for (int r = 0; r < 16; ++r) { const int tl = crow(r, h);
                    const float hv = df[r] * ivb[tl] + db[r] * ivb[32 + tl];
                    const float og = bld_bf16(ro, oo + ((r & 3) + 8 * (r >> 2)) * 1024);
                    const float y = hv * __builtin_amdgcn_rcpf(1.0f + __builtin_amdgcn_exp2f(og * -1.4426950408889634f));
                    ybuf[tl * ML_YROW + n] = (bf16)(cvtpk(y, 0.f) & 0xffffu); }
            }
#undef ML_COMP
#undef ML_PV
#pragma unroll
            for (int i = 0; i < 8; ++i) { const int idx = lane + 64 * i, tl = idx >> 4, ch = idx & 15;
                const v4u w = *(const LAS v4u*)(ybuf + tl * ML_YROW + 8 * ch); float y8[8]; float ss = 0.f;
#pragma unroll
                for (int e = 0; e < 4; ++e) { y8[2 * e] = __uint_as_float(w[e] << 16); y8[2 * e + 1] = __uint_as_float(w[e] & 0xffff0000u); ss += y8[2 * e] * y8[2 * e] + y8[2 * e + 1] * y8[2 * e + 1]; }
                ss += __shfl_xor(ss, 1); ss += __shfl_xor(ss, 2); ss += __shfl_xor(ss, 4); ss += __shfl_xor(ss, 8);
                const float rs = __builtin_amdgcn_rsqf(ss * (1.0f / 128.0f) + EPS);
                u32x4b o;
#pragma unroll
                for (int e = 0; e < 4; ++e) o[e] = cvtpk(y8[2 * e] * rs, y8[2 * e + 1] * rs);
                __builtin_amdgcn_raw_buffer_store_b128(o, rm, (unsigned)(32 * ti + tl) * 2048 + 16 * ch, 0, 0); }
        }
    }
}
constexpr int CV_WAVE_LDS = 8704;
__device__ __forceinline__ void conv_tiles(const Args& a, LAS unsigned char* lds, int G, int vcu, int nlight) {
    const int tid = threadIdx.x, lane = tid & 63, wave = __builtin_amdgcn_readfirstlane(tid >> 6);
    const int gw = vcu * NWAVES + wave, NGW = G * NWAVES;
    LAS unsigned char* raw = lds + wave * CV_WAVE_LDS;
    const bf16* proj = (const bf16*)(a.ws + WS_PROJ);
    const int g8 = lane >> 3, c8 = lane & 7;
    v4u nxt[9];
#define CV_FETCH(it_) do { const int buf_ = (it_) % 6, ct_ = ((it_) / 6) & 7, rt_ = (it_) / 48, b_ = rt_ >> 6, t0_ = (rt_ & 63) * 64; \
        const rsrc_t rs_ = mkrsrc(proj + (size_t)buf_ * PROJ_STRIDE + (size_t)b_ * SEQ * 512 + ct_ * 64, SEQ * 1024); \
        _Pragma("unroll") for (int i = 0; i < 9; ++i) { const int rr = g8 + 8 * i; nxt[i] = bld128(rs_, (unsigned)(t0_ - 1 + rr) * 1024u + c8 * 16, 0); } } while (0)

#ifndef CV_RL
#define CV_RL 9
#define CV_RH 13
#endif
    const int row_lo = (vcu < nlight) ? vcu * CV_RL : nlight * CV_RL + (vcu - nlight) * CV_RH, row_n = (G == 256) ? ((vcu < nlight) ? CV_RL : CV_RH) : 0;
    if (G != 256) {   }
    int item = (G == 256) ? row_lo * 8 + wave : gw; const int istep = (G == 256) ? 8 : NGW; const int iend = (G == 256) ? (row_lo + row_n) * 8 : 6 * 8 * 512;
    if (item < iend) CV_FETCH(item);
    for (; item < iend; item += istep) {
        const int buf = item % 6, ct = (item / 6) & 7, rt = item / 48, b = rt >> 6, t0 = (rt & 63) * 64;
#pragma unroll
        for (int i = 0; i < 9; ++i) { const int rr = g8 + 8 * i;
            if (rr < 66) *(LAS v4u*)(raw + rr * 128 + c8 * 16) = nxt[i]; }
        if (item + istep < iend) CV_FETCH(item + istep);
        LDS_WAIT();
        if (buf == 3 || buf == 4) {
            const float* cw = a.in[15] + (buf - 3) * 512 + ct * 64 + c8 * 8; const float* cb = a.in[16] + (buf - 3) * 512 + ct * 64 + c8 * 8;
            float w0[8], w1[8], w2[8], bb[8];
#pragma unroll
            for (int e = 0; e < 8; ++e) { w0[e] = cw[e]; w1[e] = cw[1024 + e]; w2[e] = cw[2048 + e]; bb[e] = cb[e]; }
            unsigned char* dst = a.ws + (buf == 3 ? WS_QF : WS_KA) + (size_t)(((b * 4 + (ct >> 1)) * 64 + (rt & 63))) * 16384 + (((ct & 1) * 4 + (c8 >> 1)) * 64 + (c8 & 1) * 32) * 16;
            const float sc = (buf == 3) ? 1.0f : 0.08838834764831845f;
#pragma unroll
            for (int i = 0; i < 8; ++i) { const int r = g8 + 8 * i;
                const v4u x0 = *(const LAS v4u*)(raw + r * 128 + c8 * 16), x1 = *(const LAS v4u*)(raw + (r + 1) * 128 + c8 * 16), x2 = *(const LAS v4u*)(raw + (r + 2) * 128 + c8 * 16);
                v4u o;
#pragma unroll
                for (int e = 0; e < 4; ++e) {
                    const float lo = bb[2 * e] + __uint_as_float(x0[e] << 16) * w0[2 * e] + __uint_as_float(x1[e] << 16) * w1[2 * e] + __uint_as_float(x2[e] << 16) * w2[2 * e];
                    const float hi = bb[2 * e + 1] + __uint_as_float(x0[e] & 0xffff0000u) * w0[2 * e + 1] + __uint_as_float(x1[e] & 0xffff0000u) * w1[2 * e + 1] + __uint_as_float(x2[e] & 0xffff0000u) * w2[2 * e + 1];
                    o[e] = cvtpk(silu(lo) * sc, silu(hi) * sc); }
                *(v4u*)(dst + ((r >> 5) * 8 * 64 + (r & 31)) * 16) = o; }
        }
        if (buf != 3) {
            const LAS bf16* col = (const LAS bf16*)raw + lane;
            float w0 = 0.f, w1 = 1.f, w2 = 0.f, bb = 0.f, sc = 1.f; unsigned char* dstf = nullptr;
            if (buf >= 3) { if (buf == 4) { const int ch = 512 + ct * 64 + lane; w0 = a.in[15][ch]; w1 = a.in[15][1024 + ch]; w2 = a.in[15][2048 + ch]; bb = a.in[16][ch]; sc = 0.08838834764831845f; }
                   const int dd = (ct & 1) * 64 + lane;
                   dstf = a.ws + (buf == 4 ? WS_KF : WS_VF) + (size_t)(((b * 4 + (ct >> 1)) * 64 + (rt & 63))) * 16384 + ((dd >> 5) * 4 * 64 + (dd & 31)) * 16; }
            if (buf < 3) {
                const int cs = lane >> 3, tg = lane & 7;
#pragma unroll
                for (int i = 0; i < 8; ++i) { const int cc = cs + 8 * i, ch = buf * 512 + ct * 64 + cc;
                    const float w0 = a.in[4][ch], w1 = a.in[4][1536 + ch], w2 = a.in[4][3072 + ch], bb = a.in[5][ch];
                    const LAS bf16* col = (const LAS bf16*)raw + cc;
                    float x[10];
#pragma unroll
                    for (int e = 0; e < 10; ++e) x[e] = bf2f(col[(8 * tg + e) * 64]);
                    v4u o;
#pragma unroll
                    for (int e = 0; e < 4; ++e) o[e] = cvtpk(bb + x[2 * e] * w0 + x[2 * e + 1] * w1 + x[2 * e + 2] * w2, bb + x[2 * e + 1] * w0 + x[2 * e + 2] * w1 + x[2 * e + 3] * w2);
                    *(v4u*)((bf16*)a.out + ((size_t)b * 1536 + ch) * SEQ + t0 + 8 * tg) = o; }
            } else {
#pragma unroll
            for (int tg = 0; tg < 8; ++tg) {
                float x[10];
#pragma unroll
                for (int e = 0; e < 10; ++e) x[e] = bf2f(col[(8 * tg + e) * 64]);
                float y[8];
#pragma unroll
                for (int e = 0; e < 8; ++e) { float v = bb + x[e] * w0 + x[e + 1] * w1 + x[e + 2] * w2; if (buf == 4) v = silu(v) * sc; y[e] = v; }
                {
                    unsigned char* pz = dstf + ((tg >> 1) * 64) * 16 + 8 * (tg & 1);
                    *(v2u*)(pz) = (v2u){cvtpk(y[0], y[1]), cvtpk(y[2], y[3])}; *(v2u*)(pz + 32 * 16) = (v2u){cvtpk(y[4], y[5]), cvtpk(y[6], y[7])}; }
            }
            }
        }
        LDS_WAIT();
    }
#undef CV_FETCH
}
__device__ __forceinline__ void hy_mix(const Args& a, int G, int vcu) {
    int tid = threadIdx.x; asm volatile("" : "+v"(tid));
    const int lane = tid & 63, wave = __builtin_amdgcn_readfirstlane(tid >> 6);
    const int gw = vcu * NWAVES + wave, NGW = G * NWAVES;
    const bf16* yT = (const bf16*)(a.ws + WS_YT); bf16* mixed = (bf16*)(a.ws + WS_MIXED);
    for (int item = gw; item < NB * 8 * 64; item += NGW) {
        const int tt = item & 63, g = (item >> 6) & 7, b = item >> 9, t0 = tt * 64;
        const rsrc_t ry = mkrsrc(yT + ((size_t)b * 512 + g * 64) * SEQ + t0, 64 * SEQ * 2);
        float v[64]; float ss = 0.f;
#pragma unroll
        for (int c = 0; c < 64; ++c) { v[c] = bld_bf16s(ry, lane * 2, c * (SEQ * 2)); ss += v[c] * v[c]; }
        const float rs = __builtin_amdgcn_rsqf(ss * (1.0f / 64.0f) + EPS);
        bf16* dst = mixed + (size_t)(b * SEQ + t0 + lane) * DM + g * 64;
#pragma unroll
        for (int i = 0; i < 8; ++i) { v4u o; o.x = cvtpk(v[8 * i] * rs, v[8 * i + 1] * rs); o.y = cvtpk(v[8 * i + 2] * rs, v[8 * i + 3] * rs);
            o.z = cvtpk(v[8 * i + 4] * rs, v[8 * i + 5] * rs); o.w = cvtpk(v[8 * i + 6] * rs, v[8 * i + 7] * rs); *(v4u*)(dst + 8 * i) = o; }
    }
}
typedef GAS unsigned gu32;
#define XB_TMO      128
#define XB_XCNT(j)  (256  + 64 * (j))
#define XB_XSUB(j)  (1280 + 64 * (j))
#define XB_XGEN(j)  (2304 + 64 * (j))
#define XB_TOP      3328
#define XB_TOPGEN   3392
#define XCD_BAR_WORDS 3456
#define XB_SPIN_CAP (1u << 18)

__device__ __forceinline__ unsigned xb_ld(unsigned* p)              { return __hip_atomic_load(p, __ATOMIC_RELAXED, __HIP_MEMORY_SCOPE_AGENT); }
__device__ __forceinline__ unsigned xb_add(unsigned* p, unsigned v) { return __hip_atomic_fetch_add(p, v, __ATOMIC_RELAXED, __HIP_MEMORY_SCOPE_AGENT); }
__device__ __forceinline__ unsigned xb_xcc_id() { return (unsigned)__builtin_amdgcn_s_getreg((3 << 11) | 20) & 0xFu; }
#define XB_SPIN(cond, bar) do { unsigned _sp = 0; while (cond) { __builtin_amdgcn_s_sleep(1); \
    if ((++_sp & 255u) == 0u) { if (xb_ld(&(bar)[XB_TMO])) break; if (_sp > XB_SPIN_CAP) { atomicAdd(&(bar)[XB_TMO], 1u); break; } } } } while (0)

struct XcdBarrier {
    unsigned* bar; unsigned x;
    volatile LAS unsigned* st;
};

__device__ __forceinline__ XcdBarrier xcd_barrier_post(unsigned* bar, volatile LAS unsigned* st) {
    XcdBarrier b; b.bar = bar; b.x = xb_xcc_id(); b.st = st;
    if (threadIdx.x == 0) (void)xb_add(&bar[XB_XCNT(b.x)], 1u);
    return b;
}
__device__ __forceinline__ void xcd_barrier_complete(unsigned* bar, unsigned x, unsigned& nloc, unsigned& nx) {
    const unsigned G = gridDim.x * gridDim.y * gridDim.z;
    unsigned sum, cnt, mine, sp = 0u;
    for (;;) {
        sum = 0u; cnt = 0u; mine = 0u;
#pragma unroll
        for (unsigned j = 0; j < 16; ++j) { const unsigned c = xb_ld(&bar[XB_XCNT(j)]); sum += c; cnt += (c > 0u) ? 1u : 0u; mine = (j == x) ? c : mine; }
        if (sum == G) break;
        __builtin_amdgcn_s_sleep(1);
        if ((++sp & 255u) == 0u) { if (xb_ld(&bar[XB_TMO])) break; if (sp > XB_SPIN_CAP) { atomicAdd(&bar[XB_TMO], 1u); break; } }
    }
    nloc = mine > 0u ? mine : 1u; nx = cnt > 0u ? cnt : 1u;
}

__device__ __forceinline__ void xcd_barrier(const XcdBarrier& b) {
    asm volatile("s_waitcnt vmcnt(0)" ::: "memory");
    __syncthreads();
    if (threadIdx.x == 0) {
        unsigned* bar = b.bar;
        __builtin_amdgcn_s_waitcnt(0);
        unsigned nloc = b.st[0], nx = b.st[1];
        if (nloc == 0u) { xcd_barrier_complete(bar, b.x, nloc, nx); b.st[0] = nloc; b.st[1] = nx; }
        const unsigned old = xb_add(&bar[XB_XSUB(b.x)], 1u);
        const unsigned gen = old / nloc;
        if (old + 1u == (gen + 1u) * nloc) {
            __builtin_amdgcn_fence(__ATOMIC_RELEASE, "agent");
            asm volatile("s_waitcnt vmcnt(0)" ::: "memory");
            const unsigned og = xb_add(&bar[XB_TOP], 1u);
            const unsigned tg = og / nx;
            if (og + 1u == (tg + 1u) * nx) xb_add(&bar[XB_TOPGEN], 1u);
            else XB_SPIN(xb_ld(&bar[XB_TOPGEN]) == tg, bar);
            __builtin_amdgcn_fence(__ATOMIC_ACQUIRE, "agent");
            xb_add(&bar[XB_XGEN(b.x)], 1u);
            asm volatile("s_waitcnt vmcnt(0)" ::: "memory");
        } else {
            XB_SPIN(xb_ld(&bar[XB_XGEN(b.x)]) == gen, bar);
            __builtin_amdgcn_fence(__ATOMIC_ACQUIRE, "agent");
            asm volatile("s_waitcnt vmcnt(0)" ::: "memory");
        }
    }
    __syncthreads();
}

#ifndef MK_ONE_LAUNCH
#define MK_ONE_LAUNCH 1
#endif
#ifndef PROBE_NULL
#define PROBE_NULL 0
#endif
struct EpiNull { static constexpr bool PERM = true, AFTER_DRAIN = false, ROWPRE = false;
    __device__ __forceinline__ void operator()(const pg8::f32x4 (&acc)[2][2][4][2], const pg8::Unit& u, int wr, int wc, int fr, int fq, const PG8_LAS float*) const {
#pragma unroll
        for (int i = 0; i < 32; ++i) asm volatile("" :: "v"(acc[i >> 4][(i >> 3) & 1][(i >> 1) & 3][i & 1])); } };
struct EpiFix { static constexpr bool PERM = true, AFTER_DRAIN = false, ROWPRE = false; pg8::bf16_t* O; int rb;
    __device__ __forceinline__ void operator()(const pg8::f32x4 (&acc)[2][2][4][2], const pg8::Unit& u, int wr, int wc, int fr, int fq, const PG8_LAS float*) const {
        const int row0 = rb * 256 + wr * 64 + fr, col0 = wc * 32 + 8 * fq;
#pragma unroll
        for (int ai = 0; ai < 2; ++ai)
#pragma unroll
            for (int m = 0; m < 4; ++m) { pg8::bf16_t* rowp = O + (size_t)(row0 + ai * 128 + m * 16) * 256 + col0;
#pragma unroll
                for (int bj = 0; bj < 2; ++bj) { pg8::f32x4 v0 = acc[ai][bj][m][0], v1 = acc[ai][bj][m][1];
#pragma unroll
                    for (int e = 0; e < 4; ++e) { const float a0 = fmaxf(v0[e], 0.f), a1 = fmaxf(v1[e], 0.f); v0[e] = a0 * a0; v1[e] = a1 * a1; }
                    pg8::u32x4 w; w.x = pg8::cvt_pk_bf16(v0[0], v0[1]); w.y = pg8::cvt_pk_bf16(v0[2], v0[3]); w.z = pg8::cvt_pk_bf16(v1[0], v1[1]); w.w = pg8::cvt_pk_bf16(v1[2], v1[3]);
                    *(pg8::u32x4*)(rowp + bj * 128) = w; } } } };
struct EpiLd { static constexpr bool PERM = true, AFTER_DRAIN = false, ROWPRE = false; const float* ssqp;
    __device__ __forceinline__ void operator()(const pg8::f32x4 (&acc)[2][2][4][2], const pg8::Unit& u, int wr, int wc, int fr, int fq, const PG8_LAS float*) const {
        const int row0 = u.pm * 256 + wr * 64 + fr;
#pragma unroll
        for (int ai = 0; ai < 2; ++ai)
#pragma unroll
            for (int m = 0; m < 4; ++m) { const int row = row0 + ai * 128 + m * 16; const pg8::f32x4* p = (const pg8::f32x4*)(ssqp + (size_t)row * 16); const pg8::f32x4 a = p[0], b = p[1], c = p[2], d = p[3];
                const float s = ((a[0] + a[1]) + (a[2] + a[3])) + ((b[0] + b[1]) + (b[2] + b[3])) + ((c[0] + c[1]) + (c[2] + c[3])) + ((d[0] + d[1]) + (d[2] + d[3]));
                const float sc = __builtin_amdgcn_rsqf(s * (1.0f / 1024.0f) + 1e-6f);
#pragma unroll
                for (int bj = 0; bj < 2; ++bj) { const pg8::f32x4 v0 = acc[ai][bj][m][0] * sc, v1 = acc[ai][bj][m][1] * sc; asm volatile("" :: "v"(v0), "v"(v1)); } } } };
constexpr int NPHASE = 14;
#define GEMM_CALL(EPI, MODE, g, S, E) pg8::gemm_phase<EPI, pg8::StaticOrder, true, true, MODE, gLDA, gLDB, gK>(ldsp, g, S, E)
__global__ void __launch_bounds__(NTHREADS, 2) mk_fwd(Args a) {
    extern __shared__ __attribute__((aligned(16))) unsigned char lds_raw[];
    LAS unsigned char* ldsp = (LAS unsigned char*)lds_raw;
    const int G = gridDim.x, bx = blockIdx.x;
    const int vcu = (G % 8 == 0) ? (bx % 8) * (G / 8) + bx / 8 : bx;
    unsigned char* ws = a.ws;
    typedef pg8::bf16_t pb;
#if MK_ONE_LAUNCH
    if (threadIdx.x < 64) ((LAS unsigned*)(ldsp + LDSCTL_OFF))[threadIdx.x] = 0u;
    __syncthreads();
    (void)xcd_barrier_post((unsigned*)(ws + WS_CTL) + 4096, (volatile LAS unsigned*)(ldsp + LDSCTL_OFF) + 8);
#define SEAM(k) do { if (a.ph_hi > 1000000) cg::this_grid().sync();   { XcdBarrier xb_; xb_.bar = (unsigned*)(a.ws + WS_CTL) + 4096; xb_.x = xb_xcc_id(); xb_.st = (volatile LAS unsigned*)(ldsp + LDSCTL_OFF) + 8; xcd_barrier(xb_); } } while (0)
#else
#define SEAM(k) do {} while (0)
#endif
    const int lo = a.ph_lo, hi = a.ph_hi;
#define IN(k) (lo <= (k) && (k) < hi)
#ifndef ECHOB_SEL
#define ECHOB_SEL (-1)
#endif
#define PH_END(k) do { if (IN((k) + 1)) { unsigned long long eb0_ = 0; if (ECHOB_SEL == (k)) eb0_ = __builtin_amdgcn_s_memrealtime(); SEAM(k); \
    if (ECHOB_SEL == (k)) { const unsigned long long t1_ = __builtin_amdgcn_s_memrealtime(), d_ = t1_ - eb0_; while (__builtin_amdgcn_s_memrealtime() - t1_ < d_) __builtin_amdgcn_s_sleep(8); } } } while (0)
#ifndef PROBE_MASK
#define PROBE_MASK 0
#endif
#if (PROBE_MASK >> 0) & 1
#define REP0(...) { __VA_ARGS__ } __syncthreads(); { __VA_ARGS__ }
#else
#define REP0(...) { __VA_ARGS__ }
#endif
#if (PROBE_MASK >> 1) & 1
#define REP1(...) { __VA_ARGS__ } __syncthreads(); { __VA_ARGS__ }
#else
#define REP1(...) { __VA_ARGS__ }
#endif
#if (PROBE_MASK >> 2) & 1
#define REP2(...) { __VA_ARGS__ } __syncthreads(); { __VA_ARGS__ }
#else
#define REP2(...) { __VA_ARGS__ }
#endif
#if (PROBE_MASK >> 3) & 1
#define REP3(...) { __VA_ARGS__ } __syncthreads(); { __VA_ARGS__ }
#else
#define REP3(...) { __VA_ARGS__ }
#endif
#if (PROBE_MASK >> 4) & 1
#define REP4(...) { __VA_ARGS__ } __syncthreads(); { __VA_ARGS__ }
#else
#define REP4(...) { __VA_ARGS__ }
#endif
#if (PROBE_MASK >> 5) & 1
#define REP5(...) { __VA_ARGS__ } __syncthreads(); { __VA_ARGS__ }
#else
#define REP5(...) { __VA_ARGS__ }
#endif
#if (PROBE_MASK >> 6) & 1
#define REP6(...) { __VA_ARGS__ } __syncthreads(); { __VA_ARGS__ }
#else
#define REP6(...) { __VA_ARGS__ }
#endif
#if (PROBE_MASK >> 7) & 1
#define REP7(...) { __VA_ARGS__ } __syncthreads(); { __VA_ARGS__ }
#else
#define REP7(...) { __VA_ARGS__ }
#endif
#if (PROBE_MASK >> 8) & 1
#define REP8(...) { __VA_ARGS__ } __syncthreads(); { __VA_ARGS__ }
#else
#define REP8(...) { __VA_ARGS__ }
#endif
#if (PROBE_MASK >> 9) & 1
#define REP9(...) { __VA_ARGS__ } __syncthreads(); { __VA_ARGS__ }
#else
#define REP9(...) { __VA_ARGS__ }
#endif
#if (PROBE_MASK >> 10) & 1
#define REP10(...) { __VA_ARGS__ } __syncthreads(); { __VA_ARGS__ }
#else
#define REP10(...) { __VA_ARGS__ }
#endif
#if (PROBE_MASK >> 11) & 1
#define REP11(...) { __VA_ARGS__ } __syncthreads(); { __VA_ARGS__ }
#else
#define REP11(...) { __VA_ARGS__ }
#endif
#if (PROBE_MASK >> 12) & 1
#define REP12(...) { __VA_ARGS__ } __syncthreads(); { __VA_ARGS__ }
#else
#define REP12(...) { __VA_ARGS__ }
#endif
    if (IN(0)) { REP0( p0_prologue(a, ldsp, G, vcu); __syncthreads(); ) PH_END(0); }
#if PROBE_NULL & 16
    if (IN(1)) { pg8::Gemm g{(const pb*)(ws + WS_XN), (const pb*)(ws + WS_WIN)}; constexpr int gLDA = DM, gLDB = DM, gK = DM; pg8::StaticOrder S; S.init(MTOK, NPROJ, G, bx); EpiNull E; GEMM_CALL(EpiNull, 0, g, S, E); __syncthreads(); }
#endif
    if (IN(1)) { REP1(
        { pg8::Gemm g{(const pb*)(ws + WS_XN), (const pb*)(ws + WS_WIN)}; constexpr int gLDA = DM, gLDB = DM, gK = DM; pg8::StaticOrder S; S.init(MTOK, NPROJ, G, bx);
          typedef pg8::EpiBf16S<1, 0> E_t; E_t E{(pb*)(ws + WS_PROJ), 512, 512, PROJ_STRIDE, (const float*)(ws + WS_SSQ), 1.0f}; GEMM_CALL(E_t, 0, g, S, E); }
        ) PH_END(1); }
    if (IN(2)) { REP2(
        if (G != 256 || vcu < 64) {
        { pg8::Gemm g{(const pb*)(ws + WS_MEMN), (const pb*)(ws + WS_WK)}; constexpr int gLDA = DM, gLDB = DM, gK = DM; pg8::StaticOrder S; if (G == 256) { S.init(MMEM, DM, 64, vcu); if (vcu >= 32) S.nwg = 0; } else S.init(MMEM, DM, G, bx);
          typedef pg8::EpiBf16S<0, 0> E_t; E_t E{(pb*)(ws + WS_KB), DM, 0, 0, nullptr, 1.0f}; GEMM_CALL(E_t, 0, g, S, E); }
        { pg8::Gemm g{(const pb*)(ws + WS_MEMN), (const pb*)(ws + WS_WV)}; constexpr int gLDA = DM, gLDB = DM, gK = DM; pg8::StaticOrder S; if (G == 256) { S.init(MMEM, DM, 64, vcu >= 32 ? vcu - 32 : 0); if (vcu < 32) S.nwg = 0; } else S.init(MMEM, DM, G, (bx + G / 2) % G);
          typedef pg8::EpiBf16S<0, 0> E_t; E_t E{(pb*)(ws + WS_VT), DM, 0, 0, nullptr, 1.0f}; GEMM_CALL(E_t, 0, g, S, E); }
        }
        { ECHO_BEGIN(11) gate_factors(a, G, vcu); ECHO_END(11) } { ECHO_BEGIN(12) filters_phase(a, ldsp, G, vcu); ECHO_END(12) } { ECHO_BEGIN(13) conv_tiles(a, ldsp, G, vcu, 64); ECHO_END(13) } ) PH_END(2); }
    if (IN(3)) { REP3(
        { pg8::Gemm g{(const pb*)(ws + WS_KB), (const pb*)(ws + WS_WQ)}; constexpr int gLDA = DM, gLDB = DM, gK = 256; pg8::StaticOrder S; S.init(8 * DM, DM, G / 2, vcu < G / 2 ? vcu : 0); if (vcu >= G / 2) S.nwg = 0;
          typedef pg8::EpiBf16S<0, 0> E_t; E_t E{(pb*)(ws + WS_MT), DM, 0, 0, nullptr, 1.0f}; GEMM_CALL(E_t, 4, g, S, E); }
        { pg8::Gemm g{(const pb*)(ws + WS_WO), (const pb*)(ws + WS_VT)}; constexpr int gLDA = DM, gLDB = DM, gK = 256; pg8::StaticOrder S; S.init(8 * DM, DM, G / 2, vcu >= G / 2 ? vcu - G / 2 : 0); if (vcu < G / 2) S.nwg = 0;
          typedef pg8::EpiBf16S<0, 0> E_t; E_t E{(pb*)(ws + WS_VWT), DM, 0, 0, nullptr, 1.0f}; GEMM_CALL(E_t, 5, g, S, E); }
        { ECHO_BEGIN(15) hyena_fft(a, ldsp, G, vcu); ECHO_END(15) } if (G != 256) mlstm_scan(a, ldsp, G, vcu); ) PH_END(3); }
    if (IN(4)) { REP4( { ECHO_BEGIN(16) mlstm_out(a, ldsp, G, vcu); ECHO_END(16) } { ECHO_BEGIN(17) hy_mix(a, G, vcu); ECHO_END(17) } ) PH_END(4); }
    if (IN(5)) { REP5( pg8::Gemm g{(const pb*)(ws + WS_MIXED), (const pb*)(ws + WS_WOUT)}; constexpr int gLDA = DM, gLDB = DM, gK = DM; pg8::StaticOrder S; S.init(MTOK, DM, G, bx);
          typedef pg8::EpiResid<true> E_t; E_t E{a.in[0], (pb*)(ws + WS_XN), (float*)(ws + WS_SSQ), DM}; GEMM_CALL(E_t, 0, g, S, E); ) PH_END(5); }
    if (IN(6)) { REP6( pg8::Gemm g{(const pb*)(ws + WS_XN), (const pb*)(ws + WS_MT)}; constexpr int gLDA = DM, gLDB = DM, gK = DM; pg8::StaticOrder S; S.init(MTOK, DM, G, bx);
          pg8::EpiSoftmax E{(pb*)(ws + WS_SP), DM, (LAS float*)(ldsp + LDSCTL_OFF + 1024), 0.0625f * 1.4426950408889634f, (const float*)(ws + WS_SSQ)}; GEMM_CALL(pg8::EpiSoftmax, 3, g, S, E); ) PH_END(9); }
    if (IN(10)) { pg8::Gemm g{(const pb*)(ws + WS_SP), (const pb*)(ws + WS_VWT)}; constexpr int gLDA = DM, gLDB = DM, gK = DM; pg8::StaticOrder S; S.init(MTOK, DM, G, bx);
          typedef pg8::EpiResid<false> E_t; E_t E{ws + WS_XN, (pb*)(ws + WS_XN), (float*)(ws + WS_SSQ), DM}; GEMM_CALL(E_t, 3, g, S, E); PH_END(10); }
#if PROBE_NULL & 1
    if (IN(11)) { pg8::Gemm g{(const pb*)(ws + WS_XN), (const pb*)(ws + WS_W1)}; constexpr int gLDA = DM, gLDB = DM, gK = DM; pg8::StaticOrder S; S.init(MTOK, DFF, G, bx); EpiNull E; GEMM_CALL(EpiNull, 0, g, S, E); __syncthreads(); }
#endif
#if PROBE_NULL & 4
    if (IN(11)) { pg8::Gemm g{(const pb*)(ws + WS_XN), (const pb*)(ws + WS_W1)}; constexpr int gLDA = DM, gLDB = DM, gK = DM; pg8::StaticOrder S; S.init(MTOK, DFF, G, bx); EpiFix E{(pb*)(ws + WS_YT), (bx >> 1) & 127}; GEMM_CALL(EpiFix, 0, g, S, E); __syncthreads(); }
#endif
#if PROBE_NULL & 8
    if (IN(11)) { pg8::Gemm g{(const pb*)(ws + WS_XN), (const pb*)(ws + WS_W1)}; constexpr int gLDA = DM, gLDB = DM, gK = DM; pg8::StaticOrder S; S.init(MTOK, DFF, G, bx); EpiLd E{(const float*)(ws + WS_SSQ)}; GEMM_CALL(EpiLd, 0, g, S, E); __syncthreads(); }
#endif
#if PROBE_NULL & 2
    if (IN(12)) { pg8::Gemm g{(const pb*)(ws + WS_HID), (const pb*)(ws + WS_W2)}; constexpr int gLDA = DFF, gLDB = DFF, gK = DFF; pg8::StaticOrder S; S.init(MTOK, DM, G, bx); EpiNull E; GEMM_CALL(EpiNull, 0, g, S, E); __syncthreads(); }
#endif
    if (IN(11)) { REP11( pg8::Gemm g{(const pb*)(ws + WS_XN), (const pb*)(ws + WS_W1)}; constexpr int gLDA = DM, gLDB = DM, gK = DM; pg8::StaticOrder S; S.init(MTOK, DFF, G, bx);
          typedef pg8::EpiBf16S<1, 1> E_t; E_t E{(pb*)(ws + WS_HID), DFF, 0, 0, (const float*)(ws + WS_SSQ), 1.0f}; GEMM_CALL(E_t, 0, g, S, E); ) PH_END(11); }
    if (IN(12)) { REP12( pg8::Gemm g{(const pb*)(ws + WS_HID), (const pb*)(ws + WS_W2)}; constexpr int gLDA = DFF, gLDB = DFF, gK = DFF; pg8::StaticOrder S; S.init(MTOK, DM, G, bx);
          typedef pg8::EpiResid<false> E_t; E_t E{ws + WS_XN, (pb*)(ws + WS_XN), (float*)(ws + WS_SSQ), DM}; GEMM_CALL(E_t, 0, g, S, E); ) PH_END(12); }
    if (IN(13)) { ECHO_BEGIN(18) final_norm(a, G, vcu); ECHO_END(18) }
}

extern "C" void kernel_launch(void* const* d_in, const int* in_sizes, int n_in, void* d_out, int out_size, void* d_ws, size_t ws_size, hipStream_t stream) {
    static int grid = 0;
    if (grid == 0) {
        if (n_in != 30 || in_sizes[0] != MTOK * DM || out_size != MTOK * DM || ws_size < WS_END) {
            fprintf(stderr, "kernel_launch: unexpected shapes (n_in %d, in0 %d, out %d, ws %zu); nothing launched\n", n_in, n_in > 0 ? in_sizes[0] : -1, out_size, ws_size); grid = -1; return; }
        int dev = 0, cus = 0, per_cu = 0;
        if (hipGetDevice(&dev) != hipSuccess || hipDeviceGetAttribute(&cus, hipDeviceAttributeMultiprocessorCount, dev) != hipSuccess) { grid = -1; return; }
        if (hipFuncSetAttribute((const void*)mk_fwd, hipFuncAttributeMaxDynamicSharedMemorySize, LDS_BYTES) != hipSuccess) { fprintf(stderr, "kernel_launch: hipFuncSetAttribute failed\n"); grid = -1; return; }
        if (hipOccupancyMaxActiveBlocksPerMultiprocessor(&per_cu, (const void*)mk_fwd, NTHREADS, LDS_BYTES) != hipSuccess || per_cu < 1) { fprintf(stderr, "kernel_launch: occupancy query says %d\n", per_cu); (void)hipGetLastError(); grid = -1; return; }
        grid = cus;
    }
    if (grid < 0) return;
    if (hipMemsetAsync((char*)d_ws + WS_CTL, 0, 65536, stream) != hipSuccess) { fprintf(stderr, "kernel_launch: hipMemsetAsync failed\n"); return; }
    Args a{};
    for (int i = 0; i < 30; ++i) a.in[i] = (const float*)d_in[i];
    a.out = (float*)d_out; a.ws = (unsigned char*)d_ws;
#if MK_ONE_LAUNCH
    a.ph_lo = 0; a.ph_hi = NPHASE;
    void* args[] = {&a};
    hipError_t e = hipLaunchCooperativeKernel((const void*)mk_fwd, dim3(grid), dim3(NTHREADS), args, LDS_BYTES, stream);
    if (e != hipSuccess) fprintf(stderr, "cooperative launch failed: %s (grid %d)\n", hipGetErrorString(e), grid);
#else
    for (int ph = 0; ph < NPHASE; ++ph) { a.ph_lo = ph; a.ph_hi = ph + 1; hipLaunchKernelGGL(mk_fwd, dim3(grid), dim3(NTHREADS), LDS_BYTES, stream, a); }
#endif
}
```

```cpp
#include <hip/hip_runtime.h>
#include <hip/hip_cooperative_groups.h>
#include <cstdio>
#include <cstdint>
namespace cg = cooperative_groups;
#ifndef ECHO_SEL
#define ECHO_SEL 0
#endif
#define ECHO_BEGIN(k) unsigned long long echo_t0_##k = 0; if (ECHO_SEL == (k)) echo_t0_##k = __builtin_amdgcn_s_memrealtime();
#define ECHO_END(k) if (ECHO_SEL == (k)) { const unsigned long long t1_ = __builtin_amdgcn_s_memrealtime(), d_ = t1_ - echo_t0_##k; while (__builtin_amdgcn_s_memrealtime() - t1_ < d_) __builtin_amdgcn_s_sleep(8); }
namespace pg8 {
#define PG8_LAS __attribute__((address_space(3)))
typedef unsigned short bf16_t;
typedef short bf16x8 __attribute__((ext_vector_type(8)));
typedef float f32x4 __attribute__((ext_vector_type(4)));
typedef unsigned u32x4 __attribute__((ext_vector_type(4)));
constexpr int BM = 256, BK = 64, HALF = 128, HTB = HALF * BK * 2  , STAGE_BYTES = 8 * HTB, NXCD = 8, WGM = 8;

__host__ __device__ __forceinline__ int lds_byte(int r, int c) { const int st = (r >> 4) * 2 + (c >> 5), rr = r & 15, cc = c & 31, ob = rr * 64 + cc * 2; return st * 1024 + (ob ^ (((ob >> 9) & 1) << 5)); }
__host__ __device__ __forceinline__ void stage_rc(int b, int& R, int& C) { const int st = b / 1024, sb = b % 1024, swz = sb ^ (((sb >> 9) & 1) << 5); R = (st >> 1) * 16 + swz / 64; C = (st & 1) * 32 + (swz % 64) / 2; }
__host__ __device__ __forceinline__ int perm32(int rho) { const int n = rho >> 4, i = rho & 15; return 8 * (i >> 2) + 4 * n + (i & 3); }

struct Unit { int pm, pn; };
struct Gemm { const bf16_t* A; const bf16_t* Bt; };
template <int MODE, int LDA> __device__ __forceinline__ size_t a_off(const Unit& u) {
    if (MODE == 0 || MODE == 3) return (size_t)u.pm * BM * LDA * 2;
    if (MODE == 4) return ((size_t)(u.pm >> 2) * BM * LDA + (size_t)(u.pm & 3) * BM) * 2;
    return ((size_t)(u.pm & 3) * BM * LDA + (size_t)u.pn * BM) * 2; }
template <int MODE, int LDB> __device__ __forceinline__ size_t b_off(const Unit& u) {
    if (MODE == 0) return (size_t)u.pn * BM * LDB * 2;
    if (MODE == 3) return ((size_t)(u.pm >> 4) * 1024 + (size_t)u.pn * BM) * LDB * 2;
    if (MODE == 4) return ((size_t)u.pn * BM * LDB + (size_t)(u.pm & 3) * BM) * 2;
    return ((size_t)(u.pm >> 2) * BM * LDB + (size_t)u.pn * BM) * 2; }

struct StaticOrder {
    int nM, nN, nwg, G, c;
    __host__ __device__ void init(int M, int N, int G_, int c_) { nM = M / BM; nN = N / BM; nwg = nM * nN; G = G_; c = c_; }
    __host__ __device__ bool next(int i, Unit& u) const {
        const long L = (long)i * G + c; if (L >= nwg) return false;
        int wgid = (int)L; { const int q = nwg / NXCD, r = nwg % NXCD, xcd = wgid % NXCD, off = wgid / NXCD; wgid = (xcd < r ? xcd * (q + 1) : r * (q + 1) + (xcd - r) * q) + off; }
        const int nig = WGM * nN, gid = wgid / nig, fm = gid * WGM, gsz = (nM - fm) < WGM ? (nM - fm) : WGM;
        u.pm = fm + ((wgid % nig) % gsz); u.pn = (wgid % nig) / gsz; return true;
    }
    __device__ __forceinline__ void a_ready(const Unit&) const {}
    __device__ __forceinline__ void done(const Unit&) const {}
};

__device__ __forceinline__ unsigned cvt_pk_bf16(float lo, float hi) { unsigned r; asm volatile("v_cvt_pk_bf16_f32 %0, %1, %2" : "=v"(r) : "v"(lo), "v"(hi)); return r; }
typedef unsigned u32x2 __attribute__((ext_vector_type(2)));
template <int ROWSCALE, int ACT> struct EpiBf16S {
    static constexpr bool PERM = true, AFTER_DRAIN = false, ROWPRE = (ROWSCALE != 0);
    bf16_t* O; int ldc; int split_cols; size_t split_stride; const float* ssqp; float mul;
    __device__ __forceinline__ void operator()(const f32x4 (&acc)[2][2][4][2], const Unit& u, int wr, int wc, int fr, int fq, const PG8_LAS float* rsl) const {
        const int row0 = u.pm * BM + wr * 64 + fr; int colt = u.pn * BM; bf16_t* base = O;
        if (split_cols) { const int t = colt / split_cols; base += (size_t)t * split_stride; colt -= t * split_cols; }
        const int col0 = colt + wc * 64 + 8 * fq;
#pragma unroll
        for (int ai = 0; ai < 2; ++ai)
#pragma unroll
            for (int m = 0; m < 4; ++m) { const int row = row0 + ai * HALF + m * 16; const float sc = ROWSCALE ? mul * rsl[ai * HALF + wr * 64 + m * 16 + fr] : mul;
                bf16_t* rowp = base + (size_t)row * ldc + col0;
#pragma unroll
                for (int bj = 0; bj < 2; ++bj) { f32x4 v0 = acc[ai][bj][m][0] * sc, v1 = acc[ai][bj][m][1] * sc;
                    if (ACT == 1) {
#pragma unroll
                        for (int e = 0; e < 4; ++e) { const float a0 = fmaxf(v0[e], 0.f), a1 = fmaxf(v1[e], 0.f); v0[e] = a0 * a0; v1[e] = a1 * a1; } }
                    u32x4 w; w.x = cvt_pk_bf16(v0[0], v0[1]); w.y = cvt_pk_bf16(v0[2], v0[3]); w.z = cvt_pk_bf16(v1[0], v1[1]); w.w = cvt_pk_bf16(v1[2], v1[3]);
                    *(u32x4*)(rowp + bj * 32) = w; } }
    }
};
struct EpiSoftmax {
    static constexpr bool PERM = true, AFTER_DRAIN = false, ROWPRE = true;
    bf16_t* O; int ldc; PG8_LAS float* xl; float c2s; const float* ssqp;
    __device__ __forceinline__ void operator()(const f32x4 (&acc)[2][2][4][2], const Unit& u, int wr, int wc, int fr, int fq, const PG8_LAS float* rsl) const {
        const int row0 = u.pm * BM + wr * 64 + fr, col0 = u.pn * BM + wc * 64 + 8 * fq;
        PG8_LAS float* pm = xl; PG8_LAS float* ps = xl + 1024;
        float mx[2][4], cr[2][4];
#pragma unroll
        for (int ai = 0; ai < 2; ++ai)
#pragma unroll
            for (int m = 0; m < 4; ++m) { float v = -3.0e38f;
#pragma unroll
                for (int bj = 0; bj < 2; ++bj)
#pragma unroll
                    for (int n = 0; n < 2; ++n) { const f32x4 x = acc[ai][bj][m][n]; v = fmaxf(v, fmaxf(fmaxf(x[0], x[1]), fmaxf(x[2], x[3]))); }
                v = fmaxf(v, __shfl_xor(v, 16)); v = fmaxf(v, __shfl_xor(v, 32));
                if (fq == 0) pm[(ai * HALF + wr * 64 + m * 16 + fr) * 4 + wc] = v; }
        asm volatile("s_waitcnt lgkmcnt(0)" ::: "memory"); __builtin_amdgcn_s_barrier(); asm volatile("" ::: "memory");
        float sm[2][4];
#pragma unroll
        for (int ai = 0; ai < 2; ++ai)
#pragma unroll
            for (int m = 0; m < 4; ++m) { const int rl = ai * HALF + wr * 64 + m * 16 + fr; const f32x4 p4 = *(const PG8_LAS f32x4*)(pm + rl * 4);
                const float mxr = fmaxf(fmaxf(p4[0], p4[1]), fmaxf(p4[2], p4[3]));
                const float c2 = c2s * rsl[rl]; cr[ai][m] = c2;
                mx[ai][m] = mxr * c2; float s = 0.f;
#pragma unroll
                for (int bj = 0; bj < 2; ++bj)
#pragma unroll
                    for (int n = 0; n < 2; ++n) { const f32x4 x = acc[ai][bj][m][n];
                        s += (__builtin_amdgcn_exp2f(x[0] * c2 - mx[ai][m]) + __builtin_amdgcn_exp2f(x[1] * c2 - mx[ai][m])) + (__builtin_amdgcn_exp2f(x[2] * c2 - mx[ai][m]) + __builtin_amdgcn_exp2f(x[3] * c2 - mx[ai][m])); }
                s += __shfl_xor(s, 16); s += __shfl_xor(s, 32);
                if (fq == 0) ps[rl * 4 + wc] = s; sm[ai][m] = 0.f; }
        asm volatile("s_waitcnt lgkmcnt(0)" ::: "memory"); __builtin_amdgcn_s_barrier(); asm volatile("" ::: "memory");
#pragma unroll
        for (int ai = 0; ai < 2; ++ai)
#pragma unroll
            for (int m = 0; m < 4; ++m) { const int rl = ai * HALF + wr * 64 + m * 16 + fr; const f32x4 s4 = *(const PG8_LAS f32x4*)(ps + rl * 4);
                const float inv = 1.0f / ((s4[0] + s4[1]) + (s4[2] + s4[3])); const float mr = mx[ai][m], c2 = cr[ai][m];
                bf16_t* rowp = O + (size_t)(row0 + ai * HALF + m * 16) * ldc + col0;
#pragma unroll
                for (int bj = 0; bj < 2; ++bj) { const f32x4 x0 = acc[ai][bj][m][0], x1 = acc[ai][bj][m][1]; u32x4 w;
                    w.x = cvt_pk_bf16(__builtin_amdgcn_exp2f(x0[0] * c2 - mr) * inv, __builtin_amdgcn_exp2f(x0[1] * c2 - mr) * inv); w.y = cvt_pk_bf16(__builtin_amdgcn_exp2f(x0[2] * c2 - mr) * inv, __builtin_amdgcn_exp2f(x0[3] * c2 - mr) * inv);
                    w.z = cvt_pk_bf16(__builtin_amdgcn_exp2f(x1[0] * c2 - mr) * inv, __builtin_amdgcn_exp2f(x1[1] * c2 - mr) * inv); w.w = cvt_pk_bf16(__builtin_amdgcn_exp2f(x1[2] * c2 - mr) * inv, __builtin_amdgcn_exp2f(x1[3] * c2 - mr) * inv);
                    *(u32x4*)(rowp + bj * 32) = w; } }
        asm volatile("s_waitcnt lgkmcnt(0)" ::: "memory"); __builtin_amdgcn_s_barrier(); asm volatile("" ::: "memory");
    }
};

template <bool BASE_F32> struct EpiResid {
    static constexpr bool PERM = true, AFTER_DRAIN = false, ROWPRE = false;
    const void* base; bf16_t* xn; float* ssqp; int ldc;
    __device__ __forceinline__ void operator()(const f32x4 (&acc)[2][2][4][2], const Unit& u, int wr, int wc, int fr, int fq, const PG8_LAS float*) const {
        const int row0 = u.pm * BM + wr * 64 + fr, col0 = u.pn * BM + wc * 64 + 8 * fq;
#pragma unroll
        for (int ai = 0; ai < 2; ++ai) {
            f32x4 bf_[4][2][2]; u32x4 bh_[4][2];
#pragma unroll
            for (int m = 0; m < 4; ++m) { const size_t off = (size_t)(row0 + ai * HALF + m * 16) * ldc + col0;
#pragma unroll
                for (int bj = 0; bj < 2; ++bj) { const size_t o2 = off + bj * 32;
                    if (BASE_F32) { bf_[m][bj][0] = *(const f32x4*)((const float*)base + o2); bf_[m][bj][1] = *(const f32x4*)((const float*)base + o2 + 4); } else bh_[m][bj] = *(const u32x4*)((const bf16_t*)base + o2); } }
#pragma unroll
            for (int m = 0; m < 4; ++m) { const int row = row0 + ai * HALF + m * 16; const size_t off = (size_t)row * ldc + col0; float ss = 0.f;
#pragma unroll
                for (int bj = 0; bj < 2; ++bj) { const size_t o2 = off + bj * 32; f32x4 b0, b1;
                    if (BASE_F32) { b0 = bf_[m][bj][0]; b1 = bf_[m][bj][1]; }
                    else { const u32x4 w = bh_[m][bj]; b0 = (f32x4){__uint_as_float(w.x << 16), __uint_as_float(w.x & 0xffff0000u), __uint_as_float(w.y << 16), __uint_as_float(w.y & 0xffff0000u)};
                           b1 = (f32x4){__uint_as_float(w.z << 16), __uint_as_float(w.z & 0xffff0000u), __uint_as_float(w.w << 16), __uint_as_float(w.w & 0xffff0000u)}; }
                    const f32x4 v0 = b0 + acc[ai][bj][m][0], v1 = b1 + acc[ai][bj][m][1];
                    ss += ((v0[0] * v0[0] + v0[1] * v0[1]) + (v0[2] * v0[2] + v0[3] * v0[3])) + ((v1[0] * v1[0] + v1[1] * v1[1]) + (v1[2] * v1[2] + v1[3] * v1[3]));
                    u32x4 w2; w2.x = cvt_pk_bf16(v0[0], v0[1]); w2.y = cvt_pk_bf16(v0[2], v0[3]); w2.z = cvt_pk_bf16(v1[0], v1[1]); w2.w = cvt_pk_bf16(v1[2], v1[3]); *(u32x4*)(xn + o2) = w2; }
                ss += __shfl_xor(ss, 16); ss += __shfl_xor(ss, 32);
                if (fq == 0) ssqp[(size_t)row * 16 + u.pn * 4 + wc] = ss; }
        }
    }
};

template <class Epi, class Sched, bool ALIGN_EPI, bool SP2, int MODE, int LDA, int LDB, int KK>
__device__ __forceinline__ void gemm_phase(PG8_LAS unsigned char* lds, const Gemm g, const Sched& S, const Epi& E) {
    const int tid = threadIdx.x, wid = __builtin_amdgcn_readfirstlane(tid >> 6), lane = tid & 63, wr = wid >> 2, wc = wid & 3, fr = lane & 15, fq = lane >> 4;
    constexpr int K = KK, nt = K / BK;
    unsigned voffA[2], voffB[2];
#pragma unroll
    for (int i = 0; i < 2; ++i) { int R, C; stage_rc(tid * 16 + i * 8192, R, C); const int Rb = (R >> 5) * 64 + perm32(R & 31);
        voffA[i] = (unsigned)(R * LDA + C) * 2u; voffB[i] = (unsigned)(Rb * LDB + C) * 2u; }
    PG8_LAS float* rsl = (PG8_LAS float*)(lds + STAGE_BYTES);
    const size_t kstep = (size_t)(BK * 2);
    const size_t hstepA = (size_t)HALF * LDA * 2, hstepB = (size_t)32 * LDB * 2;
    const unsigned ldsw = (unsigned)wid * 1024u;
    const int aoff = lds_byte(wr * 64 + fr, fq * 8), boff = lds_byte(wc * 32 + fr, fq * 8);
#define PG8_SA(b, h) (((b) * 2 + (h)) * HTB)
#define PG8_SB(b, h) ((4 + (b) * 2 + (h)) * HTB)
#define PG8_STAGE(bufoff, gbase, voff) do { _Pragma("unroll") for (int _i = 0; _i < 2; ++_i) \
        __builtin_amdgcn_global_load_lds((const unsigned*)((const char*)(gbase) + (voff)[_i]), (PG8_LAS unsigned*)(lds + (bufoff) + ldsw + _i * 8192), 16, 0, 0); } while (0)
#define PG8_LDA(dst, b, h) do { _Pragma("unroll") for (int m = 0; m < 4; ++m) _Pragma("unroll") for (int k = 0; k < 2; ++k) dst[m][k] = *(const PG8_LAS bf16x8*)(lds + PG8_SA(b, h) + aoff + m * 2048 + k * 1024); } while (0)
#define PG8_LDB(dst, b, h) do { _Pragma("unroll") for (int n = 0; n < 2; ++n) _Pragma("unroll") for (int k = 0; k < 2; ++k) dst[n][k] = *(const PG8_LAS bf16x8*)(lds + PG8_SB(b, h) + boff + n * 2048 + k * 1024); } while (0)
#define PG8_MMA(ai, bj, At, Bt) do { __builtin_amdgcn_s_setprio(1); _Pragma("unroll") for (int m = 0; m < 4; ++m) _Pragma("unroll") for (int n = 0; n < 2; ++n) _Pragma("unroll") for (int k = 0; k < 2; ++k) \
        acc[ai][bj][m][n] = __builtin_amdgcn_mfma_f32_16x16x32_bf16(Bt[n][k], At[m][k], acc[ai][bj][m][n], 0, 0, 0); __builtin_amdgcn_s_setprio(0); } while (0)
#define PG8_WAIT_V(n) asm volatile("s_waitcnt vmcnt(" #n ")" ::: "memory")
#define PG8_WAIT_L(n) asm volatile("s_waitcnt lgkmcnt(" #n ")" ::: "memory")
#define PG8_BAR __builtin_amdgcn_s_barrier()
#define PG8_SCHED __builtin_amdgcn_sched_barrier(0)
    Unit cur, nxt; int ui = 0; float rps = 0.f; typedef float f32x2 __attribute__((ext_vector_type(2))); const unsigned rpvo = (unsigned)((tid >> 1) * 16 + (tid & 1) * 8) * 4u;
    if (!S.next(0, cur)) return;
    f32x4 acc[2][2][4][2];
#pragma unroll
    for (int a = 0; a < 2; ++a)
#pragma unroll
        for (int b = 0; b < 2; ++b)
#pragma unroll
            for (int m = 0; m < 4; ++m)
#pragma unroll
                for (int n = 0; n < 2; ++n) acc[a][b][m][n] = (f32x4){0.f, 0.f, 0.f, 0.f};
    bf16x8 At[4][2], B0[2][2], B1[2][2];
    const char* cA = (const char*)g.A + a_off<MODE, LDA>(cur); const char* cB = (const char*)g.Bt + b_off<MODE, LDB>(cur);
    S.a_ready(cur);
    if constexpr (SP2) {
        PG8_STAGE(PG8_SB(0, 0), cB, voffB); PG8_STAGE(PG8_SB(0, 1), cB + hstepB, voffB); PG8_STAGE(PG8_SA(0, 0), cA, voffA); PG8_STAGE(PG8_SA(0, 1), cA + hstepA, voffA);
        if (wr == 1) PG8_BAR;
        PG8_WAIT_V(2); PG8_BAR;
        PG8_STAGE(PG8_SB(1, 0), cB + kstep, voffB); PG8_STAGE(PG8_SA(1, 0), cA + kstep, voffA); PG8_STAGE(PG8_SB(1, 1), cB + hstepB + kstep, voffB);
        PG8_WAIT_V(6); PG8_BAR;
    } else {
        PG8_STAGE(PG8_SB(0, 0), cB, voffB); PG8_STAGE(PG8_SA(0, 0), cA, voffA); PG8_STAGE(PG8_SB(0, 1), cB + hstepB, voffB); PG8_STAGE(PG8_SA(0, 1), cA + hstepA, voffA);
        if (wr == 1) PG8_BAR;
        PG8_WAIT_V(4); PG8_BAR;
        PG8_STAGE(PG8_SB(1, 0), cB + kstep, voffB); PG8_STAGE(PG8_SA(1, 0), cA + kstep, voffA); PG8_STAGE(PG8_SB(1, 1), cB + hstepB + kstep, voffB);
        PG8_WAIT_V(6); PG8_BAR;
    }
    for (;;) {
        const bool has_next = S.next(ui + 1, nxt);
        const char* nA = has_next ? (const char*)g.A + a_off<MODE, LDA>(nxt) : cA; const char* nB = has_next ? (const char*)g.Bt + b_off<MODE, LDB>(nxt) : cB;
#pragma nounroll
        for (int t = 0; t < nt; t += 2) {
            const bool last = (t == nt - 2);
            f32x2 rp = {0.f, 0.f};
            if constexpr (Epi::ROWPRE) { if (t < 8) { const float* rpb = E.ssqp + (size_t)cur.pm * (BM * 16) + t; asm volatile("global_load_dwordx2 %0, %1, %2" : "=v"(rp) : "v"(rpvo), "s"(rpb) : "memory"); } }
            const char* a1 = cA + (size_t)(t + 1) * kstep;
            const char* a2 = last ? nA : cA + (size_t)(t + 2) * kstep; const char* b2 = last ? nB : cB + (size_t)(t + 2) * kstep;
            const char* a3 = a2 + kstep; const char* b3 = b2 + kstep;
            if (last && has_next) S.a_ready(nxt);
            if constexpr (SP2) {
            PG8_LDB(B0, 0, 0); PG8_LDB(B1, 0, 1); PG8_SCHED; PG8_LDA(At, 0, 0); PG8_STAGE(PG8_SA(1, 1), a1 + hstepA, voffA);
            PG8_WAIT_V(8); PG8_WAIT_L(0); PG8_BAR; PG8_MMA(0, 0, At, B0); PG8_MMA(0, 1, At, B1); PG8_BAR; PG8_SCHED;
            PG8_LDA(At, 0, 1); PG8_STAGE(PG8_SB(0, 0), b2, voffB); PG8_STAGE(PG8_SB(0, 1), b2 + hstepB, voffB); PG8_STAGE(PG8_SA(0, 0), a2, voffA);
            PG8_WAIT_V(8); PG8_WAIT_L(0); PG8_BAR; PG8_MMA(1, 0, At, B0); PG8_MMA(1, 1, At, B1); PG8_BAR; PG8_SCHED;
            PG8_LDB(B0, 1, 0); PG8_LDB(B1, 1, 1); PG8_SCHED; PG8_LDA(At, 1, 0); PG8_STAGE(PG8_SA(0, 1), a2 + hstepA, voffA);
            PG8_WAIT_V(8); PG8_WAIT_L(0); PG8_BAR; PG8_MMA(0, 0, At, B0); PG8_MMA(0, 1, At, B1); PG8_BAR; PG8_SCHED;
            PG8_LDA(At, 1, 1); PG8_STAGE(PG8_SB(1, 0), b3, voffB); PG8_STAGE(PG8_SB(1, 1), b3 + hstepB, voffB); PG8_STAGE(PG8_SA(1, 0), a3, voffA);
            PG8_WAIT_V(8); PG8_WAIT_L(0); PG8_BAR; PG8_MMA(1, 0, At, B0); PG8_MMA(1, 1, At, B1); PG8_BAR; PG8_SCHED;
            } else {
            PG8_LDB(B0, 0, 0); PG8_SCHED; PG8_LDA(At, 0, 0); PG8_STAGE(PG8_SA(1, 1), a1 + hstepA, voffA);
            PG8_WAIT_L(8); PG8_BAR; PG8_WAIT_L(0); PG8_MMA(0, 0, At, B0); PG8_BAR; PG8_SCHED;
            PG8_LDB(B1, 0, 1); PG8_STAGE(PG8_SB(0, 0), b2, voffB);
            PG8_BAR; PG8_WAIT_L(0); PG8_MMA(0, 1, At, B1); PG8_BAR;
            PG8_LDA(At, 0, 1); PG8_STAGE(PG8_SA(0, 0), a2, voffA);
            PG8_BAR; PG8_WAIT_L(0); PG8_MMA(1, 0, At, B0); PG8_BAR; PG8_SCHED;
            PG8_STAGE(PG8_SB(0, 1), b2 + hstepB, voffB);
            PG8_WAIT_V(6); PG8_BAR; PG8_MMA(1, 1, At, B1); PG8_BAR;
            PG8_LDB(B0, 1, 0); PG8_SCHED; PG8_LDA(At, 1, 0); PG8_STAGE(PG8_SA(0, 1), a2 + hstepA, voffA);
            PG8_WAIT_L(8); PG8_BAR; PG8_WAIT_L(0); PG8_MMA(0, 0, At, B0); PG8_BAR; PG8_SCHED;
            PG8_LDB(B1, 1, 1); PG8_STAGE(PG8_SB(1, 0), b3, voffB);
            PG8_BAR; PG8_WAIT_L(0); PG8_MMA(0, 1, At, B1); PG8_BAR;
            PG8_LDA(At, 1, 1); PG8_STAGE(PG8_SA(1, 0), a3, voffA);
            PG8_BAR; PG8_WAIT_L(0); PG8_MMA(1, 0, At, B0); PG8_BAR; PG8_SCHED;
            PG8_STAGE(PG8_SB(1, 1), b3 + hstepB, voffB);
            PG8_WAIT_V(6); PG8_BAR; PG8_MMA(1, 1, At, B1); PG8_BAR;
            }
            if constexpr (Epi::ROWPRE) { if (t < 8) { asm volatile("" : "+v"(rp)); rps += rp.x + rp.y;
                if (t == 6) { float s = rps + __shfl_xor(rps, 1); if (!(tid & 1)) rsl[tid >> 1] = __builtin_amdgcn_rsqf(s * (1.0f / 1024.0f) + 1e-6f); rps = 0.f; } } }
        }
        if constexpr (ALIGN_EPI) { if (wr == 0) PG8_BAR; }
        if constexpr (!Epi::AFTER_DRAIN) { int fr_e = fr, fq_e = fq; asm volatile("" : "+v"(fr_e), "+v"(fq_e));
            { ECHO_BEGIN(20) E(acc, cur, wr, wc, fr_e, fq_e, rsl); ECHO_END(20) } S.done(cur); }
        if (!has_next) break;
#pragma unroll
        for (int a = 0; a < 2; ++a)
#pragma unroll
            for (int b = 0; b < 2; ++b)
#pragma unroll
                for (int m = 0; m < 4; ++m)
#pragma unroll
                    for (int n = 0; n < 2; ++n) acc[a][b][m][n] = (f32x4){0.f, 0.f, 0.f, 0.f};
        cur = nxt; cA = nA; cB = nB; ++ui;
        if constexpr (ALIGN_EPI) { if (wr == 1) PG8_BAR; }
    }
    PG8_WAIT_V(0);
    if constexpr (!ALIGN_EPI) { if (wr == 0) PG8_BAR; }
    PG8_BAR;
    if constexpr (Epi::AFTER_DRAIN) { E.fused(acc, cur, wr, wc, fr, fq, lds, wid, lane); S.done(cur); }
#undef PG8_SA
#undef PG8_SB
#undef PG8_STAGE
#undef PG8_LDA
#undef PG8_LDB
#undef PG8_MMA
#undef PG8_WAIT_V
#undef PG8_WAIT_L
#undef PG8_BAR
#undef PG8_SCHED
}
}

#define GAS __attribute__((address_space(1)))
#define LAS __attribute__((address_space(3)))
typedef unsigned short bf16;
typedef unsigned v4u __attribute__((ext_vector_type(4)));
typedef unsigned v2u __attribute__((ext_vector_type(2)));
typedef float f32x4 __attribute__((ext_vector_type(4)));
typedef float f32x2 __attribute__((ext_vector_type(2)));
constexpr int NWAVES = 8, NTHREADS = 512;
constexpr int NB = 8, SEQ = 4096, DM = 1024, MTOK = NB * SEQ, NMEMT = 256, MMEM = NB * NMEMT;
constexpr int DINP = 3600, NPROJ = 3584, DFF = 4096, DHY = 512, DML = 512, NHEAD = 4, DHEAD = 128;
constexpr float EPS = 1e-6f;
constexpr size_t MiB = 1u << 20;
constexpr size_t WS_CTL = 0, CTL_ZERO_BYTES = 1 * MiB;
constexpr size_t WS_WIN = 2 * MiB, WS_WOUT = 9 * MiB, WS_WQ = 11 * MiB, WS_WK = 13 * MiB, WS_WV = 15 * MiB, WS_WO = 17 * MiB, WS_W1 = 19 * MiB, WS_W2 = 27 * MiB;
constexpr size_t WS_MEMN = 35 * MiB, WS_KB = 39 * MiB, WS_VT = 43 * MiB, WS_GATES = 47 * MiB, WS_SSQ = 49 * MiB, WS_HID2 = 51 * MiB;
constexpr size_t WS_GF = 53 * MiB, WS_DEC = 55 * MiB;
constexpr size_t WS_XN = 64 * MiB;
constexpr size_t WS_QF = 64 * MiB, WS_KA = 96 * MiB;
constexpr size_t WS_PROJ = 128 * MiB, PROJ_STRIDE = (size_t)MTOK * 512;
constexpr size_t OUT_FILT = 96 * MiB;
constexpr size_t WS_HSPEC = 384 * MiB;
constexpr size_t WS_YT = 448 * MiB;
constexpr size_t WS_MIXED = 352 * MiB;
constexpr size_t WS_KF = 352 * MiB, WS_VF = 416 * MiB;
constexpr size_t WS_STATES = 128 * MiB;
constexpr size_t WS_SP = 416 * MiB, WS_HID = 192 * MiB;
constexpr size_t WS_MT = 288 * MiB, WS_VWT = 304 * MiB;
constexpr size_t WS_END = 512 * MiB;
constexpr int RING_BYTES = 131072, LDSCTL_OFF = 147456, LDS_BYTES = 163840;

__device__ __forceinline__ float bf2f(unsigned short h) { return __uint_as_float(((unsigned)h) << 16); }
__device__ __forceinline__ unsigned f2bf(float f) { unsigned u = __float_as_uint(f); return (u + 0x7fffu + ((u >> 16) & 1u)) >> 16; }
typedef __bf16 bf16x2_t __attribute__((ext_vector_type(2)));
__device__ __forceinline__ unsigned cvtpk(float lo, float hi) { const f32x2 v = {lo, hi}; const bf16x2_t b = __builtin_convertvector(v, bf16x2_t); return __builtin_bit_cast(unsigned, b); }
__device__ __forceinline__ unsigned pk2(float lo, float hi) { return cvtpk(lo, hi); }
__device__ __forceinline__ float wave_sum(float v) {
#pragma unroll
    for (int o = 1; o < 64; o <<= 1) v += __shfl_xor(v, o);
    return v;
}
#define LDS_WAIT() asm volatile("s_waitcnt lgkmcnt(0)" ::: "memory")
__device__ __forceinline__ float logsig(float x) { return fminf(x, 0.f) - log1pf(expf(-fabsf(x))); }

struct Args { const float* in[30]; float* out; unsigned char* ws; int ph_lo, ph_hi; };

typedef __amdgpu_buffer_rsrc_t rsrc_t;
typedef unsigned u32x2v __attribute__((ext_vector_type(2)));
__device__ __forceinline__ rsrc_t mkrsrc(const void* p, unsigned bytes) { return __builtin_amdgcn_make_buffer_rsrc((void*)p, 0, bytes, 0x00020000); }
__device__ __forceinline__ float bld_bf16(rsrc_t r, unsigned off) { return bf2f(__builtin_amdgcn_raw_buffer_load_b16(r, off, 0, 0)); }
__device__ __forceinline__ float bld_bf16s(rsrc_t r, unsigned off, unsigned soff) { return bf2f(__builtin_amdgcn_raw_buffer_load_b16(r, off, soff, 0)); }
__device__ __forceinline__ float bld_f32(rsrc_t r, unsigned off, unsigned soff = 0) { return __uint_as_float(__builtin_amdgcn_raw_buffer_load_b32(r, off, soff, 0)); }
typedef unsigned u32x4b __attribute__((ext_vector_type(4)));
__device__ __forceinline__ v4u bld128(rsrc_t r, unsigned voff, unsigned soff) { const u32x4b w = __builtin_amdgcn_raw_buffer_load_b128(r, voff, soff, 0); return (v4u){w.x, w.y, w.z, w.w}; }
__device__ __forceinline__ v2u bld64(rsrc_t r, unsigned voff, unsigned soff) { const u32x2v w = __builtin_amdgcn_raw_buffer_load_b64(r, voff, soff, 0); return (v2u){w.x, w.y}; }
#define P0_DISPATCH(it_, BODY) do { int r = (it_); constexpr int I_IN = 16 * 112, I_SQ = 16 * 32, I_1 = 16 * 128; \
    if (r < I_IN) { constexpr int ldw = DINP, K = DM, nblk = 112, GSPLIT = 0; const float* W = a.in[3]; bf16* WT = (bf16*)(ws + WS_WIN); const float* g = a.in[2]; BODY } \
    else if ((r -= I_IN) < I_SQ) { constexpr int ldw = DM, K = DM, nblk = 32, GSPLIT = 1; const float* W = a.in[19]; bf16* WT = (bf16*)(ws + WS_WOUT); const float* g = a.in[14]; BODY } \
    else if ((r -= I_SQ) < I_SQ) { constexpr int ldw = DM, K = DM, nblk = 32, GSPLIT = 0; const float* W = a.in[23]; bf16* WT = (bf16*)(ws + WS_WK); const float* g = a.in[21]; BODY } \
    else if ((r -= I_SQ) < I_SQ) { constexpr int ldw = DM, K = DM, nblk = 32, GSPLIT = 0; const float* W = a.in[24]; bf16* WT = (bf16*)(ws + WS_WV); const float* g = a.in[21]; BODY } \
    else if ((r -= I_SQ) < I_SQ) { constexpr int ldw = DM, K = DM, nblk = 32, GSPLIT = 0; const float* W = a.in[25]; bf16* WT = (bf16*)(ws + WS_WO); const float* g = nullptr; BODY } \
    else if ((r -= I_SQ) < I_1) { constexpr int ldw = DFF, K = DM, nblk = 128, GSPLIT = 0; const float* W = a.in[27]; bf16* WT = (bf16*)(ws + WS_W1); const float* g = a.in[26]; BODY } \
    else { r -= I_1; constexpr int ldw = DM, K = DFF, nblk = 32, GSPLIT = 0; const float* W = a.in[28]; bf16* WT = (bf16*)(ws + WS_W2); const float* g = nullptr; BODY } } while (0)
#define P0_FETCH_BODY { const int kb = r / nblk, nb = r - kb * nblk, k0 = 64 * kb, n0 = 32 * nb; (void)WT; (void)K; \
    const rsrc_t rs = mkrsrc(W + (size_t)k0 * ldw + n0, (unsigned)(64 * ldw * 4)); const unsigned vo = (unsigned)((lane >> 3) * ldw + (lane & 7) * 4) * 4u; \
    _Pragma("unroll") for (int i = 0; i < 8; ++i) buf[i] = __builtin_bit_cast(f32x4, bld128(rs, vo, (unsigned)(i * 8 * ldw * 4))); \
    if (g) { const float* gg = (GSPLIT && k0 >= 512) ? a.in[18] - 512 : g; g0 = *(const f32x4*)(gg + k0 + 8 * (lane & 7)); g1 = *(const f32x4*)(gg + k0 + 8 * (lane & 7) + 4); } else { g0 = (f32x4){1.f, 1.f, 1.f, 1.f}; g1 = g0; } }
#define P0_STORE_BODY { const int kb = r / nblk, nb = r - kb * nblk, k0 = 64 * kb, n0 = 32 * nb; (void)W; (void)g; (void)ldw; (void)GSPLIT; \
    _Pragma("unroll") for (int j = 0; j < 4; ++j) *(v4u*)(WT + (size_t)(n0 + (lane >> 3) + 8 * j) * K + k0 + 8 * (lane & 7)) = ov[j]; }
__device__ __forceinline__ void p0_prologue(const Args& a, LAS unsigned char* lds, int G, int vcu) {
    const int tid = threadIdx.x, lane = tid & 63, wave = __builtin_amdgcn_readfirstlane(tid >> 6);
    const int gw = vcu * NWAVES + wave, NGW = G * NWAVES;
    unsigned char* ws = a.ws;
#ifdef P0_TOUCH
    {
        const int g = vcu * NTHREADS + tid; float tv = 0.f;
        if (g < MTOK) tv = a.in[0][(size_t)g * DM] + ((const float*)a.out)[(size_t)g * DM];
        asm volatile("" :: "v"(tv));
    }
#endif
    ECHO_BEGIN(1)
    {
        LAS float* scr = (LAS float*)(lds + wave * 16384);
        constexpr int I_IN = 16 * 112, I_SQ = 16 * 32, I_1 = 16 * 128, I_2 = 64 * 32;
        constexpr int NITEMS = I_IN + 4 * I_SQ + I_1 + I_2;
        f32x4 buf[8], g0, g1;
        if (gw < NITEMS) P0_DISPATCH(gw, P0_FETCH_BODY);
        for (int it = gw; it < NITEMS; it += NGW) {
#pragma unroll
            for (int i = 0; i < 8; ++i) { LAS float* d = scr + (i * 8 + (lane >> 3)) * 33 + (lane & 7) * 4; d[0] = buf[i][0]; d[1] = buf[i][1]; d[2] = buf[i][2]; d[3] = buf[i][3]; }
            const f32x4 c0 = g0, c1 = g1;
            if (it + NGW < NITEMS) P0_DISPATCH(it + NGW, P0_FETCH_BODY);
            LDS_WAIT(); asm volatile("" ::: "memory");
            const int c = lane & 7; v4u ov[4];
#pragma unroll
            for (int j = 0; j < 4; ++j) { const int n = (lane >> 3) + 8 * j; const LAS float* s = scr + (8 * c) * 33 + n;
                ov[j].x = pk2(s[0 * 33] * c0[0], s[1 * 33] * c0[1]); ov[j].y = pk2(s[2 * 33] * c0[2], s[3 * 33] * c0[3]); ov[j].z = pk2(s[4 * 33] * c1[0], s[5 * 33] * c1[1]); ov[j].w = pk2(s[6 * 33] * c1[2], s[7 * 33] * c1[3]); }
            P0_DISPATCH(it, P0_STORE_BODY);
            LDS_WAIT(); asm volatile("" ::: "memory");
        }
        for (int r = gw; r < DM; r += NGW) { const float g = a.in[20][r]; const f32x4* src = (const f32x4*)(a.in[22] + (size_t)r * DM) + lane;
            unsigned long long* o8 = (unsigned long long*)((bf16*)(ws + WS_WQ) + (size_t)r * DM) + lane;
#pragma unroll
            for (int j = 0; j < 4; ++j) { const f32x4 v = src[64 * j] * g; o8[64 * j] = (unsigned long long)pk2(v[0], v[1]) | ((unsigned long long)pk2(v[2], v[3]) << 32); } }
    }
    ECHO_END(1)
    ECHO_BEGIN(2)
    __syncthreads();
    LAS v4u* frag = (LAS v4u*)lds;
#pragma unroll
    for (int e = tid; e < 32 * 64; e += NTHREADS) { const int jj = e >> 6, l = e & 63, n = l & 15, k0 = 32 * jj + 8 * (l >> 4);
        const f32x4 ga = *(const f32x4*)(a.in[2] + k0), gb = *(const f32x4*)(a.in[2] + k0 + 4); float w[8];
#pragma unroll
        for (int i = 0; i < 8; ++i) w[i] = a.in[3][(size_t)(k0 + i) * DINP + NPROJ + n] * (i < 4 ? ga[i & 3] : gb[i & 3]);
        v4u hi, lo;
#pragma unroll
        for (int i = 0; i < 4; ++i) { hi[i] = cvtpk(w[2 * i], w[2 * i + 1]); lo[i] = cvtpk(w[2 * i] - __uint_as_float(hi[i] << 16), w[2 * i + 1] - __uint_as_float(hi[i] & 0xffff0000u)); }
        frag[(jj * 2 + 0) * 64 + l] = hi; frag[(jj * 2 + 1) * 64 + l] = lo; }
    __syncthreads();
    ECHO_END(2)
    ECHO_BEGIN(3)
    {
        const int r = lane & 15, kq = lane >> 4;
        for (int blk = gw; blk < MTOK / 16; blk += NGW) {
            const int R0 = blk * 16;
            const rsrc_t rx = mkrsrc(a.in[0] + (size_t)R0 * DM, 16 * DM * 4);
            const unsigned vo = (unsigned)(r * DM + 8 * kq) * 4u;
            bf16* xo = (bf16*)(ws + WS_XN) + (size_t)(R0 + r) * DM + 8 * kq;
            f32x4 acc = {0.f, 0.f, 0.f, 0.f}; float ss = 0.f;
            f32x4 bA[8][2], bB[8][2];
#define P0_XLOAD(B_, jb) _Pragma("unroll") for (int q = 0; q < 8; ++q) { B_[q][0] = __builtin_bit_cast(f32x4, bld128(rx, vo, (unsigned)((jb) + q) * 128u)); B_[q][1] = __builtin_bit_cast(f32x4, bld128(rx, vo + 16u, (unsigned)((jb) + q) * 128u)); }
#define P0_XPROC(B_, jb) _Pragma("unroll") for (int q = 0; q < 8; ++q) { asm volatile("" ::: "memory"); const f32x4 xa = B_[q][0], xb = B_[q][1]; \
                ss += ((xa[0] * xa[0] + xa[1] * xa[1]) + (xa[2] * xa[2] + xa[3] * xa[3])) + ((xb[0] * xb[0] + xb[1] * xb[1]) + (xb[2] * xb[2] + xb[3] * xb[3])); \
                v4u hi, lo; \
                hi[0] = cvtpk(xa[0], xa[1]); hi[1] = cvtpk(xa[2], xa[3]); hi[2] = cvtpk(xb[0], xb[1]); hi[3] = cvtpk(xb[2], xb[3]); \
                lo[0] = cvtpk(xa[0] - __uint_as_float(hi[0] << 16), xa[1] - __uint_as_float(hi[0] & 0xffff0000u)); lo[1] = cvtpk(xa[2] - __uint_as_float(hi[1] << 16), xa[3] - __uint_as_float(hi[1] & 0xffff0000u)); \
                lo[2] = cvtpk(xb[0] - __uint_as_float(hi[2] << 16), xb[1] - __uint_as_float(hi[2] & 0xffff0000u)); lo[3] = cvtpk(xb[2] - __uint_as_float(hi[3] << 16), xb[3] - __uint_as_float(hi[3] & 0xffff0000u)); \
                *(v4u*)(xo + 32 * ((jb) + q)) = hi; \
                const pg8::bf16x8 wh = __builtin_bit_cast(pg8::bf16x8, frag[(((jb) + q) * 2 + 0) * 64 + lane]), wl = __builtin_bit_cast(pg8::bf16x8, frag[(((jb) + q) * 2 + 1) * 64 + lane]); \
                acc = __builtin_amdgcn_mfma_f32_16x16x32_bf16(__builtin_bit_cast(pg8::bf16x8, hi), wh, acc, 0, 0, 0); \
                acc = __builtin_amdgcn_mfma_f32_16x16x32_bf16(__builtin_bit_cast(pg8::bf16x8, lo), wh, acc, 0, 0, 0); \
                acc = __builtin_amdgcn_mfma_f32_16x16x32_bf16(__builtin_bit_cast(pg8::bf16x8, hi), wl, acc, 0, 0, 0); }
            P0_XLOAD(bA, 0) P0_XLOAD(bB, 8)
            P0_XPROC(bA, 0) P0_XLOAD(bA, 16)
            P0_XPROC(bB, 8) P0_XLOAD(bB, 24)
            P0_XPROC(bA, 16) P0_XPROC(bB, 24)
#undef P0_XLOAD
#undef P0_XPROC
            ss += __shfl_xor(ss, 16); ss += __shfl_xor(ss, 32);
            *(f32x4*)((float*)(ws + WS_SSQ) + (size_t)(R0 + r) * 16 + 4 * kq) = (f32x4){kq == 0 ? ss : 0.f, 0.f, 0.f, 0.f};
            const float rstd = __builtin_amdgcn_rsqf(ss * (1.0f / DM) + EPS);
            const float bias = a.in[17][r];
#pragma unroll
            for (int i = 0; i < 4; ++i) { float gv = acc[i] * __shfl(rstd, 4 * kq + i) + bias; if (r & 4) gv = logsig(gv); ((float*)(ws + WS_GATES))[(size_t)(R0 + 4 * kq + i) * 16 + r] = gv; }
        }
    }
    ECHO_END(3)
    ECHO_BEGIN(4)
    for (int m = gw; m < MMEM; m += NGW) {
        const f32x4* xr = (const f32x4*)(a.in[1] + (size_t)m * DM) + lane;
        f32x4 v[4]; float ss = 0.f;
#pragma unroll
        for (int j = 0; j < 4; ++j) { v[j] = xr[64 * j]; ss += (v[j][0] * v[j][0] + v[j][1] * v[j][1]) + (v[j][2] * v[j][2] + v[j][3] * v[j][3]); }
        const float rstd = 1.0f / sqrtf(wave_sum(ss) * (1.0f / DM) + EPS);
        unsigned long long* o8 = (unsigned long long*)((bf16*)(ws + WS_MEMN) + (size_t)m * DM) + lane;
#pragma unroll
        for (int j = 0; j < 4; ++j) { v[j] = v[j] * rstd; o8[64 * j] = (unsigned long long)pk2(v[j][0], v[j][1]) | ((unsigned long long)pk2(v[j][2], v[j][3]) << 32); }
    }
    ECHO_END(4)
    ECHO_BEGIN(5)
    {
        float w6[33], w9[64];
#pragma unroll
        for (int i = 0; i < 33; ++i) w6[i] = a.in[6][i * 64 + lane];
#pragma unroll
        for (int i = 0; i < 64; ++i) w9[i] = a.in[9][i * 64 + lane];
        const float b7 = a.in[7][lane], f8 = a.in[8][lane], b10 = a.in[10][lane], f11 = a.in[11][lane];
        for (int t = gw; t < SEQ; t += NGW) {
            const float tl = (float)t * (1.0f / (float)(SEQ - 1)), ang = (6.283185307179586f / (float)SEQ) * (float)t;
            const int mb = lane & 15; const float band = 1e-4f + (float)mb * ((15.0f - 1e-4f) / 15.0f); const float ph = band * ang;
            const float zf = (lane & 16) ? -sinf(ph) : cosf(ph);
            float s = tl * w6[0];
#pragma unroll
            for (int i = 0; i < 32; ++i) s += __builtin_bit_cast(float, __builtin_amdgcn_readlane(__builtin_bit_cast(int, zf), i)) * w6[1 + i];
            const float h1 = sinf(f8 * (s + b7));
            float s2 = 0.f;
#pragma unroll
            for (int i = 0; i < 64; ++i) s2 += __builtin_bit_cast(float, __builtin_amdgcn_readlane(__builtin_bit_cast(int, h1), i)) * w9[i];
            const float h2 = sinf(f11 * (s2 + b10));
            ((float*)(ws + WS_HID2))[(size_t)t * 64 + lane] = h2;
        }
    }
    ECHO_END(5)
}
__device__ __forceinline__ float sigm(float x) { return __builtin_amdgcn_rcpf(1.0f + __builtin_amdgcn_exp2f(x * -1.4426950408889634f)); }
__device__ __forceinline__ float silu(float x) { return x * sigm(x); }

__device__ __forceinline__ void filters_phase(const Args& a, LAS unsigned char* lds, int G, int vcu) {
    const int tid = threadIdx.x, lane = tid & 63, wave = __builtin_amdgcn_readfirstlane(tid >> 6);
    const int gw = vcu * NWAVES + wave, NGW = G * NWAVES;
    const float* hid2 = (const float*)(a.ws + WS_HID2); float* filt = (float*)((unsigned char*)a.out + OUT_FILT);
    LAS float* hs = (LAS float*)(lds + 73728 + wave * 4096);
    for (int item = gw; item < 32 * 256; item += NGW) {
        const int cg = item & 31, tb = item >> 5, t0 = tb * 16, ch = cg * 64 + lane, c = ch & 511;
#pragma unroll
        for (int i = 0; i < 4; ++i) *(LAS f32x4*)(hs + (lane + 64 * i) * 4) = *(const f32x4*)(hid2 + (size_t)t0 * 64 + (lane + 64 * i) * 4);
        LDS_WAIT();
        float acc[16];
#pragma unroll
        for (int i = 0; i < 16; ++i) acc[i] = 0.f;
#pragma nounroll
        for (int j4 = 0; j4 < 16; ++j4) {
            const float w0 = a.in[12][(size_t)(4 * j4 + 0) * 2048 + ch], w1 = a.in[12][(size_t)(4 * j4 + 1) * 2048 + ch], w2 = a.in[12][(size_t)(4 * j4 + 2) * 2048 + ch], w3 = a.in[12][(size_t)(4 * j4 + 3) * 2048 + ch];
#pragma unroll
            for (int i = 0; i < 16; ++i) { const f32x4 h4 = *(const LAS f32x4*)(hs + i * 64 + 4 * j4); acc[i] += (h4[0] * w0 + h4[1] * w1) + (h4[2] * w2 + h4[3] * w3); }
        }
        const float mind = -3.0701134573253944f, maxd = -15.350567286626972f;
        const float ad = fabsf(mind + (float)c * ((maxd - mind) / 511.0f));
        float* dst = filt + (size_t)ch * SEQ + t0;
#pragma unroll
        for (int i4 = 0; i4 < 4; ++i4) { f32x4 o;
#pragma unroll
            for (int e = 0; e < 4; ++e) { const float tl = (float)(t0 + 4 * i4 + e) * (1.0f / (float)(SEQ - 1)); o[e] = acc[4 * i4 + e] * expf(-tl * ad); }
            *(f32x4*)(dst + 4 * i4) = o; }
        LDS_WAIT();
    }
}
__device__ __forceinline__ void softmax_rows(const Args& a, int G, int vcu) {
    const int tid = threadIdx.x, lane = tid & 63, wave = __builtin_amdgcn_readfirstlane(tid >> 6);
    const int gw = vcu * NWAVES + wave, NGW = G * NWAVES;
    bf16* sp = (bf16*)(a.ws + WS_SP);
    for (int m = gw; m < MTOK; m += NGW) {
        v4u* p = (v4u*)(sp + (size_t)m * DM + 16 * lane);
        const v4u r0 = p[0], r1 = p[1];
        float v[16];
        const unsigned w[8] = {r0.x, r0.y, r0.z, r0.w, r1.x, r1.y, r1.z, r1.w};
        float mx = -1e30f;
#pragma unroll
        for (int e = 0; e < 8; ++e) { v[2 * e] = __uint_as_float(w[e] << 16) * 0.0625f; v[2 * e + 1] = __uint_as_float(w[e] & 0xffff0000u) * 0.0625f; mx = fmaxf(mx, fmaxf(v[2 * e], v[2 * e + 1])); }
        mx = fmaxf(mx, __shfl_xor(mx, 1)); mx = fmaxf(mx, __shfl_xor(mx, 2)); mx = fmaxf(mx, __shfl_xor(mx, 4)); mx = fmaxf(mx, __shfl_xor(mx, 8));
        float sum = 0.f;
#pragma unroll
        for (int e = 0; e < 16; ++e) { v[e] = expf(v[e] - mx); sum += v[e]; }
        sum += __shfl_xor(sum, 1); sum += __shfl_xor(sum, 2); sum += __shfl_xor(sum, 4); sum += __shfl_xor(sum, 8);
        const float inv = 1.0f / sum;
        v4u o0, o1;
        o0.x = pk2(v[0] * inv, v[1] * inv); o0.y = pk2(v[2] * inv, v[3] * inv); o0.z = pk2(v[4] * inv, v[5] * inv); o0.w = pk2(v[6] * inv, v[7] * inv);
        o1.x = pk2(v[8] * inv, v[9] * inv); o1.y = pk2(v[10] * inv, v[11] * inv); o1.z = pk2(v[12] * inv, v[13] * inv); o1.w = pk2(v[14] * inv, v[15] * inv);
        p[0] = o0; p[1] = o1;
    }
}
__device__ __forceinline__ void final_norm(const Args& a, int G, int vcu) {
    const int tid = threadIdx.x, lane = tid & 63, wave = __builtin_amdgcn_readfirstlane(tid >> 6);
    const int gw = vcu * NWAVES + wave, NGW = G * NWAVES;
    const bf16* xn = (const bf16*)(a.ws + WS_XN);
    f32x4 g4[4];
#pragma unroll
    for (int j = 0; j < 4; ++j) g4[j] = *((const f32x4*)a.in[29] + 4 * lane + j);
    for (int m = gw; m < MTOK; m += NGW) {
        const v4u* p = (const v4u*)(xn + (size_t)m * DM + 16 * lane);
        const v4u r0 = p[0], r1 = p[1];
        const unsigned w[8] = {r0.x, r0.y, r0.z, r0.w, r1.x, r1.y, r1.z, r1.w};
        float v[16]; float ss = 0.f;
#pragma unroll
        for (int e = 0; e < 8; ++e) { v[2 * e] = __uint_as_float(w[e] << 16); v[2 * e + 1] = __uint_as_float(w[e] & 0xffff0000u); ss += v[2 * e] * v[2 * e] + v[2 * e + 1] * v[2 * e + 1]; }
        const float rstd = __builtin_amdgcn_rsqf(wave_sum(ss) * (1.0f / DM) + EPS);
        f32x4* o = (f32x4*)(a.out + (size_t)m * DM + 16 * lane);
#pragma unroll
        for (int j = 0; j < 4; ++j) o[j] = (f32x4){v[4 * j] * rstd * g4[j][0], v[4 * j + 1] * rstd * g4[j][1], v[4 * j + 2] * rstd * g4[j][2], v[4 * j + 3] * rstd * g4[j][3]};
    }
}
typedef short bf16x8 __attribute__((ext_vector_type(8)));
typedef float f32x16 __attribute__((ext_vector_type(16)));
#define MFMA32(a, b, c) __builtin_amdgcn_mfma_f32_32x32x16_bf16((a), (b), (c), 0, 0, 0)
__device__ __forceinline__ int crow(int r, int h) { return (r & 3) + 8 * (r >> 2) + 4 * h; }
__device__ __forceinline__ bf16x8 scale_frag(v4u raw, float s) {
    v4u o;
#pragma unroll
    for (int e = 0; e < 4; ++e) o[e] = cvtpk(__uint_as_float(raw[e] << 16) * s, __uint_as_float(raw[e] & 0xffff0000u) * s);
    return __builtin_bit_cast(bf16x8, o);
}
__device__ __forceinline__ bf16x8 scale_frag8(v4u raw, f32x4 s0, f32x4 s1) {
    v4u o;
    o[0] = cvtpk(__uint_as_float(raw[0] << 16) * s0[0], __uint_as_float(raw[0] & 0xffff0000u) * s0[1]);
    o[1] = cvtpk(__uint_as_float(raw[1] << 16) * s0[2], __uint_as_float(raw[1] & 0xffff0000u) * s0[3]);
    o[2] = cvtpk(__uint_as_float(raw[2] << 16) * s1[0], __uint_as_float(raw[2] & 0xffff0000u) * s1[1]);
    o[3] = cvtpk(__uint_as_float(raw[3] << 16) * s1[2], __uint_as_float(raw[3] & 0xffff0000u) * s1[3]);
    return __builtin_bit_cast(bf16x8, o);
}
struct ScanCtx { f32x16 acc; v4u ar[4]; bf16x8 br[4]; float be, dc; int step; };
struct ScanEnv { const Args* a; LAS unsigned char* lds; int vcu; };
__device__ __forceinline__ void scan_load(ScanCtx& s, const ScanEnv& e, int jq, int lane, int wave) {
    const int cd = e.vcu, chain = cd >> 2, dt = cd & 3, nt = wave, b = chain >> 3, hh = (chain >> 1) & 3, dir = chain & 1;
    const int j_ = dir ? 63 - jq : jq;
    const unsigned char* ws = e.a->ws;
    const rsrc_t rva = mkrsrc((const bf16*)(ws + WS_VF) + (size_t)((b * 4 + hh) * 64) * 8192, 64 * 16384), rkb = mkrsrc((const bf16*)(ws + WS_KF) + (size_t)((b * 4 + hh) * 64) * 8192, 64 * 16384);
    const rsrc_t rgf = mkrsrc((const float*)(ws + WS_GF) + (size_t)b * SEQ * 16, SEQ * 64);
    const unsigned vo = lane * 16 + (nt < 4 ? nt : 0) * 4096, ko = lane * 16 + dt * 4096, go = lane * 64 + (hh * 4 + 2 * dir + 1) * 4;
#pragma unroll
    for (int ks = 0; ks < 4; ++ks) { s.ar[ks] = bld128(rva, vo + ks * 1024, j_ * 16384); s.br[ks] = __builtin_bit_cast(bf16x8, bld128(rkb, ko + ks * 1024, j_ * 16384)); }
    s.be = bld_f32(rgf, go, j_ * 4096); s.dc = ((const float*)(ws + WS_DEC))[(size_t)((b * 4 + hh) * 64 + j_) * 2 + dir];
}
__device__ __forceinline__ void scan_tick(ScanCtx& s, const ScanEnv& e, int lane, int wave) {
    if (wave >= 5) return;
    if (s.step >= 64) return;
    const int cd = e.vcu, chain = cd >> 2, dt = cd & 3, nt = wave, dir = chain & 1, l31 = lane & 31, h = lane >> 5;
    const int j_ = dir ? 63 - s.step : s.step;
    unsigned char* ws = e.a->ws;
    LAS float* wsc = (LAS float*)(e.lds + 139264 + wave * 256);
    bf16* ST = (bf16*)(ws + WS_STATES); bf16* NV = (bf16*)(ws + WS_STATES + 128 * MiB);
    wsc[lane] = s.be; const float decay = s.dc;
    if (nt < 4) {
        LAS unsigned short* tb = (LAS unsigned short*)(e.lds + LDSCTL_OFF + 1024 + wave * 2048) + (l31 >> 4) * 512 + (((l31 >> 3) & 1) * 32) * 8 + (l31 & 7);
#pragma unroll
        for (int r = 0; r < 16; ++r) tb[crow(r, h) * 8] = (unsigned short)(cvtpk(s.acc[r], 0.f) & 0xffffu);
        const LAS v4u* tr = (const LAS v4u*)(e.lds + LDSCTL_OFF + 1024 + wave * 2048) + lane;
        const v4u f0 = tr[0], f1 = tr[64];
        v4u* sp = (v4u*)(ST + ((size_t)(chain * 64 + j_) * 32 + nt * 8 + 2 * dt) * 512) + lane;
        sp[0] = f0; sp[64] = f1; }
    else if (h == 0) NV[(size_t)(chain * 64 + j_) * 128 + 32 * dt + l31] = (bf16)(cvtpk(s.acc[0], 0.f) & 0xffffu);
#pragma unroll
    for (int ks = 0; ks < 4; ++ks) { v4u araw = s.ar[ks]; if (nt == 4) { const unsigned w1 = (l31 == 0) ? 0x3f803f80u : 0u; araw = (v4u){w1, w1, w1, w1}; }
        const f32x4 b0 = *(const LAS f32x4*)(wsc + 16 * ks + 4 * h), b1 = *(const LAS f32x4*)(wsc + 16 * ks + 8 + 4 * h);
        s.acc = MFMA32(scale_frag8(araw, b0, b1), s.br[ks], s.acc); }
#pragma unroll
    for (int r = 0; r < 16; ++r) s.acc[r] *= decay;
    s.step += 1;
    scan_load(s, e, s.step < 64 ? s.step : 63, lane, wave);
}
__device__ __forceinline__ void scan_init(ScanCtx& s, const ScanEnv& e, int lane, int wave, bool do_scan) {
#pragma unroll
    for (int r = 0; r < 16; ++r) s.acc[r] = 0.f;
    s.step = 0;
    if (wave < 5 && do_scan) scan_load(s, e, 0, lane, wave); else { s.step = 64;
#pragma unroll
        for (int ks = 0; ks < 4; ++ks) { s.ar[ks] = (v4u){0u, 0u, 0u, 0u}; s.br[ks] = __builtin_bit_cast(bf16x8, (v4u){0u, 0u, 0u, 0u}); } s.be = 0.f; s.dc = 0.f; }
}
__device__ __forceinline__ f32x2 cmul(f32x2 a, f32x2 b) { return (f32x2){a.x * b.x - a.y * b.y, a.x * b.y + a.y * b.x}; }
__device__ __forceinline__ f32x2 cmulc(f32x2 a, f32x2 b) { return (f32x2){a.x * b.x + a.y * b.y, a.y * b.x - a.x * b.y}; }
template <bool INV> __device__ __forceinline__ void dft4(f32x2& x0, f32x2& x1, f32x2& x2, f32x2& x3) {
    const f32x2 s02 = x0 + x2, d02 = x0 - x2, s13 = x1 + x3, d13 = x1 - x3;
    const f32x2 jd = INV ? (f32x2){-d13.y, d13.x} : (f32x2){d13.y, -d13.x};
    x0 = s02 + s13; x1 = d02 + jd; x2 = s02 - s13; x3 = d02 - jd;
}
template <bool INV> __device__ __forceinline__ void fft16(f32x2 (&v)[16]) {
    constexpr float C1 = 0.9238795325112867f, S1 = 0.3826834323650898f, R2 = 0.7071067811865476f;
    constexpr float WR[10] = {1.f, C1, R2, S1, 0.f, 0.f, -R2, 0.f, 0.f, -C1};
    constexpr float WI[10] = {0.f, -S1, -R2, -C1, -1.f, 0.f, -R2, 0.f, 0.f, S1};
#pragma unroll
    for (int b = 0; b < 4; ++b) {
        dft4<INV>(v[b], v[4 + b], v[8 + b], v[12 + b]);
#pragma unroll
        for (int c = 1; c < 4; ++c) { if (b == 0) continue; const f32x2 w = {WR[b * c], INV ? -WI[b * c] : WI[b * c]}; v[4 * c + b] = cmul(v[4 * c + b], w); }
    }
    f32x2 o[16];
#pragma unroll
    for (int c = 0; c < 4; ++c) {
        f32x2 y0 = v[4 * c + 0], y1 = v[4 * c + 1], y2 = v[4 * c + 2], y3 = v[4 * c + 3];
        dft4<INV>(y0, y1, y2, y3);
        o[c] = y0; o[c + 4] = y1; o[c + 8] = y2; o[c + 12] = y3;
    }
#pragma unroll
    for (int k = 0; k < 16; ++k) v[k] = o[k];
}
__device__ __forceinline__ f32x2 w32c(int a) {
    constexpr float CR[16] = {1.f, 0.9807852804032304f, 0.9238795325112867f, 0.8314696123025452f, 0.7071067811865476f, 0.5555702330196022f, 0.3826834323650898f, 0.1950903220161283f,
                              0.f, -0.1950903220161283f, -0.3826834323650898f, -0.5555702330196022f, -0.7071067811865476f, -0.8314696123025452f, -0.9238795325112867f, -0.9807852804032304f};
    constexpr float CI[16] = {0.f, -0.1950903220161283f, -0.3826834323650898f, -0.5555702330196022f, -0.7071067811865476f, -0.8314696123025452f, -0.9238795325112867f, -0.9807852804032304f,
                              -1.f, -0.9807852804032304f, -0.9238795325112867f, -0.8314696123025452f, -0.7071067811865476f, -0.5555702330196022f, -0.3826834323650898f, -0.1950903220161283f};
    return (f32x2){CR[a], CI[a]};
}
constexpr int HY_BUF_BYTES = 34816, HY_TW1_OFF = 2 * HY_BUF_BYTES, HY_TW2_OFF = HY_TW1_OFF + 32768;
__device__ __forceinline__ void hy_fwd(LAS f32x2* hb, int half, int u, f32x2 wu, const LAS f32x2* tw1, const LAS f32x2* tw2, f32x2 (&V)[16], ScanCtx& sc, const ScanEnv& se) {
    const int sl_ = threadIdx.x & 63, sw_ = __builtin_amdgcn_readfirstlane(threadIdx.x >> 6);
    const int p1 = u + (u >> 4), p2 = 272 * (u >> 4) + (u & 15), p3 = 17 * u;
#pragma unroll
    for (int k = 0; k < 16; ++k) V[k] = hb[272 * k + p1];
    if (half) {
#pragma unroll
        for (int k = 1; k < 16; ++k) V[k] = cmul(V[k], w32c(k));
    }
    fft16<false>(V);
#pragma unroll
    for (int k = 0; k < 16; ++k) { if (k == 0 && !half) continue; V[k] = cmul(V[k], tw1[k * 256 + u]); }
#pragma unroll
    for (int k = 0; k < 16; ++k) hb[272 * k + p1] = V[k];
    __syncthreads(); scan_tick(sc, se, sl_, sw_);
#pragma unroll
    for (int k = 0; k < 16; ++k) V[k] = hb[p2 + 17 * k];
    fft16<false>(V);
#pragma unroll
    for (int k = 1; k < 16; ++k) V[k] = cmul(V[k], tw2[k * 16 + (u & 15)]);
#pragma unroll
    for (int k = 0; k < 16; ++k) hb[p2 + 17 * k] = V[k];
    __syncthreads(); scan_tick(sc, se, sl_, sw_);
#pragma unroll
    for (int k = 0; k < 16; ++k) V[k] = hb[p3 + k];
    fft16<false>(V);
}
__device__ __forceinline__ void hy_inv(LAS f32x2* hb, int half, int u, f32x2 wu, const LAS f32x2* tw1, const LAS f32x2* tw2, f32x2 (&V)[16], ScanCtx& sc, const ScanEnv& se) {
    const int sl_ = threadIdx.x & 63, sw_ = __builtin_amdgcn_readfirstlane(threadIdx.x >> 6);
    const int p1 = u + (u >> 4), p2 = 272 * (u >> 4) + (u & 15), p3 = 17 * u;
    fft16<true>(V);
#pragma unroll
    for (int k = 1; k < 16; ++k) V[k] = cmulc(V[k], tw2[k * 16 + (u & 15)]);
#pragma unroll
    for (int k = 0; k < 16; ++k) hb[p3 + k] = V[k];
    __syncthreads(); scan_tick(sc, se, sl_, sw_);
#pragma unroll
    for (int k = 0; k < 16; ++k) V[k] = hb[p2 + 17 * k];
    fft16<true>(V);
#pragma unroll
    for (int k = 0; k < 16; ++k) V[k] = cmulc(V[k], tw1[(u >> 4) * 256 + 16 * k + (u & 15)]);
#pragma unroll
    for (int k = 0; k < 16; ++k) hb[p2 + 17 * k] = V[k];
    __syncthreads(); scan_tick(sc, se, sl_, sw_);
#pragma unroll
    for (int k = 0; k < 16; ++k) V[k] = hb[272 * k + p1];
    fft16<true>(V);
    if (half) {
#pragma unroll
        for (int k = 1; k < 16; ++k) V[k] = cmulc(V[k], w32c(k));
    }
#pragma unroll
    for (int k = 0; k < 16; ++k) hb[272 * k + p1] = V[k];
}
__device__ __forceinline__ int hpos(int n) { return n + (n >> 4); }
template <int O> __device__ __forceinline__ void hy_order(const Args& a, LAS f32x2* bufE, LAS f32x2* bufO, LAS f32x2* hb, int half, int u, f32x2 wu, const LAS f32x2* t1, const LAS f32x2* tw2,
                                                          rsrc_t rH, f32x2 (&xin)[8], int c, int b0, float skip, ScanCtx& sc, const ScanEnv& se) {
    const int tid = threadIdx.x;
    const bf16* hyT = (const bf16*)a.out; bf16* yT = (bf16*)(a.ws + WS_YT);
    f32x2 V[16];
    u32x2v hw[16];
#pragma unroll
    for (int k = 0; k < 16; ++k) hw[k] = __builtin_amdgcn_raw_buffer_load_b64(rH, tid * 8, (O * 16 + k) * 4096, 0);
    __syncthreads();
    hy_fwd(hb, half, u, wu, t1, tw2, V, sc, se);
    const rsrc_t rg0 = mkrsrc(hyT + ((size_t)b0 * 1536 + 512 * (O + 1) + c) * SEQ, SEQ * 2), rg1 = mkrsrc(hyT + ((size_t)(b0 + 1) * 1536 + 512 * (O + 1) + c) * SEQ, SEQ * 2);
    const v4u gq0 = bld128(rg0, tid * 16, 0), gq1 = bld128(rg1, tid * 16, 0);
#pragma unroll
    for (int k = 0; k < 16; ++k) V[k] = cmul(V[k], (f32x2){__uint_as_float(hw[k].x), __uint_as_float(hw[k].y)});
    hy_inv(hb, half, u, wu, t1, tw2, V, sc, se);
    __syncthreads();
    const rsrc_t ry0 = mkrsrc(yT + ((size_t)b0 * 512 + c) * SEQ, SEQ * 2), ry1 = mkrsrc(yT + ((size_t)(b0 + 1) * 512 + c) * SEQ, SEQ * 2);
    const int p0 = 8 * tid + (tid >> 1);
    v4u o0, o1;
#pragma unroll
    for (int e = 0; e < 8; ++e) { const int p = p0 + e;
        const f32x2 y = (bufE[p] + bufO[p]) * (1.0f / 8192.0f);
        const float g0 = (e & 1) ? __uint_as_float(gq0[e >> 1] & 0xffff0000u) : __uint_as_float(gq0[e >> 1] << 16), g1 = (e & 1) ? __uint_as_float(gq1[e >> 1] & 0xffff0000u) : __uint_as_float(gq1[e >> 1] << 16);
        f32x2 r; r.x = g0 * (y.x + skip * xin[e].x); r.y = g1 * (y.y + skip * xin[e].y);
        if (O == 0) { xin[e] = r; bufE[p] = r; bufO[p] = r; } else xin[e] = r; }
    if (O == 1) {
#pragma unroll
        for (int q = 0; q < 4; ++q) { o0[q] = cvtpk(xin[2 * q].x, xin[2 * q + 1].x); o1[q] = cvtpk(xin[2 * q].y, xin[2 * q + 1].y); }
        __builtin_amdgcn_raw_buffer_store_b128(__builtin_bit_cast(u32x4b, o0), ry0, tid * 16, 0, 0); __builtin_amdgcn_raw_buffer_store_b128(__builtin_bit_cast(u32x4b, o1), ry1, tid * 16, 0, 0); }
}
__device__ __forceinline__ void hyena_fft(const Args& a, LAS unsigned char* lds, int G, int vcu) {
    const int tid = threadIdx.x, half = __builtin_amdgcn_readfirstlane(tid >> 8), u = tid & 255;
    LAS f32x2* bufE = (LAS f32x2*)lds; LAS f32x2* bufO = (LAS f32x2*)(lds + HY_BUF_BYTES);
    LAS f32x2* tw1 = (LAS f32x2*)(lds + HY_TW1_OFF); LAS f32x2* tw2 = (LAS f32x2*)(lds + HY_TW2_OFF);
    LAS f32x2* hb = half ? bufO : bufE;
    LAS f32x2* tw1o = (LAS f32x2*)(lds + HY_TW2_OFF + 2048);
    const LAS f32x2* t1 = half ? tw1o : tw1;
    const bf16* hyT = (const bf16*)a.out; const float* filt = (const float*)((const unsigned char*)a.out + OUT_FILT);
    __syncthreads();
    for (int idx = tid; idx < 4096; idx += NTHREADS) { const int m = (idx & 255) * (idx >> 8); float s, c; sincospif((float)m * (1.0f / 2048.0f), &s, &c); tw1[idx] = (f32x2){c, -s};
        sincospif((float)(2 * m + (idx & 255)) * (1.0f / 4096.0f), &s, &c); tw1o[idx] = (f32x2){c, -s}; }
    if (tid < 256) { const int m = 16 * (tid & 15) * (tid >> 4); float s, c; sincospif((float)m * (1.0f / 2048.0f), &s, &c); tw2[tid] = (f32x2){c, -s}; }
    f32x2 wu; { float s, c; sincospif((float)u * (1.0f / 4096.0f), &s, &c); wu = (f32x2){c, -s}; }
    ScanCtx sc; const ScanEnv se = {&a, lds, vcu};
    { const int sl_ = tid & 63, sw_ = __builtin_amdgcn_readfirstlane(tid >> 6); scan_init(sc, se, sl_, sw_, G == 256); }
    const rsrc_t rH = mkrsrc(a.ws + WS_HSPEC + (size_t)blockIdx.x * (2 * 16 * NTHREADS * 8), 2 * 16 * NTHREADS * 8);
    for (int c = vcu; c < DHY; c += G) {
#pragma nounroll
        for (int o = 0; o < 2; ++o) {
            const rsrc_t rf = mkrsrc(filt + ((size_t)(o * 2 + 0) * 512 + c) * SEQ, SEQ * 4), rk = mkrsrc(filt + ((size_t)(o * 2 + 1) * 512 + c) * SEQ, SEQ * 4);
            __syncthreads();
            {
                const v4u fa = bld128(rf, tid * 32, 0), fb = bld128(rf, tid * 32 + 16, 0), ra = bld128(rk, (SEQ - 8 * tid - 8) * 4, 0), rb = bld128(rk, (SEQ - 8 * tid - 8) * 4 + 16, 0);
                const float r0 = bld_f32(rk, (SEQ - 8 * tid) * 4);
                const int p0 = 8 * tid + (tid >> 1);
#pragma unroll
                for (int e = 0; e < 8; ++e) { const float f = __uint_as_float(e < 4 ? fa[e & 3] : fb[e & 3]); const int m = 8 - e;
                    const float r = (e == 0) ? r0 : __uint_as_float(m < 4 ? ra[m & 3] : rb[m & 3]);
                    bufE[p0 + e] = (f32x2){f + r, 0.f}; bufO[p0 + e] = (f32x2){f - r, 0.f}; } }
            __syncthreads();
            f32x2 V[16];
            hy_fwd(hb, half, u, wu, t1, tw2, V, sc, se);
#pragma unroll
            for (int k = 0; k < 16; ++k) { u32x2v w; w.x = __float_as_uint(V[k].x); w.y = __float_as_uint(V[k].y); __builtin_amdgcn_raw_buffer_store_b64(w, rH, tid * 8, (o * 16 + k) * 4096, 0); }
        }
        const float skip0 = a.in[13][c], skip1 = a.in[13][512 + c];
#pragma nounroll
        for (int pr = 0; pr < 4; ++pr) {
            const int b0 = 2 * pr;
            f32x2 xin[8];
            const rsrc_t rv0 = mkrsrc(hyT + ((size_t)b0 * 1536 + c) * SEQ, SEQ * 2), rv1 = mkrsrc(hyT + ((size_t)(b0 + 1) * 1536 + c) * SEQ, SEQ * 2);
            __syncthreads();
            { const v4u va = bld128(rv0, tid * 16, 0), vb = bld128(rv1, tid * 16, 0); const int p0 = 8 * tid + (tid >> 1);
#pragma unroll
              for (int e = 0; e < 8; ++e) { xin[e] = (e & 1) ? (f32x2){__uint_as_float(va[e >> 1] & 0xffff0000u), __uint_as_float(vb[e >> 1] & 0xffff0000u)} : (f32x2){__uint_as_float(va[e >> 1] << 16), __uint_as_float(vb[e >> 1] << 16)};
                  bufE[p0 + e] = xin[e]; bufO[p0 + e] = xin[e]; } }
            hy_order<0>(a, bufE, bufO, hb, half, u, wu, t1, tw2, rH, xin, c, b0, skip0, sc, se);
            hy_order<1>(a, bufE, bufO, hb, half, u, wu, t1, tw2, rH, xin, c, b0, skip1, sc, se);
        }
    }
    { const int sl_ = tid & 63, sw_ = __builtin_amdgcn_readfirstlane(tid >> 6); while (sc.step < 64) scan_tick(sc, se, sl_, sw_); }
    __syncthreads();
}
__device__ __forceinline__ float incl_prefix(float x, int lane) {
#pragma unroll
    for (int d = 1; d < 64; d <<= 1) { const float t = __shfl_up(x, d); if (lane >= d) x += t; }
    return x;
}
__device__ __forceinline__ float incl_suffix(float x, int lane) {
#pragma unroll
    for (int d = 1; d < 64; d <<= 1) { const float t = __shfl_down(x, d); if (lane + d < 64) x += t; }
    return x;
}
__device__ __forceinline__ void gate_factors(const Args& a, int G, int vcu) {
    const int tid = threadIdx.x, lane = tid & 63, wave = __builtin_amdgcn_readfirstlane(tid >> 6);
    const int gw = vcu * NWAVES + wave, NGW = G * NWAVES;
    const float* gates = (const float*)(a.ws + WS_GATES); float* gf = (float*)(a.ws + WS_GF); float* dec = (float*)(a.ws + WS_DEC);
    for (int task = gw; task < NB * NHEAD * 64; task += NGW) {
        const int b = task >> 8, hh = (task >> 6) & 3, j = task & 63; const size_t row = (size_t)b * SEQ + j * 64 + lane;
        const float* gp = gates + row * 16 + hh;
        const float i_f = gp[0], a_f = gp[4], i_b = gp[8], a_b = gp[12];
        const float F = incl_prefix(a_f, lane), Gs = incl_suffix(a_b, lane);
        *(f32x4*)(gf + row * 16 + hh * 4) = (f32x4){expf(F), expf(i_f - F), expf(Gs), expf(i_b - Gs)};
        if (lane == 63) dec[(size_t)task * 2] = expf(F);
        if (lane == 0) dec[(size_t)task * 2 + 1] = expf(Gs);
    }
}
__device__ __forceinline__ void mlstm_scan(const Args& a, LAS unsigned char* lds, int G, int vcu) {
    int tid = threadIdx.x; asm volatile("" : "+v"(tid));
    const int lane = tid & 63, wave = __builtin_amdgcn_readfirstlane(tid >> 6), l31 = lane & 31, h = lane >> 5;
    const int gw = wave * G + vcu, NGW = G * NWAVES;
    LAS float* wsc = (LAS float*)(lds + wave * 1024);
    const bf16* KFp = (const bf16*)(a.ws + WS_KF); const bf16* VFp = (const bf16*)(a.ws + WS_VF);
    const float* gf = (const float*)(a.ws + WS_GF); const float* dec = (const float*)(a.ws + WS_DEC); bf16* ST = (bf16*)(a.ws + WS_STATES); bf16* NV = (bf16*)(a.ws + WS_STATES + 128 * MiB);
    for (int cd = vcu; cd < 64 * 4; cd += G) { if (wave >= 5) break;
        const int chain = cd >> 2, dt = cd & 3, nt = wave;
        const int b = chain >> 3, hh = (chain >> 1) & 3, dir = chain & 1;
        f32x16 acc;
#pragma unroll
        for (int r = 0; r < 16; ++r) acc[r] = 0.f;
        const rsrc_t rva = mkrsrc(VFp + (size_t)((b * 4 + hh) * 64) * 8192, 64 * 16384), rkb = mkrsrc(KFp + (size_t)((b * 4 + hh) * 64) * 8192, 64 * 16384);
        const rsrc_t rgf = mkrsrc(gf + (size_t)b * SEQ * 16, SEQ * 64);
        const unsigned vo = lane * 16 + (nt < 4 ? nt : 0) * 4096, ko = lane * 16 + dt * 4096, go = lane * 64 + (hh * 4 + 2 * dir + 1) * 4;
        const float* dbase = dec + (size_t)((b * 4 + hh) * 64) * 2 + dir;
        const v4u ones = {0x3f803f80u, 0x3f803f80u, 0x3f803f80u, 0x3f803f80u}, zeros = {0u, 0u, 0u, 0u};
        struct Stg { v4u ar[4]; bf16x8 br[4]; float be, dc; };
#define SCAN_LOAD(S, jq) do { const int jc_ = (jq) < 0 ? 0 : ((jq) > 63 ? 63 : (jq)); const int j_ = dir ? 63 - jc_ : jc_; _Pragma("unroll") for (int ks = 0; ks < 4; ++ks) { \
            S.ar[ks] = bld128(rva, vo + ks * 1024, j_ * 16384); S.br[ks] = __builtin_bit_cast(bf16x8, bld128(rkb, ko + ks * 1024, j_ * 16384)); } S.be = bld_f32(rgf, go, j_ * 4096); S.dc = dbase[j_ * 2]; } while (0)
#define SCAN_STEP(S, jq) do { const int j_ = dir ? 63 - (jq) : (jq); \
            wsc[lane] = S.be; const float decay = S.dc; \
            if (nt < 4) { bf16* sp = ST + ((size_t)(chain * 64 + j_) * 32 + nt * 8 + 2 * dt + (l31 >> 4)) * 512 + (((l31 >> 3) & 1) * 32) * 8 + (l31 & 7); \
                _Pragma("unroll") for (int r = 0; r < 16; ++r) sp[crow(r, h) * 8] = (bf16)f2bf(acc[r]); } \
            else if (h == 0) NV[(size_t)(chain * 64 + j_) * 128 + 32 * dt + l31] = (bf16)f2bf(acc[0]);     \
            _Pragma("unroll") for (int ks = 0; ks < 4; ++ks) { v4u araw = S.ar[ks]; if (nt == 4) araw = (l31 == 0) ? ones : zeros; \
                const f32x4 b0 = *(const LAS f32x4*)(wsc + 16 * ks + 4 * h), b1 = *(const LAS f32x4*)(wsc + 16 * ks + 8 + 4 * h); \
                acc = MFMA32(scale_frag8(araw, b0, b1), S.br[ks], acc); } \
            _Pragma("unroll") for (int r = 0; r < 16; ++r) acc[r] *= decay; } while (0)
        Stg s0, s1, s2;
        SCAN_LOAD(s0, 0); SCAN_LOAD(s1, 1);
#pragma nounroll
        for (int jj = 0; jj < 63; jj += 3) {
            SCAN_LOAD(s2, jj + 2); SCAN_STEP(s0, jj);
            SCAN_LOAD(s0, jj + 3); SCAN_STEP(s1, jj + 1);
            SCAN_LOAD(s1, jj + 4); SCAN_STEP(s2, jj + 2);
        }
        SCAN_STEP(s0, 63);
#undef SCAN_LOAD
#undef SCAN_STEP
    }
}
constexpr int ML_WAVE_LDS = 18432, ML_YROW = 136;
__device__ __forceinline__ void mlstm_out(const Args& a, LAS unsigned char* lds, int G, int vcu) {
    int tid = threadIdx.x; asm volatile("" : "+v"(tid));
    const int lane = tid & 63, wave = __builtin_amdgcn_readfirstlane(tid >> 6), l31 = lane & 31, h = lane >> 5;
    const int gw = vcu * NWAVES + wave, NGW = G * NWAVES;
    LAS float* sc = (LAS float*)(lds + wave * ML_WAVE_LDS);
    LAS bf16* ybuf = (LAS bf16*)(lds + wave * ML_WAVE_LDS + 1024); LAS float* rsb = (LAS float*)(lds + wave * ML_WAVE_LDS + 1024 + 32 * ML_YROW * 2);
    LAS float* ivb = rsb + 32;
    LAS v4u* pfl = (LAS v4u*)(lds + wave * ML_WAVE_LDS + 10240) + lane;
    const unsigned char* QFp = a.ws + WS_QF; const unsigned char* KAp = a.ws + WS_KA; const unsigned char* VFp = a.ws + WS_VF;
    const bf16* om = (const bf16*)(a.ws + WS_PROJ) + 6 * PROJ_STRIDE; const float* gf = (const float*)(a.ws + WS_GF);
    const bf16* ST = (const bf16*)(a.ws + WS_STATES); const bf16* NV = (const bf16*)(a.ws + WS_STATES + 128 * MiB); bf16* mixed = (bf16*)(a.ws + WS_MIXED);
    const unsigned lo = lane * 16;
    for (int t4 = vcu * NWAVES; t4 < NB * NHEAD * 64; t4 += NGW)
    for (int rr = 0; rr < 2; ++rr) {
        const int task = t4 + rr * 4 + (wave & 3);
        const int b = task >> 8, hh = (task >> 6) & 3, j = task & 63, t0 = j * 64, row0 = b * SEQ + t0;
        { const f32x4 g4 = *(const f32x4*)(gf + (size_t)(row0 + lane) * 16 + hh * 4);
          sc[lane] = g4[0]; sc[64 + lane] = g4[1]; sc[128 + lane] = g4[2]; sc[192 + lane] = g4[3]; }
        const size_t fo = (size_t)(((b * 4 + hh) * 64 + j)) * 16384;
        const rsrc_t rq = mkrsrc(QFp + fo, 16384), rk = mkrsrc(KAp + fo, 16384), rv = mkrsrc(VFp + fo, 16384);
        const rsrc_t rs0 = mkrsrc(ST + ((size_t)(((b * 4 + hh) * 2 + 0) * 64 + j) * 32) * 512, 32768), rs1 = mkrsrc(ST + ((size_t)(((b * 4 + hh) * 2 + 1) * 64 + j) * 32) * 512, 32768);
        const rsrc_t rn0 = mkrsrc(NV + (size_t)(((b * 4 + hh) * 2 + 0) * 64 + j) * 128, 256), rn1 = mkrsrc(NV + (size_t)(((b * 4 + hh) * 2 + 1) * 64 + j) * 128, 256);
        const unsigned lon = (l31 == 0) ? (unsigned)(16 * h) : 0x40000000u;
        const rsrc_t ro = mkrsrc(om + (size_t)row0 * 512 + hh * 128, 64 * 1024), rm = mkrsrc(mixed + (size_t)row0 * DM + 512 + hh * 128, 64 * 2048);
        {
            const int ti = wave >> 2;
            const int t = 32 * ti + l31;
            v4u qf[8];
#pragma unroll
            for (int ks = 0; ks < 8; ++ks) qf[ks] = bld128(rq, lo, ti * 8192 + 1024 * ks);
            {
                f32x16 X[2];
#pragma unroll
                for (int r = 0; r < 16; ++r) { X[0][r] = 0.f; X[1][r] = 0.f; }
                v4u xa[8], xb[8];
#pragma unroll
                for (int ks = 0; ks < 8; ++ks) { xa[ks] = bld128(rk, lo, 1024 * ks); xb[ks] = bld128(rk, lo, 8192 + 1024 * ks); }
#pragma unroll
                for (int ks = 0; ks < 8; ++ks) { const bf16x8 Bq = __builtin_bit_cast(bf16x8, qf[ks]);
                    X[0] = MFMA32(__builtin_bit_cast(bf16x8, xa[ks]), Bq, X[0]); X[1] = MFMA32(__builtin_bit_cast(bf16x8, xb[ks]), Bq, X[1]); }
                asm volatile("" ::: "memory");
#pragma unroll
                for (int si = 0; si < 2; ++si)
#pragma unroll
                    for (int ss = 0; ss < 2; ++ss) {
                        v4u pf, pb;
#pragma unroll
                        for (int e = 0; e < 4; ++e) { float f2[2], b2[2];
#pragma unroll
                            for (int q2 = 0; q2 < 2; ++q2) { const int r = 8 * ss + 2 * e + q2, s = 32 * si + crow(r, h);
                                const float x = X[si][r], bef = sc[64 + s], beb = sc[192 + s];
                                const float vf = x * bef, vb = x * beb;
                                f2[q2] = (s <= t) ? vf : 0.f; b2[q2] = (s >= t) ? vb : 0.f; }
                            pf[e] = cvtpk(f2[0], f2[1]); pb[e] = cvtpk(b2[0], b2[1]); }
                        pfl[(si * 2 + ss) * 64] = pf; pfl[(4 + si * 2 + ss) * 64] = pb;
                    }
            }
            v4u F[8];
#define ML_COMP(D, RN, VO, SB, SS) do { \
        _Pragma("unroll") for (int ks = 0; ks < 8; ++ks) { D = MFMA32(__builtin_bit_cast(bf16x8, qf[ks]), __builtin_bit_cast(bf16x8, F[ks]), D); F[ks] = bld128(RN, VO, (SB) + (SS) * ks); asm volatile("" ::: "memory"); } } while (0)
#define ML_PV(vf_) do { _Pragma("unroll") for (int r = 0; r < 16; ++r) { df[r] = 0.f; db[r] = 0.f; } \
        _Pragma("unroll") for (int si = 0; si < 2; ++si) _Pragma("unroll") for (int ss = 0; ss < 2; ++ss) { const bf16x8 B_ = __builtin_bit_cast(bf16x8, vf_[si * 2 + ss]); \
            if (si <= ti) df = MFMA32(__builtin_bit_cast(bf16x8, pfl[(si * 2 + ss) * 64]), B_, df); if (si >= ti) db = MFMA32(__builtin_bit_cast(bf16x8, pfl[(4 + si * 2 + ss) * 64]), B_, db); } } while (0)
#pragma unroll
            for (int ks = 0; ks < 8; ++ks) F[ks] = bld128(rn0, lon, 32 * ks);
            asm volatile("" ::: "memory");
            {
                f32x16 df, db; v4u vfr[4];
#pragma unroll
                for (int q4 = 0; q4 < 4; ++q4) { const unsigned w1 = (l31 == 0) ? 0x3f803f80u : 0u; vfr[q4] = (v4u){w1, w1, w1, w1}; }
                ML_PV(vfr);
                ML_COMP(df, rn1, lon, 0, 32);
                ML_COMP(db, rs0, lo, 0, 1024);
#pragma unroll
                for (int r = 0; r < 16; ++r) {
                    if (l31 == 0) { const int tl = crow(r, h); const float af = sc[32 * ti + tl], ab = sc[128 + 32 * ti + tl];
                        ivb[tl] = af * __builtin_amdgcn_rcpf(fmaxf(af * fabsf(df[r]), 1.0f)); ivb[32 + tl] = ab * __builtin_amdgcn_rcpf(fmaxf(ab * fabsf(db[r]), 1.0f)); } }
            }
#pragma nounroll
            for (int nt = 0; nt < 4; ++nt) {
                const int n = 32 * nt + l31;
                f32x16 df, db;
                { v4u vfr[4];
#pragma unroll
                  for (int q4 = 0; q4 < 4; ++q4) vfr[q4] = bld128(rv, lo, nt * 4096 + q4 * 1024);
                  ML_PV(vfr); }
                ML_COMP(df, rs1, lo, nt * 8192, 1024);
                ML_COMP(db, rs0, lo, (nt < 3 ? nt + 1 : 3) * 8192, 1024);
#pragma unroll
                for (int r = 0; r < 16; ++r) { const int tl = crow(r, h);
                    const float hv = df[r] * ivb[tl] + db[r] * ivb[32 + tl];
                    ybuf[tl * ML_YROW + n] = (bf16)(cvtpk(hv, 0.f) & 0xffffu); }
            }
#undef ML_COMP
#undef ML_PV
            v4u og8[8];
#pragma unroll
            for (int i = 0; i < 8; ++i) { const int idx = lane + 64 * i, tl = idx >> 4, ch = idx & 15; og8[i] = bld128(ro, (unsigned)(32 * ti + tl) * 1024 + 16 * ch, 0); }
#pragma unroll
            for (int i = 0; i < 8; ++i) { const int idx = lane + 64 * i, tl = idx >> 4, ch = idx & 15;
                const v4u w = *(const LAS v4u*)(ybuf + tl * ML_YROW + 8 * ch); float y8[8]; float ss = 0.f;
#pragma unroll
                for (int e = 0; e < 4; ++e) { y8[2 * e] = __uint_as_float(w[e] << 16) * sigm(__uint_as_float(og8[i][e] << 16)); y8[2 * e + 1] = __uint_as_float(w[e] & 0xffff0000u) * sigm(__uint_as_float(og8[i][e] & 0xffff0000u));
                    ss += y8[2 * e] * y8[2 * e] + y8[2 * e + 1] * y8[2 * e + 1]; }
                ss += __shfl_xor(ss, 1); ss += __shfl_xor(ss, 2); ss += __shfl_xor(ss, 4); ss += __shfl_xor(ss, 8);
                const float rs = __builtin_amdgcn_rsqf(ss * (1.0f / 128.0f) + EPS);
                u32x4b o;
#pragma unroll
                for (int e = 0; e < 4; ++e) o[e] = cvtpk(y8[2 * e] * rs, y8[2 * e + 1] * rs);
                __builtin_amdgcn_raw_buffer_store_b128(o, rm, (unsigned)(32 * ti + tl) * 2048 + 16 * ch, 0, 0); }
        }
    }
}
constexpr int CV_WAVE_LDS = 8704;
__device__ __forceinline__ void conv_tiles(const Args& a, LAS unsigned char* lds, int G, int vcu, int nlight) {
    const int tid = threadIdx.x, lane = tid & 63, wave = __builtin_amdgcn_readfirstlane(tid >> 6);
    const int gw = vcu * NWAVES + wave, NGW = G * NWAVES;
    LAS unsigned char* raw = lds + wave * CV_WAVE_LDS;
    const bf16* proj = (const bf16*)(a.ws + WS_PROJ);
    const int g8 = lane >> 3, c8 = lane & 7;
    v4u nxt[9];
#define CV_FETCH(it_) do { const int buf_ = (it_) % 6, ct_ = ((it_) / 6) & 7, rt_ = (it_) / 48, b_ = rt_ >> 6, t0_ = (rt_ & 63) * 64; \
        const rsrc_t rs_ = mkrsrc(proj + (size_t)buf_ * PROJ_STRIDE + (size_t)b_ * SEQ * 512 + ct_ * 64, SEQ * 1024); \
        _Pragma("unroll") for (int i = 0; i < 9; ++i) { const int rr = g8 + 8 * i; nxt[i] = bld128(rs_, (unsigned)(t0_ - 1 + rr) * 1024u + c8 * 16, 0); } } while (0)

#ifndef CV_RL
#define CV_RL 9
#define CV_RH 13
#endif
    const int row_lo = (vcu < nlight) ? vcu * CV_RL : nlight * CV_RL + (vcu - nlight) * CV_RH, row_n = (G == 256) ? ((vcu < nlight) ? CV_RL : CV_RH) : 0;
    if (G != 256) {   }
    int item = (G == 256) ? row_lo * 8 + wave : gw; const int istep = (G == 256) ? 8 : NGW; const int iend = (G == 256) ? (row_lo + row_n) * 8 : 6 * 8 * 512;
    if (item < iend) CV_FETCH(item);
    for (; item < iend; item += istep) {
        const int buf = item % 6, ct = (item / 6) & 7, rt = item / 48, b = rt >> 6, t0 = (rt & 63) * 64;
#pragma unroll
        for (int i = 0; i < 9; ++i) { const int rr = g8 + 8 * i;
            if (rr < 66) *(LAS v4u*)(raw + rr * 128 + c8 * 16) = nxt[i]; }
        if (item + istep < iend) CV_FETCH(item + istep);
        LDS_WAIT();
        if (buf == 3 || buf == 4) {
            const float* cw = a.in[15] + (buf - 3) * 512 + ct * 64 + c8 * 8; const float* cb = a.in[16] + (buf - 3) * 512 + ct * 64 + c8 * 8;
            float w0[8], w1[8], w2[8], bb[8];
#pragma unroll
            for (int e = 0; e < 8; ++e) { w0[e] = cw[e]; w1[e] = cw[1024 + e]; w2[e] = cw[2048 + e]; bb[e] = cb[e]; }
            unsigned char* dst = a.ws + (buf == 3 ? WS_QF : WS_KA) + (size_t)(((b * 4 + (ct >> 1)) * 64 + (rt & 63))) * 16384 + (((ct & 1) * 4 + (c8 >> 1)) * 64 + (c8 & 1) * 32) * 16;
            const float sc = (buf == 3) ? 1.0f : 0.08838834764831845f;
#pragma unroll
            for (int i = 0; i < 8; ++i) { const int r = g8 + 8 * i;
                const v4u x0 = *(const LAS v4u*)(raw + r * 128 + c8 * 16), x1 = *(const LAS v4u*)(raw + (r + 1) * 128 + c8 * 16), x2 = *(const LAS v4u*)(raw + (r + 2) * 128 + c8 * 16);
                v4u o;
#pragma unroll
                for (int e = 0; e < 4; ++e) {
                    const float lo = bb[2 * e] + __uint_as_float(x0[e] << 16) * w0[2 * e] + __uint_as_float(x1[e] << 16) * w1[2 * e] + __uint_as_float(x2[e] << 16) * w2[2 * e];
                    const float hi = bb[2 * e + 1] + __uint_as_float(x0[e] & 0xffff0000u) * w0[2 * e + 1] + __uint_as_float(x1[e] & 0xffff0000u) * w1[2 * e + 1] + __uint_as_float(x2[e] & 0xffff0000u) * w2[2 * e + 1];
                    o[e] = cvtpk(silu(lo) * sc, silu(hi) * sc); }
                *(v4u*)(dst + ((r >> 5) * 8 * 64 + (r & 31)) * 16) = o; }
        }
        if (buf != 3) {
            const LAS bf16* col = (const LAS bf16*)raw + lane;
            float w0 = 0.f, w1 = 1.f, w2 = 0.f, bb = 0.f, sc = 1.f; unsigned char* dstf = nullptr;
            if (buf >= 3) { if (buf == 4) { const int ch = 512 + ct * 64 + lane; w0 = a.in[15][ch]; w1 = a.in[15][1024 + ch]; w2 = a.in[15][2048 + ch]; bb = a.in[16][ch]; sc = 0.08838834764831845f; }
                   const int dd = (ct & 1) * 64 + lane;
                   dstf = a.ws + (buf == 4 ? WS_KF : WS_VF) + (size_t)(((b * 4 + (ct >> 1)) * 64 + (rt & 63))) * 16384 + ((dd >> 5) * 4 * 64 + (dd & 31)) * 16; }
            if (buf < 3) {
                const int cs = lane >> 3, tg = lane & 7;
#pragma unroll
                for (int i = 0; i < 8; ++i) { const int cc = cs + 8 * i, ch = buf * 512 + ct * 64 + cc;
                    const float w0 = a.in[4][ch], w1 = a.in[4][1536 + ch], w2 = a.in[4][3072 + ch], bb = a.in[5][ch];
                    const LAS bf16* col = (const LAS bf16*)raw + cc;
                    float x[10];
#pragma unroll
                    for (int e = 0; e < 10; ++e) x[e] = bf2f(col[(8 * tg + e) * 64]);
                    v4u o;
#pragma unroll
                    for (int e = 0; e < 4; ++e) o[e] = cvtpk(bb + x[2 * e] * w0 + x[2 * e + 1] * w1 + x[2 * e + 2] * w2, bb + x[2 * e + 1] * w0 + x[2 * e + 2] * w1 + x[2 * e + 3] * w2);
                    *(v4u*)((bf16*)a.out + ((size_t)b * 1536 + ch) * SEQ + t0 + 8 * tg) = o; }
            } else {
#pragma unroll
            for (int tg = 0; tg < 8; ++tg) {
                float x[10];
#pragma unroll
                for (int e = 0; e < 10; ++e) x[e] = bf2f(col[(8 * tg + e) * 64]);
                float y[8];
#pragma unroll
                for (int e = 0; e < 8; ++e) { float v = bb + x[e] * w0 + x[e + 1] * w1 + x[e + 2] * w2; if (buf == 4) v = silu(v) * sc; y[e] = v; }
                {
                    unsigned char* pz = dstf + ((tg >> 1) * 64) * 16 + 8 * (tg & 1);
                    *(v2u*)(pz) = (v2u){cvtpk(y[0], y[1]), cvtpk(y[2], y[3])}; *(v2u*)(pz + 32 * 16) = (v2u){cvtpk(y[4], y[5]), cvtpk(y[6], y[7])}; }
            }
            }
        }
        LDS_WAIT();
    }
#undef CV_FETCH
}
__device__ __forceinline__ void hy_mix(const Args& a, int G, int vcu) {
    int tid = threadIdx.x; asm volatile("" : "+v"(tid));
    const int lane = tid & 63, wave = __builtin_amdgcn_readfirstlane(tid >> 6);
    const int gw = vcu * NWAVES + wave, NGW = G * NWAVES;
    const bf16* yT = (const bf16*)(a.ws + WS_YT); bf16* mixed = (bf16*)(a.ws + WS_MIXED);
    for (int item = gw; item < NB * 8 * 64; item += NGW) {
        const int tt = item & 63, g = (item >> 6) & 7, b = item >> 9, t0 = tt * 64;
        const rsrc_t ry = mkrsrc(yT + ((size_t)b * 512 + g * 64) * SEQ + t0, 64 * SEQ * 2);
        float v[64]; float ss = 0.f;
#pragma unroll
        for (int c = 0; c < 64; ++c) { v[c] = bld_bf16s(ry, lane * 2, c * (SEQ * 2)); ss += v[c] * v[c]; }
        const float rs = __builtin_amdgcn_rsqf(ss * (1.0f / 64.0f) + EPS);
        bf16* dst = mixed + (size_t)(b * SEQ + t0 + lane) * DM + g * 64;
#pragma unroll
        for (int i = 0; i < 8; ++i) { v4u o; o.x = cvtpk(v[8 * i] * rs, v[8 * i + 1] * rs); o.y = cvtpk(v[8 * i + 2] * rs, v[8 * i + 3] * rs);
            o.z = cvtpk(v[8 * i + 4] * rs, v[8 * i + 5] * rs); o.w = cvtpk(v[8 * i + 6] * rs, v[8 * i + 7] * rs); *(v4u*)(dst + 8 * i) = o; }
    }
}
typedef GAS unsigned gu32;
#define XB_TMO      128
#define XB_XCNT(j)  (256  + 64 * (j))
#define XB_XSUB(j)  (1280 + 64 * (j))
#define XB_XGEN(j)  (2304 + 64 * (j))
#define XB_TOP      3328
#define XB_TOPGEN   3392
#define XCD_BAR_WORDS 3456
#define XB_SPIN_CAP (1u << 18)

__device__ __forceinline__ unsigned xb_ld(unsigned* p)              { return __hip_atomic_load(p, __ATOMIC_RELAXED, __HIP_MEMORY_SCOPE_AGENT); }
__device__ __forceinline__ unsigned xb_add(unsigned* p, unsigned v) { return __hip_atomic_fetch_add(p, v, __ATOMIC_RELAXED, __HIP_MEMORY_SCOPE_AGENT); }
__device__ __forceinline__ unsigned xb_xcc_id() { return (unsigned)__builtin_amdgcn_s_getreg((3 << 11) | 20) & 0xFu; }
#define XB_SPIN(cond, bar) do { unsigned _sp = 0; while (cond) { __builtin_amdgcn_s_sleep(1); \
    if ((++_sp & 255u) == 0u) { if (xb_ld(&(bar)[XB_TMO])) break; if (_sp > XB_SPIN_CAP) { atomicAdd(&(bar)[XB_TMO], 1u); break; } } } } while (0)

struct XcdBarrier {
    unsigned* bar; unsigned x;
    volatile LAS unsigned* st;
};

__device__ __forceinline__ XcdBarrier xcd_barrier_post(unsigned* bar, volatile LAS unsigned* st) {
    XcdBarrier b; b.bar = bar; b.x = xb_xcc_id(); b.st = st;
    if (threadIdx.x == 0) (void)xb_add(&bar[XB_XCNT(b.x)], 1u);
    return b;
}
__device__ __forceinline__ void xcd_barrier_complete(unsigned* bar, unsigned x, unsigned& nloc, unsigned& nx) {
    const unsigned G = gridDim.x * gridDim.y * gridDim.z;
    unsigned sum, cnt, mine, sp = 0u;
    for (;;) {
        sum = 0u; cnt = 0u; mine = 0u;
#pragma unroll
        for (unsigned j = 0; j < 16; ++j) { const unsigned c = xb_ld(&bar[XB_XCNT(j)]); sum += c; cnt += (c > 0u) ? 1u : 0u; mine = (j == x) ? c : mine; }
        if (sum == G) break;
        __builtin_amdgcn_s_sleep(1);
        if ((++sp & 255u) == 0u) { if (xb_ld(&bar[XB_TMO])) break; if (sp > XB_SPIN_CAP) { atomicAdd(&bar[XB_TMO], 1u); break; } }
    }
    nloc = mine > 0u ? mine : 1u; nx = cnt > 0u ? cnt : 1u;
}

__device__ __forceinline__ void xcd_barrier(const XcdBarrier& b) {
    asm volatile("s_waitcnt vmcnt(0)" ::: "memory");
    __syncthreads();
    if (threadIdx.x == 0) {
        unsigned* bar = b.bar;
        __builtin_amdgcn_s_waitcnt(0);
        unsigned nloc = b.st[0], nx = b.st[1];
        if (nloc == 0u) { xcd_barrier_complete(bar, b.x, nloc, nx); b.st[0] = nloc; b.st[1] = nx; }
        const unsigned old = xb_add(&bar[XB_XSUB(b.x)], 1u);
        const unsigned gen = old / nloc;
        if (old + 1u == (gen + 1u) * nloc) {
            __builtin_amdgcn_fence(__ATOMIC_RELEASE, "agent");
            asm volatile("s_waitcnt vmcnt(0)" ::: "memory");
            const unsigned og = xb_add(&bar[XB_TOP], 1u);
            const unsigned tg = og / nx;
            if (og + 1u == (tg + 1u) * nx) xb_add(&bar[XB_TOPGEN], 1u);
            else XB_SPIN(xb_ld(&bar[XB_TOPGEN]) == tg, bar);
            __builtin_amdgcn_fence(__ATOMIC_ACQUIRE, "agent");
            xb_add(&bar[XB_XGEN(b.x)], 1u);
            asm volatile("s_waitcnt vmcnt(0)" ::: "memory");
        } else {
            XB_SPIN(xb_ld(&bar[XB_XGEN(b.x)]) == gen, bar);
            __builtin_amdgcn_fence(__ATOMIC_ACQUIRE, "agent");
            asm volatile("s_waitcnt vmcnt(0)" ::: "memory");
        }
    }
    __syncthreads();
}

#ifndef MK_ONE_LAUNCH
#define MK_ONE_LAUNCH 1
#endif
#ifndef PROBE_NULL
#define PROBE_NULL 0
#endif
struct EpiNull { static constexpr bool PERM = true, AFTER_DRAIN = false, ROWPRE = false;
    __device__ __forceinline__ void operator()(const pg8::f32x4 (&acc)[2][2][4][2], const pg8::Unit& u, int wr, int wc, int fr, int fq, const PG8_LAS float*) const {
#pragma unroll
        for (int i = 0; i < 32; ++i) asm volatile("" :: "v"(acc[i >> 4][(i >> 3) & 1][(i >> 1) & 3][i & 1])); } };
struct EpiFix { static constexpr bool PERM = true, AFTER_DRAIN = false, ROWPRE = false; pg8::bf16_t* O; int rb;
    __device__ __forceinline__ void operator()(const pg8::f32x4 (&acc)[2][2][4][2], const pg8::Unit& u, int wr, int wc, int fr, int fq, const PG8_LAS float*) const {
        const int row0 = rb * 256 + wr * 64 + fr, col0 = wc * 32 + 8 * fq;
#pragma unroll
        for (int ai = 0; ai < 2; ++ai)
#pragma unroll
            for (int m = 0; m < 4; ++m) { pg8::bf16_t* rowp = O + (size_t)(row0 + ai * 128 + m * 16) * 256 + col0;
#pragma unroll
                for (int bj = 0; bj < 2; ++bj) { pg8::f32x4 v0 = acc[ai][bj][m][0], v1 = acc[ai][bj][m][1];
#pragma unroll
                    for (int e = 0; e < 4; ++e) { const float a0 = fmaxf(v0[e], 0.f), a1 = fmaxf(v1[e], 0.f); v0[e] = a0 * a0; v1[e] = a1 * a1; }
                    pg8::u32x4 w; w.x = pg8::cvt_pk_bf16(v0[0], v0[1]); w.y = pg8::cvt_pk_bf16(v0[2], v0[3]); w.z = pg8::cvt_pk_bf16(v1[0], v1[1]); w.w = pg8::cvt_pk_bf16(v1[2], v1[3]);
                    *(pg8::u32x4*)(rowp + bj * 128) = w; } } } };
struct EpiLd { static constexpr bool PERM = true, AFTER_DRAIN = false, ROWPRE = false; const float* ssqp;
    __device__ __forceinline__ void operator()(const pg8::f32x4 (&acc)[2][2][4][2], const pg8::Unit& u, int wr, int wc, int fr, int fq, const PG8_LAS float*) const {
        const int row0 = u.pm * 256 + wr * 64 + fr;
#pragma unroll
        for (int ai = 0; ai < 2; ++ai)
#pragma unroll
            for (int m = 0; m < 4; ++m) { const int row = row0 + ai * 128 + m * 16; const pg8::f32x4* p = (const pg8::f32x4*)(ssqp + (size_t)row * 16); const pg8::f32x4 a = p[0], b = p[1], c = p[2], d = p[3];
                const float s = ((a[0] + a[1]) + (a[2] + a[3])) + ((b[0] + b[1]) + (b[2] + b[3])) + ((c[0] + c[1]) + (c[2] + c[3])) + ((d[0] + d[1]) + (d[2] + d[3]));
                const float sc = __builtin_amdgcn_rsqf(s * (1.0f / 1024.0f) + 1e-6f);
#pragma unroll
                for (int bj = 0; bj < 2; ++bj) { const pg8::f32x4 v0 = acc[ai][bj][m][0] * sc, v1 = acc[ai][bj][m][1] * sc; asm volatile("" :: "v"(v0), "v"(v1)); } } } };
constexpr int NPHASE = 14;
#define GEMM_CALL(EPI, MODE, g, S, E) pg8::gemm_phase<EPI, pg8::StaticOrder, true, true, MODE, gLDA, gLDB, gK>(ldsp, g, S, E)
__global__ void __launch_bounds__(NTHREADS, 2) mk_fwd(Args a) {
    extern __shared__ __attribute__((aligned(16))) unsigned char lds_raw[];
    LAS unsigned char* ldsp = (LAS unsigned char*)lds_raw;
    const int G = gridDim.x, bx = blockIdx.x;
    const int vcu = (G % 8 == 0) ? (bx % 8) * (G / 8) + bx / 8 : bx;
    unsigned char* ws = a.ws;
    typedef pg8::bf16_t pb;
#if MK_ONE_LAUNCH
    if (threadIdx.x < 64) ((LAS unsigned*)(ldsp + LDSCTL_OFF))[threadIdx.x] = 0u;
    __syncthreads();
    (void)xcd_barrier_post((unsigned*)(ws + WS_CTL) + 4096, (volatile LAS unsigned*)(ldsp + LDSCTL_OFF) + 8);
#define SEAM(k) do { if (a.ph_hi > 1000000) cg::this_grid().sync();   { XcdBarrier xb_; xb_.bar = (unsigned*)(a.ws + WS_CTL) + 4096; xb_.x = xb_xcc_id(); xb_.st = (volatile LAS unsigned*)(ldsp + LDSCTL_OFF) + 8; xcd_barrier(xb_); } } while (0)
#else
#define SEAM(k) do {} while (0)
#endif
    const int lo = a.ph_lo, hi = a.ph_hi;
#define IN(k) (lo <= (k) && (k) < hi)
#ifndef ECHOB_SEL
#define ECHOB_SEL (-1)
#endif
#define PH_END(k) do { if (IN((k) + 1)) { unsigned long long eb0_ = 0; if (ECHOB_SEL == (k)) eb0_ = __builtin_amdgcn_s_memrealtime(); SEAM(k); \
    if (ECHOB_SEL == (k)) { const unsigned long long t1_ = __builtin_amdgcn_s_memrealtime(), d_ = t1_ - eb0_; while (__builtin_amdgcn_s_memrealtime() - t1_ < d_) __builtin_amdgcn_s_sleep(8); } } } while (0)
#ifndef PROBE_MASK
#define PROBE_MASK 0
#endif
#if (PROBE_MASK >> 0) & 1
#define REP0(...) { __VA_ARGS__ } __syncthreads(); { __VA_ARGS__ }
#else
#define REP0(...) { __VA_ARGS__ }
#endif
#if (PROBE_MASK >> 1) & 1
#define REP1(...) { __VA_ARGS__ } __syncthreads(); { __VA_ARGS__ }
#else
#define REP1(...) { __VA_ARGS__ }
#endif
#if (PROBE_MASK >> 2) & 1
#define REP2(...) { __VA_ARGS__ } __syncthreads(); { __VA_ARGS__ }
#else
#define REP2(...) { __VA_ARGS__ }
#endif
#if (PROBE_MASK >> 3) & 1
#define REP3(...) { __VA_ARGS__ } __syncthreads(); { __VA_ARGS__ }
#else
#define REP3(...) { __VA_ARGS__ }
#endif
#if (PROBE_MASK >> 4) & 1
#define REP4(...) { __VA_ARGS__ } __syncthreads(); { __VA_ARGS__ }
#else
#define REP4(...) { __VA_ARGS__ }
#endif
#if (PROBE_MASK >> 5) & 1
#define REP5(...) { __VA_ARGS__ } __syncthreads(); { __VA_ARGS__ }
#else
#define REP5(...) { __VA_ARGS__ }
#endif
#if (PROBE_MASK >> 6) & 1
#define REP6(...) { __VA_ARGS__ } __syncthreads(); { __VA_ARGS__ }
#else
#define REP6(...) { __VA_ARGS__ }
#endif
#if (PROBE_MASK >> 7) & 1
#define REP7(...) { __VA_ARGS__ } __syncthreads(); { __VA_ARGS__ }
#else
#define REP7(...) { __VA_ARGS__ }
#endif
#if (PROBE_MASK >> 8) & 1
#define REP8(...) { __VA_ARGS__ } __syncthreads(); { __VA_ARGS__ }
#else
#define REP8(...) { __VA_ARGS__ }
#endif
#if (PROBE_MASK >> 9) & 1
#define REP9(...) { __VA_ARGS__ } __syncthreads(); { __VA_ARGS__ }
#else
#define REP9(...) { __VA_ARGS__ }
#endif
#if (PROBE_MASK >> 10) & 1
#define REP10(...) { __VA_ARGS__ } __syncthreads(); { __VA_ARGS__ }
#else
#define REP10(...) { __VA_ARGS__ }
#endif
#if (PROBE_MASK >> 11) & 1
#define REP11(...) { __VA_ARGS__ } __syncthreads(); { __VA_ARGS__ }
#else
#define REP11(...) { __VA_ARGS__ }
#endif
#if (PROBE_MASK >> 12) & 1
#define REP12(...) { __VA_ARGS__ } __syncthreads(); { __VA_ARGS__ }
#else
#define REP12(...) { __VA_ARGS__ }
#endif
    if (IN(0)) { REP0( p0_prologue(a, ldsp, G, vcu); __syncthreads(); ) PH_END(0); }
#if PROBE_NULL & 16
    if (IN(1)) { pg8::Gemm g{(const pb*)(ws + WS_XN), (const pb*)(ws + WS_WIN)}; constexpr int gLDA = DM, gLDB = DM, gK = DM; pg8::StaticOrder S; S.init(MTOK, NPROJ, G, bx); EpiNull E; GEMM_CALL(EpiNull, 0, g, S, E); __syncthreads(); }
#endif
    if (IN(1)) { REP1(
        { pg8::Gemm g{(const pb*)(ws + WS_XN), (const pb*)(ws + WS_WIN)}; constexpr int gLDA = DM, gLDB = DM, gK = DM; pg8::StaticOrder S; S.init(MTOK, NPROJ, G, bx);
          typedef pg8::EpiBf16S<1, 0> E_t; E_t E{(pb*)(ws + WS_PROJ), 512, 512, PROJ_STRIDE, (const float*)(ws + WS_SSQ), 1.0f}; GEMM_CALL(E_t, 0, g, S, E); }
        ) PH_END(1); }
    if (IN(2)) { REP2(
        if (G != 256 || vcu < 64) {
        { pg8::Gemm g{(const pb*)(ws + WS_MEMN), (const pb*)(ws + WS_WK)}; constexpr int gLDA = DM, gLDB = DM, gK = DM; pg8::StaticOrder S; if (G == 256) { S.init(MMEM, DM, 64, vcu); if (vcu >= 32) S.nwg = 0; } else S.init(MMEM, DM, G, bx);
          typedef pg8::EpiBf16S<0, 0> E_t; E_t E{(pb*)(ws + WS_KB), DM, 0, 0, nullptr, 1.0f}; GEMM_CALL(E_t, 0, g, S, E); }
        { pg8::Gemm g{(const pb*)(ws + WS_MEMN), (const pb*)(ws + WS_WV)}; constexpr int gLDA = DM, gLDB = DM, gK = DM; pg8::StaticOrder S; if (G == 256) { S.init(MMEM, DM, 64, vcu >= 32 ? vcu - 32 : 0); if (vcu < 32) S.nwg = 0; } else S.init(MMEM, DM, G, (bx + G / 2) % G);
          typedef pg8::EpiBf16S<0, 0> E_t; E_t E{(pb*)(ws + WS_VT), DM, 0, 0, nullptr, 1.0f}; GEMM_CALL(E_t, 0, g, S, E); }
        }
        { ECHO_BEGIN(11) gate_factors(a, G, vcu); ECHO_END(11) } { ECHO_BEGIN(12) filters_phase(a, ldsp, G, vcu); ECHO_END(12) } { ECHO_BEGIN(13) conv_tiles(a, ldsp, G, vcu, 64); ECHO_END(13) } ) PH_END(2); }
    if (IN(3)) { REP3(
        { pg8::Gemm g{(const pb*)(ws + WS_KB), (const pb*)(ws + WS_WQ)}; constexpr int gLDA = DM, gLDB = DM, gK = 256; pg8::StaticOrder S; S.init(8 * DM, DM, G / 2, vcu < G / 2 ? vcu : 0); if (vcu >= G / 2) S.nwg = 0;
          typedef pg8::EpiBf16S<0, 0> E_t; E_t E{(pb*)(ws + WS_MT), DM, 0, 0, nullptr, 1.0f}; GEMM_CALL(E_t, 4, g, S, E); }
        { pg8::Gemm g{(const pb*)(ws + WS_WO), (const pb*)(ws + WS_VT)}; constexpr int gLDA = DM, gLDB = DM, gK = 256; pg8::StaticOrder S; S.init(8 * DM, DM, G / 2, vcu >= G / 2 ? vcu - G / 2 : 0); if (vcu < G / 2) S.nwg = 0;
          typedef pg8::EpiBf16S<0, 0> E_t; E_t E{(pb*)(ws + WS_VWT), DM, 0, 0, nullptr, 1.0f}; GEMM_CALL(E_t, 5, g, S, E); }
        { ECHO_BEGIN(15) hyena_fft(a, ldsp, G, vcu); ECHO_END(15) } if (G != 256) mlstm_scan(a, ldsp, G, vcu); ) PH_END(3); }
    if (IN(4)) { REP4( { ECHO_BEGIN(16) mlstm_out(a, ldsp, G, vcu); ECHO_END(16) } { ECHO_BEGIN(17) hy_mix(a, G, vcu); ECHO_END(17) } ) PH_END(4); }
    if (IN(5)) { REP5( pg8::Gemm g{(const pb*)(ws + WS_MIXED), (const pb*)(ws + WS_WOUT)}; constexpr int gLDA = DM, gLDB = DM, gK = DM; pg8::StaticOrder S; S.init(MTOK, DM, G, bx);
          typedef pg8::EpiResid<true> E_t; E_t E{a.in[0], (pb*)(ws + WS_XN), (float*)(ws + WS_SSQ), DM}; GEMM_CALL(E_t, 0, g, S, E); ) PH_END(5); }
    if (IN(6)) { REP6( pg8::Gemm g{(const pb*)(ws + WS_XN), (const pb*)(ws + WS_MT)}; constexpr int gLDA = DM, gLDB = DM, gK = DM; pg8::StaticOrder S; S.init(MTOK, DM, G, bx);
          pg8::EpiSoftmax E{(pb*)(ws + WS_SP), DM, (LAS float*)(ldsp + LDSCTL_OFF + 1024), 0.0625f * 1.4426950408889634f, (const float*)(ws + WS_SSQ)}; GEMM_CALL(pg8::EpiSoftmax, 3, g, S, E); ) PH_END(9); }
    if (IN(10)) { pg8::Gemm g{(const pb*)(ws + WS_SP), (const pb*)(ws + WS_VWT)}; constexpr int gLDA = DM, gLDB = DM, gK = DM; pg8::StaticOrder S; S.init(MTOK, DM, G, bx);
          typedef pg8::EpiResid<false> E_t; E_t E{ws + WS_XN, (pb*)(ws + WS_XN), (float*)(ws + WS_SSQ), DM}; GEMM_CALL(E_t, 3, g, S, E); PH_END(10); }
#if PROBE_NULL & 1
    if (IN(11)) { pg8::Gemm g{(const pb*)(ws + WS_XN), (const pb*)(ws + WS_W1)}; constexpr int gLDA = DM, gLDB = DM, gK = DM; pg8::StaticOrder S; S.init(MTOK, DFF, G, bx); EpiNull E; GEMM_CALL(EpiNull, 0, g, S, E); __syncthreads(); }
#endif
#if PROBE_NULL & 4
    if (IN(11)) { pg8::Gemm g{(const pb*)(ws + WS_XN), (const pb*)(ws + WS_W1)}; constexpr int gLDA = DM, gLDB = DM, gK = DM; pg8::StaticOrder S; S.init(MTOK, DFF, G, bx); EpiFix E{(pb*)(ws + WS_YT), (bx >> 1) & 127}; GEMM_CALL(EpiFix, 0, g, S, E); __syncthreads(); }
#endif
#if PROBE_NULL & 8
    if (IN(11)) { pg8::Gemm g{(const pb*)(ws + WS_XN), (const pb*)(ws + WS_W1)}; constexpr int gLDA = DM, gLDB = DM, gK = DM; pg8::StaticOrder S; S.init(MTOK, DFF, G, bx); EpiLd E{(const float*)(ws + WS_SSQ)}; GEMM_CALL(EpiLd, 0, g, S, E); __syncthreads(); }
#endif
#if PROBE_NULL & 2
    if (IN(12)) { pg8::Gemm g{(const pb*)(ws + WS_HID), (const pb*)(ws + WS_W2)}; constexpr int gLDA = DFF, gLDB = DFF, gK = DFF; pg8::StaticOrder S; S.init(MTOK, DM, G, bx); EpiNull E; GEMM_CALL(EpiNull, 0, g, S, E); __syncthreads(); }
#endif
    if (IN(11)) { REP11( pg8::Gemm g{(const pb*)(ws + WS_XN), (const pb*)(ws + WS_W1)}; constexpr int gLDA = DM, gLDB = DM, gK = DM; pg8::StaticOrder S; S.init(MTOK, DFF, G, bx);
          typedef pg8::EpiBf16S<1, 1> E_t; E_t E{(pb*)(ws + WS_HID), DFF, 0, 0, (const float*)(ws + WS_SSQ), 1.0f}; GEMM_CALL(E_t, 0, g, S, E); ) PH_END(11); }
    if (IN(12)) { REP12( pg8::Gemm g{(const pb*)(ws + WS_HID), (const pb*)(ws + WS_W2)}; constexpr int gLDA = DFF, gLDB = DFF, gK = DFF; pg8::StaticOrder S; S.init(MTOK, DM, G, bx);
          typedef pg8::EpiResid<false> E_t; E_t E{ws + WS_XN, (pb*)(ws + WS_XN), (float*)(ws + WS_SSQ), DM}; GEMM_CALL(E_t, 0, g, S, E); ) PH_END(12); }
    if (IN(13)) { ECHO_BEGIN(18) final_norm(a, G, vcu); ECHO_END(18) }
}

extern "C" void kernel_launch(void* const* d_in, const int* in_sizes, int n_in, void* d_out, int out_size, void* d_ws, size_t ws_size, hipStream_t stream) {
    static int grid = 0;
    if (grid == 0) {
        if (n_in != 30 || in_sizes[0] != MTOK * DM || out_size != MTOK * DM || ws_size < WS_END) {
            fprintf(stderr, "kernel_launch: unexpected shapes (n_in %d, in0 %d, out %d, ws %zu); nothing launched\n", n_in, n_in > 0 ? in_sizes[0] : -1, out_size, ws_size); grid = -1; return; }
        int dev = 0, cus = 0, per_cu = 0;
        if (hipGetDevice(&dev) != hipSuccess || hipDeviceGetAttribute(&cus, hipDeviceAttributeMultiprocessorCount, dev) != hipSuccess) { grid = -1; return; }
        if (hipFuncSetAttribute((const void*)mk_fwd, hipFuncAttributeMaxDynamicSharedMemorySize, LDS_BYTES) != hipSuccess) { fprintf(stderr, "kernel_launch: hipFuncSetAttribute failed\n"); grid = -1; return; }
        if (hipOccupancyMaxActiveBlocksPerMultiprocessor(&per_cu, (const void*)mk_fwd, NTHREADS, LDS_BYTES) != hipSuccess || per_cu < 1) { fprintf(stderr, "kernel_launch: occupancy query says %d\n", per_cu); (void)hipGetLastError(); grid = -1; return; }
        grid = cus;
    }
    if (grid < 0) return;
    if (hipMemsetAsync((char*)d_ws + WS_CTL, 0, 65536, stream) != hipSuccess) { fprintf(stderr, "kernel_launch: hipMemsetAsync failed\n"); return; }
    Args a{};
    for (int i = 0; i < 30; ++i) a.in[i] = (const float*)d_in[i];
    a.out = (float*)d_out; a.ws = (unsigned char*)d_ws;
#if MK_ONE_LAUNCH
    a.ph_lo = 0; a.ph_hi = NPHASE;
    void* args[] = {&a};
    hipError_t e = hipLaunchCooperativeKernel((const void*)mk_fwd, dim3(grid), dim3(NTHREADS), args, LDS_BYTES, stream);
    if (e != hipSuccess) fprintf(stderr, "cooperative launch failed: %s (grid %d)\n", hipGetErrorString(e), grid);
#else
    for (int ph = 0; ph < NPHASE; ++ph) { a.ph_lo = ph; a.ph_hi = ph + 1; hipLaunchKernelGGL(mk_fwd, dim3(grid), dim3(NTHREADS), LDS_BYTES, stream, a); }
#endif
}
```
